# Optimizing an MI355X kernel written in HIP

```python
import jax
import jax.numpy as jnp
from jax import lax
import numpy as np

D_MODEL = 1024
BATCH = 8
SEQ = 2048
DEPTH = 4


HEAD_DIM = 64
D_MIX = D_MODEL
N_MIX_HEADS = D_MIX // HEAD_DIM
NSA_HEADS = 8
NSA_GROUPS = 2
NSA_HPG = NSA_HEADS // NSA_GROUPS
NSA_WIDTH = NSA_HEADS * HEAD_DIM
NSA_KV_WIDTH = NSA_GROUPS * HEAD_DIM
CMP_BLOCK = 32
CMP_STRIDE = 16
CMP_HIDDEN = 256
SEL_BLOCK = 64
SEL_TOPK = 16
SEL_LOCAL = 2
SEL_Q_BLOCK = 64
WINDOW = 512
WIN_Q_BLOCK = 128
FORCE_BONUS = 1.0e4
LRU_BLOCKS = 4
LRU_WIDTH = LRU_BLOCKS * HEAD_DIM
LRU_BW = LRU_WIDTH // LRU_BLOCKS
CONV_WIDTH = 4
LRU_C = 8.0
ML_HEADS = 4
ML_WIDTH = ML_HEADS * HEAD_DIM
ML_CHUNK = 64
D_FF = 2816
EPS = 1e-6
NEG = -1e30

IN_SPLITS = (NSA_WIDTH,
             NSA_KV_WIDTH, NSA_KV_WIDTH,
             NSA_KV_WIDTH, NSA_KV_WIDTH,
             NSA_KV_WIDTH, NSA_KV_WIDTH,
             NSA_HEADS * 3,
             LRU_WIDTH, LRU_WIDTH,
             ML_WIDTH, ML_WIDTH, ML_WIDTH,
             ML_HEADS, ML_HEADS,
             ML_WIDTH)
D_IN = sum(IN_SPLITS)
IN_SPLIT_POINTS = tuple(int(c) for c in np.cumsum(IN_SPLITS)[:-1])

kernel_name = 'hymba_nsa_rglru_mlstm_macaron'


def rms_norm(x, g):
    xf = x.astype(jnp.float32)
    y = xf * lax.rsqrt(jnp.mean(xf * xf, axis=-1, keepdims=True) + EPS)
    return (y * g.astype(jnp.float32)).astype(x.dtype)


def swiglu(x, w1, w3, w2):
    return (jax.nn.silu(x @ w1) * (x @ w3)) @ w2


def masked_softmax(s, mask):
    s = jnp.where(mask, s.astype(jnp.float32), NEG)
    p = jax.nn.softmax(s, axis=-1)
    return jnp.where(mask, p, 0.0)


def alibi_slopes(n_heads):
    return jnp.asarray(2.0 ** (-8.0 * np.arange(1, n_heads + 1) / n_heads), dtype=jnp.float32)


def compress_blocks(z, blk_idx, pos, w1, w2):
    B = z.shape[0]
    n_cmp = blk_idx.shape[0]
    blocks = jnp.transpose(z[:, blk_idx], (0, 1, 3, 2, 4)) + pos
    flat = blocks.reshape(B, n_cmp, NSA_GROUPS, CMP_BLOCK * HEAD_DIM)
    return jax.nn.silu(flat @ w1) @ w2


def nsa_mixer(q, k_cmp, v_cmp, k_slc, v_slc, k_win, v_win, gate_logits,
              pos_k, w1_k, w2_k, pos_v, w1_v, w2_v):
    B, S = q.shape[0], q.shape[1]
    G, R, dh = NSA_GROUPS, NSA_HPG, HEAD_DIM
    slopes = alibi_slopes(NSA_HEADS).reshape(G, R)
    qg = (q * dh ** -0.5).reshape(B, S, G, R, dh)
    t = jnp.arange(S)

    n_cmp = (S - CMP_BLOCK) // CMP_STRIDE + 1
    cmp_start = np.arange(n_cmp) * CMP_STRIDE
    cmp_end = cmp_start + CMP_BLOCK - 1
    blk_idx = cmp_start[:, None] + np.arange(CMP_BLOCK)[None, :]
    kc = compress_blocks(k_cmp, blk_idx, pos_k, w1_k, w2_k)
    vc = compress_blocks(v_cmp, blk_idx, pos_v, w1_v, w2_v)
    dist_c = t[:, None] - cmp_end[None, :]
    s_c = jnp.einsum('bsgrd,bngd->bgrsn', qg, kc) - slopes[:, :, None, None] * dist_c
    p_c = masked_softmax(s_c, dist_c >= 0)
    o_c = jnp.einsum('bgrsn,bngd->bsgrd', p_c.astype(vc.dtype), vc).reshape(B, S, NSA_HEADS, dh)

    n_slc = S // SEL_BLOCK
    n_sel = min(SEL_TOPK, n_slc)
    slc_start = np.arange(n_slc) * SEL_BLOCK
    overlap = ((cmp_start[:, None] <= slc_start[None, :] + SEL_BLOCK - 1)
               & (cmp_end[:, None] >= slc_start[None, :])).astype(np.float32)
    imp = jnp.einsum('bgrsn,nj->bgsj', p_c, jnp.asarray(overlap))
    cur = t // SEL_BLOCK
    j = jnp.arange(n_slc)
    valid = j[None, :] <= cur[:, None]
    forced = valid & ((j[None, :] == 0) | (j[None, :] > cur[:, None] - SEL_LOCAL))
    score = jnp.where(valid, imp + jnp.where(forced, FORCE_BONUS, 0.0), NEG)
    _, sel_idx = lax.top_k(score, n_sel)

    kb = jnp.transpose(k_slc.reshape(B, n_slc, SEL_BLOCK, G, dh), (0, 3, 1, 2, 4))
    vb = jnp.transpose(v_slc.reshape(B, n_slc, SEL_BLOCK, G, dh), (0, 3, 1, 2, 4))
    nqc = S // SEL_Q_BLOCK
    n_keys = n_sel * SEL_BLOCK
    q_ch = jnp.transpose(qg.reshape(B, nqc, SEL_Q_BLOCK, G, R, dh), (1, 0, 2, 3, 4, 5))
    i_ch = jnp.transpose(sel_idx.reshape(B, G, nqc, SEL_Q_BLOCK, n_sel), (2, 0, 1, 3, 4))
    t_ch = t.reshape(nqc, SEL_Q_BLOCK)
    gather = jax.vmap(jax.vmap(lambda blocks, ids: blocks[ids]))

    def sel_chunk(args):
        qc, ic, tc = args
        kg = gather(kb, ic).reshape(B, G, SEL_Q_BLOCK, n_keys, dh)
        vg = gather(vb, ic).reshape(B, G, SEL_Q_BLOCK, n_keys, dh)
        kpos = (ic[..., None] * SEL_BLOCK + jnp.arange(SEL_BLOCK)).reshape(B, G, SEL_Q_BLOCK, n_keys)
        dist = tc[None, None, :, None] - kpos
        s = jnp.einsum('bqgrd,bgqkd->bgrqk', qc, kg) - slopes[None, :, :, None, None] * dist[:, :, None]
        p = masked_softmax(s, (dist >= 0)[:, :, None])
        return jnp.einsum('bgrqk,bgqkd->bqgrd', p.astype(vg.dtype), vg)

    o_s = lax.map(sel_chunk, (q_ch, i_ch, t_ch))
    o_s = jnp.transpose(o_s, (1, 0, 2, 3, 4, 5)).reshape(B, S, NSA_HEADS, dh)

    nqb = S // WIN_Q_BLOCK
    span = WINDOW + WIN_Q_BLOCK
    win_idx = np.arange(nqb)[:, None] * WIN_Q_BLOCK + np.arange(span)[None, :]
    pad = ((0, 0), (WINDOW, 0), (0, 0), (0, 0))
    kw = jnp.pad(k_win, pad)[:, win_idx]
    vw = jnp.pad(v_win, pad)[:, win_idx]
    kpos_w = win_idx - WINDOW
    dist_w = t.reshape(nqb, WIN_Q_BLOCK)[:, :, None] - kpos_w[:, None, :]
    mask_w = (dist_w >= 0) & (dist_w < WINDOW) & (kpos_w[:, None, :] >= 0)
    qw = qg.reshape(B, nqb, WIN_Q_BLOCK, G, R, dh)
    s_w = jnp.einsum('bcqgrd,bckgd->bgrcqk', qw, kw) - slopes[:, :, None, None, None] * dist_w
    p_w = masked_softmax(s_w, mask_w)
    o_w = jnp.einsum('bgrcqk,bckgd->bcqgrd', p_w.astype(vw.dtype), vw).reshape(B, S, NSA_HEADS, dh)

    g = jax.nn.sigmoid(gate_logits.astype(jnp.float32)).astype(q.dtype)
    return g[..., 0:1] * o_c + g[..., 1:2] * o_s + g[..., 2:3] * o_w


def rglru_mixer(x, gate, conv_w, conv_b, w_a, b_a, w_x, b_x, lam):
    B, S, C = x.shape
    xp = jnp.pad(x, ((0, 0), (CONV_WIDTH - 1, 0), (0, 0)))
    xc = conv_b + xp[:, 0:S] * conv_w[0]
    for tap in range(1, CONV_WIDTH):
        xc = xc + xp[:, tap:tap + S] * conv_w[tap]
    xb = xc.reshape(B, S, LRU_BLOCKS, LRU_BW)
    r = jax.nn.sigmoid(jnp.einsum('bsnc,ncd->bsnd', xb, w_a) + b_a).reshape(B, S, C)
    i = jax.nn.sigmoid(jnp.einsum('bsnc,ncd->bsnd', xb, w_x) + b_x).reshape(B, S, C)
    log_a = -LRU_C * r.astype(jnp.float32) * jax.nn.softplus(-lam.astype(jnp.float32))
    a = jnp.exp(log_a)
    u = jnp.sqrt(-jnp.expm1(2.0 * log_a)) * (i * xc).astype(jnp.float32)

    def combine(left, right):
        a1, b1 = left
        a2, b2 = right
        return a1 * a2, a2 * b1 + b2

    _, h = lax.associative_scan(combine, (a, u), axis=1)
    return h.astype(x.dtype) * jax.nn.gelu(gate)


def mlstm_mixer(q, k, v, i_pre, f_pre, o_pre):
    B, S, NH, dh = q.shape
    L = ML_CHUNK
    NC = S // L
    f32 = jnp.float32

    def to_chunks(z):
        z = z.astype(f32).reshape((B, NC, L) + z.shape[2:])
        return jnp.moveaxis(z, 3, 1)

    qc = to_chunks(q)
    kc = to_chunks(k) * dh ** -0.5
    vc = to_chunks(v)
    ig = to_chunks(i_pre)
    lf = jax.nn.log_sigmoid(to_chunks(f_pre))
    a = jnp.cumsum(lf, axis=-1)
    A = a[..., -1]
    causal = np.tril(np.ones((L, L), dtype=bool))
    D = jnp.where(causal, a[..., :, None] - a[..., None, :] + ig[..., None, :], NEG)
    w_end = A[..., None] - a + ig

    def step(carry, xs):
        C, n, m = carry
        A_c, w_c, k_c, v_c = xs
        m_new = jnp.maximum(A_c + m, jnp.max(w_c, axis=-1))
        decay = jnp.exp(A_c + m - m_new)
        wk = jnp.exp(w_c - m_new[..., None])
        C_new = decay[..., None, None] * C + jnp.einsum('bhs,bhsd,bhse->bhde', wk, k_c, v_c)
        n_new = decay[..., None] * n + jnp.einsum('bhs,bhsd->bhd', wk, k_c)
        return (C_new, n_new, m_new), (C, n, m)

    init = (jnp.zeros((B, NH, dh, dh), f32), jnp.zeros((B, NH, dh), f32), jnp.zeros((B, NH), f32))
    xs = (jnp.moveaxis(A, 2, 0), jnp.moveaxis(w_end, 2, 0), jnp.moveaxis(kc, 2, 0), jnp.moveaxis(vc, 2, 0))
    _, (C_prev, n_prev, m_prev) = lax.scan(step, init, xs)
    C_prev = jnp.moveaxis(C_prev, 0, 2)
    n_prev = jnp.moveaxis(n_prev, 0, 2)
    m_prev = jnp.moveaxis(m_prev, 0, 2)

    m_inter = a + m_prev[..., None]
    m = jnp.maximum(m_inter, jnp.max(D, axis=-1))
    inter = jnp.exp(m_inter - m)
    W = jnp.exp(D - m[..., None]) * jnp.einsum('bhcjd,bhcsd->bhcjs', qc, kc)
    num = inter[..., None] * jnp.einsum('bhcjd,bhcde->bhcje', qc, C_prev) + jnp.einsum('bhcjs,bhcse->bhcje', W, vc)
    den = inter * jnp.einsum('bhcjd,bhcd->bhcj', qc, n_prev) + jnp.sum(W, axis=-1)
    h = num / jnp.maximum(jnp.abs(den), jnp.exp(-m))[..., None]
    h = jnp.moveaxis(h, 1, 3).reshape(B, S, NH * dh)
    return (jax.nn.sigmoid(o_pre.astype(f32)) * h).astype(q.dtype)


def setup_inputs(seed: int = 0) -> dict:
    key = jax.random.key(seed)
    ks = jax.random.split(key, 32)

    def nrm(i, shape, scale):
        return jax.random.normal(ks[i], shape, jnp.float32) * scale

    def gain(i, shape):
        return 1.0 + 0.01 * jax.random.normal(ks[i], shape, jnp.float32)

    a0 = jax.random.uniform(ks[19], (DEPTH, LRU_WIDTH), jnp.float32, minval=0.9, maxval=0.999)
    b_f = jnp.linspace(3.0, 6.0, ML_HEADS, dtype=jnp.float32)[None, :] + nrm(21, (DEPTH, ML_HEADS), 0.01)
    return {
        'x': nrm(0, (BATCH, SEQ, D_MODEL), 1.0),
        'ffn1_norm': gain(1, (DEPTH, D_MODEL)),
        'ffn1_w1': nrm(2, (DEPTH, D_MODEL, D_FF), D_MODEL ** -0.5),
        'ffn1_w3': nrm(3, (DEPTH, D_MODEL, D_FF), D_MODEL ** -0.5),
        'ffn1_w2': nrm(4, (DEPTH, D_FF, D_MODEL), D_FF ** -0.5),
        'mix_norm': gain(5, (DEPTH, D_MODEL)),
        'w_in': nrm(6, (DEPTH, D_MODEL, D_IN), D_MODEL ** -0.5),
        'nsa_cmp_pos_k': nrm(7, (DEPTH, CMP_BLOCK, HEAD_DIM), 0.1),
        'nsa_cmp_w1_k': nrm(8, (DEPTH, CMP_BLOCK * HEAD_DIM, CMP_HIDDEN), (CMP_BLOCK * HEAD_DIM) ** -0.5),
        'nsa_cmp_w2_k': nrm(9, (DEPTH, CMP_HIDDEN, HEAD_DIM), CMP_HIDDEN ** -0.5),
        'nsa_cmp_pos_v': nrm(10, (DEPTH, CMP_BLOCK, HEAD_DIM), 0.1),
        'nsa_cmp_w1_v': nrm(11, (DEPTH, CMP_BLOCK * HEAD_DIM, CMP_HIDDEN), (CMP_BLOCK * HEAD_DIM) ** -0.5),
        'nsa_cmp_w2_v': nrm(12, (DEPTH, CMP_HIDDEN, HEAD_DIM), CMP_HIDDEN ** -0.5),
        'lru_conv_w': nrm(13, (DEPTH, CONV_WIDTH, LRU_WIDTH), CONV_WIDTH ** -0.5),
        'lru_conv_b': nrm(14, (DEPTH, LRU_WIDTH), 0.02),
        'lru_w_a': nrm(15, (DEPTH, LRU_BLOCKS, LRU_BW, LRU_BW), LRU_BW ** -0.5),
        'lru_b_a': nrm(16, (DEPTH, LRU_BLOCKS, LRU_BW), 0.02),
        'lru_w_x': nrm(17, (DEPTH, LRU_BLOCKS, LRU_BW, LRU_BW), LRU_BW ** -0.5),
        'lru_b_x': nrm(18, (DEPTH, LRU_BLOCKS, LRU_BW), 0.02),
        'lru_lambda': jnp.log(a0) - jnp.log1p(-a0),
        'ml_b_i': nrm(20, (DEPTH, ML_HEADS), 0.02),
        'ml_b_f': b_f,
        'head_norm': gain(22, (DEPTH, N_MIX_HEADS, HEAD_DIM)),
        'w_out': nrm(23, (DEPTH, D_MIX, D_MODEL), D_MIX ** -0.5),
        'ffn2_norm': gain(24, (DEPTH, D_MODEL)),
        'ffn2_w1': nrm(25, (DEPTH, D_MODEL, D_FF), D_MODEL ** -0.5),
        'ffn2_w3': nrm(26, (DEPTH, D_MODEL, D_FF), D_MODEL ** -0.5),
        'ffn2_w2': nrm(27, (DEPTH, D_FF, D_MODEL), D_FF ** -0.5),
        'final_norm': gain(28, (D_MODEL,)),
    }


def reference(x, ffn1_norm, ffn1_w1, ffn1_w3, ffn1_w2, mix_norm, w_in,
              nsa_cmp_pos_k, nsa_cmp_w1_k, nsa_cmp_w2_k, nsa_cmp_pos_v, nsa_cmp_w1_v, nsa_cmp_w2_v,
              lru_conv_w, lru_conv_b, lru_w_a, lru_b_a, lru_w_x, lru_b_x, lru_lambda,
              ml_b_i, ml_b_f, head_norm, w_out, ffn2_norm, ffn2_w1, ffn2_w3, ffn2_w2, final_norm):
    B, S = x.shape[0], x.shape[1]
    h = x
    for l in range(DEPTH):
        h = h + 0.5 * swiglu(rms_norm(h, ffn1_norm[l]), ffn1_w1[l], ffn1_w3[l], ffn1_w2[l])

        u = rms_norm(h, mix_norm[l]) @ w_in[l]
        (q_n, kc_n, vc_n, ks_n, vs_n, kw_n, vw_n, g_n,
         x_r, g_r, q_m, k_m, v_m, i_m, f_m, o_m) = jnp.split(u, IN_SPLIT_POINTS, axis=-1)
        kv = lambda z: z.reshape(B, S, NSA_GROUPS, HEAD_DIM)
        o_nsa = nsa_mixer(q_n.reshape(B, S, NSA_HEADS, HEAD_DIM), kv(kc_n), kv(vc_n), kv(ks_n), kv(vs_n),
                          kv(kw_n), kv(vw_n), g_n.reshape(B, S, NSA_HEADS, 3),
                          nsa_cmp_pos_k[l], nsa_cmp_w1_k[l], nsa_cmp_w2_k[l],
                          nsa_cmp_pos_v[l], nsa_cmp_w1_v[l], nsa_cmp_w2_v[l])
        o_lru = rglru_mixer(x_r, g_r, lru_conv_w[l], lru_conv_b[l], lru_w_a[l], lru_b_a[l],
                            lru_w_x[l], lru_b_x[l], lru_lambda[l])
        mh = lambda z: z.reshape(B, S, ML_HEADS, HEAD_DIM)
        o_ml = mlstm_mixer(mh(q_m), mh(k_m), mh(v_m), i_m + ml_b_i[l], f_m + ml_b_f[l], o_m)
        heads = jnp.concatenate([o_nsa, o_lru.reshape(B, S, LRU_BLOCKS, HEAD_DIM),
                                 o_ml.reshape(B, S, ML_HEADS, HEAD_DIM)], axis=2)
        heads = rms_norm(heads, head_norm[l]).reshape(B, S, D_MIX)
        h = h + heads @ w_out[l]

        h = h + 0.5 * swiglu(rms_norm(h, ffn2_norm[l]), ffn2_w1[l], ffn2_w3[l], ffn2_w2[l])
    return rms_norm(h, final_norm)
```

```cpp
#include <hip/hip_runtime.h>
#include <hip/hip_cooperative_groups.h>
#include <cstdio>
namespace cg = cooperative_groups;

#define LAS __attribute__((address_space(3)))
typedef unsigned short bf16_t;
typedef short bf16x8 __attribute__((ext_vector_type(8)));
typedef float f32x4 __attribute__((ext_vector_type(4)));
typedef float f32x2 __attribute__((ext_vector_type(2)));
typedef unsigned u32x4 __attribute__((ext_vector_type(4)));
typedef unsigned u32x2 __attribute__((ext_vector_type(2)));

#ifndef ONE_LAUNCH
#define ONE_LAUNCH 1
#endif
#ifndef PHMASK
#define PHMASK 0xFFFF
#endif
#define PHEN(k) ((PHMASK >> (k)) & 1)
#ifndef REP_SUB
#define REP_SUB -1
#endif
#ifndef REP_CLASS
#define REP_CLASS 7
#endif

constexpr int T_ = 16384, SEQ = 2048, DM = 1024, DFF = 2816, NUP = 5632, NINP = 3072, UW = 2816, DIN = 2848;
constexpr float EPS = 1e-6f;
constexpr float NEGF = -1e30f;
constexpr int NTHREADS = 512;
constexpr int LDS_BYTES = 147456;

constexpr size_t SZ_W13T = (size_t)NUP * DM * 2, SZ_W2T = (size_t)DM * DFF * 2, SZ_WINT = (size_t)NINP * DM * 2, SZ_WOUTT = (size_t)DM * DM * 2, SZ_CW1T = (size_t)256 * 2048 * 2;
constexpr size_t LO_W13A = 0, LO_W2A = LO_W13A + SZ_W13T, LO_W13B = LO_W2A + SZ_W2T, LO_W2B = LO_W13B + SZ_W13T, LO_WIN = LO_W2B + SZ_W2T, LO_WOUT = LO_WIN + SZ_WINT,
                 LO_CW1K = LO_WOUT + SZ_WOUTT, LO_CW1V = LO_CW1K + SZ_CW1T, LAYER_W = LO_CW1V + SZ_CW1T;
constexpr size_t WS_W = 0;
constexpr size_t WS_HB = WS_W + 4 * LAYER_W;
constexpr size_t WS_U = WS_HB + (size_t)T_ * DM * 2;
constexpr size_t WS_HEADS = WS_U + (size_t)T_ * UW * 2;
constexpr size_t SZ_CMPIN = (size_t)16 * 2048 * 64 * 2 + 4096;
constexpr size_t WS_KCMP = WS_HEADS + (size_t)T_ * DM * 2;
constexpr size_t WS_VCMP = WS_KCMP + SZ_CMPIN;
constexpr size_t WS_HID = WS_VCMP + SZ_CMPIN;
constexpr size_t WS_KC = WS_HID + (size_t)4 * 2 * 2048 * 256 * 4;
constexpr size_t WS_GATES = WS_KC + (size_t)2 * 2048 * 64 * 2;
constexpr size_t WS_SSQ = WS_GATES + (size_t)T_ * 32 * 4;
constexpr size_t WS_CBIAS = WS_SSQ + (size_t)2 * T_ * 16 * 4;
constexpr size_t WS_LRUH = WS_CBIAS + 8192;
constexpr size_t WS_LRUA = WS_LRUH + (size_t)T_ * 256 * 4;
constexpr size_t WS_LRUC = WS_LRUA + (size_t)T_ * 256 * 4;
constexpr size_t WS_MLC = WS_LRUC + (size_t)8 * 32 * 256 * 4;
constexpr size_t WS_MLN = WS_MLC + (size_t)1024 * 4096 * 4;
constexpr size_t WS_MLMU = WS_MLN + (size_t)1024 * 64 * 4;
constexpr size_t WS_MLAT = WS_MLMU + 4096;
constexpr size_t WS_MLMP = WS_MLAT + 4096;
constexpr size_t WS_CBP = WS_MLMP + 4096;
constexpr size_t WS_LRUWT = WS_CBP + 262144;
constexpr size_t WS_BAR = WS_LRUWT + 262144;
constexpr size_t WS_END = WS_BAR + 16384;
static_assert(WS_END <= 425365632ull, "workspace too large");
static_assert(LAYER_W % 256 == 0 && WS_HB % 256 == 0 && WS_U % 256 == 0 && WS_KCMP % 256 == 0 && WS_VCMP % 256 == 0 && WS_HID % 256 == 0, "align");

struct Params {
    const float* in[29];
    float* out;
    unsigned char* ws;
    int ph_lo, ph_hi;
};
static_assert(sizeof(Params) == 256, "Params has padding");
#define GAS __attribute__((address_space(1)))
__device__ __forceinline__ unsigned char* ws_of(const Params& p) { unsigned long long w = (unsigned long long)p.ws; asm volatile("" : "+s"(w)); return (unsigned char*)(GAS unsigned char*)w; }
__device__ __forceinline__ float* out_of(const Params& p) { unsigned long long w = (unsigned long long)p.out; asm volatile("" : "+s"(w)); return (float*)(GAS float*)w; }
__device__ __forceinline__ const float* in_of(const Params& p, int i) { unsigned long long w = (unsigned long long)p.in[i]; asm volatile("" : "+s"(w)); return (const float*)(GAS const float*)w; }
__device__ __forceinline__ unsigned cvt_pk_bf16(float lo, float hi) { unsigned r; asm volatile("v_cvt_pk_bf16_f32 %0, %1, %2" : "=v"(r) : "v"(lo), "v"(hi)); return r; }
__device__ __forceinline__ bf16_t f2bf(float f) { return (bf16_t)(cvt_pk_bf16(f, 0.f) & 0xffffu); }
__device__ __forceinline__ float bf2f(bf16_t b) { return __uint_as_float(((unsigned)b) << 16); }
__device__ __forceinline__ float sigmoidf_(float x) { return 1.0f / (1.0f + __expf(-x)); }
__device__ __forceinline__ int opaque_tid() { int x = threadIdx.x; asm volatile("" : "+v"(x)); return x; }
__device__ __forceinline__ float row_rstd(const float* part, int row) {
    const f32x4 a = *(const f32x4*)(part + (size_t)row * 16), b = *(const f32x4*)(part + (size_t)row * 16 + 4), c = *(const f32x4*)(part + (size_t)row * 16 + 8), d = *(const f32x4*)(part + (size_t)row * 16 + 12);
    const float s = (((a[0] + a[1]) + (a[2] + a[3])) + ((b[0] + b[1]) + (b[2] + b[3]))) + (((c[0] + c[1]) + (c[2] + c[3])) + ((d[0] + d[1]) + (d[2] + d[3])));
    return rsqrtf(s * (1.0f / DM) + EPS);
}
__device__ __forceinline__ float fq_max(float x) {
    auto a = __builtin_amdgcn_permlane16_swap(__float_as_uint(x), __float_as_uint(x), false, false);
    const float m = fmaxf(__uint_as_float(a[0]), __uint_as_float(a[1]));
    auto b = __builtin_amdgcn_permlane32_swap(__float_as_uint(m), __float_as_uint(m), false, false);
    return fmaxf(__uint_as_float(b[0]), __uint_as_float(b[1]));
}
__device__ __forceinline__ float fq_sum(float x) {
    auto a = __builtin_amdgcn_permlane16_swap(__float_as_uint(x), __float_as_uint(x), false, false);
    const float m = __uint_as_float(a[0]) + __uint_as_float(a[1]);
    auto b = __builtin_amdgcn_permlane32_swap(__float_as_uint(m), __float_as_uint(m), false, false);
    return __uint_as_float(b[0]) + __uint_as_float(b[1]);
}
__device__ __forceinline__ float wave_sum(float v) {
#pragma unroll
    for (int o = 32; o >= 1; o >>= 1) v += __shfl_xor(v, o);
    return v;
}
__device__ __forceinline__ float wave_max(float v) {
#pragma unroll
    for (int o = 32; o >= 1; o >>= 1) v = fmaxf(v, __shfl_xor(v, o));
    return v;
}

namespace pg8 {
constexpr int BM = 256, BK = 64, HALF = 128, HTB = HALF * BK * 2, STAGE_BYTES = 8 * HTB, NXCD = 8, WGM = 8;
__device__ __forceinline__ int lds_byte(int r, int c) { const int st = (r >> 4) * 2 + (c >> 5), rr = r & 15, cc = c & 31, ob = rr * 64 + cc * 2; return st * 1024 + (ob ^ (((ob >> 9) & 1) << 5)); }
__device__ __forceinline__ void stage_rc(int b, int& R, int& C) { const int st = b / 1024, sb = b % 1024, swz = sb ^ (((sb >> 9) & 1) << 5); R = (st >> 1) * 16 + swz / 64; C = (st & 1) * 32 + (swz % 64) / 2; }

struct Unit { int pm, pn; };
struct Gemm { const bf16_t* A; const bf16_t* Bt; int M, N, K, lda, ldb; };

struct StaticOrder {
    int nM, nN, nwg, G, c;
    __device__ void init(int M, int N, int G_, int c_) { nM = M / BM; nN = N / BM; nwg = nM * nN; G = G_; c = c_; }
    __device__ bool next(int i, Unit& u) const {
        const long L = (long)i * G + c; if (L >= nwg) return false;
        int wgid = (int)L; { const int q = nwg / NXCD, r = nwg % NXCD, xcd = wgid % NXCD, off = wgid / NXCD; wgid = (xcd < r ? xcd * (q + 1) : r * (q + 1) + (xcd - r) * q) + off; }
        const int nig = WGM * nN, gid = wgid / nig, fm = gid * WGM, gsz = (nM - fm) < WGM ? (nM - fm) : WGM;
        u.pm = fm + ((wgid % nig) % gsz); u.pn = (wgid % nig) / gsz; return true;
    }
};
struct SingleUnit {
    int pm;
    __device__ bool next(int i, Unit& u) const { if (i != 0 || pm < 0) return false; u.pm = pm; u.pn = 0; return true; }
};

template <class Epi, class Sched>
__device__ __forceinline__ void gemm_phase(LAS unsigned char* lds, const Gemm g, const Sched& S, const Epi& E) {
    const int tid = opaque_tid(), wid = __builtin_amdgcn_readfirstlane(tid >> 6), lane = tid & 63, wr = wid >> 2, wc = wid & 3, fr = lane & 15, fq = lane >> 4;
    const int K = g.K, nt = K / BK;
    unsigned voffA[2], voffB[2];
#pragma unroll
    for (int i = 0; i < 2; ++i) { int R, C; stage_rc(tid * 16 + i * 8192, R, C);
        voffA[i] = (unsigned)(R * g.lda + C) * 2u; voffB[i] = (unsigned)(R * g.ldb + C) * 2u; }
    const size_t kstep = (size_t)(BK * 2);
    const size_t hstepA = (size_t)HALF * g.lda * 2, hstepB = (size_t)HALF * g.ldb * 2;
    const size_t tstepA = 2 * hstepA, tstepB = 2 * hstepB;
    const unsigned ldsw = (unsigned)wid * 1024u;
    const int aoff = lds_byte(wr * 64 + fr, fq * 8), boff = lds_byte(wc * 32 + fr, fq * 8);
#define PG8_SA(b, h) (((b) * 2 + (h)) * HTB)
#define PG8_SB(b, h) ((4 + (b) * 2 + (h)) * HTB)
#define PG8_STAGE(bufoff, gbase, voff) do { _Pragma("unroll") for (int _i = 0; _i < 2; ++_i) \
        __builtin_amdgcn_global_load_lds((const unsigned*)((const char*)(gbase) + (voff)[_i]), (LAS unsigned*)(lds + (bufoff) + ldsw + _i * 8192), 16, 0, 0); } while (0)
#define PG8_LDA(dst, b, h) do { _Pragma("unroll") for (int m = 0; m < 4; ++m) _Pragma("unroll") for (int k = 0; k < 2; ++k) dst[m][k] = *(const LAS bf16x8*)(lds + PG8_SA(b, h) + aoff + m * 2048 + k * 1024); } while (0)
#define PG8_LDB(dst, b, h) do { _Pragma("unroll") for (int n = 0; n < 2; ++n) _Pragma("unroll") for (int k = 0; k < 2; ++k) dst[n][k] = *(const LAS bf16x8*)(lds + PG8_SB(b, h) + boff + n * 2048 + k * 1024); } while (0)
#define PG8_MMA(ai, bj, At, Bt) do { __builtin_amdgcn_s_setprio(1); _Pragma("unroll") for (int m = 0; m < 4; ++m) _Pragma("unroll") for (int n = 0; n < 2; ++n) _Pragma("unroll") for (int k = 0; k < 2; ++k) \
        acc[ai][bj][m][n] = __builtin_amdgcn_mfma_f32_16x16x32_bf16(Bt[n][k], At[m][k], acc[ai][bj][m][n], 0, 0, 0); __builtin_amdgcn_s_setprio(0); } while (0)
#define PG8_WAIT_V(n) asm volatile("s_waitcnt vmcnt(" #n ")" ::: "memory")
#define PG8_WAIT_L(n) asm volatile("s_waitcnt lgkmcnt(" #n ")" ::: "memory")
#define PG8_BAR __builtin_amdgcn_s_barrier()
#define PG8_SCHED __builtin_amdgcn_sched_barrier(0)
    Unit cur, nxt; int ui = 0;
    if (!S.next(0, cur)) return;
    f32x4 acc[2][2][4][2];
#pragma unroll
    for (int a = 0; a < 2; ++a)
#pragma unroll
        for (int b = 0; b < 2; ++b)
#pragma unroll
            for (int m = 0; m < 4; ++m)
#pragma unroll
                for (int n = 0; n < 2; ++n) acc[a][b][m][n] = (f32x4){0.f, 0.f, 0.f, 0.f};
    bf16x8 At[4][2], B0[2][2], B1[2][2];
    const char* cA = (const char*)g.A + (size_t)cur.pm * tstepA; const char* cB = (const char*)g.Bt + (size_t)cur.pn * tstepB;
    PG8_STAGE(PG8_SB(0, 0), cB, voffB); PG8_STAGE(PG8_SA(0, 0), cA, voffA); PG8_STAGE(PG8_SB(0, 1), cB + hstepB, voffB); PG8_STAGE(PG8_SA(0, 1), cA + hstepA, voffA);
    if (wr == 1) PG8_BAR;
    PG8_WAIT_V(4); PG8_BAR;
    PG8_STAGE(PG8_SB(1, 0), cB + kstep, voffB); PG8_STAGE(PG8_SA(1, 0), cA + kstep, voffA); PG8_STAGE(PG8_SB(1, 1), cB + hstepB + kstep, voffB);
    PG8_WAIT_V(6); PG8_BAR;
    for (;;) {
        const bool has_next = S.next(ui + 1, nxt);
        const char* nA = has_next ? (const char*)g.A + (size_t)nxt.pm * tstepA : cA; const char* nB = has_next ? (const char*)g.Bt + (size_t)nxt.pn * tstepB : cB;
        for (int t = 0; t < nt; t += 2) {
            const bool last = (t == nt - 2);
            const char* a1 = cA + (size_t)(t + 1) * kstep;
            const char* a2 = last ? nA : cA + (size_t)(t + 2) * kstep; const char* b2 = last ? nB : cB + (size_t)(t + 2) * kstep;
            const char* a3 = a2 + kstep; const char* b3 = b2 + kstep;
            PG8_LDB(B0, 0, 0); PG8_SCHED; PG8_LDA(At, 0, 0); PG8_STAGE(PG8_SA(1, 1), a1 + hstepA, voffA);
            PG8_WAIT_L(8); PG8_BAR; PG8_WAIT_L(0); PG8_MMA(0, 0, At, B0); PG8_BAR; PG8_SCHED;
            PG8_LDB(B1, 0, 1); PG8_STAGE(PG8_SB(0, 0), b2, voffB);
            PG8_BAR; PG8_WAIT_L(0); PG8_MMA(0, 1, At, B1); PG8_BAR;
            PG8_LDA(At, 0, 1); PG8_STAGE(PG8_SA(0, 0), a2, voffA);
            PG8_BAR; PG8_WAIT_L(0); PG8_MMA(1, 0, At, B0); PG8_BAR; PG8_SCHED;
            PG8_STAGE(PG8_SB(0, 1), b2 + hstepB, voffB);
            PG8_WAIT_V(6); PG8_BAR; PG8_MMA(1, 1, At, B1); PG8_BAR;
            PG8_LDB(B0, 1, 0); PG8_SCHED; PG8_LDA(At, 1, 0); PG8_STAGE(PG8_SA(0, 1), a2 + hstepA, voffA);
            PG8_WAIT_L(8); PG8_BAR; PG8_WAIT_L(0); PG8_MMA(0, 0, At, B0); PG8_BAR; PG8_SCHED;
            PG8_LDB(B1, 1, 1); PG8_STAGE(PG8_SB(1, 0), b3, voffB);
            PG8_BAR; PG8_WAIT_L(0); PG8_MMA(0, 1, At, B1); PG8_BAR;
            PG8_LDA(At, 1, 1); PG8_STAGE(PG8_SA(1, 0), a3, voffA);
            PG8_BAR; PG8_WAIT_L(0); PG8_MMA(1, 0, At, B0); PG8_BAR; PG8_SCHED;
            PG8_STAGE(PG8_SB(1, 1), b3 + hstepB, voffB);
            PG8_WAIT_V(6); PG8_BAR; PG8_MMA(1, 1, At, B1); PG8_BAR;
        }
        E(acc, cur, wr, wc, fr, fq);
        if (!has_next) break;
#pragma unroll
        for (int a = 0; a < 2; ++a)
#pragma unroll
            for (int b = 0; b < 2; ++b)
#pragma unroll
                for (int m = 0; m < 4; ++m)
#pragma unroll
                    for (int n = 0; n < 2; ++n) acc[a][b][m][n] = (f32x4){0.f, 0.f, 0.f, 0.f};
        cur = nxt; cA = nA; cB = nB; ++ui;
    }
    PG8_WAIT_V(0);
    if (wr == 0) PG8_BAR;
    PG8_BAR;
#undef PG8_SA
#undef PG8_SB
#undef PG8_STAGE
#undef PG8_LDA
#undef PG8_LDB
#undef PG8_MMA
#undef PG8_WAIT_V
#undef PG8_WAIT_L
#undef PG8_BAR
#undef PG8_SCHED
}
}

typedef __attribute__((address_space(1))) float gf32;
typedef __attribute__((address_space(1))) const float gcf32;
typedef __attribute__((address_space(1))) bf16_t gbf16;
typedef __attribute__((address_space(1))) f32x4 gf32x4;
typedef __attribute__((address_space(1))) const f32x4 gcf32x4;
typedef __attribute__((address_space(1))) u32x2 gu32x2;
__device__ __forceinline__ void rows_rstd(const float* ssq, int row0, int fq, float (&r8)[2][4]) {
    f32x4 pv[2][4];
#pragma unroll
    for (int ai = 0; ai < 2; ++ai)
#pragma unroll
        for (int m = 0; m < 4; ++m) pv[ai][m] = *(gcf32x4*)(ssq + (size_t)(row0 + ai * 128 + m * 16) * 16 + 4 * fq);
#pragma unroll
    for (int ai = 0; ai < 2; ++ai)
#pragma unroll
        for (int m = 0; m < 4; ++m) {
            float sm = (pv[ai][m][0] + pv[ai][m][1]) + (pv[ai][m][2] + pv[ai][m][3]);
            sm = fq_sum(sm);
            r8[ai][m] = rsqrtf(sm * (1.0f / DM) + EPS);
        }
}
struct EpiSwiGLU {
    bf16_t* act; const float* ssq;
    __device__ __forceinline__ void operator()(const f32x4 (&acc)[2][2][4][2], const pg8::Unit& u, int wr, int wc, int fr, int fq) const {
        const int row0 = u.pm * 256 + wr * 64 + fr, col0 = u.pn * 128 + wc * 32 + 8 * fq;
        float r8[2][4];
        rows_rstd(ssq, row0, fq, r8);
#pragma unroll
        for (int ai = 0; ai < 2; ++ai)
#pragma unroll
            for (int m = 0; m < 4; ++m) {
                const int row = row0 + ai * 128 + m * 16;
                const float r = r8[ai][m];
                float o[8];
#pragma unroll
                for (int n = 0; n < 2; ++n) {
                    const f32x4 a1 = acc[ai][0][m][n] * r, a3 = acc[ai][1][m][n] * r;
#pragma unroll
                    for (int j = 0; j < 4; ++j) o[4 * n + j] = a1[j] * __builtin_amdgcn_rcpf(1.0f + __expf(-a1[j])) * a3[j];
                }
                u32x4 w; w.x = cvt_pk_bf16(o[0], o[1]); w.y = cvt_pk_bf16(o[2], o[3]); w.z = cvt_pk_bf16(o[4], o[5]); w.w = cvt_pk_bf16(o[6], o[7]);
                *(GAS u32x4*)(act + (size_t)row * DFF + col0) = w;
            }
    }
};
struct EpiResid {
    const float* resid; float* out; bf16_t* hb; float* ssq_next; float scale;
    __device__ __forceinline__ void load2(f32x4 (&rs)[2][2][2], int row0, int col0, int ai, int mp) const {
#pragma unroll
        for (int mm = 0; mm < 2; ++mm)
#pragma unroll
            for (int bj = 0; bj < 2; ++bj)
#pragma unroll
                for (int n = 0; n < 2; ++n)
                    rs[mm][bj][n] = *(gcf32x4*)(resid + (size_t)(row0 + ai * 128 + (2 * mp + mm) * 16) * DM + col0 + bj * 128 + n * 4);
    }
    __device__ __forceinline__ void operator()(const f32x4 (&acc)[2][2][4][2], const pg8::Unit& u, int wr, int wc, int fr, int fq) const {
        const int row0 = u.pm * 256 + wr * 64 + fr, col0 = u.pn * 256 + wc * 32 + 8 * fq;
        f32x4 rsA[2][2][2], rsB[2][2][2];
        load2(rsA, row0, col0, 0, 0);
#pragma unroll
        for (int bt = 0; bt < 4; ++bt) {
            const int ai = bt >> 1, mp = bt & 1;
            if (bt < 3) { if (bt & 1) load2(rsA, row0, col0, (bt + 1) >> 1, (bt + 1) & 1); else load2(rsB, row0, col0, (bt + 1) >> 1, (bt + 1) & 1); }
#pragma unroll
            for (int mm = 0; mm < 2; ++mm) {
                const int m = 2 * mp + mm, row = row0 + ai * 128 + m * 16;
                const size_t off = (size_t)row * DM + col0;
                float ss = 0.f;
#pragma unroll
                for (int bj = 0; bj < 2; ++bj) {
                    const f32x4 r0 = (bt & 1) ? rsB[mm][bj][0] : rsA[mm][bj][0], r1 = (bt & 1) ? rsB[mm][bj][1] : rsA[mm][bj][1];
                    const f32x4 v0 = r0 + acc[ai][bj][m][0] * scale, v1 = r1 + acc[ai][bj][m][1] * scale;
                    *(gf32x4*)(out + off + bj * 128) = v0;
                    *(gf32x4*)(out + off + bj * 128 + 4) = v1;
                    u32x4 w; w.x = cvt_pk_bf16(v0[0], v0[1]); w.y = cvt_pk_bf16(v0[2], v0[3]); w.z = cvt_pk_bf16(v1[0], v1[1]); w.w = cvt_pk_bf16(v1[2], v1[3]);
                    *(GAS u32x4*)(hb + off + bj * 128) = w;
                    ss += ((v0[0] * v0[0] + v0[1] * v0[1]) + (v0[2] * v0[2] + v0[3] * v0[3])) + ((v1[0] * v1[0] + v1[1] * v1[1]) + (v1[2] * v1[2] + v1[3] * v1[3]));
                }
                ss = fq_sum(ss);
                if (fq == 0) *(gf32*)(ssq_next + (size_t)row * 16 + u.pn * 4 + wc) = ss;
            }
            asm volatile("" ::: "memory");
        }
    }
};
struct EpiWin {
    bf16_t* U; bf16_t* kcmp; bf16_t* vcmp; float* gates; const float* ssq;
    __device__ __forceinline__ void operator()(const f32x4 (&acc)[2][2][4][2], const pg8::Unit& u, int wr, int wc, int fr, int fq) const {
        const int row0 = u.pm * 256 + wr * 64 + fr;
        float r8[2][4];
        rows_rstd(ssq, row0, fq, r8);
#pragma unroll
        for (int bj = 0; bj < 2; ++bj) {
            const int c0 = u.pn * 256 + bj * 128 + wc * 32;
            if (c0 >= 2848) continue;
            const float sc = (c0 < 512) ? 0.125f * 1.4426950408889634f : ((c0 >= 2048 && c0 < 2304) ? 0.125f : 1.0f);
            const int cl = 8 * fq;
#pragma unroll
            for (int ai = 0; ai < 2; ++ai)
#pragma unroll
                for (int m = 0; m < 4; ++m) {
                    const int row = row0 + ai * 128 + m * 16;
                    const float r = r8[ai][m] * sc;
                    const f32x4 v0 = acc[ai][bj][m][0] * r, v1 = acc[ai][bj][m][1] * r;
                    if (c0 == 2816) { *(gf32x4*)(gates + (size_t)row * 32 + cl) = v0; *(gf32x4*)(gates + (size_t)row * 32 + cl + 4) = v1; }
                    else {
                        u32x4 w; w.x = cvt_pk_bf16(v0[0], v0[1]); w.y = cvt_pk_bf16(v0[2], v0[3]); w.z = cvt_pk_bf16(v1[0], v1[1]); w.w = cvt_pk_bf16(v1[2], v1[3]);
                        if (c0 >= 512 && c0 < 768) {
                            const int cc = c0 - 512 + cl;
                            const int gg = (cc >> 6) & 1, d = cc & 63;
                            bf16_t* dst = (cc < 128 ? kcmp : vcmp) + ((size_t)(((row >> 11) * 2 + gg) * 2048 + (row & 2047))) * 64 + d;
                            *(GAS u32x4*)dst = w;
                        } else {
                            *(GAS u32x4*)(U + (size_t)row * UW + c0 + cl) = w;
                        }
                    }
                }
        }
    }
};
struct EpiCmp {
    float* part;
    __device__ __forceinline__ void operator()(const f32x4 (&acc)[2][2][4][2], const pg8::Unit& u, int wr, int wc, int fr, int fq) const {
        const int row0 = u.pm * 256 + wr * 64 + fr, col0 = wc * 32 + 8 * fq;
#pragma unroll
        for (int ai = 0; ai < 2; ++ai)
#pragma unroll
            for (int m = 0; m < 4; ++m) {
                const int row = row0 + ai * 128 + m * 16;
#pragma unroll
                for (int bj = 0; bj < 2; ++bj)
#pragma unroll
                    for (int n = 0; n < 2; ++n) *(gf32x4*)(part + (size_t)row * 256 + col0 + bj * 128 + n * 4) = acc[ai][bj][m][n];
            }
    }
};

__device__ __forceinline__ int winmap(int n) {
    if (n < 1280) return n;
    if (n < 2560) return n + 24;
    if (n < 2816) return n + 32;
    if (n < 2840) return 1280 + (n - 2816);
    if (n < 2844) return 2584 + (n - 2840);
    if (n < 2848) return 2588 + (n - 2844);
    return -1;
}
struct TrTile { const float* colp; const float* gain; bf16_t* dst; int ld, K, k0, n0; };
__device__ __forceinline__ void tr_decode(const Params& p, int idx, int tid, TrTile& t) {
    constexpr int TPL = 1376;
    const int l = idx / TPL; int r = idx % TPL;
    int m, ntile, ktile, K;
    if (r < 352) { m = 0; ntile = r % 22; ktile = r / 22; K = DM; }
    else if (r < 528) { r -= 352; m = 1; ntile = r % 4; ktile = r / 4; K = DFF; }
    else if (r < 880) { r -= 528; m = 2; ntile = r % 22; ktile = r / 22; K = DM; }
    else if (r < 1056) { r -= 880; m = 3; ntile = r % 4; ktile = r / 4; K = DFF; }
    else if (r < 1248) { r -= 1056; m = 4; ntile = r % 12; ktile = r / 12; K = DM; }
    else if (r < 1312) { r -= 1248; m = 5; ntile = r % 4; ktile = r / 4; K = DM; }
    else if (r < 1344) { r -= 1312; m = 6; ntile = 0; ktile = r; K = 2048; }
    else { r -= 1344; m = 7; ntile = 0; ktile = r; K = 2048; }
    t.K = K; t.k0 = ktile * 64; t.n0 = ntile * 256; t.colp = nullptr; t.gain = nullptr; t.ld = 0;
    const int npp = t.n0 + 4 * ((tid >> 3));
    const int np = (npp & ~31) + 8 * ((npp & 15) >> 2) + 4 * ((npp >> 4) & 1);
    unsigned char* wl = ws_of(p) + WS_W + (size_t)l * LAYER_W;
    if (m == 0 || m == 2) {
        const int pb = np >> 8, w = np & 255;
        const float* src = (w < 128) ? in_of(p, m == 0 ? 2 : 25) : in_of(p, m == 0 ? 3 : 26);
        t.colp = src + (size_t)l * DM * DFF + pb * 128 + (w & 127); t.ld = DFF; t.gain = in_of(p, m == 0 ? 1 : 24) + l * DM;
        t.dst = (bf16_t*)(wl + (m == 0 ? LO_W13A : LO_W13B));
    } else if (m == 1 || m == 3) {
        t.colp = in_of(p, m == 1 ? 4 : 27) + (size_t)l * DFF * DM + np; t.ld = DM;
        t.dst = (bf16_t*)(wl + (m == 1 ? LO_W2A : LO_W2B));
    } else if (m == 4) {
        const int sc = winmap(np);
        if (sc >= 0) t.colp = in_of(p, 6) + (size_t)l * DM * DIN + sc;
        t.ld = DIN; t.gain = in_of(p, 5) + l * DM;
        t.dst = (bf16_t*)(wl + LO_WIN);
    } else if (m == 5) {
        t.colp = in_of(p, 23) + (size_t)l * DM * DM + np; t.ld = DM;
        t.dst = (bf16_t*)(wl + LO_WOUT);
    } else {
        t.colp = in_of(p, m == 6 ? 8 : 11) + (size_t)l * 2048 * 256 + np; t.ld = 256;
        t.dst = (bf16_t*)(wl + (m == 6 ? LO_CW1K : LO_CW1V));
    }
}
__device__ __forceinline__ void tr_load(const TrTile& t, int tid, f32x4 (&v)[8]) {
    const int kc = (tid & 7);
#pragma unroll
    for (int e = 0; e < 8; ++e) {
        const int k = t.k0 + 8 * kc + e;
        f32x4 x = (f32x4){0.f, 0.f, 0.f, 0.f};
        if (t.colp) { x = *(const f32x4*)(t.colp + (size_t)k * t.ld); if (t.gain) x = x * t.gain[k]; }
        v[e] = x;
    }
}
__device__ void prologue(const Params& p, LAS unsigned char* lds, int bid, int G) {
    const int tid = opaque_tid();
    LAS float* tile = (LAS float*)lds;
    {
        constexpr int N_TR = 4 * 1376;
        int it = bid;
        TrTile t; f32x4 v[8];
        if (it < N_TR) { tr_decode(p, it, tid, t); tr_load(t, tid, v); }
        while (it < N_TR) {
            bf16_t* dst = t.dst + (size_t)(t.n0 + 4 * ((tid >> 3))) * t.K + t.k0 + 8 * ((tid & 7));
            const int K = t.K;
            u32x4 o[4];
#pragma unroll
            for (int q = 0; q < 4; ++q) { o[q].x = cvt_pk_bf16(v[0][q], v[1][q]); o[q].y = cvt_pk_bf16(v[2][q], v[3][q]); o[q].z = cvt_pk_bf16(v[4][q], v[5][q]); o[q].w = cvt_pk_bf16(v[6][q], v[7][q]); }
            const int nx = it + G;
            if (nx < N_TR) { tr_decode(p, nx, tid, t); tr_load(t, tid, v); }
#pragma unroll
            for (int q = 0; q < 4; ++q) *(u32x4*)(dst + (size_t)q * K) = o[q];
            it = nx;
        }
    }
    constexpr int N_BIAS = 256, N_XROW = T_ / 16, N_LW = 32;
    for (int it = bid; it < N_BIAS + N_XROW + N_LW; it += G) {
        if (it >= N_BIAS + N_XROW) {
            const int q = it - N_BIAS - N_XROW, ln = q >> 1, gate = q & 1;
            const float* W = in_of(p, gate ? 17 : 15) + (size_t)ln * 4096;
            bf16_t* WT = (bf16_t*)(ws_of(p) + WS_LRUWT) + (size_t)q * 4096;
#pragma unroll
            for (int rr = 0; rr < 8; ++rr) { const int idx = tid + rr * NTHREADS, d = idx >> 6, c = idx & 63; WT[idx] = f2bf(W[c * 64 + d]); }
        } else if (it < N_BIAS) {
            const int lkv = it >> 5, part = it & 31, l = lkv >> 1, kv = lkv & 1;
            const float* pos = in_of(p, kv ? 10 : 7) + (size_t)l * 2048;
            const float* w1 = in_of(p, kv ? 11 : 8) + (size_t)l * 2048 * 256;
            const int j = tid & 255, half = tid >> 8;
            float sacc = 0.f;
            const int kb = part * 64 + half * 32;
            for (int k = kb; k < kb + 32; k += 8) {
                float a[8];
#pragma unroll
                for (int q = 0; q < 8; ++q) a[q] = w1[(size_t)(k + q) * 256 + j];
#pragma unroll
                for (int q = 0; q < 8; ++q) sacc += pos[k + q] * a[q];
            }
            tile[tid] = sacc;
            __syncthreads();
            if (tid < 256) ((float*)(ws_of(p) + WS_CBP))[(size_t)it * 256 + tid] = tile[tid] + tile[tid + 256];
            __syncthreads();
        } else {
            const int row0 = (it - N_BIAS) * 16 + (tid >> 6) * 2, lane = tid & 63;
            f32x4 xv[2][4];
#pragma unroll
            for (int rq = 0; rq < 2; ++rq)
#pragma unroll
                for (int i = 0; i < 4; ++i) xv[rq][i] = *(const f32x4*)(in_of(p, 0) + (size_t)(row0 + rq) * DM + i * 256 + lane * 4);
#pragma unroll
            for (int rq = 0; rq < 2; ++rq) {
                const int row = row0 + rq;
                bf16_t* hb = (bf16_t*)(ws_of(p) + WS_HB) + (size_t)row * DM;
                float ss = 0.f;
#pragma unroll
                for (int i = 0; i < 4; ++i) {
                    const f32x4 v = xv[rq][i];
                    ss += (v[0] * v[0] + v[1] * v[1]) + (v[2] * v[2] + v[3] * v[3]);
                    u32x2 w; w.x = cvt_pk_bf16(v[0], v[1]); w.y = cvt_pk_bf16(v[2], v[3]);
                    *(u32x2*)(hb + i * 256 + lane * 4) = w;
                }
                ss = wave_sum(ss);
                if (lane < 16) ((float*)(ws_of(p) + WS_SSQ))[(size_t)row * 16 + lane] = (lane == 0) ? ss : 0.f;
            }
        }
    }
}

__device__ void lru_x_item(const Params& p, int l, int b, int n, int ck, LAS unsigned char* lds) {
    const int tid = opaque_tid(), lane = tid & 63, w = __builtin_amdgcn_readfirstlane(tid >> 6), fr = lane & 15, fq = lane >> 4;
    LAS float* xs = (LAS float*)lds;
    LAS float* xc = (LAS float*)(lds + 17152);
    LAS bf16_t* xb = (LAS bf16_t*)(lds + 33536);
    LAS bf16_t* wt = (LAS bf16_t*)(lds + 42752);
    LAS float* pre = (LAS float*)(lds + 61184);
    LAS float* segA = (LAS float*)(lds + 93952);
    LAS float* segH = segA + 512;
    const bf16_t* U = (const bf16_t*)(ws_of(p) + WS_U);
    const int t0 = ck * 64, rowbase = b * SEQ;
    {
        u32x4 xv[2];
#pragma unroll
        for (int rr = 0; rr < 2; ++rr) {
            const int idx = tid + rr * NTHREADS, tt = idx >> 3, ch = idx & 7, t = t0 - 3 + tt;
            xv[rr] = (u32x4){0u, 0u, 0u, 0u};
            if (idx < 67 * 8 && t >= 0) xv[rr] = *(const u32x4*)(U + (size_t)(rowbase + t) * UW + 1280 + n * 64 + ch * 8);
        }
#pragma unroll
        for (int rr = 0; rr < 2; ++rr) {
            const int idx = tid + rr * NTHREADS, tt = idx >> 3, ch = idx & 7;
            if (idx < 67 * 8) {
                f32x4 lo, hi;
                lo[0] = __uint_as_float(xv[rr][0] << 16); lo[1] = __uint_as_float(xv[rr][0] & 0xffff0000u); lo[2] = __uint_as_float(xv[rr][1] << 16); lo[3] = __uint_as_float(xv[rr][1] & 0xffff0000u);
                hi[0] = __uint_as_float(xv[rr][2] << 16); hi[1] = __uint_as_float(xv[rr][2] & 0xffff0000u); hi[2] = __uint_as_float(xv[rr][3] << 16); hi[3] = __uint_as_float(xv[rr][3] & 0xffff0000u);
                *(LAS f32x4*)(xs + tt * 64 + ch * 8) = lo; *(LAS f32x4*)(xs + tt * 64 + ch * 8 + 4) = hi;
            }
        }
    }
    {
        const bf16_t* WT = (const bf16_t*)(ws_of(p) + WS_LRUWT) + (size_t)((l * 4 + n) * 2) * 4096;
#pragma unroll
        for (int rr = 0; rr < 2; ++rr) {
            const int idx = tid + rr * NTHREADS, row = idx >> 3, ch = idx & 7;
            *(LAS u32x4*)(wt + row * 72 + ch * 8) = *(const u32x4*)(WT + row * 64 + ch * 8);
        }
    }
    __syncthreads();
    {
        const float* cw = in_of(p, 13) + (size_t)l * 4 * 256 + n * 64; const float* cb = in_of(p, 14) + l * 256 + n * 64;
        const int c = tid & 63;
        const float w0 = cw[c], w1 = cw[256 + c], w2 = cw[512 + c], w3 = cw[768 + c], bc = cb[c];
#pragma unroll
        for (int k = 0; k < 8; ++k) {
            const int t = (tid >> 6) + 8 * k;
            const float v = bc + xs[t * 64 + c] * w0 + xs[(t + 1) * 64 + c] * w1 + xs[(t + 2) * 64 + c] * w2 + xs[(t + 3) * 64 + c] * w3;
            xc[t * 64 + c] = v; xb[t * 72 + c] = f2bf(v);
        }
    }
    __syncthreads();
    {
        const int tt = w & 3, gate = w >> 2;
        bf16x8 xa[2];
#pragma unroll
        for (int ks = 0; ks < 2; ++ks) xa[ks] = *(const LAS bf16x8*)(xb + (16 * tt + fr) * 72 + 32 * ks + 8 * fq);
        const float* bias = in_of(p, gate ? 18 : 16) + (l * 4 + n) * 64;
#pragma unroll
        for (int dt = 0; dt < 4; ++dt) {
            f32x4 acc = (f32x4){0.f, 0.f, 0.f, 0.f};
#pragma unroll
            for (int ks = 0; ks < 2; ++ks) {
                const bf16x8 wb = *(const LAS bf16x8*)(wt + (gate * 64 + 16 * dt + fr) * 72 + 32 * ks + 8 * fq);
                acc = __builtin_amdgcn_mfma_f32_16x16x32_bf16(xa[ks], wb, acc, 0, 0, 0);
            }
            const float bv = bias[16 * dt + fr];
#pragma unroll
            for (int i = 0; i < 4; ++i) pre[(gate * 64 + 16 * tt + 4 * fq + i) * 64 + 16 * dt + fr] = acc[i] + bv;
        }
    }
    __syncthreads();
    const int d = tid & 63, tq = tid >> 6;
    const float lam = in_of(p, 19)[l * 256 + n * 64 + d];
    const float sp = log1pf(expf(-lam));
    float hl[8], cl[8];
    float h = 0.f, ca = 1.f;
#pragma unroll
    for (int i = 0; i < 8; ++i) {
        const float r = __builtin_amdgcn_rcpf(1.0f + __expf(-pre[(tq * 8 + i) * 64 + d])), ii = __builtin_amdgcn_rcpf(1.0f + __expf(-pre[(64 + tq * 8 + i) * 64 + d]));
        const float la = -8.0f * r * sp;
        const float a = __expf(la);
        const float uu = __builtin_amdgcn_sqrtf(fmaxf(1.0f - a * a, 0.f)) * (ii * xc[(tq * 8 + i) * 64 + d]);
        h = a * h + uu; ca *= a; hl[i] = h; cl[i] = ca;
    }
    segA[tq * 64 + d] = ca; segH[tq * 64 + d] = h;
    __syncthreads();
    float cin_h = 0.f, cin_a = 1.f;
    for (int sgi = 0; sgi < tq; ++sgi) { const float sa = segA[sgi * 64 + d]; cin_h = sa * cin_h + segH[sgi * 64 + d]; cin_a *= sa; }
    float* LH = (float*)(ws_of(p) + WS_LRUH); float* LA = (float*)(ws_of(p) + WS_LRUA);
#pragma unroll
    for (int i = 0; i < 8; ++i) {
        const size_t o = (size_t)(rowbase + t0 + tq * 8 + i) * 256 + n * 64 + d;
        LH[o] = hl[i] + cl[i] * cin_h; LA[o] = cl[i] * cin_a;
    }
    __syncthreads();
}

__device__ __forceinline__ float logsigmoidf_(float x) { return fminf(x, 0.f) - log1pf(expf(-fabsf(x))); }

__device__ __forceinline__ int vt_off(int d, int key, int pitch) {
    const int kc = key >> 3;
    return d * pitch + ((((kc ^ (d >> 3)) & 7) | (kc & ~7)) << 3) + (key & 7);
}
__device__ void ml_x_item(const Params& p, int l, int bh, int ck, LAS unsigned char* lds) {
    const int tid = opaque_tid(), lane = tid & 63, w = __builtin_amdgcn_readfirstlane(tid >> 6), fr = lane & 15, fq = lane >> 4;
    const int b = bh >> 2, hh = bh & 3;
    LAS bf16_t* KwT = (LAS bf16_t*)lds;
    LAS bf16_t* VT = (LAS bf16_t*)(lds + 9216);
    LAS float* wks = (LAS float*)(lds + 20736);
    const bf16_t* U = (const bf16_t*)(ws_of(p) + WS_U);
    const float* GT = (const float*)(ws_of(p) + WS_GATES);
    const int rowbase = b * SEQ + ck * 64;
    if (tid < 64) {
        const float ig = GT[(size_t)(rowbase + lane) * 32 + 24 + hh] + in_of(p, 20)[l * 4 + hh];
        const float fp = GT[(size_t)(rowbase + lane) * 32 + 28 + hh] + in_of(p, 21)[l * 4 + hh];
        float a = logsigmoidf_(fp);
#pragma unroll
        for (int o = 1; o < 64; o <<= 1) { const float t = __shfl_up(a, o); if (lane >= o) a += t; }
        const float A = __shfl(a, 63);
        const float wend = A - a + ig;
        const float mu = wave_max(wend);
        wks[lane] = expf(wend - mu);
        if (lane == 0) { ((float*)(ws_of(p) + WS_MLMU))[bh * 32 + ck] = mu; ((float*)(ws_of(p) + WS_MLAT))[bh * 32 + ck] = A; }
    }
    const int srow = tid >> 3, sch = tid & 7;
    const bf16_t* src = U + (size_t)(rowbase + srow) * UW + hh * 64 + sch * 8;
    const u32x4 kk = *(const u32x4*)(src + 2048);
    {
        const u32x4 vv = *(const u32x4*)(src + 2304);
#pragma unroll
        for (int e = 0; e < 4; ++e) {
            VT[vt_off(sch * 8 + 2 * e, srow, 72)] = (bf16_t)(vv[e] & 0xffffu);
            VT[vt_off(sch * 8 + 2 * e + 1, srow, 72)] = (bf16_t)(vv[e] >> 16);
        }
        for (int idx = tid; idx < 16 * 72; idx += NTHREADS) VT[64 * 72 + idx] = (idx < 72) ? (bf16_t)0x3f80 : (bf16_t)0;
    }
    __syncthreads();
    {
        const float wk = wks[srow];
#pragma unroll
        for (int e = 0; e < 4; ++e) {
            KwT[vt_off(sch * 8 + 2 * e, srow, 72)] = f2bf(wk * __uint_as_float(kk[e] << 16));
            KwT[vt_off(sch * 8 + 2 * e + 1, srow, 72)] = f2bf(wk * __uint_as_float(kk[e] & 0xffff0000u));
        }
    }
    __syncthreads();
    {
        const int dt = w & 3, hf = w >> 2;
        bf16x8 ka[2];
#pragma unroll
        for (int ks = 0; ks < 2; ++ks) ka[ks] = *(const LAS bf16x8*)(KwT + vt_off(16 * dt + fr, 32 * ks + 8 * fq, 72));
        float* C = (float*)(ws_of(p) + WS_MLC) + (size_t)(bh * 32 + ck) * 4096;
#pragma unroll
        for (int ee = 0; ee < 2; ++ee) {
            const int et = 2 * hf + ee;
            f32x4 acc = (f32x4){0.f, 0.f, 0.f, 0.f};
#pragma unroll
            for (int ks = 0; ks < 2; ++ks) {
                const bf16x8 vb = *(const LAS bf16x8*)(VT + vt_off(16 * et + fr, 32 * ks + 8 * fq, 72));
                acc = __builtin_amdgcn_mfma_f32_16x16x32_bf16(ka[ks], vb, acc, 0, 0, 0);
            }
#pragma unroll
            for (int i = 0; i < 4; ++i) C[(16 * dt + 4 * fq + i) * 64 + 16 * et + fr] = acc[i];
        }
        if (hf == 0) {
            f32x4 acc = (f32x4){0.f, 0.f, 0.f, 0.f};
#pragma unroll
            for (int ks = 0; ks < 2; ++ks) {
                const bf16x8 vb = *(const LAS bf16x8*)(VT + (64 + fr) * 72 + 32 * ks + 8 * fq);
                acc = __builtin_amdgcn_mfma_f32_16x16x32_bf16(ka[ks], vb, acc, 0, 0, 0);
            }
            if (fr == 0) {
#pragma unroll
                for (int i = 0; i < 4; ++i) ((float*)(ws_of(p) + WS_MLN))[(size_t)(bh * 32 + ck) * 64 + 16 * dt + 4 * fq + i] = acc[i];
            }
        }
    }
    __syncthreads();
}

__device__ void phase_m2(const Params& p, int l, int cls, LAS unsigned char* lds, int bid, int G) {
    const int tid = opaque_tid();
    constexpr int N_KC = 128, N_LC = 4, N_MC = 256, N_MN = 4, TOTAL = N_KC + N_LC + N_MC + N_MN;
    for (int it = bid; it < TOTAL; it += G) {
        if (it < N_KC) {
            if (!(cls & 1)) continue;
            const int kv = it >> 6, r0 = (it & 63) * 32;
            LAS float* hid = (LAS float*)lds;
            LAS float* w2s = hid + 32 * 256;
            const float* part = (const float*)(ws_of(p) + WS_HID) + (size_t)(kv * 2048 + r0) * 256;
            const float* cb = (const float*)(ws_of(p) + WS_CBIAS) + (l * 2 + kv) * 256;
            const float* w2 = in_of(p, kv ? 12 : 9) + (size_t)l * 256 * 64;
            f32x4 pr[4][4];
#pragma unroll
            for (int rr = 0; rr < 4; ++rr) {
                const int idx = tid + rr * NTHREADS, row = idx >> 6, j4 = (idx & 63) * 4;
#pragma unroll
                for (int kp = 0; kp < 4; ++kp) pr[rr][kp] = *(const f32x4*)(part + (size_t)kp * 2 * 2048 * 256 + row * 256 + j4);
            }
#pragma unroll
            for (int rr = 0; rr < 4; ++rr) {
                const int idx = tid + rr * NTHREADS, row = idx >> 6, j4 = (idx & 63) * 4;
                f32x4 hv = *(const f32x4*)(cb + j4);
#pragma unroll
                for (int kp = 0; kp < 4; ++kp) hv = hv + pr[rr][kp];
#pragma unroll
                for (int q = 0; q < 4; ++q) hv[q] = hv[q] * __builtin_amdgcn_rcpf(1.0f + __expf(-hv[q]));
                *(LAS f32x4*)(hid + row * 256 + j4) = hv;
            }
#pragma unroll
            for (int rr = 0; rr < 8; ++rr) { const int idx = tid + rr * NTHREADS; *(LAS f32x4*)(w2s + idx * 4) = *(const f32x4*)(w2 + idx * 4); }
            __syncthreads();
            {
                const int d = tid & 63, rq = tid >> 6;
                float acc[4] = {0.f, 0.f, 0.f, 0.f};
                for (int j = 0; j < 256; j += 4) {
                    float wv[4];
#pragma unroll
                    for (int q = 0; q < 4; ++q) wv[q] = w2s[(j + q) * 64 + d];
#pragma unroll
                    for (int i = 0; i < 4; ++i) {
                        const f32x4 hv = *(const LAS f32x4*)(hid + (rq * 4 + i) * 256 + j);
#pragma unroll
                        for (int q = 0; q < 4; ++q) acc[i] += hv[q] * wv[q];
                    }
                }
                bf16_t* KCo = (bf16_t*)(ws_of(p) + WS_KC);
#pragma unroll
                for (int i = 0; i < 4; ++i) {
                    const int r = r0 + rq * 4 + i;
                    KCo[(size_t)(kv * 2048 + r) * 64 + d] = f2bf(((r & 127) == 127) ? 0.f : acc[i]);
                }
            }
            __syncthreads();
        } else if (it < N_KC + N_LC) {
            if (!(cls & 2)) continue;
            const int idx = (it - N_KC) * NTHREADS + tid;
            const int b = idx >> 8, ch = idx & 255;
            const float* LH = (const float*)(ws_of(p) + WS_LRUH); const float* LA = (const float*)(ws_of(p) + WS_LRUA);
            float* LC = (float*)(ws_of(p) + WS_LRUC);
            float la[32], lh[32];
#pragma unroll
            for (int ck = 0; ck < 32; ++ck) { const size_t o = (size_t)(b * SEQ + ck * 64 + 63) * 256 + ch; la[ck] = LA[o]; lh[ck] = LH[o]; }
            float carry = 0.f;
#pragma unroll
            for (int ck = 0; ck < 32; ++ck) { LC[(b * 32 + ck) * 256 + ch] = carry; carry = la[ck] * carry + lh[ck]; }
        } else {
            if (!(cls & 4)) continue;
            const bool isn = it >= N_KC + N_LC + N_MC;
            const int idx = (it - N_KC - N_LC - (isn ? N_MC : 0)) * NTHREADS + tid;
            const int bh = isn ? (idx >> 6) : (idx >> 12), de = isn ? (idx & 63) : (idx & 4095);
            const int esz = isn ? 64 : 4096;
            float* buf = (float*)(ws_of(p) + (isn ? WS_MLN : WS_MLC)) + (size_t)bh * 32 * esz + de;
            const float* MU = (const float*)(ws_of(p) + WS_MLMU) + bh * 32; const float* AT = (const float*)(ws_of(p) + WS_MLAT) + bh * 32;
            float* MP = (float*)(ws_of(p) + WS_MLMP) + bh * 32;
            float dc[32];
#pragma unroll
            for (int ck = 0; ck < 32; ++ck) dc[ck] = buf[(size_t)ck * esz];
            float C = 0.f, m = 0.f;
#pragma unroll
            for (int ck = 0; ck < 32; ++ck) {
                buf[(size_t)ck * esz] = C;
                if (!isn && de == 0) MP[ck] = m;
                const float at = AT[ck], mu = MU[ck];
                const float mn = fmaxf(at + m, mu);
                C = expf(at + m - mn) * C + expf(mu - mn) * dc[ck];
                m = mn;
            }
        }
    }
}

__device__ __forceinline__ float gelu_tanh(float x) { const float u = 0.7978845608028654f * (x + 0.044715f * x * x * x); return 0.5f * x * (1.0f + tanhf(u)); }

__device__ void lru_y_item(const Params& p, int l, int item) {
    const int tid = opaque_tid(), lane = tid & 63;
    const float* LH = (const float*)(ws_of(p) + WS_LRUH); const float* LA = (const float*)(ws_of(p) + WS_LRUA); const float* LC = (const float*)(ws_of(p) + WS_LRUC);
    const bf16_t* U = (const bf16_t*)(ws_of(p) + WS_U);
    const float* hn = in_of(p, 22) + l * 1024;
    bf16_t* HD = (bf16_t*)(ws_of(p) + WS_HEADS);
    const int pair0 = item * 64 + (tid >> 6) * 8;
    float lh[8], la[8], lc[8], gg[8], gn[8];
#pragma unroll
    for (int q = 0; q < 8; ++q) {
        const int pair = pair0 + q, row = pair >> 2, n = pair & 3, ch = n * 64 + lane;
        lh[q] = LH[(size_t)row * 256 + ch]; la[q] = LA[(size_t)row * 256 + ch];
        lc[q] = LC[((row >> 11) * 32 + ((row & 2047) >> 6)) * 256 + ch];
        gg[q] = bf2f(U[(size_t)row * UW + 1536 + ch]);
        gn[q] = hn[(8 + n) * 64 + lane];
    }
#pragma unroll
    for (int q = 0; q < 8; ++q) {
        const int pair = pair0 + q, row = pair >> 2, n = pair & 3;
        const float h = lh[q] + la[q] * lc[q];
        const float y = h * gelu_tanh(gg[q]);
        const float ss = wave_sum(y * y);
        HD[(size_t)row * DM + (8 + n) * 64 + lane] = f2bf(y * rsqrtf(ss * (1.0f / 64.0f) + EPS) * gn[q]);
    }
}

__device__ __forceinline__ int vt_lane(int fr, int fq, int pitch) { return fr * pitch + ((((fq >> 1) ^ (fr >> 3)) & 1) << 3) + ((fq & 1) << 2); }
__device__ __forceinline__ constexpr int vt_cst(int dt, int kc2, int pitch) { return dt * 16 * pitch + ((((kc2 ^ (2 * dt)) & 6) | (kc2 & ~7)) << 3); }
__device__ void ml_y_item(const Params& p, int l, int bh, int ck, LAS unsigned char* lds) {
    const int tid = opaque_tid(), lane = tid & 63, w = __builtin_amdgcn_readfirstlane(tid >> 6), fr = lane & 15, fq = lane >> 4;
    const int b = bh >> 2, hh = bh & 3;
    LAS bf16_t* Ql = (LAS bf16_t*)lds;
    LAS bf16_t* Kl = (LAS bf16_t*)(lds + 9216);
    LAS bf16_t* Vt = (LAS bf16_t*)(lds + 18432);
    LAS bf16_t* Ct = (LAS bf16_t*)(lds + 27648);
    LAS bf16_t* Wl = (LAS bf16_t*)(lds + 39168);
    LAS float* as_ = (LAS float*)(lds + 57600);
    LAS float* bs_ = as_ + 64;
    LAS float* Ms_ = bs_ + 64;
    LAS float* ssl = Ms_ + 64;
    const bf16_t* U = (const bf16_t*)(ws_of(p) + WS_U);
    const float* GT = (const float*)(ws_of(p) + WS_GATES);
    const int rowbase = b * SEQ + ck * 64;
    const float mprev = ((const float*)(ws_of(p) + WS_MLMP))[bh * 32 + ck];
    if (tid < 64) {
        const float ig = GT[(size_t)(rowbase + lane) * 32 + 24 + hh] + in_of(p, 20)[l * 4 + hh];
        const float fp = GT[(size_t)(rowbase + lane) * 32 + 28 + hh] + in_of(p, 21)[l * 4 + hh];
        float a = logsigmoidf_(fp);
#pragma unroll
        for (int o = 1; o < 64; o <<= 1) { const float t = __shfl_up(a, o); if (lane >= o) a += t; }
        const float bb = ig - a;
        float pm = bb;
#pragma unroll
        for (int o = 1; o < 64; o <<= 1) { const float t = __shfl_up(pm, o); if (lane >= o) pm = fmaxf(pm, t); }
        as_[lane] = a; bs_[lane] = bb; Ms_[lane] = fmaxf(mprev, pm);
        Ct[64 * 72 + lane] = f2bf(((const float*)(ws_of(p) + WS_MLN))[(size_t)(bh * 32 + ck) * 64 + lane]);
    }
    {
        const int row = tid >> 3, ch = tid & 7;
        const bf16_t* src = U + (size_t)(rowbase + row) * UW + hh * 64 + ch * 8;
        *(LAS u32x4*)(Ql + row * 72 + ch * 8) = *(const u32x4*)(src + 1792);
        *(LAS u32x4*)(Kl + row * 72 + ch * 8) = *(const u32x4*)(src + 2048);
        const u32x4 vv = *(const u32x4*)(src + 2304);
#pragma unroll
        for (int e = 0; e < 4; ++e) {
            Vt[vt_off(ch * 8 + 2 * e, row, 72)] = (bf16_t)(vv[e] & 0xffffu);
            Vt[vt_off(ch * 8 + 2 * e + 1, row, 72)] = (bf16_t)(vv[e] >> 16);
        }
        const float* C = (const float*)(ws_of(p) + WS_MLC) + (size_t)(bh * 32 + ck) * 4096;
#pragma unroll
        for (int rr = 0; rr < 2; ++rr) {
            const int idx = tid + rr * NTHREADS, d = idx >> 4, e4 = (idx & 15) * 4;
            const f32x4 c = *(const f32x4*)(C + d * 64 + e4);
#pragma unroll
            for (int i = 0; i < 4; ++i) Ct[(e4 + i) * 72 + d] = f2bf(c[i]);
        }
        for (int idx = tid; idx < 15 * 72; idx += NTHREADS) Ct[65 * 72 + idx] = 0;
    }
    __syncthreads();
    const int jt = w & 3, hf = w >> 2;
    bf16_t opre[2][4];
#pragma unroll
    for (int i = 0; i < 4; ++i)
#pragma unroll
        for (int ee = 0; ee < 2; ++ee) opre[ee][i] = U[(size_t)(rowbase + 16 * jt + 4 * fq + i) * UW + 2560 + hh * 64 + 16 * (2 * hf + ee) + fr];
    bf16x8 qa[2];
#pragma unroll
    for (int ks = 0; ks < 2; ++ks) qa[ks] = *(const LAS bf16x8*)(Ql + (16 * jt + fr) * 72 + 32 * ks + 8 * fq);
    f32x4 sacc[4];
#pragma unroll
    for (int st = 0; st < 4; ++st) {
        const bf16x8 k0 = *(const LAS bf16x8*)(Kl + (16 * st + fr) * 72 + 8 * fq), k1 = *(const LAS bf16x8*)(Kl + (16 * st + fr) * 72 + 32 + 8 * fq);
        sacc[st] = __builtin_amdgcn_mfma_f32_16x16x32_bf16(qa[0], k0, (f32x4){0.f, 0.f, 0.f, 0.f}, 0, 0, 0);
        sacc[st] = __builtin_amdgcn_mfma_f32_16x16x32_bf16(qa[1], k1, sacc[st], 0, 0, 0);
    }
    float sw[4], Mj[4];
    LAS bf16_t* Ww = Wl + w * (16 * 72);
#pragma unroll
    for (int i = 0; i < 4; ++i) {
        const int j = 16 * jt + 4 * fq + i;
        Mj[i] = Ms_[j];
        float acc = 0.f;
#pragma unroll
        for (int st = 0; st < 4; ++st) {
            const int sidx = 16 * st + fr;
            const float wv = (sidx <= j) ? __expf(bs_[sidx] - Mj[i]) * sacc[st][i] : 0.f;
            acc += wv;
            Ww[(4 * fq + i) * 72 + sidx] = f2bf(wv);
        }
        acc += __shfl_xor(acc, 1); acc += __shfl_xor(acc, 2); acc += __shfl_xor(acc, 4); acc += __shfl_xor(acc, 8);
        sw[i] = acc;
    }
    asm volatile("s_waitcnt lgkmcnt(0)" ::: "memory");
    bf16x8 wa[2];
#pragma unroll
    for (int ks = 0; ks < 2; ++ks) wa[ks] = *(const LAS bf16x8*)(Ww + fr * 72 + 32 * ks + 8 * fq);
    f32x4 acc1[2], acc2[2], accn;
#pragma unroll
    for (int ee = 0; ee < 2; ++ee) {
        const int et = 2 * hf + ee;
        acc1[ee] = (f32x4){0.f, 0.f, 0.f, 0.f}; acc2[ee] = (f32x4){0.f, 0.f, 0.f, 0.f};
#pragma unroll
        for (int ks = 0; ks < 2; ++ks) {
            const bf16x8 cf = *(const LAS bf16x8*)(Ct + (16 * et + fr) * 72 + 32 * ks + 8 * fq);
            const bf16x8 vf = *(const LAS bf16x8*)(Vt + vt_off(16 * et + fr, 32 * ks + 8 * fq, 72));
            acc1[ee] = __builtin_amdgcn_mfma_f32_16x16x32_bf16(qa[ks], cf, acc1[ee], 0, 0, 0);
            acc2[ee] = __builtin_amdgcn_mfma_f32_16x16x32_bf16(wa[ks], vf, acc2[ee], 0, 0, 0);
        }
    }
    accn = (f32x4){0.f, 0.f, 0.f, 0.f};
#pragma unroll
    for (int ks = 0; ks < 2; ++ks) {
        const bf16x8 cf = *(const LAS bf16x8*)(Ct + (64 + fr) * 72 + 32 * ks + 8 * fq);
        accn = __builtin_amdgcn_mfma_f32_16x16x32_bf16(qa[ks], cf, accn, 0, 0, 0);
    }
    float ov[2][4];
#pragma unroll
    for (int i = 0; i < 4; ++i) {
        const int j = 16 * jt + 4 * fq + i;
        const float qn = __shfl(accn[i], lane & 48);
        const float inter = expf(mprev - Mj[i]);
        const float den = inter * qn + sw[i];
        const float lim = expf(-(as_[j] + Mj[i]));
        const float inv = 1.0f / fmaxf(fabsf(den), lim);
        float ssp = 0.f;
#pragma unroll
        for (int ee = 0; ee < 2; ++ee) {
            const int e = 16 * (2 * hf + ee) + fr;
            const float hv = (inter * acc1[ee][i] + acc2[ee][i]) * inv;
            const float o = sigmoidf_(bf2f(opre[ee][i])) * hv;
            ov[ee][i] = o; ssp += o * o;
        }
        ssp += __shfl_xor(ssp, 1); ssp += __shfl_xor(ssp, 2); ssp += __shfl_xor(ssp, 4); ssp += __shfl_xor(ssp, 8);
        if (fr == 0) ssl[w * 16 + 4 * fq + i] = ssp;
    }
    __syncthreads();
    {
        bf16_t* HD = (bf16_t*)(ws_of(p) + WS_HEADS);
        const float* hn = in_of(p, 22) + l * 1024 + (12 + hh) * 64;
#pragma unroll
        for (int i = 0; i < 4; ++i) {
            const int j = 16 * jt + 4 * fq + i;
            const float tot = ssl[jt * 16 + 4 * fq + i] + ssl[(jt + 4) * 16 + 4 * fq + i];
            const float rs = rsqrtf(tot * (1.0f / 64.0f) + EPS);
#pragma unroll
            for (int ee = 0; ee < 2; ++ee) {
                const int e = 16 * (2 * hf + ee) + fr;
                HD[(size_t)(rowbase + j) * DM + (12 + hh) * 64 + e] = f2bf(ov[ee][i] * rs * hn[e]);
            }
        }
    }
    __syncthreads();
}

__device__ __forceinline__ bf16x8 pack8(const f32x4 lo, const f32x4 hi) {
    u32x4 r; r.x = cvt_pk_bf16(lo[0], lo[1]); r.y = cvt_pk_bf16(lo[2], lo[3]); r.z = cvt_pk_bf16(hi[0], hi[1]); r.w = cvt_pk_bf16(hi[2], hi[3]);
    return __builtin_bit_cast(bf16x8, r);
}
__device__ __forceinline__ bf16x8 join8(const u32x2 lo, const u32x2 hi) { u32x4 r; r.x = lo.x; r.y = lo.y; r.z = hi.x; r.w = hi.y; return __builtin_bit_cast(bf16x8, r); }
__device__ void nsa_item(const Params& p, int l, int b, int g, int qb, LAS unsigned char* lds, int mode = 0) {
    int tid = opaque_tid(), w = __builtin_amdgcn_readfirstlane(tid >> 6), lane = tid & 63, fr = lane & 15, fq = lane >> 4;
    LAS bf16_t* Kc = (LAS bf16_t*)lds;
    LAS bf16_t* Vc = (LAS bf16_t*)(lds + 18432);
    LAS bf16_t* Pl = (LAS bf16_t*)(lds + 36864);
    LAS float* impl = (LAS float*)(lds + 106496);
    LAS unsigned* selm = (LAS unsigned*)(lds + 114688);
    LAS int* steps = (LAS int*)(lds + 114944);
    const bf16_t* U = (const bf16_t*)(ws_of(p) + WS_U);
    const int bg = b * 2 + g, rowbase = b * SEQ;
    const int head = 4 * g + (w >> 1);
    const float sl2 = exp2f(-(float)(head + 1)) * 1.4426950408889634f;
    const int tw0 = qb * 64 + (w & 1) * 32;
    bf16x8 qf[2][2];
#pragma unroll
    for (int mt = 0; mt < 2; ++mt)
#pragma unroll
        for (int ks = 0; ks < 2; ++ks)
            qf[mt][ks] = *(const bf16x8*)(U + (size_t)(rowbase + tw0 + mt * 16 + fr) * UW + head * 64 + ks * 32 + fq * 8);
    const float* GT = (const float*)(ws_of(p) + WS_GATES);
    float gpre[2][3];
#pragma unroll
    for (int mt = 0; mt < 2; ++mt)
#pragma unroll
        for (int q = 0; q < 3; ++q) gpre[mt][q] = GT[(size_t)(rowbase + tw0 + mt * 16 + fr) * 32 + head * 3 + q];
    f32x4 y[2][4];
    {
        LAS float* impM = (LAS float*)Pl;
        LAS float* impT = impM + 4 * 64 * 33;
        const bf16_t* KC = (const bf16_t*)(ws_of(p) + WS_KC) + (size_t)bg * 128 * 64;
        const bf16_t* VC = KC + (size_t)2048 * 64;
        u32x4 kvr[2], vvr[2];
#pragma unroll
        for (int rr = 0; rr < 2; ++rr) { const int idx = tid + rr * NTHREADS; kvr[rr] = *(const u32x4*)(KC + idx * 8); vvr[rr] = *(const u32x4*)(VC + idx * 8); }
#pragma unroll
        for (int rr = 0; rr < 2; ++rr) {
            const int idx = tid + rr * NTHREADS, key = idx >> 3, ch = idx & 7;
            const u32x4 kv = kvr[rr];
            const u32x4 vv = vvr[rr];
            *(LAS u32x4*)(Kc + key * 72 + ch * 8) = kv;
#pragma unroll
            for (int e = 0; e < 4; ++e) {
                Vc[vt_off(ch * 8 + 2 * e, key, 136)] = (bf16_t)(vv[e] & 0xffffu);
                Vc[vt_off(ch * 8 + 2 * e + 1, key, 136)] = (bf16_t)(vv[e] >> 16);
            }
        }
        __syncthreads();
        const int vl136 = vt_lane(fr, fq, 136);
#pragma unroll
        for (int mt = 0; mt < 2; ++mt) {
            const int t = tw0 + mt * 16 + fr;
            f32x4 s[8];
#pragma unroll
            for (int nt = 0; nt < 8; ++nt) {
                const bf16x8 k0 = *(const LAS bf16x8*)(Kc + (16 * nt + fr) * 72 + fq * 8), k1 = *(const LAS bf16x8*)(Kc + (16 * nt + fr) * 72 + 32 + fq * 8);
                s[nt] = __builtin_amdgcn_mfma_f32_16x16x32_bf16(k0, qf[mt][0], (f32x4){0.f, 0.f, 0.f, 0.f}, 0, 0, 0);
                s[nt] = __builtin_amdgcn_mfma_f32_16x16x32_bf16(k1, qf[mt][1], s[nt], 0, 0, 0);
            }
            float mx = NEGF;
#pragma unroll
            for (int nt = 0; nt < 8; ++nt)
#pragma unroll
                for (int i = 0; i < 4; ++i) {
                    const int n = 16 * nt + 4 * fq + i, cend = 16 * n + 31;
                    const bool valid = (t >= cend) && (n < 127);
                    const float sv = valid ? fmaf(sl2, (float)cend, s[nt][i]) : NEGF;
                    s[nt][i] = sv; mx = fmaxf(mx, sv);
                }
            mx = fq_max(mx);
            const float ms = (mx < -1e29f) ? 0.f : mx;
            float sum = 0.f;
#pragma unroll
            for (int nt = 0; nt < 8; ++nt)
#pragma unroll
                for (int i = 0; i < 4; ++i) { const float pv = __builtin_amdgcn_exp2f(s[nt][i] - ms); s[nt][i] = pv; sum += pv; }
            sum = fq_sum(sum);
            const float inv = sum > 0.f ? 1.0f / sum : 0.f;
            {
                LAS float* mrow_ = impM + ((w >> 1) * 64 + (w & 1) * 32 + mt * 16 + fr) * 33 + fq;
                LAS float* trow_ = impT + ((w >> 1) * 64 + (w & 1) * 32 + mt * 16 + fr) * 33 + fq + 1;
#pragma unroll
                for (int nt = 0; nt < 8; ++nt) {
                    s[nt] = s[nt] * inv;
                    mrow_[4 * nt] = (s[nt][0] + s[nt][1]) + (s[nt][2] + s[nt][3]);
                    trow_[4 * nt] = s[nt][3];
                }
            }
            f32x4 oc[4];
#pragma unroll
            for (int dt = 0; dt < 4; ++dt) oc[dt] = (f32x4){0.f, 0.f, 0.f, 0.f};
#pragma unroll
            for (int ks2 = 0; ks2 < 4; ++ks2) {
                const bf16x8 pb = pack8(s[2 * ks2], s[2 * ks2 + 1]);
#pragma unroll
                for (int dt = 0; dt < 4; ++dt) {
                    const u32x2 lo = *(const LAS u32x2*)(Vc + vl136 + vt_cst(dt, 4 * ks2, 136));
                    const u32x2 hi = *(const LAS u32x2*)(Vc + vl136 + vt_cst(dt, 4 * ks2 + 2, 136));
                    oc[dt] = __builtin_amdgcn_mfma_f32_16x16x32_bf16(join8(lo, hi), pb, oc[dt], 0, 0, 0);
                }
            }
            const float g0 = sigmoidf_(gpre[mt][0]);
#pragma unroll
            for (int dt = 0; dt < 4; ++dt) y[mt][dt] = oc[dt] * g0;
        }
        if (tid < 256) impT[tid * 33] = 0.f;
        __syncthreads();
#pragma unroll 1
        for (int rr = 0; rr < 4; ++rr) {
            const int idx = tid + rr * NTHREADS, tau = idx >> 5, j = idx & 31;
            float mine = 0.f;
#pragma unroll
            for (int hh = 0; hh < 4; ++hh) mine += impM[(hh * 64 + tau) * 33 + j] + impT[(hh * 64 + tau) * 33 + j];
            bool sel;
            if (qb < 16) sel = (j <= qb);
            else {
                const bool forced = (j == 0) || (j == qb) || (j == qb - 1);
                const bool cand = (j >= 1) && (j <= qb - 2);
                int rank = 0;
#pragma unroll
                for (int jp = 1; jp < 30; ++jp) {
                    const float o = __shfl(mine, (lane & 32) + jp);
                    rank += (jp <= qb - 2 && (o > mine || (o == mine && jp < j))) ? 1 : 0;
                }
                sel = forced || (cand && rank < 13);
            }
            const unsigned long long bal = __ballot(sel);
            if ((lane & 31) == 0) selm[tau] = (lane < 32) ? (unsigned)bal : (unsigned)(bal >> 32);
        }
        __syncthreads();
        if (tid < 64) {
            unsigned m = selm[tid], uni = m, all = m;
#pragma unroll
            for (int o = 32; o >= 1; o >>= 1) { uni |= __shfl_xor(uni, o); all &= __shfl_xor(all, o); }
            uni &= (qb >= 31) ? 0xffffffffu : ((2u << qb) - 1u);
            const int nsel = __popc(uni);
            const int kb = tid;
            if (kb <= qb && ((uni >> kb) & 1u)) {
                const int pos = __popc(uni & ((1u << kb) - 1u));
                steps[1 + pos] = ((((all >> kb) & 1u) && kb < qb) ? 4096 : 0) | (1 << 8) | kb;
            }
            const int kb0 = (qb - 8 < 0) ? 0 : qb - 8;
            if (kb >= kb0 && kb <= qb) steps[1 + nsel + (kb - kb0)] = ((kb > qb - 8 && kb < qb) ? 4096 : 0) | (2 << 8) | kb;
            if (tid == 0) steps[0] = nsel + (qb - kb0 + 1);
        }
        __syncthreads();
    }
    if (mode == 1) { asm volatile("" :: "v"(y[0][0][0]), "v"(y[1][3][3])); __syncthreads(); return; }
    tid = opaque_tid(); w = __builtin_amdgcn_readfirstlane(tid >> 6); lane = tid & 63; fr = lane & 15; fq = lane >> 4;
    unsigned smask[2];
#pragma unroll
    for (int mt = 0; mt < 2; ++mt) smask[mt] = selm[(w & 1) * 32 + mt * 16 + fr];
    const int nsteps = __builtin_amdgcn_readfirstlane(steps[0]);
    float mrow[2], lrow[2];
    f32x4 oacc[2][4];
#pragma unroll
    for (int mt = 0; mt < 2; ++mt) {
        mrow[mt] = NEGF; lrow[mt] = 0.f;
#pragma unroll
        for (int dt = 0; dt < 4; ++dt) oacc[mt][dt] = (f32x4){0.f, 0.f, 0.f, 0.f};
    }
    const int skey = tid >> 3, sch = tid & 7;
    const int vl72 = vt_lane(fr, fq, 72);
    const int vsw = vt_off(sch * 8, skey, 72);
    const bf16_t* Ubase = U + (size_t)(rowbase + skey) * UW + g * 64 + sch * 8;
#define NSA_SRC(st_) (Ubase + (size_t)((st_) & 255) * 64 * UW + ((((st_) >> 8) & 15) == 1 ? 768 : 1024))
#define NSA_STAGE(buf_, kr_, vr_) do { \
        *(LAS u32x4*)(Kc + (buf_) * (64 * 72) + skey * 72 + sch * 8) = kr_; \
        LAS bf16_t* _vn = Vc + (buf_) * (64 * 72) + vsw; \
        _Pragma("unroll") for (int e = 0; e < 4; ++e) { _vn[(2 * e) * 72] = (bf16_t)(vr_[e] & 0xffffu); _vn[(2 * e + 1) * 72] = (bf16_t)(vr_[e] >> 16); } } while (0)
    u32x4 kregA, vregA;
    {
        const bf16_t* src = NSA_SRC(__builtin_amdgcn_readfirstlane(steps[1]));
        kregA = *(const u32x4*)src; vregA = *(const u32x4*)(src + 128);
        NSA_STAGE(0, kregA, vregA);
    }
    if (nsteps > 1) { const bf16_t* src = NSA_SRC(__builtin_amdgcn_readfirstlane(steps[2])); kregA = *(const u32x4*)src; vregA = *(const u32x4*)(src + 128); }
    __syncthreads();
    int curkind = 1;
#define NSA_STEP(si, kX, vX) do { \
        const int st = __builtin_amdgcn_readfirstlane(steps[1 + (si)]), kind = (st >> 8) & 15, kb = st & 255; \
        const bool nomask = (st & 4096) != 0; \
        LAS bf16_t* Kl = Kc + ((si) & 1) * (64 * 72); \
        LAS bf16_t* Vt = Vc + ((si) & 1) * (64 * 72); \
        if (kind != curkind) { \
            _Pragma("unroll") for (int mt = 0; mt < 2; ++mt) { \
                float lt = lrow[mt]; \
                lt = fq_sum(lt); \
                const float sc = sigmoidf_(gpre[mt][1]) / lt; \
                _Pragma("unroll") for (int dt = 0; dt < 4; ++dt) { y[mt][dt] += oacc[mt][dt] * sc; oacc[mt][dt] = (f32x4){0.f, 0.f, 0.f, 0.f}; } \
                mrow[mt] = NEGF; lrow[mt] = 0.f; \
            } \
            curkind = kind; \
        } \
        float kbf = (float)(kb * 64 + 4 * fq); \
        int kbi = kb * 64 + 4 * fq; \
        asm volatile("" : "+v"(kbf), "+v"(kbi)); \
        f32x4 s[2][4]; \
        _Pragma("unroll") for (int nt = 0; nt < 4; ++nt) { \
            const bf16x8 k0 = *(const LAS bf16x8*)(Kl + (16 * nt + fr) * 72 + fq * 8), k1 = *(const LAS bf16x8*)(Kl + (16 * nt + fr) * 72 + 32 + fq * 8); \
            _Pragma("unroll") for (int mt = 0; mt < 2; ++mt) { \
                s[mt][nt] = __builtin_amdgcn_mfma_f32_16x16x32_bf16(k0, qf[mt][0], (f32x4){0.f, 0.f, 0.f, 0.f}, 0, 0, 0); \
                s[mt][nt] = __builtin_amdgcn_mfma_f32_16x16x32_bf16(k1, qf[mt][1], s[mt][nt], 0, 0, 0); \
            } \
        } \
        bf16x8 pb[2][2]; \
        _Pragma("unroll") for (int mt = 0; mt < 2; ++mt) { \
            float mx = NEGF; \
            if (nomask) { \
                _Pragma("unroll") for (int nt = 0; nt < 4; ++nt) \
                    _Pragma("unroll") for (int i = 0; i < 4; ++i) { const float sv = fmaf(sl2, kbf + (float)(16 * nt + i), s[mt][nt][i]); s[mt][nt][i] = sv; mx = fmaxf(mx, sv); } \
            } else { \
                const int t = tw0 + mt * 16 + fr; \
                const bool rowok = (kind == 1) ? (((smask[mt] >> kb) & 1u) != 0u) : true; \
                _Pragma("unroll") for (int nt = 0; nt < 4; ++nt) \
                    _Pragma("unroll") for (int i = 0; i < 4; ++i) { \
                        const int dist = t - (kbi + 16 * nt + i); \
                        const bool valid = rowok && dist >= 0 && (kind == 1 || dist < 512); \
                        const float sv = valid ? fmaf(sl2, kbf + (float)(16 * nt + i), s[mt][nt][i]) : NEGF; \
                        s[mt][nt][i] = sv; mx = fmaxf(mx, sv); \
                    } \
            } \
            mx = fq_max(mx); \
            const float mn = fmaxf(mrow[mt], mx); \
            const float alpha = __builtin_amdgcn_exp2f(mrow[mt] - mn); \
            mrow[mt] = mn; \
            const float ms = (mn < -1e29f) ? 0.f : mn; \
            float ls = 0.f; \
            _Pragma("unroll") for (int nt = 0; nt < 4; ++nt) \
                _Pragma("unroll") for (int i = 0; i < 4; ++i) { const float pv = __builtin_amdgcn_exp2f(s[mt][nt][i] - ms); s[mt][nt][i] = pv; ls += pv; } \
            lrow[mt] = lrow[mt] * alpha + ls; \
            _Pragma("unroll") for (int dt = 0; dt < 4; ++dt) oacc[mt][dt] = oacc[mt][dt] * alpha; \
            pb[mt][0] = pack8(s[mt][0], s[mt][1]); pb[mt][1] = pack8(s[mt][2], s[mt][3]); \
        } \
        _Pragma("unroll") for (int ks2 = 0; ks2 < 2; ++ks2) \
            _Pragma("unroll") for (int dt = 0; dt < 4; ++dt) { \
                const u32x2 lo = *(const LAS u32x2*)(Vt + vl72 + vt_cst(dt, 4 * ks2, 72)); \
                const u32x2 hi = *(const LAS u32x2*)(Vt + vl72 + vt_cst(dt, 4 * ks2 + 2, 72)); \
                const bf16x8 va = join8(lo, hi); \
                _Pragma("unroll") for (int mt = 0; mt < 2; ++mt) oacc[mt][dt] = __builtin_amdgcn_mfma_f32_16x16x32_bf16(va, pb[mt][ks2], oacc[mt][dt], 0, 0, 0); \
            } \
        if ((si) + 1 < nsteps) NSA_STAGE(((si) + 1) & 1, kX, vX); \
        if ((si) + 2 < nsteps) { const bf16_t* src = NSA_SRC(__builtin_amdgcn_readfirstlane(steps[3 + (si)])); kX = *(const u32x4*)src; vX = *(const u32x4*)(src + 128); } \
        __syncthreads(); \
    } while (0)
    for (int si = 0; si < nsteps; ++si) {
        NSA_STEP(si, kregA, vregA);
    }
#undef NSA_STEP
#undef NSA_STAGE
#undef NSA_SRC
    tid = opaque_tid(); lane = tid & 63; fr = lane & 15; fq = lane >> 4;
    {
        const float* hn = in_of(p, 22) + l * 1024 + head * 64;
        bf16_t* HD = (bf16_t*)(ws_of(p) + WS_HEADS);
        f32x4 gnv[4];
#pragma unroll
        for (int dt = 0; dt < 4; ++dt) gnv[dt] = *(const f32x4*)(hn + 16 * dt + 4 * fq);
#pragma unroll
        for (int mt = 0; mt < 2; ++mt) {
            const int t = tw0 + mt * 16 + fr;
            float lt = lrow[mt];
            lt = fq_sum(lt);
            const float sc = sigmoidf_(gpre[mt][2]) / lt;
            float ss = 0.f;
            f32x4 yy[4];
#pragma unroll
            for (int dt = 0; dt < 4; ++dt) { yy[dt] = y[mt][dt] + oacc[mt][dt] * sc; ss += (yy[dt][0] * yy[dt][0] + yy[dt][1] * yy[dt][1]) + (yy[dt][2] * yy[dt][2] + yy[dt][3] * yy[dt][3]); }
            ss = fq_sum(ss);
            const float rs = rsqrtf(ss * (1.0f / 64.0f) + EPS);
#pragma unroll
            for (int dt = 0; dt < 4; ++dt) {
                const f32x4 gn = gnv[dt];
                const f32x4 o = yy[dt] * rs * gn;
                u32x2 pk; pk.x = cvt_pk_bf16(o[0], o[1]); pk.y = cvt_pk_bf16(o[2], o[3]);
                *(u32x2*)(HD + (size_t)(rowbase + t) * DM + head * 64 + 16 * dt + 4 * fq) = pk;
            }
        }
    }
    __syncthreads();
}

#define XB_TMO      128
#define XB_XCNT(j)  (256  + 64 * (j))
#define XB_XSUB(j)  (1280 + 64 * (j))
#define XB_XGEN(j)  (2304 + 64 * (j))
#define XB_TOP      3328
#define XB_TOPGEN   3392
#define XCD_BAR_WORDS 3456
#define XB_SPIN_CAP (1u << 22)
__device__ __forceinline__ unsigned xb_ld(unsigned* p)              { return __hip_atomic_load(p, __ATOMIC_RELAXED, __HIP_MEMORY_SCOPE_AGENT); }
__device__ __forceinline__ unsigned xb_add(unsigned* p, unsigned v) { return __hip_atomic_fetch_add(p, v, __ATOMIC_RELAXED, __HIP_MEMORY_SCOPE_AGENT); }
__device__ __forceinline__ unsigned xb_xcc_id() { return (unsigned)__builtin_amdgcn_s_getreg((3 << 11) | 20) & 0xFu; }
#define XB_SPIN(cond, bar) do { unsigned _sp = 0; while (cond) { __builtin_amdgcn_s_sleep(1); \
    if ((++_sp & 255u) == 0u) { if (xb_ld(&(bar)[XB_TMO])) break; if (_sp > XB_SPIN_CAP) { atomicAdd(&(bar)[XB_TMO], 1u); break; } } } } while (0)
struct XcdBarrier { unsigned* bar; unsigned x; volatile LAS unsigned* st; };
__device__ __forceinline__ XcdBarrier xcd_barrier_post(unsigned* bar, volatile LAS unsigned* st) {
    XcdBarrier b; b.bar = bar; b.x = xb_xcc_id(); b.st = st;
    if (threadIdx.x == 0) (void)xb_add(&bar[XB_XCNT(b.x)], 1u);
    return b;
}
__device__ __forceinline__ void xcd_barrier_complete(unsigned* bar, unsigned x, unsigned& nloc, unsigned& nx) {
    const unsigned G = gridDim.x * gridDim.y * gridDim.z;
    unsigned sum, cnt, mine, sp = 0u;
    for (;;) {
        sum = 0u; cnt = 0u; mine = 0u;
#pragma unroll
        for (unsigned j = 0; j < 16; ++j) { const unsigned c = xb_ld(&bar[XB_XCNT(j)]); sum += c; cnt += (c > 0u) ? 1u : 0u; mine = (j == x) ? c : mine; }
        if (sum == G) break;
        __builtin_amdgcn_s_sleep(1);
        if ((++sp & 255u) == 0u) { if (xb_ld(&bar[XB_TMO])) break; if (sp > XB_SPIN_CAP) { atomicAdd(&bar[XB_TMO], 1u); break; } }
    }
    nloc = mine > 0u ? mine : 1u; nx = cnt > 0u ? cnt : 1u;
}
__device__ __forceinline__ void xcd_barrier(const XcdBarrier& b) {
    asm volatile("s_waitcnt vmcnt(0)" ::: "memory");
    __syncthreads();
    if (threadIdx.x == 0) {
        unsigned* bar = b.bar;
        __builtin_amdgcn_s_waitcnt(0);
        unsigned nloc = b.st[0], nx = b.st[1];
        if (nloc == 0u) { xcd_barrier_complete(bar, b.x, nloc, nx); b.st[0] = nloc; b.st[1] = nx; }
        const unsigned old = xb_add(&bar[XB_XSUB(b.x)], 1u);
        const unsigned gen = old / nloc;
        if (old + 1u == (gen + 1u) * nloc) {
            __builtin_amdgcn_fence(__ATOMIC_RELEASE, "agent");
            asm volatile("s_waitcnt vmcnt(0)" ::: "memory");
            const unsigned og = xb_add(&bar[XB_TOP], 1u);
            const unsigned tg = og / nx;
            if (og + 1u == (tg + 1u) * nx) xb_add(&bar[XB_TOPGEN], 1u);
            else XB_SPIN(xb_ld(&bar[XB_TOPGEN]) == tg, bar);
            __builtin_amdgcn_fence(__ATOMIC_ACQUIRE, "agent");
            xb_add(&bar[XB_XGEN(b.x)], 1u);
            asm volatile("s_waitcnt vmcnt(0)" ::: "memory");
        } else {
            XB_SPIN(xb_ld(&bar[XB_XGEN(b.x)]) == gen, bar);
            __builtin_amdgcn_fence(__ATOMIC_ACQUIRE, "agent");
            asm volatile("s_waitcnt vmcnt(0)" ::: "memory");
        }
    }
    __syncthreads();
}

__global__ void __launch_bounds__(NTHREADS) hymba_fwd(Params p) {
    extern __shared__ __attribute__((aligned(16))) unsigned char lds_raw[];
    LAS unsigned char* lds = (LAS unsigned char*)lds_raw;
    cg::grid_group grid = cg::this_grid();
    volatile LAS unsigned* xbw = (volatile LAS unsigned*)(lds + LDS_BYTES - 16);
    if (threadIdx.x < 4) xbw[threadIdx.x] = 0u;
    __syncthreads();
    XcdBarrier xbar = xcd_barrier_post((unsigned*)(ws_of(p) + WS_BAR), xbw);
    if (p.ph_hi - p.ph_lo > 1) grid.sync();
    for (int ph = p.ph_lo; ph < p.ph_hi; ++ph) {
        int G = gridDim.x, bid = blockIdx.x;
        asm volatile("" : "+s"(G), "+s"(bid));
        const int tpx = opaque_tid();
        if (ph == 0) {
            if (PHEN(0)) prologue(p, lds, bid, G);
            if (REP_SUB == 100) { __syncthreads(); prologue(p, lds, bid, G); }
        } else if (ph == 37) { if (PHEN(10)) {
            const float* ssq = (const float*)(ws_of(p) + WS_SSQ) + (size_t)(12 & 1) * T_ * 16;
            float* outp = out_of(p);
            const f32x4 gn = *(const f32x4*)(in_of(p, 28) + (tpx & 255) * 4);
            for (int it = bid; it < T_ / 8; it += G) {
                f32x4 v[4]; float r[4];
#pragma unroll
                for (int q = 0; q < 4; ++q) {
                    const int row = it * 8 + q * 2 + (tpx >> 8);
                    v[q] = *(const f32x4*)(outp + (size_t)row * DM + (tpx & 255) * 4);
                    r[q] = row_rstd(ssq, row);
                }
#pragma unroll
                for (int q = 0; q < 4; ++q) {
                    const int row = it * 8 + q * 2 + (tpx >> 8);
                    *(f32x4*)(outp + (size_t)row * DM + (tpx & 255) * 4) = v[q] * r[q] * gn;
                }
            } }
        } else {
            const int l = (ph - 1) / 9, sub = (ph - 1) % 9;
            unsigned char* wl = ws_of(p) + WS_W + (size_t)l * LAYER_W;
            float* ssq = (float*)(ws_of(p) + WS_SSQ);
            bf16_t* HB = (bf16_t*)(ws_of(p) + WS_HB);
            bf16_t* UB = (bf16_t*)(ws_of(p) + WS_U);
            if (PHEN(1) && (sub == 0 || sub == 7)) {
                const bool second = sub == 7;
                pg8::Gemm g{HB, (const bf16_t*)(wl + (second ? LO_W13B : LO_W13A)), T_, NUP, DM, DM, DM};
                pg8::StaticOrder S; S.init(T_, NUP, G, bid);
                EpiSwiGLU E{UB, ssq + (size_t)((3 * l + (second ? 2 : 0)) & 1) * T_ * 16};
                pg8::gemm_phase(lds, g, S, E);
                if (REP_SUB == 0) { __syncthreads(); pg8::gemm_phase(lds, g, S, E); }
            } else if (PHEN(2) && (sub == 1 || sub == 8 || sub == 6)) {
                const bool wout = sub == 6, second = sub == 8;
                pg8::Gemm g;
                if (wout) g = pg8::Gemm{(const bf16_t*)(ws_of(p) + WS_HEADS), (const bf16_t*)(wl + LO_WOUT), T_, DM, DM, DM, DM};
                else g = pg8::Gemm{UB, (const bf16_t*)(wl + (second ? LO_W2B : LO_W2A)), T_, DM, DFF, DFF, DFF};
                pg8::StaticOrder S; S.init(T_, DM, G, bid);
                const float* resid = (l == 0 && sub == 1) ? in_of(p, 0) : out_of(p);
                const int nxt = 3 * l + (sub == 1 ? 1 : (sub == 6 ? 2 : 3));
                EpiResid E{resid, out_of(p), HB, ssq + (size_t)(nxt & 1) * T_ * 16, wout ? 1.0f : 0.5f};
                pg8::gemm_phase(lds, g, S, E);
                if (REP_SUB == 1) { __syncthreads(); EpiResid E2{out_of(p), out_of(p), HB, ssq + (size_t)(nxt & 1) * T_ * 16, 0.0f}; pg8::gemm_phase(lds, g, S, E2); }
            } else if (PHEN(3) && sub == 2) {
                if (bid < 2 && tpx < 256) {
                    const float* cbp = (const float*)(ws_of(p) + WS_CBP) + (size_t)((l * 2 + bid) * 32) * 256 + tpx;
                    float sb = 0.f;
#pragma unroll
                    for (int q = 0; q < 32; ++q) sb += cbp[q * 256];
                    ((float*)(ws_of(p) + WS_CBIAS))[(l * 2 + bid) * 256 + tpx] = sb;
                }
                pg8::Gemm g{HB, (const bf16_t*)(wl + LO_WIN), T_, NINP, DM, DM, DM};
                pg8::StaticOrder S; S.init(T_, NINP, G, bid);
                EpiWin E{UB, (bf16_t*)(ws_of(p) + WS_KCMP), (bf16_t*)(ws_of(p) + WS_VCMP), (float*)(ws_of(p) + WS_GATES), ssq + (size_t)((3 * l + 1) & 1) * T_ * 16};
                pg8::gemm_phase(lds, g, S, E);
                if (REP_SUB == 2) { __syncthreads(); pg8::gemm_phase(lds, g, S, E); }
            } else if (sub == 3) {
                const int ngemm = 64;
                for (int rep = 0; rep < (REP_SUB == 3 ? 2 : 1); ++rep) {
                const int cls = rep == 0 ? 7 : REP_CLASS;
                if (rep) __syncthreads();
                if (G > ngemm) {
                    if (bid < ngemm) { if (PHEN(4) && (cls & 1)) {
                        const int kp = bid >> 4, kv = (bid >> 3) & 1;
                        pg8::Gemm g{(const bf16_t*)(ws_of(p) + (kv ? WS_VCMP : WS_KCMP)) + kp * 512, (const bf16_t*)(wl + (kv ? LO_CW1V : LO_CW1K)) + kp * 512, 2048, 256, 512, 1024, 2048};
                        pg8::SingleUnit S{bid & 7};
                        EpiCmp E{(float*)(ws_of(p) + WS_HID) + (size_t)(kp * 2 + kv) * 2048 * 256};
                        pg8::gemm_phase(lds, g, S, E); }
                    }
                    if (PHEN(5)) {
                        const bool gb = bid < ngemm;
                        const int i0 = gb ? 1728 + bid : bid - ngemm, i1 = gb ? 2048 : 1728, st = gb ? ngemm : G - ngemm;
                        for (int it = i0; it < i1; it += st) {
                            if (it < 1024) { if (cls & 2) lru_x_item(p, l, it >> 7, (it >> 5) & 3, it & 31, lds); }
                            else if (cls & 4) ml_x_item(p, l, (it - 1024) >> 5, it & 31, lds);
                        }
                    }
                }
                }
            } else if (PHEN(6) && sub == 4) {
                phase_m2(p, l, 7, lds, bid, G);
                if (REP_SUB == 4) { __syncthreads(); phase_m2(p, l, REP_CLASS, lds, bid, G); }
            } else if (sub == 5) {
                for (int rep = 0; rep < (REP_SUB == 5 ? 2 : 1); ++rep) {
                const int cls = rep == 0 ? 7 : REP_CLASS;
                if (rep) __syncthreads();
                for (int it = bid; it < 512 + 1024 + 1024; it += G) {
                    if (it < 512) { if (PHEN(7) && (cls & 1)) {
                        const int qb = it < 256 ? 31 - (it >> 4) : ((it - 256) >> 4), bg = it & 15;
                        nsa_item(p, l, bg >> 1, bg & 1, qb, lds, (rep == 1 && REP_CLASS == 9) ? 1 : 0); }
                    } else if (it < 1536) {
                        if (PHEN(8) && (cls & 2)) ml_y_item(p, l, (it - 512) >> 5, (it - 512) & 31, lds);
                    } else {
                        if (PHEN(9) && (cls & 4)) lru_y_item(p, l, it - 1536);
                    }
                }
                }
            }
        }
        if (ph + 1 < p.ph_hi) {
            xcd_barrier(xbar);
            if (REP_SUB == 200) xcd_barrier(xbar);
        }
    }
}

extern "C" void kernel_launch(void* const* d_in, const int* in_sizes, int n_in, void* d_out, int out_size, void* d_ws, size_t ws_size, hipStream_t stream) {
    static int grid = 0;
    if (grid == 0) {
        if (n_in != 29 || out_size != T_ * DM || ws_size < WS_END) { fprintf(stderr, "kernel_launch: unexpected shapes (n_in %d out %d ws %zu need %zu)\n", n_in, out_size, ws_size, (size_t)WS_END); grid = -1; return; }
        int dev = 0, cus = 0, per_cu = 0;
        hipGetDevice(&dev);
        hipDeviceGetAttribute(&cus, hipDeviceAttributeMultiprocessorCount, dev);
        hipFuncSetAttribute((const void*)hymba_fwd, hipFuncAttributeMaxDynamicSharedMemorySize, LDS_BYTES);
        hipOccupancyMaxActiveBlocksPerMultiprocessor(&per_cu, (const void*)hymba_fwd, NTHREADS, LDS_BYTES);
        if (per_cu < 1) { fprintf(stderr, "kernel_launch: occupancy query says %d blocks per CU\n", per_cu); per_cu = 1; }
        (void)hipGetLastError();
        grid = cus;
    }
    if (grid < 0) return;
    Params p{};
    for (int i = 0; i < 29; ++i) p.in[i] = (const float*)d_in[i];
    p.out = (float*)d_out; p.ws = (unsigned char*)d_ws;
#if ONE_LAUNCH
    (void)hipMemsetAsync((unsigned char*)d_ws + WS_BAR, 0, 16384, stream);
    p.ph_lo = 0; p.ph_hi = 38;
    void* args[] = {&p};
    hipError_t e = hipLaunchCooperativeKernel((const void*)hymba_fwd, dim3(grid), dim3(NTHREADS), args, LDS_BYTES, stream);
    if (e != hipSuccess) fprintf(stderr, "cooperative launch failed: %s (grid %d)\n", hipGetErrorString(e), grid);
#else
    for (int ph = 0; ph < 38; ++ph) {
        p.ph_lo = ph; p.ph_hi = ph + 1;
        hipLaunchKernelGGL(hymba_fwd, dim3(grid), dim3(NTHREADS), LDS_BYTES, stream, p);
    }
#endif
}
```

```cpp
#include <hip/hip_runtime.h>
#include <hip/hip_cooperative_groups.h>
#include <cstdio>
namespace cg = cooperative_groups;

#define LAS __attribute__((address_space(3)))
typedef unsigned short bf16_t;
typedef short bf16x8 __attribute__((ext_vector_type(8)));
typedef float f32x4 __attribute__((ext_vector_type(4)));
typedef float f32x2 __attribute__((ext_vector_type(2)));
typedef unsigned u32x4 __attribute__((ext_vector_type(4)));
typedef unsigned u32x2 __attribute__((ext_vector_type(2)));

#ifndef ONE_LAUNCH
#define ONE_LAUNCH 1
#endif
#ifndef PHMASK
#define PHMASK 0xFFFF
#endif
#define PHEN(k) ((PHMASK >> (k)) & 1)
#ifndef REP_SUB
#define REP_SUB -1
#endif
#ifndef REP_CLASS
#define REP_CLASS 7
#endif

constexpr int T_ = 16384, SEQ = 2048, DM = 1024, DFF = 2816, NUP = 5632, NINP = 3072, UW = 2816, DIN = 2848;
constexpr float EPS = 1e-6f;
constexpr float NEGF = -1e30f;
constexpr int NTHREADS = 512;
constexpr int LDS_BYTES = 147456;

constexpr size_t SZ_W13T = (size_t)NUP * DM * 2, SZ_W2T = (size_t)DM * DFF * 2, SZ_WINT = (size_t)NINP * DM * 2, SZ_WOUTT = (size_t)DM * DM * 2, SZ_CW1T = (size_t)256 * 2048 * 2;
constexpr size_t LO_W13A = 0, LO_W2A = LO_W13A + SZ_W13T, LO_W13B = LO_W2A + SZ_W2T, LO_W2B = LO_W13B + SZ_W13T, LO_WIN = LO_W2B + SZ_W2T, LO_WOUT = LO_WIN + SZ_WINT,
                 LO_CW1K = LO_WOUT + SZ_WOUTT, LO_CW1V = LO_CW1K + SZ_CW1T, LAYER_W = LO_CW1V + SZ_CW1T;
constexpr size_t WS_W = 0;
constexpr size_t WS_HB = WS_W + 4 * LAYER_W;
constexpr size_t WS_U = WS_HB + (size_t)T_ * DM * 2;
constexpr size_t WS_HEADS = WS_U + (size_t)T_ * UW * 2;
constexpr size_t SZ_CMPIN = (size_t)16 * 2048 * 64 * 2 + 4096;
constexpr size_t WS_KCMP = WS_HEADS + (size_t)T_ * DM * 2;
constexpr size_t WS_VCMP = WS_KCMP + SZ_CMPIN;
constexpr size_t WS_HID = WS_VCMP + SZ_CMPIN;
constexpr size_t WS_KC = WS_HID + (size_t)4 * 2 * 2048 * 256 * 4;
constexpr size_t WS_GATES = WS_KC + (size_t)2 * 2048 * 64 * 2;
constexpr size_t WS_SSQ = WS_GATES + (size_t)T_ * 32 * 4;
constexpr size_t WS_CBIAS = WS_SSQ + (size_t)2 * T_ * 16 * 4;
constexpr size_t WS_LRUH = WS_CBIAS + 8192;
constexpr size_t WS_LRUA = WS_LRUH + (size_t)T_ * 256 * 4;
constexpr size_t WS_LRUC = WS_LRUA + (size_t)T_ * 256 * 4;
constexpr size_t WS_MLC = WS_LRUC + (size_t)8 * 32 * 256 * 4;
constexpr size_t WS_MLN = WS_MLC + (size_t)1024 * 4096 * 4;
constexpr size_t WS_MLMU = WS_MLN + (size_t)1024 * 64 * 4;
constexpr size_t WS_MLAT = WS_MLMU + 4096;
constexpr size_t WS_MLMP = WS_MLAT + 4096;
constexpr size_t WS_CBP = WS_MLMP + 4096;
constexpr size_t WS_LRUWT = WS_CBP + 262144;
constexpr size_t WS_BAR = WS_LRUWT + 262144;
constexpr size_t WS_END = WS_BAR + 16384;
static_assert(WS_END <= 425365632ull, "workspace too large");
static_assert(LAYER_W % 256 == 0 && WS_HB % 256 == 0 && WS_U % 256 == 0 && WS_KCMP % 256 == 0 && WS_VCMP % 256 == 0 && WS_HID % 256 == 0, "align");

struct Params {
    const float* in[29];
    float* out;
    unsigned char* ws;
    int ph_lo, ph_hi;
};
static_assert(sizeof(Params) == 256, "Params has padding");
#define GAS __attribute__((address_space(1)))
__device__ __forceinline__ unsigned char* ws_of(const Params& p) { unsigned long long w = (unsigned long long)p.ws; asm volatile("" : "+s"(w)); return (unsigned char*)(GAS unsigned char*)w; }
__device__ __forceinline__ float* out_of(const Params& p) { unsigned long long w = (unsigned long long)p.out; asm volatile("" : "+s"(w)); return (float*)(GAS float*)w; }
__device__ __forceinline__ const float* in_of(const Params& p, int i) { unsigned long long w = (unsigned long long)p.in[i]; asm volatile("" : "+s"(w)); return (const float*)(GAS const float*)w; }
__device__ __forceinline__ unsigned cvt_pk_bf16(float lo, float hi) { unsigned r; asm volatile("v_cvt_pk_bf16_f32 %0, %1, %2" : "=v"(r) : "v"(lo), "v"(hi)); return r; }
__device__ __forceinline__ bf16_t f2bf(float f) { return (bf16_t)(cvt_pk_bf16(f, 0.f) & 0xffffu); }
__device__ __forceinline__ float bf2f(bf16_t b) { return __uint_as_float(((unsigned)b) << 16); }
__device__ __forceinline__ float sigmoidf_(float x) { return 1.0f / (1.0f + __expf(-x)); }
__device__ __forceinline__ int opaque_tid() { int x = threadIdx.x; asm volatile("" : "+v"(x)); return x; }
__device__ __forceinline__ float row_rstd(const float* part, int row) {
    const f32x4 a = *(const f32x4*)(part + (size_t)row * 16), b = *(const f32x4*)(part + (size_t)row * 16 + 4), c = *(const f32x4*)(part + (size_t)row * 16 + 8), d = *(const f32x4*)(part + (size_t)row * 16 + 12);
    const float s = (((a[0] + a[1]) + (a[2] + a[3])) + ((b[0] + b[1]) + (b[2] + b[3]))) + (((c[0] + c[1]) + (c[2] + c[3])) + ((d[0] + d[1]) + (d[2] + d[3])));
    return rsqrtf(s * (1.0f / DM) + EPS);
}
__device__ __forceinline__ float fq_max(float x) {
    auto a = __builtin_amdgcn_permlane16_swap(__float_as_uint(x), __float_as_uint(x), false, false);
    const float m = fmaxf(__uint_as_float(a[0]), __uint_as_float(a[1]));
    auto b = __builtin_amdgcn_permlane32_swap(__float_as_uint(m), __float_as_uint(m), false, false);
    return fmaxf(__uint_as_float(b[0]), __uint_as_float(b[1]));
}
__device__ __forceinline__ float fq_sum(float x) {
    auto a = __builtin_amdgcn_permlane16_swap(__float_as_uint(x), __float_as_uint(x), false, false);
    const float m = __uint_as_float(a[0]) + __uint_as_float(a[1]);
    auto b = __builtin_amdgcn_permlane32_swap(__float_as_uint(m), __float_as_uint(m), false, false);
    return __uint_as_float(b[0]) + __uint_as_float(b[1]);
}
__device__ __forceinline__ float wave_sum(float v) {
#pragma unroll
    for (int o = 32; o >= 1; o >>= 1) v += __shfl_xor(v, o);
    return v;
}
__device__ __forceinline__ float wave_max(float v) {
#pragma unroll
    for (int o = 32; o >= 1; o >>= 1) v = fmaxf(v, __shfl_xor(v, o));
    return v;
}

namespace pg8 {
constexpr int BM = 256, BK = 64, HALF = 128, HTB = HALF * BK * 2, STAGE_BYTES = 8 * HTB, NXCD = 8, WGM = 8;
__device__ __forceinline__ int lds_byte(int r, int c) { const int st = (r >> 4) * 2 + (c >> 5), rr = r & 15, cc = c & 31, ob = rr * 64 + cc * 2; return st * 1024 + (ob ^ (((ob >> 9) & 1) << 5)); }
__device__ __forceinline__ void stage_rc(int b, int& R, int& C) { const int st = b / 1024, sb = b % 1024, swz = sb ^ (((sb >> 9) & 1) << 5); R = (st >> 1) * 16 + swz / 64; C = (st & 1) * 32 + (swz % 64) / 2; }

struct Unit { int pm, pn; };
struct Gemm { const bf16_t* A; const bf16_t* Bt; int M, N, K, lda, ldb; };

struct StaticOrder {
    int nM, nN, nwg, G, c;
    __device__ void init(int M, int N, int G_, int c_) { nM = M / BM; nN = N / BM; nwg = nM * nN; G = G_; c = c_; }
    __device__ bool next(int i, Unit& u) const {
        const long L = (long)i * G + c; if (L >= nwg) return false;
        int wgid = (int)L; { const int q = nwg / NXCD, r = nwg % NXCD, xcd = wgid % NXCD, off = wgid / NXCD; wgid = (xcd < r ? xcd * (q + 1) : r * (q + 1) + (xcd - r) * q) + off; }
        const int nig = WGM * nN, gid = wgid / nig, fm = gid * WGM, gsz = (nM - fm) < WGM ? (nM - fm) : WGM;
        u.pm = fm + ((wgid % nig) % gsz); u.pn = (wgid % nig) / gsz; return true;
    }
};
struct SingleUnit {
    int pm;
    __device__ bool next(int i, Unit& u) const { if (i != 0 || pm < 0) return false; u.pm = pm; u.pn = 0; return true; }
};

template <class Epi, class Sched>
__device__ __forceinline__ void gemm_phase(LAS unsigned char* lds, const Gemm g, const Sched& S, const Epi& E) {
    const int tid = opaque_tid(), wid = __builtin_amdgcn_readfirstlane(tid >> 6), lane = tid & 63, wr = wid >> 2, wc = wid & 3, fr = lane & 15, fq = lane >> 4;
    const int K = g.K, nt = K / BK;
    unsigned voffA[2], voffB[2];
#pragma unroll
    for (int i = 0; i < 2; ++i) { int R, C; stage_rc(tid * 16 + i * 8192, R, C);
        voffA[i] = (unsigned)(R * g.lda + C) * 2u; voffB[i] = (unsigned)(R * g.ldb + C) * 2u; }
    const size_t kstep = (size_t)(BK * 2);
    const size_t hstepA = (size_t)HALF * g.lda * 2, hstepB = (size_t)HALF * g.ldb * 2;
    const size_t tstepA = 2 * hstepA, tstepB = 2 * hstepB;
    const unsigned ldsw = (unsigned)wid * 1024u;
    const int aoff = lds_byte(wr * 64 + fr, fq * 8), boff = lds_byte(wc * 32 + fr, fq * 8);
#define PG8_SA(b, h) (((b) * 2 + (h)) * HTB)
#define PG8_SB(b, h) ((4 + (b) * 2 + (h)) * HTB)
#define PG8_STAGE(bufoff, gbase, voff) do { _Pragma("unroll") for (int _i = 0; _i < 2; ++_i) \
        __builtin_amdgcn_global_load_lds((const unsigned*)((const char*)(gbase) + (voff)[_i]), (LAS unsigned*)(lds + (bufoff) + ldsw + _i * 8192), 16, 0, 0); } while (0)
#define PG8_LDA(dst, b, h) do { _Pragma("unroll") for (int m = 0; m < 4; ++m) _Pragma("unroll") for (int k = 0; k < 2; ++k) dst[m][k] = *(const LAS bf16x8*)(lds + PG8_SA(b, h) + aoff + m * 2048 + k * 1024); } while (0)
#define PG8_LDB(dst, b, h) do { _Pragma("unroll") for (int n = 0; n < 2; ++n) _Pragma("unroll") for (int k = 0; k < 2; ++k) dst[n][k] = *(const LAS bf16x8*)(lds + PG8_SB(b, h) + boff + n * 2048 + k * 1024); } while (0)
#define PG8_MMA(ai, bj, At, Bt) do { __builtin_amdgcn_s_setprio(1); _Pragma("unroll") for (int m = 0; m < 4; ++m) _Pragma("unroll") for (int n = 0; n < 2; ++n) _Pragma("unroll") for (int k = 0; k < 2; ++k) \
        acc[ai][bj][m][n] = __builtin_amdgcn_mfma_f32_16x16x32_bf16(Bt[n][k], At[m][k], acc[ai][bj][m][n], 0, 0, 0); __builtin_amdgcn_s_setprio(0); } while (0)
#define PG8_WAIT_V(n) asm volatile("s_waitcnt vmcnt(" #n ")" ::: "memory")
#define PG8_WAIT_L(n) asm volatile("s_waitcnt lgkmcnt(" #n ")" ::: "memory")
#define PG8_BAR __builtin_amdgcn_s_barrier()
#define PG8_SCHED __builtin_amdgcn_sched_barrier(0)
    Unit cur, nxt; int ui = 0;
    if (!S.next(0, cur)) return;
    f32x4 acc[2][2][4][2];
#pragma unroll
    for (int a = 0; a < 2; ++a)
#pragma unroll
        for (int b = 0; b < 2; ++b)
#pragma unroll
            for (int m = 0; m < 4; ++m)
#pragma unroll
                for (int n = 0; n < 2; ++n) acc[a][b][m][n] = (f32x4){0.f, 0.f, 0.f, 0.f};
    bf16x8 At[4][2], B0[2][2], B1[2][2];
    const char* cA = (const char*)g.A + (size_t)cur.pm * tstepA; const char* cB = (const char*)g.Bt + (size_t)cur.pn * tstepB;
    PG8_STAGE(PG8_SB(0, 0), cB, voffB); PG8_STAGE(PG8_SA(0, 0), cA, voffA); PG8_STAGE(PG8_SB(0, 1), cB + hstepB, voffB); PG8_STAGE(PG8_SA(0, 1), cA + hstepA, voffA);
    if (wr == 1) PG8_BAR;
    PG8_WAIT_V(4); PG8_BAR;
    PG8_STAGE(PG8_SB(1, 0), cB + kstep, voffB); PG8_STAGE(PG8_SA(1, 0), cA + kstep, voffA); PG8_STAGE(PG8_SB(1, 1), cB + hstepB + kstep, voffB);
    PG8_WAIT_V(6); PG8_BAR;
    for (;;) {
        const bool has_next = S.next(ui + 1, nxt);
        const char* nA = has_next ? (const char*)g.A + (size_t)nxt.pm * tstepA : cA; const char* nB = has_next ? (const char*)g.Bt + (size_t)nxt.pn * tstepB : cB;
        for (int t = 0; t < nt; t += 2) {
            const bool last = (t == nt - 2);
            const char* a1 = cA + (size_t)(t + 1) * kstep;
            const char* a2 = last ? nA : cA + (size_t)(t + 2) * kstep; const char* b2 = last ? nB : cB + (size_t)(t + 2) * kstep;
            const char* a3 = a2 + kstep; const char* b3 = b2 + kstep;
            PG8_LDB(B0, 0, 0); PG8_SCHED; PG8_LDA(At, 0, 0); PG8_STAGE(PG8_SA(1, 1), a1 + hstepA, voffA);
            PG8_WAIT_L(8); PG8_BAR; PG8_WAIT_L(0); PG8_MMA(0, 0, At, B0); PG8_BAR; PG8_SCHED;
            PG8_LDB(B1, 0, 1); PG8_STAGE(PG8_SB(0, 0), b2, voffB);
            PG8_BAR; PG8_WAIT_L(0); PG8_MMA(0, 1, At, B1); PG8_BAR;
            PG8_LDA(At, 0, 1); PG8_STAGE(PG8_SA(0, 0), a2, voffA);
            PG8_BAR; PG8_WAIT_L(0); PG8_MMA(1, 0, At, B0); PG8_BAR; PG8_SCHED;
            PG8_STAGE(PG8_SB(0, 1), b2 + hstepB, voffB);
            PG8_WAIT_V(6); PG8_BAR; PG8_MMA(1, 1, At, B1); PG8_BAR;
            PG8_LDB(B0, 1, 0); PG8_SCHED; PG8_LDA(At, 1, 0); PG8_STAGE(PG8_SA(0, 1), a2 + hstepA, voffA);
            PG8_WAIT_L(8); PG8_BAR; PG8_WAIT_L(0); PG8_MMA(0, 0, At, B0); PG8_BAR; PG8_SCHED;
            PG8_LDB(B1, 1, 1); PG8_STAGE(PG8_SB(1, 0), b3, voffB);
            PG8_BAR; PG8_WAIT_L(0); PG8_MMA(0, 1, At, B1); PG8_BAR;
            PG8_LDA(At, 1, 1); PG8_STAGE(PG8_SA(1, 0), a3, voffA);
            PG8_BAR; PG8_WAIT_L(0); PG8_MMA(1, 0, At, B0); PG8_BAR; PG8_SCHED;
            PG8_STAGE(PG8_SB(1, 1), b3 + hstepB, voffB);
            PG8_WAIT_V(6); PG8_BAR; PG8_MMA(1, 1, At, B1); PG8_BAR;
        }
        E(acc, cur, wr, wc, fr, fq);
        if (!has_next) break;
#pragma unroll
        for (int a = 0; a < 2; ++a)
#pragma unroll
            for (int b = 0; b < 2; ++b)
#pragma unroll
                for (int m = 0; m < 4; ++m)
#pragma unroll
                    for (int n = 0; n < 2; ++n) acc[a][b][m][n] = (f32x4){0.f, 0.f, 0.f, 0.f};
        cur = nxt; cA = nA; cB = nB; ++ui;
    }
    PG8_WAIT_V(0);
    if (wr == 0) PG8_BAR;
    PG8_BAR;
#undef PG8_SA
#undef PG8_SB
#undef PG8_STAGE
#undef PG8_LDA
#undef PG8_LDB
#undef PG8_MMA
#undef PG8_WAIT_V
#undef PG8_WAIT_L
#undef PG8_BAR
#undef PG8_SCHED
}
}

typedef __attribute__((address_space(1))) float gf32;
typedef __attribute__((address_space(1))) const float gcf32;
typedef __attribute__((address_space(1))) bf16_t gbf16;
typedef __attribute__((address_space(1))) f32x4 gf32x4;
typedef __attribute__((address_space(1))) const f32x4 gcf32x4;
typedef __attribute__((address_space(1))) u32x2 gu32x2;
__device__ __forceinline__ void rows_rstd(const float* ssq, int row0, int fq, float (&r8)[2][4]) {
    f32x4 pv[2][4];
#pragma unroll
    for (int ai = 0; ai < 2; ++ai)
#pragma unroll
        for (int m = 0; m < 4; ++m) pv[ai][m] = *(gcf32x4*)(ssq + (size_t)(row0 + ai * 128 + m * 16) * 16 + 4 * fq);
#pragma unroll
    for (int ai = 0; ai < 2; ++ai)
#pragma unroll
        for (int m = 0; m < 4; ++m) {
            float sm = (pv[ai][m][0] + pv[ai][m][1]) + (pv[ai][m][2] + pv[ai][m][3]);
            sm = fq_sum(sm);
            r8[ai][m] = rsqrtf(sm * (1.0f / DM) + EPS);
        }
}
struct EpiSwiGLU {
    bf16_t* act; const float* ssq;
    __device__ __forceinline__ void operator()(const f32x4 (&acc)[2][2][4][2], const pg8::Unit& u, int wr, int wc, int fr, int fq) const {
        const int row0 = u.pm * 256 + wr * 64 + fr, col0 = u.pn * 128 + wc * 32 + 8 * fq;
        float r8[2][4];
        rows_rstd(ssq, row0, fq, r8);
#pragma unroll
        for (int ai = 0; ai < 2; ++ai)
#pragma unroll
            for (int m = 0; m < 4; ++m) {
                const int row = row0 + ai * 128 + m * 16;
                const float r = r8[ai][m];
                float o[8];
#pragma unroll
                for (int n = 0; n < 2; ++n) {
                    const f32x4 a1 = acc[ai][0][m][n] * r, a3 = acc[ai][1][m][n] * r;
#pragma unroll
                    for (int j = 0; j < 4; ++j) o[4 * n + j] = a1[j] * __builtin_amdgcn_rcpf(1.0f + __expf(-a1[j])) * a3[j];
                }
                u32x4 w; w.x = cvt_pk_bf16(o[0], o[1]); w.y = cvt_pk_bf16(o[2], o[3]); w.z = cvt_pk_bf16(o[4], o[5]); w.w = cvt_pk_bf16(o[6], o[7]);
                *(GAS u32x4*)(act + (size_t)row * DFF + col0) = w;
            }
    }
};
struct EpiResid {
    const float* resid; float* out; bf16_t* hb; float* ssq_next; float scale;
    __device__ __forceinline__ void load2(f32x4 (&rs)[2][2][2], int row0, int col0, int ai, int mp) const {
#pragma unroll
        for (int mm = 0; mm < 2; ++mm)
#pragma unroll
            for (int bj = 0; bj < 2; ++bj)
#pragma unroll
                for (int n = 0; n < 2; ++n)
                    rs[mm][bj][n] = *(gcf32x4*)(resid + (size_t)(row0 + ai * 128 + (2 * mp + mm) * 16) * DM + col0 + bj * 128 + n * 4);
    }
    __device__ __forceinline__ void operator()(const f32x4 (&acc)[2][2][4][2], const pg8::Unit& u, int wr, int wc, int fr, int fq) const {
        const int row0 = u.pm * 256 + wr * 64 + fr, col0 = u.pn * 256 + wc * 32 + 8 * fq;
        f32x4 rsA[2][2][2], rsB[2][2][2];
        load2(rsA, row0, col0, 0, 0);
#pragma unroll
        for (int bt = 0; bt < 4; ++bt) {
            const int ai = bt >> 1, mp = bt & 1;
            if (bt < 3) { if (bt & 1) load2(rsA, row0, col0, (bt + 1) >> 1, (bt + 1) & 1); else load2(rsB, row0, col0, (bt + 1) >> 1, (bt + 1) & 1); }
#pragma unroll
            for (int mm = 0; mm < 2; ++mm) {
                const int m = 2 * mp + mm, row = row0 + ai * 128 + m * 16;
                const size_t off = (size_t)row * DM + col0;
                float ss = 0.f;
#pragma unroll
                for (int bj = 0; bj < 2; ++bj) {
                    const f32x4 r0 = (bt & 1) ? rsB[mm][bj][0] : rsA[mm][bj][0], r1 = (bt & 1) ? rsB[mm][bj][1] : rsA[mm][bj][1];
                    const f32x4 v0 = r0 + acc[ai][bj][m][0] * scale, v1 = r1 + acc[ai][bj][m][1] * scale;
                    *(gf32x4*)(out + off + bj * 128) = v0;
                    *(gf32x4*)(out + off + bj * 128 + 4) = v1;
                    u32x4 w; w.x = cvt_pk_bf16(v0[0], v0[1]); w.y = cvt_pk_bf16(v0[2], v0[3]); w.z = cvt_pk_bf16(v1[0], v1[1]); w.w = cvt_pk_bf16(v1[2], v1[3]);
                    *(GAS u32x4*)(hb + off + bj * 128) = w;
                    ss += ((v0[0] * v0[0] + v0[1] * v0[1]) + (v0[2] * v0[2] + v0[3] * v0[3])) + ((v1[0] * v1[0] + v1[1] * v1[1]) + (v1[2] * v1[2] + v1[3] * v1[3]));
                }
                ss = fq_sum(ss);
                if (fq == 0) *(gf32*)(ssq_next + (size_t)row * 16 + u.pn * 4 + wc) = ss;
            }
            asm volatile("" ::: "memory");
        }
    }
};
struct EpiWin {
    bf16_t* U; bf16_t* kcmp; bf16_t* vcmp; float* gates; const float* ssq;
    __device__ __forceinline__ void operator()(const f32x4 (&acc)[2][2][4][2], const pg8::Unit& u, int wr, int wc, int fr, int fq) const {
        const int row0 = u.pm * 256 + wr * 64 + fr;
        float r8[2][4];
        rows_rstd(ssq, row0, fq, r8);
#pragma unroll
        for (int bj = 0; bj < 2; ++bj) {
            const int c0 = u.pn * 256 + bj * 128 + wc * 32;
            if (c0 >= 2848) continue;
            const float sc = (c0 < 512) ? 0.125f * 1.4426950408889634f : ((c0 >= 2048 && c0 < 2304) ? 0.125f : 1.0f);
            const int cl = 8 * fq;
#pragma unroll
            for (int ai = 0; ai < 2; ++ai)
#pragma unroll
                for (int m = 0; m < 4; ++m) {
                    const int row = row0 + ai * 128 + m * 16;
                    const float r = r8[ai][m] * sc;
                    const f32x4 v0 = acc[ai][bj][m][0] * r, v1 = acc[ai][bj][m][1] * r;
                    if (c0 == 2816) { *(gf32x4*)(gates + (size_t)row * 32 + cl) = v0; *(gf32x4*)(gates + (size_t)row * 32 + cl + 4) = v1; }
                    else {
                        u32x4 w; w.x = cvt_pk_bf16(v0[0], v0[1]); w.y = cvt_pk_bf16(v0[2], v0[3]); w.z = cvt_pk_bf16(v1[0], v1[1]); w.w = cvt_pk_bf16(v1[2], v1[3]);
                        if (c0 >= 512 && c0 < 768) {
                            const int cc = c0 - 512 + cl;
                            const int gg = (cc >> 6) & 1, d = cc & 63;
                            bf16_t* dst = (cc < 128 ? kcmp : vcmp) + ((size_t)(((row >> 11) * 2 + gg) * 2048 + (row & 2047))) * 64 + d;
                            *(GAS u32x4*)dst = w;
                        } else {
                            *(GAS u32x4*)(U + (size_t)row * UW + c0 + cl) = w;
                        }
                    }
                }
        }
    }
};
struct EpiCmp {
    float* part;
    __device__ __forceinline__ void operator()(const f32x4 (&acc)[2][2][4][2], const pg8::Unit& u, int wr, int wc, int fr, int fq) const {
        const int row0 = u.pm * 256 + wr * 64 + fr, col0 = wc * 32 + 8 * fq;
#pragma unroll
        for (int ai = 0; ai < 2; ++ai)
#pragma unroll
            for (int m = 0; m < 4; ++m) {
                const int row = row0 + ai * 128 + m * 16;
#pragma unroll
                for (int bj = 0; bj < 2; ++bj)
#pragma unroll
                    for (int n = 0; n < 2; ++n) *(gf32x4*)(part + (size_t)row * 256 + col0 + bj * 128 + n * 4) = acc[ai][bj][m][n];
            }
    }
};

__device__ __forceinline__ int winmap(int n) {
    if (n < 1280) return n;
    if (n < 2560) return n + 24;
    if (n < 2816) return n + 32;
    if (n < 2840) return 1280 + (n - 2816);
    if (n < 2844) return 2584 + (n - 2840);
    if (n < 2848) return 2588 + (n - 2844);
    return -1;
}
struct TrTile { const float* colp; const float* gain; bf16_t* dst; int ld, K, k0, n0; };
__device__ __forceinline__ void tr_decode(const Params& p, int idx, int tid, TrTile& t) {
    constexpr int TPL = 1376;
    const int l = idx / TPL; int r = idx % TPL;
    int m, ntile, ktile, K;
    if (r < 352) { m = 0; ntile = r % 22; ktile = r / 22; K = DM; }
    else if (r < 528) { r -= 352; m = 1; ntile = r % 4; ktile = r / 4; K = DFF; }
    else if (r < 880) { r -= 528; m = 2; ntile = r % 22; ktile = r / 22; K = DM; }
    else if (r < 1056) { r -= 880; m = 3; ntile = r % 4; ktile = r / 4; K = DFF; }
    else if (r < 1248) { r -= 1056; m = 4; ntile = r % 12; ktile = r / 12; K = DM; }
    else if (r < 1312) { r -= 1248; m = 5; ntile = r % 4; ktile = r / 4; K = DM; }
    else if (r < 1344) { r -= 1312; m = 6; ntile = 0; ktile = r; K = 2048; }
    else { r -= 1344; m = 7; ntile = 0; ktile = r; K = 2048; }
    t.K = K; t.k0 = ktile * 64; t.n0 = ntile * 256; t.colp = nullptr; t.gain = nullptr; t.ld = 0;
    const int npp = t.n0 + 4 * ((tid >> 3));
    const int np = (npp & ~31) + 8 * ((npp & 15) >> 2) + 4 * ((npp >> 4) & 1);
    unsigned char* wl = ws_of(p) + WS_W + (size_t)l * LAYER_W;
    if (m == 0 || m == 2) {
        const int pb = np >> 8, w = np & 255;
        const float* src = (w < 128) ? in_of(p, m == 0 ? 2 : 25) : in_of(p, m == 0 ? 3 : 26);
        t.colp = src + (size_t)l * DM * DFF + pb * 128 + (w & 127); t.ld = DFF; t.gain = in_of(p, m == 0 ? 1 : 24) + l * DM;
        t.dst = (bf16_t*)(wl + (m == 0 ? LO_W13A : LO_W13B));
    } else if (m == 1 || m == 3) {
        t.colp = in_of(p, m == 1 ? 4 : 27) + (size_t)l * DFF * DM + np; t.ld = DM;
        t.dst = (bf16_t*)(wl + (m == 1 ? LO_W2A : LO_W2B));
    } else if (m == 4) {
        const int sc = winmap(np);
        if (sc >= 0) t.colp = in_of(p, 6) + (size_t)l * DM * DIN + sc;
        t.ld = DIN; t.gain = in_of(p, 5) + l * DM;
        t.dst = (bf16_t*)(wl + LO_WIN);
    } else if (m == 5) {
        t.colp = in_of(p, 23) + (size_t)l * DM * DM + np; t.ld = DM;
        t.dst = (bf16_t*)(wl + LO_WOUT);
    } else {
        t.colp = in_of(p, m == 6 ? 8 : 11) + (size_t)l * 2048 * 256 + np; t.ld = 256;
        t.dst = (bf16_t*)(wl + (m == 6 ? LO_CW1K : LO_CW1V));
    }
}
__device__ __forceinline__ void tr_load(const TrTile& t, int tid, f32x4 (&v)[8]) {
    const int kc = (tid & 7);
#pragma unroll
    for (int e = 0; e < 8; ++e) {
        const int k = t.k0 + 8 * kc + e;
        f32x4 x = (f32x4){0.f, 0.f, 0.f, 0.f};
        if (t.colp) { x = *(const f32x4*)(t.colp + (size_t)k * t.ld); if (t.gain) x = x * t.gain[k]; }
        v[e] = x;
    }
}
__device__ void prologue(const Params& p, LAS unsigned char* lds, int bid, int G) {
    const int tid = opaque_tid();
    LAS float* tile = (LAS float*)lds;
    {
        constexpr int N_TR = 4 * 1376;
        int it = bid;
        TrTile t; f32x4 v[8];
        if (it < N_TR) { tr_decode(p, it, tid, t); tr_load(t, tid, v); }
        while (it < N_TR) {
            bf16_t* dst = t.dst + (size_t)(t.n0 + 4 * ((tid >> 3))) * t.K + t.k0 + 8 * ((tid & 7));
            const int K = t.K;
            u32x4 o[4];
#pragma unroll
            for (int q = 0; q < 4; ++q) { o[q].x = cvt_pk_bf16(v[0][q], v[1][q]); o[q].y = cvt_pk_bf16(v[2][q], v[3][q]); o[q].z = cvt_pk_bf16(v[4][q], v[5][q]); o[q].w = cvt_pk_bf16(v[6][q], v[7][q]); }
            const int nx = it + G;
            if (nx < N_TR) { tr_decode(p, nx, tid, t); tr_load(t, tid, v); }
#pragma unroll
            for (int q = 0; q < 4; ++q) *(u32x4*)(dst + (size_t)q * K) = o[q];
            it = nx;
        }
    }
    constexpr int N_BIAS = 256, N_XROW = T_ / 16, N_LW = 32;
    for (int it = bid; it < N_BIAS + N_XROW + N_LW; it += G) {
        if (it >= N_BIAS + N_XROW) {
            const int q = it - N_BIAS - N_XROW, ln = q >> 1, gate = q & 1;
            const float* W = in_of(p, gate ? 17 : 15) + (size_t)ln * 4096;
            bf16_t* WT = (bf16_t*)(ws_of(p) + WS_LRUWT) + (size_t)q * 4096;
#pragma unroll
            for (int rr = 0; rr < 8; ++rr) { const int idx = tid + rr * NTHREADS, d = idx >> 6, c = idx & 63; WT[idx] = f2bf(W[c * 64 + d]); }
        } else if (it < N_BIAS) {
            const int lkv = it >> 5, part = it & 31, l = lkv >> 1, kv = lkv & 1;
            const float* pos = in_of(p, kv ? 10 : 7) + (size_t)l * 2048;
            const float* w1 = in_of(p, kv ? 11 : 8) + (size_t)l * 2048 * 256;
            const int j = tid & 255, half = tid >> 8;
            float sacc = 0.f;
            const int kb = part * 64 + half * 32;
            for (int k = kb; k < kb + 32; k += 8) {
                float a[8];
#pragma unroll
                for (int q = 0; q < 8; ++q) a[q] = w1[(size_t)(k + q) * 256 + j];
#pragma unroll
                for (int q = 0; q < 8; ++q) sacc += pos[k + q] * a[q];
            }
            tile[tid] = sacc;
            __syncthreads();
            if (tid < 256) ((float*)(ws_of(p) + WS_CBP))[(size_t)it * 256 + tid] = tile[tid] + tile[tid + 256];
            __syncthreads();
        } else {
            const int row0 = (it - N_BIAS) * 16 + (tid >> 6) * 2, lane = tid & 63;
            f32x4 xv[2][4];
#pragma unroll
            for (int rq = 0; rq < 2; ++rq)
#pragma unroll
                for (int i = 0; i < 4; ++i) xv[rq][i] = *(const f32x4*)(in_of(p, 0) + (size_t)(row0 + rq) * DM + i * 256 + lane * 4);
#pragma unroll
            for (int rq = 0; rq < 2; ++rq) {
                const int row = row0 + rq;
                bf16_t* hb = (bf16_t*)(ws_of(p) + WS_HB) + (size_t)row * DM;
                float ss = 0.f;
#pragma unroll
                for (int i = 0; i < 4; ++i) {
                    const f32x4 v = xv[rq][i];
                    ss += (v[0] * v[0] + v[1] * v[1]) + (v[2] * v[2] + v[3] * v[3]);
                    u32x2 w; w.x = cvt_pk_bf16(v[0], v[1]); w.y = cvt_pk_bf16(v[2], v[3]);
                    *(u32x2*)(hb + i * 256 + lane * 4) = w;
                }
                ss = wave_sum(ss);
                if (lane < 16) ((float*)(ws_of(p) + WS_SSQ))[(size_t)row * 16 + lane] = (lane == 0) ? ss : 0.f;
            }
        }
    }
}

__device__ void lru_x_item(const Params& p, int l, int b, int n, int ck, LAS unsigned char* lds) {
    const int tid = opaque_tid(), lane = tid & 63, w = __builtin_amdgcn_readfirstlane(tid >> 6), fr = lane & 15, fq = lane >> 4;
    LAS float* xs = (LAS float*)lds;
    LAS float* xc = (LAS float*)(lds + 17152);
    LAS bf16_t* xb = (LAS bf16_t*)(lds + 33536);
    LAS bf16_t* wt = (LAS bf16_t*)(lds + 42752);
    LAS float* pre = (LAS float*)(lds + 61184);
    LAS float* segA = (LAS float*)(lds + 93952);
    LAS float* segH = segA + 512;
    const bf16_t* U = (const bf16_t*)(ws_of(p) + WS_U);
    const int t0 = ck * 64, rowbase = b * SEQ;
    {
        u32x4 xv[2];
#pragma unroll
        for (int rr = 0; rr < 2; ++rr) {
            const int idx = tid + rr * NTHREADS, tt = idx >> 3, ch = idx & 7, t = t0 - 3 + tt;
            xv[rr] = (u32x4){0u, 0u, 0u, 0u};
            if (idx < 67 * 8 && t >= 0) xv[rr] = *(const u32x4*)(U + (size_t)(rowbase + t) * UW + 1280 + n * 64 + ch * 8);
        }
#pragma unroll
        for (int rr = 0; rr < 2; ++rr) {
            const int idx = tid + rr * NTHREADS, tt = idx >> 3, ch = idx & 7;
            if (idx < 67 * 8) {
                f32x4 lo, hi;
                lo[0] = __uint_as_float(xv[rr][0] << 16); lo[1] = __uint_as_float(xv[rr][0] & 0xffff0000u); lo[2] = __uint_as_float(xv[rr][1] << 16); lo[3] = __uint_as_float(xv[rr][1] & 0xffff0000u);
                hi[0] = __uint_as_float(xv[rr][2] << 16); hi[1] = __uint_as_float(xv[rr][2] & 0xffff0000u); hi[2] = __uint_as_float(xv[rr][3] << 16); hi[3] = __uint_as_float(xv[rr][3] & 0xffff0000u);
                *(LAS f32x4*)(xs + tt * 64 + ch * 8) = lo; *(LAS f32x4*)(xs + tt * 64 + ch * 8 + 4) = hi;
            }
        }
    }
    {
        const bf16_t* WT = (const bf16_t*)(ws_of(p) + WS_LRUWT) + (size_t)((l * 4 + n) * 2) * 4096;
#pragma unroll
        for (int rr = 0; rr < 2; ++rr) {
            const int idx = tid + rr * NTHREADS, row = idx >> 3, ch = idx & 7;
            *(LAS u32x4*)(wt + row * 72 + ch * 8) = *(const u32x4*)(WT + row * 64 + ch * 8);
        }
    }
    __syncthreads();
    {
        const float* cw = in_of(p, 13) + (size_t)l * 4 * 256 + n * 64; const float* cb = in_of(p, 14) + l * 256 + n * 64;
        const int c = tid & 63;
        const float w0 = cw[c], w1 = cw[256 + c], w2 = cw[512 + c], w3 = cw[768 + c], bc = cb[c];
#pragma unroll
        for (int k = 0; k < 8; ++k) {
            const int t = (tid >> 6) + 8 * k;
            const float v = bc + xs[t * 64 + c] * w0 + xs[(t + 1) * 64 + c] * w1 + xs[(t + 2) * 64 + c] * w2 + xs[(t + 3) * 64 + c] * w3;
            xc[t * 64 + c] = v; xb[t * 72 + c] = f2bf(v);
        }
    }
    __syncthreads();
    {
        const int tt = w & 3, gate = w >> 2;
        bf16x8 xa[2];
#pragma unroll
        for (int ks = 0; ks < 2; ++ks) xa[ks] = *(const LAS bf16x8*)(xb + (16 * tt + fr) * 72 + 32 * ks + 8 * fq);
        const float* bias = in_of(p, gate ? 18 : 16) + (l * 4 + n) * 64;
#pragma unroll
        for (int dt = 0; dt < 4; ++dt) {
            f32x4 acc = (f32x4){0.f, 0.f, 0.f, 0.f};
#pragma unroll
            for (int ks = 0; ks < 2; ++ks) {
                const bf16x8 wb = *(const LAS bf16x8*)(wt + (gate * 64 + 16 * dt + fr) * 72 + 32 * ks + 8 * fq);
                acc = __builtin_amdgcn_mfma_f32_16x16x32_bf16(xa[ks], wb, acc, 0, 0, 0);
            }
            const float bv = bias[16 * dt + fr];
#pragma unroll
            for (int i = 0; i < 4; ++i) pre[(gate * 64 + 16 * tt + 4 * fq + i) * 64 + 16 * dt + fr] = acc[i] + bv;
        }
    }
    __syncthreads();
    const int d = tid & 63, tq = tid >> 6;
    const float lam = in_of(p, 19)[l * 256 + n * 64 + d];
    const float sp = log1pf(expf(-lam));
    float hl[8], cl[8];
    float h = 0.f, ca = 1.f;
#pragma unroll
    for (int i = 0; i < 8; ++i) {
        const float r = __builtin_amdgcn_rcpf(1.0f + __expf(-pre[(tq * 8 + i) * 64 + d])), ii = __builtin_amdgcn_rcpf(1.0f + __expf(-pre[(64 + tq * 8 + i) * 64 + d]));
        const float la = -8.0f * r * sp;
        const float a = __expf(la);
        const float uu = __builtin_amdgcn_sqrtf(fmaxf(1.0f - a * a, 0.f)) * (ii * xc[(tq * 8 + i) * 64 + d]);
        h = a * h + uu; ca *= a; hl[i] = h; cl[i] = ca;
    }
    segA[tq * 64 + d] = ca; segH[tq * 64 + d] = h;
    __syncthreads();
    float cin_h = 0.f, cin_a = 1.f;
    for (int sgi = 0; sgi < tq; ++sgi) { const float sa = segA[sgi * 64 + d]; cin_h = sa * cin_h + segH[sgi * 64 + d]; cin_a *= sa; }
    float* LH = (float*)(ws_of(p) + WS_LRUH); float* LA = (float*)(ws_of(p) + WS_LRUA);
#pragma unroll
    for (int i = 0; i < 8; ++i) {
        const size_t o = (size_t)(rowbase + t0 + tq * 8 + i) * 256 + n * 64 + d;
        LH[o] = hl[i] + cl[i] * cin_h; LA[o] = cl[i] * cin_a;
    }
    __syncthreads();
}

__device__ __forceinline__ float logsigmoidf_(float x) { return fminf(x, 0.f) - log1pf(expf(-fabsf(x))); }

__device__ __forceinline__ int vt_off(int d, int key, int pitch) {
    const int kc = key >> 3;
    return d * pitch + ((((kc ^ (d >> 3)) & 7) | (kc & ~7)) << 3) + (key & 7);
}
__device__ void ml_x_item(const Params& p, int l, int bh, int ck, LAS unsigned char* lds) {
    const int tid = opaque_tid(), lane = tid & 63, w = __builtin_amdgcn_readfirstlane(tid >> 6), fr = lane & 15, fq = lane >> 4;
    const int b = bh >> 2, hh = bh & 3;
    LAS bf16_t* KwT = (LAS bf16_t*)lds;
    LAS bf16_t* VT = (LAS bf16_t*)(lds + 9216);
    LAS float* wks = (LAS float*)(lds + 20736);
    const bf16_t* U = (const bf16_t*)(ws_of(p) + WS_U);
    const float* GT = (const float*)(ws_of(p) + WS_GATES);
    const int rowbase = b * SEQ + ck * 64;
    if (tid < 64) {
        const float ig = GT[(size_t)(rowbase + lane) * 32 + 24 + hh] + in_of(p, 20)[l * 4 + hh];
        const float fp = GT[(size_t)(rowbase + lane) * 32 + 28 + hh] + in_of(p, 21)[l * 4 + hh];
        float a = logsigmoidf_(fp);
#pragma unroll
        for (int o = 1; o < 64; o <<= 1) { const float t = __shfl_up(a, o); if (lane >= o) a += t; }
        const float A = __shfl(a, 63);
        const float wend = A - a + ig;
        const float mu = wave_max(wend);
        wks[lane] = expf(wend - mu);
        if (lane == 0) { ((float*)(ws_of(p) + WS_MLMU))[bh * 32 + ck] = mu; ((float*)(ws_of(p) + WS_MLAT))[bh * 32 + ck] = A; }
    }
    const int srow = tid >> 3, sch = tid & 7;
    const bf16_t* src = U + (size_t)(rowbase + srow) * UW + hh * 64 + sch * 8;
    const u32x4 kk = *(const u32x4*)(src + 2048);
    {
        const u32x4 vv = *(const u32x4*)(src + 2304);
#pragma unroll
        for (int e = 0; e < 4; ++e) {
            VT[vt_off(sch * 8 + 2 * e, srow, 72)] = (bf16_t)(vv[e] & 0xffffu);
            VT[vt_off(sch * 8 + 2 * e + 1, srow, 72)] = (bf16_t)(vv[e] >> 16);
        }
        for (int idx = tid; idx < 16 * 72; idx += NTHREADS) VT[64 * 72 + idx] = (idx < 72) ? (bf16_t)0x3f80 : (bf16_t)0;
    }
    __syncthreads();
    {
        const float wk = wks[srow];
#pragma unroll
        for (int e = 0; e < 4; ++e) {
            KwT[vt_off(sch * 8 + 2 * e, srow, 72)] = f2bf(wk * __uint_as_float(kk[e] << 16));
            KwT[vt_off(sch * 8 + 2 * e + 1, srow, 72)] = f2bf(wk * __uint_as_float(kk[e] & 0xffff0000u));
        }
    }
    __syncthreads();
    {
        const int dt = w & 3, hf = w >> 2;
        bf16x8 ka[2];
#pragma unroll
        for (int ks = 0; ks < 2; ++ks) ka[ks] = *(const LAS bf16x8*)(KwT + vt_off(16 * dt + fr, 32 * ks + 8 * fq, 72));
        float* C = (float*)(ws_of(p) + WS_MLC) + (size_t)(bh * 32 + ck) * 4096;
#pragma unroll
        for (int ee = 0; ee < 2; ++ee) {
            const int et = 2 * hf + ee;
            f32x4 acc = (f32x4){0.f, 0.f, 0.f, 0.f};
#pragma unroll
            for (int ks = 0; ks < 2; ++ks) {
                const bf16x8 vb = *(const LAS bf16x8*)(VT + vt_off(16 * et + fr, 32 * ks + 8 * fq, 72));
                acc = __builtin_amdgcn_mfma_f32_16x16x32_bf16(ka[ks], vb, acc, 0, 0, 0);
            }
#pragma unroll
            for (int i = 0; i < 4; ++i) C[(16 * dt + 4 * fq + i) * 64 + 16 * et + fr] = acc[i];
        }
        if (hf == 0) {
            f32x4 acc = (f32x4){0.f, 0.f, 0.f, 0.f};
#pragma unroll
            for (int ks = 0; ks < 2; ++ks) {
                const bf16x8 vb = *(const LAS bf16x8*)(VT + (64 + fr) * 72 + 32 * ks + 8 * fq);
                acc = __builtin_amdgcn_mfma_f32_16x16x32_bf16(ka[ks], vb, acc, 0, 0, 0);
            }
            if (fr == 0) {
#pragma unroll
                for (int i = 0; i < 4; ++i) ((float*)(ws_of(p) + WS_MLN))[(size_t)(bh * 32 + ck) * 64 + 16 * dt + 4 * fq + i] = acc[i];
            }
        }
    }
    __syncthreads();
}

__device__ void phase_m2(const Params& p, int l, int cls, LAS unsigned char* lds, int bid, int G) {
    const int tid = opaque_tid();
    constexpr int N_KC = 128, N_LC = 4, N_MC = 256, N_MN = 4, TOTAL = N_KC + N_LC + N_MC + N_MN;
    for (int it = bid; it < TOTAL; it += G) {
        if (it < N_KC) {
            if (!(cls & 1)) continue;
            const int kv = it >> 6, r0 = (it & 63) * 32;
            LAS float* hid = (LAS float*)lds;
            LAS float* w2s = hid + 32 * 256;
            const float* part = (const float*)(ws_of(p) + WS_HID) + (size_t)(kv * 2048 + r0) * 256;
            const float* cb = (const float*)(ws_of(p) + WS_CBIAS) + (l * 2 + kv) * 256;
            const float* w2 = in_of(p, kv ? 12 : 9) + (size_t)l * 256 * 64;
            f32x4 pr[4][4];
#pragma unroll
            for (int rr = 0; rr < 4; ++rr) {
                const int idx = tid + rr * NTHREADS, row = idx >> 6, j4 = (idx & 63) * 4;
#pragma unroll
                for (int kp = 0; kp < 4; ++kp) pr[rr][kp] = *(const f32x4*)(part + (size_t)kp * 2 * 2048 * 256 + row * 256 + j4);
            }
#pragma unroll
            for (int rr = 0; rr < 4; ++rr) {
                const int idx = tid + rr * NTHREADS, row = idx >> 6, j4 = (idx & 63) * 4;
                f32x4 hv = *(const f32x4*)(cb + j4);
#pragma unroll
                for (int kp = 0; kp < 4; ++kp) hv = hv + pr[rr][kp];
#pragma unroll
                for (int q = 0; q < 4; ++q) hv[q] = hv[q] * __builtin_amdgcn_rcpf(1.0f + __expf(-hv[q]));
                *(LAS f32x4*)(hid + row * 256 + j4) = hv;
            }
#pragma unroll
            for (int rr = 0; rr < 8; ++rr) { const int idx = tid + rr * NTHREADS; *(LAS f32x4*)(w2s + idx * 4) = *(const f32x4*)(w2 + idx * 4); }
            __syncthreads();
            {
                const int d = tid & 63, rq = tid >> 6;
                float acc[4] = {0.f, 0.f, 0.f, 0.f};
                for (int j = 0; j < 256; j += 4) {
                    float wv[4];
#pragma unroll
                    for (int q = 0; q < 4; ++q) wv[q] = w2s[(j + q) * 64 + d];
#pragma unroll
                    for (int i = 0; i < 4; ++i) {
                        const f32x4 hv = *(const LAS f32x4*)(hid + (rq * 4 + i) * 256 + j);
#pragma unroll
                        for (int q = 0; q < 4; ++q) acc[i] += hv[q] * wv[q];
                    }
                }
                bf16_t* KCo = (bf16_t*)(ws_of(p) + WS_KC);
#pragma unroll
                for (int i = 0; i < 4; ++i) {
                    const int r = r0 + rq * 4 + i;
                    KCo[(size_t)(kv * 2048 + r) * 64 + d] = f2bf(((r & 127) == 127) ? 0.f : acc[i]);
                }
            }
            __syncthreads();
        } else if (it < N_KC + N_LC) {
            if (!(cls & 2)) continue;
            const int idx = (it - N_KC) * NTHREADS + tid;
            const int b = idx >> 8, ch = idx & 255;
            const float* LH = (const float*)(ws_of(p) + WS_LRUH); const float* LA = (const float*)(ws_of(p) + WS_LRUA);
            float* LC = (float*)(ws_of(p) + WS_LRUC);
            float la[32], lh[32];
#pragma unroll
            for (int ck = 0; ck < 32; ++ck) { const size_t o = (size_t)(b * SEQ + ck * 64 + 63) * 256 + ch; la[ck] = LA[o]; lh[ck] = LH[o]; }
            float carry = 0.f;
#pragma unroll
            for (int ck = 0; ck < 32; ++ck) { LC[(b * 32 + ck) * 256 + ch] = carry; carry = la[ck] * carry + lh[ck]; }
        } else {
            if (!(cls & 4)) continue;
            const bool isn = it >= N_KC + N_LC + N_MC;
            const int idx = (it - N_KC - N_LC - (isn ? N_MC : 0)) * NTHREADS + tid;
            const int bh = isn ? (idx >> 6) : (idx >> 12), de = isn ? (idx & 63) : (idx & 4095);
            const int esz = isn ? 64 : 4096;
            float* buf = (float*)(ws_of(p) + (isn ? WS_MLN : WS_MLC)) + (size_t)bh * 32 * esz + de;
            const float* MU = (const float*)(ws_of(p) + WS_MLMU) + bh * 32; const float* AT = (const float*)(ws_of(p) + WS_MLAT) + bh * 32;
            float* MP = (float*)(ws_of(p) + WS_MLMP) + bh * 32;
            float dc[32];
#pragma unroll
            for (int ck = 0; ck < 32; ++ck) dc[ck] = buf[(size_t)ck * esz];
            float C = 0.f, m = 0.f;
#pragma unroll
            for (int ck = 0; ck < 32; ++ck) {
                buf[(size_t)ck * esz] = C;
                if (!isn && de == 0) MP[ck] = m;
                const float at = AT[ck], mu = MU[ck];
                const float mn = fmaxf(at + m, mu);
                C = expf(at + m - mn) * C + expf(mu - mn) * dc[ck];
                m = mn;
            }
        }
    }
}

__device__ __forceinline__ float gelu_tanh(float x) { const float u = 0.7978845608028654f * (x + 0.044715f * x * x * x); return 0.5f * x * (1.0f + tanhf(u)); }

__device__ void lru_y_item(const Params& p, int l, int item) {
    const int tid = opaque_tid(), lane = tid & 63;
    const float* LH = (const float*)(ws_of(p) + WS_LRUH); const float* LA = (const float*)(ws_of(p) + WS_LRUA); const float* LC = (const float*)(ws_of(p) + WS_LRUC);
    const bf16_t* U = (const bf16_t*)(ws_of(p) + WS_U);
    const float* hn = in_of(p, 22) + l * 1024;
    bf16_t* HD = (bf16_t*)(ws_of(p) + WS_HEADS);
    const int pair0 = item * 64 + (tid >> 6) * 8;
    float lh[8], la[8], lc[8], gg[8], gn[8];
#pragma unroll
    for (int q = 0; q < 8; ++q) {
        const int pair = pair0 + q, row = pair >> 2, n = pair & 3, ch = n * 64 + lane;
        lh[q] = LH[(size_t)row * 256 + ch]; la[q] = LA[(size_t)row * 256 + ch];
        lc[q] = LC[((row >> 11) * 32 + ((row & 2047) >> 6)) * 256 + ch];
        gg[q] = bf2f(U[(size_t)row * UW + 1536 + ch]);
        gn[q] = hn[(8 + n) * 64 + lane];
    }
#pragma unroll
    for (int q = 0; q < 8; ++q) {
        const int pair = pair0 + q, row = pair >> 2, n = pair & 3;
        const float h = lh[q] + la[q] * lc[q];
        const float y = h * gelu_tanh(gg[q]);
        const float ss = wave_sum(y * y);
        HD[(size_t)row * DM + (8 + n) * 64 + lane] = f2bf(y * rsqrtf(ss * (1.0f / 64.0f) + EPS) * gn[q]);
    }
}

__device__ __forceinline__ int vt_lane(int fr, int fq, int pitch) { return fr * pitch + ((((fq >> 1) ^ (fr >> 3)) & 1) << 3) + ((fq & 1) << 2); }
__device__ __forceinline__ constexpr int vt_cst(int dt, int kc2, int pitch) { return dt * 16 * pitch + ((((kc2 ^ (2 * dt)) & 6) | (kc2 & ~7)) << 3); }
__device__ void ml_y_item(const Params& p, int l, int bh, int ck, LAS unsigned char* lds) {
    const int tid = opaque_tid(), lane = tid & 63, w = __builtin_amdgcn_readfirstlane(tid >> 6), fr = lane & 15, fq = lane >> 4;
    const int b = bh >> 2, hh = bh & 3;
    LAS bf16_t* Ql = (LAS bf16_t*)lds;
    LAS bf16_t* Kl = (LAS bf16_t*)(lds + 9216);
    LAS bf16_t* Vt = (LAS bf16_t*)(lds + 18432);
    LAS bf16_t* Ct = (LAS bf16_t*)(lds + 27648);
    LAS bf16_t* Wl = (LAS bf16_t*)(lds + 39168);
    LAS float* as_ = (LAS float*)(lds + 57600);
    LAS float* bs_ = as_ + 64;
    LAS float* Ms_ = bs_ + 64;
    LAS float* ssl = Ms_ + 64;
    const bf16_t* U = (const bf16_t*)(ws_of(p) + WS_U);
    const float* GT = (const float*)(ws_of(p) + WS_GATES);
    const int rowbase = b * SEQ + ck * 64;
    const float mprev = ((const float*)(ws_of(p) + WS_MLMP))[bh * 32 + ck];
    if (tid < 64) {
        const float ig = GT[(size_t)(rowbase + lane) * 32 + 24 + hh] + in_of(p, 20)[l * 4 + hh];
        const float fp = GT[(size_t)(rowbase + lane) * 32 + 28 + hh] + in_of(p, 21)[l * 4 + hh];
        float a = logsigmoidf_(fp);
#pragma unroll
        for (int o = 1; o < 64; o <<= 1) { const float t = __shfl_up(a, o); if (lane >= o) a += t; }
        const float bb = ig - a;
        float pm = bb;
#pragma unroll
        for (int o = 1; o < 64; o <<= 1) { const float t = __shfl_up(pm, o); if (lane >= o) pm = fmaxf(pm, t); }
        as_[lane] = a; bs_[lane] = bb; Ms_[lane] = fmaxf(mprev, pm);
        Ct[64 * 72 + lane] = f2bf(((const float*)(ws_of(p) + WS_MLN))[(size_t)(bh * 32 + ck) * 64 + lane]);
    }
    {
        const int row = tid >> 3, ch = tid & 7;
        const bf16_t* src = U + (size_t)(rowbase + row) * UW + hh * 64 + ch * 8;
        *(LAS u32x4*)(Ql + row * 72 + ch * 8) = *(const u32x4*)(src + 1792);
        *(LAS u32x4*)(Kl + row * 72 + ch * 8) = *(const u32x4*)(src + 2048);
        const u32x4 vv = *(const u32x4*)(src + 2304);
#pragma unroll
        for (int e = 0; e < 4; ++e) {
            Vt[vt_off(ch * 8 + 2 * e, row, 72)] = (bf16_t)(vv[e] & 0xffffu);
            Vt[vt_off(ch * 8 + 2 * e + 1, row, 72)] = (bf16_t)(vv[e] >> 16);
        }
        const float* C = (const float*)(ws_of(p) + WS_MLC) + (size_t)(bh * 32 + ck) * 4096;
#pragma unroll
        for (int rr = 0; rr < 2; ++rr) {
            const int idx = tid + rr * NTHREADS, d = idx >> 4, e4 = (idx & 15) * 4;
            const f32x4 c = *(const f32x4*)(C + d * 64 + e4);
#pragma unroll
            for (int i = 0; i < 4; ++i) Ct[(e4 + i) * 72 + d] = f2bf(c[i]);
        }
        for (int idx = tid; idx < 15 * 72; idx += NTHREADS) Ct[65 * 72 + idx] = 0;
    }
    __syncthreads();
    const int jt = w & 3, hf = w >> 2;
    bf16_t opre[2][4];
#pragma unroll
    for (int i = 0; i < 4; ++i)
#pragma unroll
        for (int ee = 0; ee < 2; ++ee) opre[ee][i] = U[(size_t)(rowbase + 16 * jt + 4 * fq + i) * UW + 2560 + hh * 64 + 16 * (2 * hf + ee) + fr];
    bf16x8 qa[2];
#pragma unroll
    for (int ks = 0; ks < 2; ++ks) qa[ks] = *(const LAS bf16x8*)(Ql + (16 * jt + fr) * 72 + 32 * ks + 8 * fq);
    f32x4 sacc[4];
#pragma unroll
    for (int st = 0; st < 4; ++st) {
        const bf16x8 k0 = *(const LAS bf16x8*)(Kl + (16 * st + fr) * 72 + 8 * fq), k1 = *(const LAS bf16x8*)(Kl + (16 * st + fr) * 72 + 32 + 8 * fq);
        sacc[st] = __builtin_amdgcn_mfma_f32_16x16x32_bf16(qa[0], k0, (f32x4){0.f, 0.f, 0.f, 0.f}, 0, 0, 0);
        sacc[st] = __builtin_amdgcn_mfma_f32_16x16x32_bf16(qa[1], k1, sacc[st], 0, 0, 0);
    }
    float sw[4], Mj[4];
    LAS bf16_t* Ww = Wl + w * (16 * 72);
#pragma unroll
    for (int i = 0; i < 4; ++i) {
        const int j = 16 * jt + 4 * fq + i;
        Mj[i] = Ms_[j];
        float acc = 0.f;
#pragma unroll
        for (int st = 0; st < 4; ++st) {
            const int sidx = 16 * st + fr;
            const float wv = (sidx <= j) ? __expf(bs_[sidx] - Mj[i]) * sacc[st][i] : 0.f;
            acc += wv;
            Ww[(4 * fq + i) * 72 + sidx] = f2bf(wv);
        }
        acc += __shfl_xor(acc, 1); acc += __shfl_xor(acc, 2); acc += __shfl_xor(acc, 4); acc += __shfl_xor(acc, 8);
        sw[i] = acc;
    }
    asm volatile("s_waitcnt lgkmcnt(0)" ::: "memory");
    bf16x8 wa[2];
#pragma unroll
    for (int ks = 0; ks < 2; ++ks) wa[ks] = *(const LAS bf16x8*)(Ww + fr * 72 + 32 * ks + 8 * fq);
    f32x4 acc1[2], acc2[2], accn;
#pragma unroll
    for (int ee = 0; ee < 2; ++ee) {
        const int et = 2 * hf + ee;
        acc1[ee] = (f32x4){0.f, 0.f, 0.f, 0.f}; acc2[ee] = (f32x4){0.f, 0.f, 0.f, 0.f};
#pragma unroll
        for (int ks = 0; ks < 2; ++ks) {
            const bf16x8 cf = *(const LAS bf16x8*)(Ct + (16 * et + fr) * 72 + 32 * ks + 8 * fq);
            const bf16x8 vf = *(const LAS bf16x8*)(Vt + vt_off(16 * et + fr, 32 * ks + 8 * fq, 72));
            acc1[ee] = __builtin_amdgcn_mfma_f32_16x16x32_bf16(qa[ks], cf, acc1[ee], 0, 0, 0);
            acc2[ee] = __builtin_amdgcn_mfma_f32_16x16x32_bf16(wa[ks], vf, acc2[ee], 0, 0, 0);
        }
    }
    accn = (f32x4){0.f, 0.f, 0.f, 0.f};
#pragma unroll
    for (int ks = 0; ks < 2; ++ks) {
        const bf16x8 cf = *(const LAS bf16x8*)(Ct + (64 + fr) * 72 + 32 * ks + 8 * fq);
        accn = __builtin_amdgcn_mfma_f32_16x16x32_bf16(qa[ks], cf, accn, 0, 0, 0);
    }
    float ov[2][4];
#pragma unroll
    for (int i = 0; i < 4; ++i) {
        const int j = 16 * jt + 4 * fq + i;
        const float qn = __shfl(accn[i], lane & 48);
        const float inter = expf(mprev - Mj[i]);
        const float den = inter * qn + sw[i];
        const float lim = expf(-(as_[j] + Mj[i]));
        const float inv = 1.0f / fmaxf(fabsf(den), lim);
        float ssp = 0.f;
#pragma unroll
        for (int ee = 0; ee < 2; ++ee) {
            const int e = 16 * (2 * hf + ee) + fr;
            const float hv = (inter * acc1[ee][i] + acc2[ee][i]) * inv;
            const float o = sigmoidf_(bf2f(opre[ee][i])) * hv;
            ov[ee][i] = o; ssp += o * o;
        }
        ssp += __shfl_xor(ssp, 1); ssp += __shfl_xor(ssp, 2); ssp += __shfl_xor(ssp, 4); ssp += __shfl_xor(ssp, 8);
        if (fr == 0) ssl[w * 16 + 4 * fq + i] = ssp;
    }
    __syncthreads();
    {
        bf16_t* HD = (bf16_t*)(ws_of(p) + WS_HEADS);
        const float* hn = in_of(p, 22) + l * 1024 + (12 + hh) * 64;
#pragma unroll
        for (int i = 0; i < 4; ++i) {
            const int j = 16 * jt + 4 * fq + i;
            const float tot = ssl[jt * 16 + 4 * fq + i] + ssl[(jt + 4) * 16 + 4 * fq + i];
            const float rs = rsqrtf(tot * (1.0f / 64.0f) + EPS);
#pragma unroll
            for (int ee = 0; ee < 2; ++ee) {
                const int e = 16 * (2 * hf + ee) + fr;
                HD[(size_t)(rowbase + j) * DM + (12 + hh) * 64 + e] = f2bf(ov[ee][i] * rs * hn[e]);
            }
        }
    }
    __syncthreads();
}

__device__ __forceinline__ bf16x8 pack8(const f32x4 lo, const f32x4 hi) {
    u32x4 r; r.x = cvt_pk_bf16(lo[0], lo[1]); r.y = cvt_pk_bf16(lo[2], lo[3]); r.z = cvt_pk_bf16(hi[0], hi[1]); r.w = cvt_pk_bf16(hi[2], hi[3]);
    return __builtin_bit_cast(bf16x8, r);
}
__device__ __forceinline__ bf16x8 join8(const u32x2 lo, const u32x2 hi) { u32x4 r; r.x = lo.x; r.y = lo.y; r.z = hi.x; r.w = hi.y; return __builtin_bit_cast(bf16x8, r); }
__device__ void nsa_item(const Params& p, int l, int b, int g, int qb, LAS unsigned char* lds, int mode = 0) {
    int tid = opaque_tid(), w = __builtin_amdgcn_readfirstlane(tid >> 6), lane = tid & 63, fr = lane & 15, fq = lane >> 4;
    LAS bf16_t* Kc = (LAS bf16_t*)lds;
    LAS bf16_t* Vc = (LAS bf16_t*)(lds + 18432);
    LAS bf16_t* Pl = (LAS bf16_t*)(lds + 36864);
    LAS float* impl = (LAS float*)(lds + 106496);
    LAS unsigned* selm = (LAS unsigned*)(lds + 114688);
    LAS int* steps = (LAS int*)(lds + 114944);
    const bf16_t* U = (const bf16_t*)(ws_of(p) + WS_U);
    const int bg = b * 2 + g, rowbase = b * SEQ;
    const int head = 4 * g + (w >> 1);
    const float sl2 = exp2f(-(float)(head + 1)) * 1.4426950408889634f;
    const int tw0 = qb * 64 + (w & 1) * 32;
    bf16x8 qf[2][2];
#pragma unroll
    for (int mt = 0; mt < 2; ++mt)
#pragma unroll
        for (int ks = 0; ks < 2; ++ks)
            qf[mt][ks] = *(const bf16x8*)(U + (size_t)(rowbase + tw0 + mt * 16 + fr) * UW + head * 64 + ks * 32 + fq * 8);
    const float* GT = (const float*)(ws_of(p) + WS_GATES);
    float gpre[2][3];
#pragma unroll
    for (int mt = 0; mt < 2; ++mt)
#pragma unroll
        for (int q = 0; q < 3; ++q) gpre[mt][q] = GT[(size_t)(rowbase + tw0 + mt * 16 + fr) * 32 + head * 3 + q];
    f32x4 y[2][4];
    {
        LAS float* impM = (LAS float*)Pl;
        LAS float* impT = impM + 4 * 64 * 33;
        const bf16_t* KC = (const bf16_t*)(ws_of(p) + WS_KC) + (size_t)bg * 128 * 64;
        const bf16_t* VC = KC + (size_t)2048 * 64;
        u32x4 kvr[2], vvr[2];
#pragma unroll
        for (int rr = 0; rr < 2; ++rr) { const int idx = tid + rr * NTHREADS; kvr[rr] = *(const u32x4*)(KC + idx * 8); vvr[rr] = *(const u32x4*)(VC + idx * 8); }
#pragma unroll
        for (int rr = 0; rr < 2; ++rr) {
            const int idx = tid + rr * NTHREADS, key = idx >> 3, ch = idx & 7;
            const u32x4 kv = kvr[rr];
            const u32x4 vv = vvr[rr];
            *(LAS u32x4*)(Kc + key * 72 + ch * 8) = kv;
#pragma unroll
            for (int e = 0; e < 4; ++e) {
                Vc[vt_off(ch * 8 + 2 * e, key, 136)] = (bf16_t)(vv[e] & 0xffffu);
                Vc[vt_off(ch * 8 + 2 * e + 1, key, 136)] = (bf16_t)(vv[e] >> 16);
            }
        }
        __syncthreads();
        const int vl136 = vt_lane(fr, fq, 136);
#pragma unroll
        for (int mt = 0; mt < 2; ++mt) {
            const int t = tw0 + mt * 16 + fr;
            f32x4 s[8];
#pragma unroll
            for (int nt = 0; nt < 8; ++nt) {
                const bf16x8 k0 = *(const LAS bf16x8*)(Kc + (16 * nt + fr) * 72 + fq * 8), k1 = *(const LAS bf16x8*)(Kc + (16 * nt + fr) * 72 + 32 + fq * 8);
                s[nt] = __builtin_amdgcn_mfma_f32_16x16x32_bf16(k0, qf[mt][0], (f32x4){0.f, 0.f, 0.f, 0.f}, 0, 0, 0);
                s[nt] = __builtin_amdgcn_mfma_f32_16x16x32_bf16(k1, qf[mt][1], s[nt], 0, 0, 0);
            }
            float mx = NEGF;
#pragma unroll
            for (int nt = 0; nt < 8; ++nt)
#pragma unroll
                for (int i = 0; i < 4; ++i) {
                    const int n = 16 * nt + 4 * fq + i, cend = 16 * n + 31;
                    const bool valid = (t >= cend) && (n < 127);
                    const float sv = valid ? fmaf(sl2, (float)cend, s[nt][i]) : NEGF;
                    s[nt][i] = sv; mx = fmaxf(mx, sv);
                }
            mx = fq_max(mx);
            const float ms = (mx < -1e29f) ? 0.f : mx;
            float sum = 0.f;
#pragma unroll
            for (int nt = 0; nt < 8; ++nt)
#pragma unroll
                for (int i = 0; i < 4; ++i) { const float pv = __builtin_amdgcn_exp2f(s[nt][i] - ms); s[nt][i] = pv; sum += pv; }
            sum = fq_sum(sum);
            const float inv = sum > 0.f ? 1.0f / sum : 0.f;
            {
                LAS float* mrow_ = impM + ((w >> 1) * 64 + (w & 1) * 32 + mt * 16 + fr) * 33 + fq;
                LAS float* trow_ = impT + ((w >> 1) * 64 + (w & 1) * 32 + mt * 16 + fr) * 33 + fq + 1;
#pragma unroll
                for (int nt = 0; nt < 8; ++nt) {
                    s[nt] = s[nt] * inv;
                    mrow_[4 * nt] = (s[nt][0] + s[nt][1]) + (s[nt][2] + s[nt][3]);
                    trow_[4 * nt] = s[nt][3];
                }
            }
            f32x4 oc[4];
#pragma unroll
            for (int dt = 0; dt < 4; ++dt) oc[dt] = (f32x4){0.f, 0.f, 0.f, 0.f};
#pragma unroll
            for (int ks2 = 0; ks2 < 4; ++ks2) {
                const bf16x8 pb = pack8(s[2 * ks2], s[2 * ks2 + 1]);
#pragma unroll
                for (int dt = 0; dt < 4; ++dt) {
                    const u32x2 lo = *(const LAS u32x2*)(Vc + vl136 + vt_cst(dt, 4 * ks2, 136));
                    const u32x2 hi = *(const LAS u32x2*)(Vc + vl136 + vt_cst(dt, 4 * ks2 + 2, 136));
                    oc[dt] = __builtin_amdgcn_mfma_f32_16x16x32_bf16(join8(lo, hi), pb, oc[dt], 0, 0, 0);
                }
            }
            const float g0 = sigmoidf_(gpre[mt][0]);
#pragma unroll
            for (int dt = 0; dt < 4; ++dt) y[mt][dt] = oc[dt] * g0;
        }
        if (tid < 256) impT[tid * 33] = 0.f;
        __syncthreads();
#pragma unroll 1
        for (int rr = 0; rr < 4; ++rr) {
            const int idx = tid + rr * NTHREADS, tau = idx >> 5, j = idx & 31;
            float mine = 0.f;
#pragma unroll
            for (int hh = 0; hh < 4; ++hh) mine += impM[(hh * 64 + tau) * 33 + j] + impT[(hh * 64 + tau) * 33 + j];
            bool sel;
            if (qb < 16) sel = (j <= qb);
            else {
                const bool forced = (j == 0) || (j == qb) || (j == qb - 1);
                const bool cand = (j >= 1) && (j <= qb - 2);
                int rank = 0;
#pragma unroll
                for (int jp = 1; jp < 30; ++jp) {
                    const float o = __shfl(mine, (lane & 32) + jp);
                    rank += (jp <= qb - 2 && (o > mine || (o == mine && jp < j))) ? 1 : 0;
                }
                sel = forced || (cand && rank < 13);
            }
            const unsigned long long bal = __ballot(sel);
            if ((lane & 31) == 0) selm[tau] = (lane < 32) ? (unsigned)bal : (unsigned)(bal >> 32);
        }
        __syncthreads();
        if (tid < 64) {
            unsigned m = selm[tid], uni = m, all = m;
#pragma unroll
            for (int o = 32; o >= 1; o >>= 1) { uni |= __shfl_xor(uni, o); all &= __shfl_xor(all, o); }
            uni &= (qb >= 31) ? 0xffffffffu : ((2u << qb) - 1u);
            const int nsel = __popc(uni);
            const int kb = tid;
            if (kb <= qb && ((uni >> kb) & 1u)) {
                const int pos = __popc(uni & ((1u << kb) - 1u));
                steps[1 + pos] = ((((all >> kb) & 1u) && kb < qb) ? 4096 : 0) | (1 << 8) | kb;
            }
            const int kb0 = (qb - 8 < 0) ? 0 : qb - 8;
            if (kb >= kb0 && kb <= qb) steps[1 + nsel + (kb - kb0)] = ((kb > qb - 8 && kb < qb) ? 4096 : 0) | (2 << 8) | kb;
            if (tid == 0) steps[0] = nsel + (qb - kb0 + 1);
        }
        __syncthreads();
    }
    if (mode == 1) { asm volatile("" :: "v"(y[0][0][0]), "v"(y[1][3][3])); __syncthreads(); return; }
    tid = opaque_tid(); w = __builtin_amdgcn_readfirstlane(tid >> 6); lane = tid & 63; fr = lane & 15; fq = lane >> 4;
    unsigned smask[2];
#pragma unroll
    for (int mt = 0; mt < 2; ++mt) smask[mt] = selm[(w & 1) * 32 + mt * 16 + fr];
    const int nsteps = __builtin_amdgcn_readfirstlane(steps[0]);
    const int mystep = steps[1 + (lane < 48 ? lane : 47)];
#define NSA_ST(k) __builtin_amdgcn_readlane(mystep, (k))
    float mrow[2], lrow[2];
    f32x4 oacc[2][4];
#pragma unroll
    for (int mt = 0; mt < 2; ++mt) {
        mrow[mt] = NEGF; lrow[mt] = 0.f;
#pragma unroll
        for (int dt = 0; dt < 4; ++dt) oacc[mt][dt] = (f32x4){0.f, 0.f, 0.f, 0.f};
    }
    const int skey = tid >> 3, sch = tid & 7;
    const int vl72 = vt_lane(fr, fq, 72);
    const int vsw = vt_off(sch * 8, skey, 72);
    bf16x8 kx[4], qx;
    {
        const float sh = bf2f(f2bf(sl2)), slo = sl2 - sh;
        u32x4 t = (u32x4){0u, 0u, 0u, 0u};
        if (fq == 0) t.x = cvt_pk_bf16(sh, slo);
        qx = __builtin_bit_cast(bf16x8, t);
#pragma unroll
        for (int nt = 0; nt < 4; ++nt) {
            u32x4 k = (u32x4){0u, 0u, 0u, 0u};
            const float r = (float)(16 * nt + fr);
            if (fq == 0) k.x = cvt_pk_bf16(r, r);
            kx[nt] = __builtin_bit_cast(bf16x8, k);
        }
    }
    const bf16_t* Ubase = U + (size_t)(rowbase + skey) * UW + g * 64 + sch * 8;
#define NSA_SRC(st_) (Ubase + (size_t)((st_) & 255) * 64 * UW + ((((st_) >> 8) & 15) == 1 ? 768 : 1024))
#define NSA_STAGE(buf_, kr_, vr_) do { \
        *(LAS u32x4*)(Kc + (buf_) * (64 * 72) + skey * 72 + sch * 8) = kr_; \
        LAS bf16_t* _vn = Vc + (buf_) * (64 * 72) + vsw; \
        _Pragma("unroll") for (int e = 0; e < 4; ++e) { _vn[(2 * e) * 72] = (bf16_t)(vr_[e] & 0xffffu); _vn[(2 * e + 1) * 72] = (bf16_t)(vr_[e] >> 16); } } while (0)
    u32x4 kregA, vregA;
    {
        const bf16_t* src = NSA_SRC(NSA_ST(0));
        kregA = *(const u32x4*)src; vregA = *(const u32x4*)(src + 128);
        NSA_STAGE(0, kregA, vregA);
    }
    if (nsteps > 1) { const bf16_t* src = NSA_SRC(NSA_ST(1)); kregA = *(const u32x4*)src; vregA = *(const u32x4*)(src + 128); }
    __syncthreads();
    int curkind = 1;
#define NSA_STEP(si, kX, vX) do { \
        const int st = NSA_ST(si), kind = (st >> 8) & 15, kb = st & 255; \
        const bool nomask = (st & 4096) != 0; \
        LAS bf16_t* Kl = Kc + ((si) & 1) * (64 * 72); \
        LAS bf16_t* Vt = Vc + ((si) & 1) * (64 * 72); \
        if (kind != curkind) { \
            _Pragma("unroll") for (int mt = 0; mt < 2; ++mt) { \
                float lt = lrow[mt]; \
                lt = fq_sum(lt); \
                const float sc = sigmoidf_(gpre[mt][1]) / lt; \
                _Pragma("unroll") for (int dt = 0; dt < 4; ++dt) { y[mt][dt] += oacc[mt][dt] * sc; oacc[mt][dt] = (f32x4){0.f, 0.f, 0.f, 0.f}; } \
                mrow[mt] = NEGF; lrow[mt] = 0.f; \
            } \
            curkind = kind; \
        } \
        const float Bs = sl2 * (float)(kb * 64); \
        int kbi = kb * 64 + 4 * fq; \
        asm volatile("" : "+v"(kbi)); \
        f32x4 s[2][4]; \
        _Pragma("unroll") for (int nt = 0; nt < 4; ++nt) { \
            const bf16x8 k0 = *(const LAS bf16x8*)(Kl + (16 * nt + fr) * 72 + fq * 8), k1 = *(const LAS bf16x8*)(Kl + (16 * nt + fr) * 72 + 32 + fq * 8); \
            _Pragma("unroll") for (int mt = 0; mt < 2; ++mt) { \
                s[mt][nt] = __builtin_amdgcn_mfma_f32_16x16x32_bf16(k0, qf[mt][0], (f32x4){0.f, 0.f, 0.f, 0.f}, 0, 0, 0); \
                s[mt][nt] = __builtin_amdgcn_mfma_f32_16x16x32_bf16(k1, qf[mt][1], s[mt][nt], 0, 0, 0); \
                s[mt][nt] = __builtin_amdgcn_mfma_f32_16x16x32_bf16(kx[nt], qx, s[mt][nt], 0, 0, 0); \
            } \
        } \
        bf16x8 pb[2][2]; \
        _Pragma("unroll") for (int mt = 0; mt < 2; ++mt) { \
            float mx = NEGF; \
            if (nomask) { \
                _Pragma("unroll") for (int nt = 0; nt < 4; ++nt) \
                    _Pragma("unroll") for (int i = 0; i < 4; ++i) mx = fmaxf(mx, s[mt][nt][i]); \
            } else { \
                const int t = tw0 + mt * 16 + fr; \
                const bool rowok = (kind == 1) ? (((smask[mt] >> kb) & 1u) != 0u) : true; \
                _Pragma("unroll") for (int nt = 0; nt < 4; ++nt) \
                    _Pragma("unroll") for (int i = 0; i < 4; ++i) { \
                        const int dist = t - (kbi + 16 * nt + i); \
                        const bool valid = rowok && dist >= 0 && (kind == 1 || dist < 512); \
                        const float sv = valid ? s[mt][nt][i] : NEGF; \
                        s[mt][nt][i] = sv; mx = fmaxf(mx, sv); \
                    } \
            } \
            mx = fq_max(mx) + Bs; \
            const float mn = fmaxf(mrow[mt], mx); \
            const float alpha = __builtin_amdgcn_exp2f(mrow[mt] - mn); \
            mrow[mt] = mn; \
            const float ms = ((mn < -1e29f) ? 0.f : mn) - Bs; \
            float ls = 0.f; \
            _Pragma("unroll") for (int nt = 0; nt < 4; ++nt) \
                _Pragma("unroll") for (int i = 0; i < 4; ++i) { const float pv = __builtin_amdgcn_exp2f(s[mt][nt][i] - ms); s[mt][nt][i] = pv; ls += pv; } \
            lrow[mt] = lrow[mt] * alpha + ls; \
            _Pragma("unroll") for (int dt = 0; dt < 4; ++dt) oacc[mt][dt] = oacc[mt][dt] * alpha; \
            pb[mt][0] = pack8(s[mt][0], s[mt][1]); pb[mt][1] = pack8(s[mt][2], s[mt][3]); \
        } \
        _Pragma("unroll") for (int ks2 = 0; ks2 < 2; ++ks2) \
            _Pragma("unroll") for (int dt = 0; dt < 4; ++dt) { \
                const u32x2 lo = *(const LAS u32x2*)(Vt + vl72 + vt_cst(dt, 4 * ks2, 72)); \
                const u32x2 hi = *(const LAS u32x2*)(Vt + vl72 + vt_cst(dt, 4 * ks2 + 2, 72)); \
                const bf16x8 va = join8(lo, hi); \
                _Pragma("unroll") for (int mt = 0; mt < 2; ++mt) oacc[mt][dt] = __builtin_amdgcn_mfma_f32_16x16x32_bf16(va, pb[mt][ks2], oacc[mt][dt], 0, 0, 0); \
            } \
        if ((si) + 1 < nsteps) NSA_STAGE(((si) + 1) & 1, kX, vX); \
        if ((si) + 2 < nsteps) { const bf16_t* src = NSA_SRC(NSA_ST((si) + 2)); kX = *(const u32x4*)src; vX = *(const u32x4*)(src + 128); } \
        __syncthreads(); \
    } while (0)
    for (int si = 0; si < nsteps; ++si) {
        NSA_STEP(si, kregA, vregA);
    }
#undef NSA_STEP
#undef NSA_ST
#undef NSA_STAGE
#undef NSA_SRC
    tid = opaque_tid(); lane = tid & 63; fr = lane & 15; fq = lane >> 4;
    {
        const float* hn = in_of(p, 22) + l * 1024 + head * 64;
        bf16_t* HD = (bf16_t*)(ws_of(p) + WS_HEADS);
        f32x4 gnv[4];
#pragma unroll
        for (int dt = 0; dt < 4; ++dt) gnv[dt] = *(const f32x4*)(hn + 16 * dt + 4 * fq);
#pragma unroll
        for (int mt = 0; mt < 2; ++mt) {
            const int t = tw0 + mt * 16 + fr;
            float lt = lrow[mt];
            lt = fq_sum(lt);
            const float sc = sigmoidf_(gpre[mt][2]) / lt;
            float ss = 0.f;
            f32x4 yy[4];
#pragma unroll
            for (int dt = 0; dt < 4; ++dt) { yy[dt] = y[mt][dt] + oacc[mt][dt] * sc; ss += (yy[dt][0] * yy[dt][0] + yy[dt][1] * yy[dt][1]) + (yy[dt][2] * yy[dt][2] + yy[dt][3] * yy[dt][3]); }
            ss = fq_sum(ss);
            const float rs = rsqrtf(ss * (1.0f / 64.0f) + EPS);
#pragma unroll
            for (int dt = 0; dt < 4; ++dt) {
                const f32x4 gn = gnv[dt];
                const f32x4 o = yy[dt] * rs * gn;
                u32x2 pk; pk.x = cvt_pk_bf16(o[0], o[1]); pk.y = cvt_pk_bf16(o[2], o[3]);
                *(u32x2*)(HD + (size_t)(rowbase + t) * DM + head * 64 + 16 * dt + 4 * fq) = pk;
            }
        }
    }
    __syncthreads();
}

#define XB_TMO      128
#define XB_XCNT(j)  (256  + 64 * (j))
#define XB_XSUB(j)  (1280 + 64 * (j))
#define XB_XGEN(j)  (2304 + 64 * (j))
#define XB_TOP      3328
#define XB_TOPGEN   3392
#define XCD_BAR_WORDS 3456
#define XB_SPIN_CAP (1u << 22)
__device__ __forceinline__ unsigned xb_ld(unsigned* p)              { return __hip_atomic_load(p, __ATOMIC_RELAXED, __HIP_MEMORY_SCOPE_AGENT); }
__device__ __forceinline__ unsigned xb_add(unsigned* p, unsigned v) { return __hip_atomic_fetch_add(p, v, __ATOMIC_RELAXED, __HIP_MEMORY_SCOPE_AGENT); }
__device__ __forceinline__ unsigned xb_xcc_id() { return (unsigned)__builtin_amdgcn_s_getreg((3 << 11) | 20) & 0xFu; }
#define XB_SPIN(cond, bar) do { unsigned _sp = 0; while (cond) { __builtin_amdgcn_s_sleep(1); \
    if ((++_sp & 255u) == 0u) { if (xb_ld(&(bar)[XB_TMO])) break; if (_sp > XB_SPIN_CAP) { atomicAdd(&(bar)[XB_TMO], 1u); break; } } } } while (0)
struct XcdBarrier { unsigned* bar; unsigned x; volatile LAS unsigned* st; };
__device__ __forceinline__ XcdBarrier xcd_barrier_post(unsigned* bar, volatile LAS unsigned* st) {
    XcdBarrier b; b.bar = bar; b.x = xb_xcc_id(); b.st = st;
    if (threadIdx.x == 0) (void)xb_add(&bar[XB_XCNT(b.x)], 1u);
    return b;
}
__device__ __forceinline__ void xcd_barrier_complete(unsigned* bar, unsigned x, unsigned& nloc, unsigned& nx) {
    const unsigned G = gridDim.x * gridDim.y * gridDim.z;
    unsigned sum, cnt, mine, sp = 0u;
    for (;;) {
        sum = 0u; cnt = 0u; mine = 0u;
#pragma unroll
        for (unsigned j = 0; j < 16; ++j) { const unsigned c = xb_ld(&bar[XB_XCNT(j)]); sum += c; cnt += (c > 0u) ? 1u : 0u; mine = (j == x) ? c : mine; }
        if (sum == G) break;
        __builtin_amdgcn_s_sleep(1);
        if ((++sp & 255u) == 0u) { if (xb_ld(&bar[XB_TMO])) break; if (sp > XB_SPIN_CAP) { atomicAdd(&bar[XB_TMO], 1u); break; } }
    }
    nloc = mine > 0u ? mine : 1u; nx = cnt > 0u ? cnt : 1u;
}
__device__ __forceinline__ void xcd_barrier(const XcdBarrier& b) {
    asm volatile("s_waitcnt vmcnt(0)" ::: "memory");
    __syncthreads();
    if (threadIdx.x == 0) {
        unsigned* bar = b.bar;
        __builtin_amdgcn_s_waitcnt(0);
        unsigned nloc = b.st[0], nx = b.st[1];
        if (nloc == 0u) { xcd_barrier_complete(bar, b.x, nloc, nx); b.st[0] = nloc; b.st[1] = nx; }
        const unsigned old = xb_add(&bar[XB_XSUB(b.x)], 1u);
        const unsigned gen = old / nloc;
        if (old + 1u == (gen + 1u) * nloc) {
            __builtin_amdgcn_fence(__ATOMIC_RELEASE, "agent");
            asm volatile("s_waitcnt vmcnt(0)" ::: "memory");
            const unsigned og = xb_add(&bar[XB_TOP], 1u);
            const unsigned tg = og / nx;
            if (og + 1u == (tg + 1u) * nx) xb_add(&bar[XB_TOPGEN], 1u);
            else XB_SPIN(xb_ld(&bar[XB_TOPGEN]) == tg, bar);
            __builtin_amdgcn_fence(__ATOMIC_ACQUIRE, "agent");
            xb_add(&bar[XB_XGEN(b.x)], 1u);
            asm volatile("s_waitcnt vmcnt(0)" ::: "memory");
        } else {
            XB_SPIN(xb_ld(&bar[XB_XGEN(b.x)]) == gen, bar);
            __builtin_amdgcn_fence(__ATOMIC_ACQUIRE, "agent");
            asm volatile("s_waitcnt vmcnt(0)" ::: "memory");
        }
    }
    __syncthreads();
}

__global__ void __launch_bounds__(NTHREADS) hymba_fwd(Params p) {
    extern __shared__ __attribute__((aligned(16))) unsigned char lds_raw[];
    LAS unsigned char* lds = (LAS unsigned char*)lds_raw;
    cg::grid_group grid = cg::this_grid();
    volatile LAS unsigned* xbw = (volatile LAS unsigned*)(lds + LDS_BYTES - 16);
    if (threadIdx.x < 4) xbw[threadIdx.x] = 0u;
    __syncthreads();
    XcdBarrier xbar = xcd_barrier_post((unsigned*)(ws_of(p) + WS_BAR), xbw);
    if (p.ph_hi - p.ph_lo > 1) grid.sync();
    for (int ph = p.ph_lo; ph < p.ph_hi; ++ph) {
        int G = gridDim.x, bid = blockIdx.x;
        asm volatile("" : "+s"(G), "+s"(bid));
        const int tpx = opaque_tid();
        if (ph == 0) {
            if (PHEN(0)) prologue(p, lds, bid, G);
            if (REP_SUB == 100) { __syncthreads(); prologue(p, lds, bid, G); }
        } else if (ph == 37) { if (PHEN(10)) {
            const float* ssq = (const float*)(ws_of(p) + WS_SSQ) + (size_t)(12 & 1) * T_ * 16;
            float* outp = out_of(p);
            const f32x4 gn = *(const f32x4*)(in_of(p, 28) + (tpx & 255) * 4);
            for (int it = bid; it < T_ / 8; it += G) {
                f32x4 v[4]; float r[4];
#pragma unroll
                for (int q = 0; q < 4; ++q) {
                    const int row = it * 8 + q * 2 + (tpx >> 8);
                    v[q] = *(const f32x4*)(outp + (size_t)row * DM + (tpx & 255) * 4);
                    r[q] = row_rstd(ssq, row);
                }
#pragma unroll
                for (int q = 0; q < 4; ++q) {
                    const int row = it * 8 + q * 2 + (tpx >> 8);
                    *(f32x4*)(outp + (size_t)row * DM + (tpx & 255) * 4) = v[q] * r[q] * gn;
                }
            } }
        } else {
            const int l = (ph - 1) / 9, sub = (ph - 1) % 9;
            unsigned char* wl = ws_of(p) + WS_W + (size_t)l * LAYER_W;
            float* ssq = (float*)(ws_of(p) + WS_SSQ);
            bf16_t* HB = (bf16_t*)(ws_of(p) + WS_HB);
            bf16_t* UB = (bf16_t*)(ws_of(p) + WS_U);
            if (PHEN(1) && (sub == 0 || sub == 7)) {
                const bool second = sub == 7;
                pg8::Gemm g{HB, (const bf16_t*)(wl + (second ? LO_W13B : LO_W13A)), T_, NUP, DM, DM, DM};
                pg8::StaticOrder S; S.init(T_, NUP, G, bid);
                EpiSwiGLU E{UB, ssq + (size_t)((3 * l + (second ? 2 : 0)) & 1) * T_ * 16};
                pg8::gemm_phase(lds, g, S, E);
                if (REP_SUB == 0) { __syncthreads(); pg8::gemm_phase(lds, g, S, E); }
            } else if (PHEN(2) && (sub == 1 || sub == 8 || sub == 6)) {
                const bool wout = sub == 6, second = sub == 8;
                pg8::Gemm g;
                if (wout) g = pg8::Gemm{(const bf16_t*)(ws_of(p) + WS_HEADS), (const bf16_t*)(wl + LO_WOUT), T_, DM, DM, DM, DM};
                else g = pg8::Gemm{UB, (const bf16_t*)(wl + (second ? LO_W2B : LO_W2A)), T_, DM, DFF, DFF, DFF};
                pg8::StaticOrder S; S.init(T_, DM, G, bid);
                const float* resid = (l == 0 && sub == 1) ? in_of(p, 0) : out_of(p);
                const int nxt = 3 * l + (sub == 1 ? 1 : (sub == 6 ? 2 : 3));
                EpiResid E{resid, out_of(p), HB, ssq + (size_t)(nxt & 1) * T_ * 16, wout ? 1.0f : 0.5f};
                pg8::gemm_phase(lds, g, S, E);
                if (REP_SUB == 1) { __syncthreads(); EpiResid E2{out_of(p), out_of(p), HB, ssq + (size_t)(nxt & 1) * T_ * 16, 0.0f}; pg8::gemm_phase(lds, g, S, E2); }
            } else if (PHEN(3) && sub == 2) {
                if (bid < 2 && tpx < 256) {
                    const float* cbp = (const float*)(ws_of(p) + WS_CBP) + (size_t)((l * 2 + bid) * 32) * 256 + tpx;
                    float sb = 0.f;
#pragma unroll
                    for (int q = 0; q < 32; ++q) sb += cbp[q * 256];
                    ((float*)(ws_of(p) + WS_CBIAS))[(l * 2 + bid) * 256 + tpx] = sb;
                }
                pg8::Gemm g{HB, (const bf16_t*)(wl + LO_WIN), T_, NINP, DM, DM, DM};
                pg8::StaticOrder S; S.init(T_, NINP, G, bid);
                EpiWin E{UB, (bf16_t*)(ws_of(p) + WS_KCMP), (bf16_t*)(ws_of(p) + WS_VCMP), (float*)(ws_of(p) + WS_GATES), ssq + (size_t)((3 * l + 1) & 1) * T_ * 16};
                pg8::gemm_phase(lds, g, S, E);
                if (REP_SUB == 2) { __syncthreads(); pg8::gemm_phase(lds, g, S, E); }
            } else if (sub == 3) {
                const int ngemm = 64;
                for (int rep = 0; rep < (REP_SUB == 3 ? 2 : 1); ++rep) {
                const int cls = rep == 0 ? 7 : REP_CLASS;
                if (rep) __syncthreads();
                if (G > ngemm) {
                    if (bid < ngemm) { if (PHEN(4) && (cls & 1)) {
                        const int kp = bid >> 4, kv = (bid >> 3) & 1;
                        pg8::Gemm g{(const bf16_t*)(ws_of(p) + (kv ? WS_VCMP : WS_KCMP)) + kp * 512, (const bf16_t*)(wl + (kv ? LO_CW1V : LO_CW1K)) + kp * 512, 2048, 256, 512, 1024, 2048};
                        pg8::SingleUnit S{bid & 7};
                        EpiCmp E{(float*)(ws_of(p) + WS_HID) + (size_t)(kp * 2 + kv) * 2048 * 256};
                        pg8::gemm_phase(lds, g, S, E); }
                    }
                    if (PHEN(5)) {
                        const bool gb = bid < ngemm;
                        const int i0 = gb ? 1728 + bid : bid - ngemm, i1 = gb ? 2048 : 1728, st = gb ? ngemm : G - ngemm;
                        for (int it = i0; it < i1; it += st) {
                            if (it < 1024) { if (cls & 2) lru_x_item(p, l, it >> 7, (it >> 5) & 3, it & 31, lds); }
                            else if (cls & 4) ml_x_item(p, l, (it - 1024) >> 5, it & 31, lds);
                        }
                    }
                }
                }
            } else if (PHEN(6) && sub == 4) {
                phase_m2(p, l, 7, lds, bid, G);
                if (REP_SUB == 4) { __syncthreads(); phase_m2(p, l, REP_CLASS, lds, bid, G); }
            } else if (sub == 5) {
                for (int rep = 0; rep < (REP_SUB == 5 ? 2 : 1); ++rep) {
                const int cls = rep == 0 ? 7 : REP_CLASS;
                if (rep) __syncthreads();
                for (int it = bid; it < 512 + 1024 + 1024; it += G) {
                    if (it < 512) { if (PHEN(7) && (cls & 1)) {
                        const int qb = it < 256 ? 31 - (it >> 4) : ((it - 256) >> 4), bg = it & 15;
                        nsa_item(p, l, bg >> 1, bg & 1, qb, lds, (rep == 1 && REP_CLASS == 9) ? 1 : 0); }
                    } else if (it < 1536) {
                        if (PHEN(8) && (cls & 2)) ml_y_item(p, l, (it - 512) >> 5, (it - 512) & 31, lds);
                    } else {
                        if (PHEN(9) && (cls & 4)) lru_y_item(p, l, it - 1536);
                    }
                }
                }
            }
        }
        if (ph + 1 < p.ph_hi) {
            xcd_barrier(xbar);
            if (REP_SUB == 200) xcd_barrier(xbar);
        }
    }
}

extern "C" void kernel_launch(void* const* d_in, const int* in_sizes, int n_in, void* d_out, int out_size, void* d_ws, size_t ws_size, hipStream_t stream) {
    static int grid = 0;
    if (grid == 0) {
        if (n_in != 29 || out_size != T_ * DM || ws_size < WS_END) { fprintf(stderr, "kernel_launch: unexpected shapes (n_in %d out %d ws %zu need %zu)\n", n_in, out_size, ws_size, (size_t)WS_END); grid = -1; return; }
        int dev = 0, cus = 0, per_cu = 0;
        hipGetDevice(&dev);
        hipDeviceGetAttribute(&cus, hipDeviceAttributeMultiprocessorCount, dev);
        hipFuncSetAttribute((const void*)hymba_fwd, hipFuncAttributeMaxDynamicSharedMemorySize, LDS_BYTES);
        hipOccupancyMaxActiveBlocksPerMultiprocessor(&per_cu, (const void*)hymba_fwd, NTHREADS, LDS_BYTES);
        if (per_cu < 1) { fprintf(stderr, "kernel_launch: occupancy query says %d blocks per CU\n", per_cu); per_cu = 1; }
        (void)hipGetLastError();
        grid = cus;
    }
    if (grid < 0) return;
    Params p{};
    for (int i = 0; i < 29; ++i) p.in[i] = (const float*)d_in[i];
    p.out = (float*)d_out; p.ws = (unsigned char*)d_ws;
#if ONE_LAUNCH
    (void)hipMemsetAsync((unsigned char*)d_ws + WS_BAR, 0, 16384, stream);
    p.ph_lo = 0; p.ph_hi = 38;
    void* args[] = {&p};
    hipError_t e = hipLaunchCooperativeKernel((const void*)hymba_fwd, dim3(grid), dim3(NTHREADS), args, LDS_BYTES, stream);
    if (e != hipSuccess) fprintf(stderr, "cooperative launch failed: %s (grid %d)\n", hipGetErrorString(e), grid);
#else
    for (int ph = 0; ph < 38; ++ph) {
        p.ph_lo = ph; p.ph_hi = ph + 1;
        hipLaunchKernelGGL(hymba_fwd, dim3(grid), dim3(NTHREADS), LDS_BYTES, stream, p);
    }
#endif
}
```

```cpp
#include <hip/hip_runtime.h>
#include <hip/hip_cooperative_groups.h>
#include <cstdio>
namespace cg = cooperative_groups;

#define LAS __attribute__((address_space(3)))
typedef unsigned short bf16_t;
typedef short bf16x8 __attribute__((ext_vector_type(8)));
typedef float f32x4 __attribute__((ext_vector_type(4)));
typedef float f32x2 __attribute__((ext_vector_type(2)));
typedef unsigned u32x4 __attribute__((ext_vector_type(4)));
typedef unsigned u32x2 __attribute__((ext_vector_type(2)));

#ifndef ONE_LAUNCH
#define ONE_LAUNCH 1
#endif
#ifndef PHMASK
#define PHMASK 0xFFFF
#endif
#define PHEN(k) ((PHMASK >> (k)) & 1)
#ifndef REP_SUB
#define REP_SUB -1
#endif
#ifndef REP_CLASS
#define REP_CLASS 7
#endif

constexpr int T_ = 16384, SEQ = 2048, DM = 1024, DFF = 2816, NUP = 5632, NINP = 3072, UW = 2816, DIN = 2848;
constexpr float EPS = 1e-6f;
constexpr float NEGF = -1e30f;
constexpr int NTHREADS = 512;
constexpr int LDS_BYTES = 147456;

constexpr size_t SZ_W13T = (size_t)NUP * DM * 2, SZ_W2T = (size_t)DM * DFF * 2, SZ_WINT = (size_t)NINP * DM * 2, SZ_WOUTT = (size_t)DM * DM * 2, SZ_CW1T = (size_t)256 * 2048 * 2;
constexpr size_t LO_W13A = 0, LO_W2A = LO_W13A + SZ_W13T, LO_W13B = LO_W2A + SZ_W2T, LO_W2B = LO_W13B + SZ_W13T, LO_WIN = LO_W2B + SZ_W2T, LO_WOUT = LO_WIN + SZ_WINT,
                 LO_CW1K = LO_WOUT + SZ_WOUTT, LO_CW1V = LO_CW1K + SZ_CW1T, LAYER_W = LO_CW1V + SZ_CW1T;
constexpr size_t WS_W = 0;
constexpr size_t WS_HB = WS_W + 4 * LAYER_W;
constexpr size_t WS_U = WS_HB + (size_t)T_ * DM * 2;
constexpr size_t WS_HEADS = WS_U + (size_t)T_ * UW * 2;
constexpr size_t SZ_CMPIN = (size_t)16 * 2048 * 64 * 2 + 4096;
constexpr size_t WS_KCMP = WS_HEADS + (size_t)T_ * DM * 2;
constexpr size_t WS_VCMP = WS_KCMP + SZ_CMPIN;
constexpr size_t WS_HID = WS_VCMP + SZ_CMPIN;
constexpr size_t WS_KC = WS_HID + (size_t)4 * 2 * 2048 * 256 * 4;
constexpr size_t WS_GATES = WS_KC + (size_t)2 * 2048 * 64 * 2;
constexpr size_t WS_SSQ = WS_GATES + (size_t)T_ * 32 * 4;
constexpr size_t WS_CBIAS = WS_SSQ + (size_t)2 * T_ * 16 * 4;
constexpr size_t WS_LRUH = WS_CBIAS + 8192;
constexpr size_t WS_LRUA = WS_LRUH + (size_t)T_ * 256 * 4;
constexpr size_t WS_LRUC = WS_LRUA + (size_t)T_ * 256 * 4;
constexpr size_t WS_MLC = WS_LRUC + (size_t)8 * 32 * 256 * 4;
constexpr size_t WS_MLN = WS_MLC + (size_t)1024 * 4096 * 4;
constexpr size_t WS_MLMU = WS_MLN + (size_t)1024 * 64 * 4;
constexpr size_t WS_MLAT = WS_MLMU + 4096;
constexpr size_t WS_MLMP = WS_MLAT + 4096;
constexpr size_t WS_CBP = WS_MLMP + 4096;
constexpr size_t WS_LRUWT = WS_CBP + 262144;
constexpr size_t WS_BAR = WS_LRUWT + 262144;
constexpr size_t WS_END = WS_BAR + 16384;
static_assert(WS_END <= 425365632ull, "workspace too large");
static_assert(LAYER_W % 256 == 0 && WS_HB % 256 == 0 && WS_U % 256 == 0 && WS_KCMP % 256 == 0 && WS_VCMP % 256 == 0 && WS_HID % 256 == 0, "align");

struct Params {
    const float* in[29];
    float* out;
    unsigned char* ws;
    int ph_lo, ph_hi;
};
static_assert(sizeof(Params) == 256, "Params has padding");
#define GAS __attribute__((address_space(1)))
__device__ __forceinline__ unsigned char* ws_of(const Params& p) { unsigned long long w = (unsigned long long)p.ws; asm volatile("" : "+s"(w)); return (unsigned char*)(GAS unsigned char*)w; }
__device__ __forceinline__ float* out_of(const Params& p) { unsigned long long w = (unsigned long long)p.out; asm volatile("" : "+s"(w)); return (float*)(GAS float*)w; }
__device__ __forceinline__ const float* in_of(const Params& p, int i) { unsigned long long w = (unsigned long long)p.in[i]; asm volatile("" : "+s"(w)); return (const float*)(GAS const float*)w; }
__device__ __forceinline__ unsigned cvt_pk_bf16(float lo, float hi) { unsigned r; asm volatile("v_cvt_pk_bf16_f32 %0, %1, %2" : "=v"(r) : "v"(lo), "v"(hi)); return r; }
__device__ __forceinline__ bf16_t f2bf(float f) { return (bf16_t)(cvt_pk_bf16(f, 0.f) & 0xffffu); }
__device__ __forceinline__ float bf2f(bf16_t b) { return __uint_as_float(((unsigned)b) << 16); }
__device__ __forceinline__ float sigmoidf_(float x) { return 1.0f / (1.0f + __expf(-x)); }
__device__ __forceinline__ int opaque_tid() { int x = threadIdx.x; asm volatile("" : "+v"(x)); return x; }
__device__ __forceinline__ float row_rstd(const float* part, int row) {
    const f32x4 a = *(const f32x4*)(part + (size_t)row * 16), b = *(const f32x4*)(part + (size_t)row * 16 + 4), c = *(const f32x4*)(part + (size_t)row * 16 + 8), d = *(const f32x4*)(part + (size_t)row * 16 + 12);
    const float s = (((a[0] + a[1]) + (a[2] + a[3])) + ((b[0] + b[1]) + (b[2] + b[3]))) + (((c[0] + c[1]) + (c[2] + c[3])) + ((d[0] + d[1]) + (d[2] + d[3])));
    return rsqrtf(s * (1.0f / DM) + EPS);
}
__device__ __forceinline__ float fq_max(float x) {
    auto a = __builtin_amdgcn_permlane16_swap(__float_as_uint(x), __float_as_uint(x), false, false);
    const float m = fmaxf(__uint_as_float(a[0]), __uint_as_float(a[1]));
    auto b = __builtin_amdgcn_permlane32_swap(__float_as_uint(m), __float_as_uint(m), false, false);
    return fmaxf(__uint_as_float(b[0]), __uint_as_float(b[1]));
}
__device__ __forceinline__ float fq_sum(float x) {
    auto a = __builtin_amdgcn_permlane16_swap(__float_as_uint(x), __float_as_uint(x), false, false);
    const float m = __uint_as_float(a[0]) + __uint_as_float(a[1]);
    auto b = __builtin_amdgcn_permlane32_swap(__float_as_uint(m), __float_as_uint(m), false, false);
    return __uint_as_float(b[0]) + __uint_as_float(b[1]);
}
__device__ __forceinline__ float wave_sum(float v) {
#pragma unroll
    for (int o = 32; o >= 1; o >>= 1) v += __shfl_xor(v, o);
    return v;
}
__device__ __forceinline__ float wave_max(float v) {
#pragma unroll
    for (int o = 32; o >= 1; o >>= 1) v = fmaxf(v, __shfl_xor(v, o));
    return v;
}

namespace pg8 {
constexpr int BM = 256, BK = 64, HALF = 128, HTB = HALF * BK * 2, STAGE_BYTES = 8 * HTB, NXCD = 8, WGM = 8;
__device__ __forceinline__ int lds_byte(int r, int c) { const int st = (r >> 4) * 2 + (c >> 5), rr = r & 15, cc = c & 31, ob = rr * 64 + cc * 2; return st * 1024 + (ob ^ (((ob >> 9) & 1) << 5)); }
__device__ __forceinline__ void stage_rc(int b, int& R, int& C) { const int st = b / 1024, sb = b % 1024, swz = sb ^ (((sb >> 9) & 1) << 5); R = (st >> 1) * 16 + swz / 64; C = (st & 1) * 32 + (swz % 64) / 2; }

struct Unit { int pm, pn; };
struct Gemm { const bf16_t* A; const bf16_t* Bt; int M, N, K, lda, ldb; };

struct StaticOrder {
    int nM, nN, nwg, G, c;
    __device__ void init(int M, int N, int G_, int c_) { nM = M / BM; nN = N / BM; nwg = nM * nN; G = G_; c = c_; }
    __device__ bool next(int i, Unit& u) const {
        const long L = (long)i * G + c; if (L >= nwg) return false;
        int wgid = (int)L; { const int q = nwg / NXCD, r = nwg % NXCD, xcd = wgid % NXCD, off = wgid / NXCD; wgid = (xcd < r ? xcd * (q + 1) : r * (q + 1) + (xcd - r) * q) + off; }
        const int nig = WGM * nN, gid = wgid / nig, fm = gid * WGM, gsz = (nM - fm) < WGM ? (nM - fm) : WGM;
        u.pm = fm + ((wgid % nig) % gsz); u.pn = (wgid % nig) / gsz; return true;
    }
};
struct SingleUnit {
    int pm;
    __device__ bool next(int i, Unit& u) const { if (i != 0 || pm < 0) return false; u.pm = pm; u.pn = 0; return true; }
};

template <class Epi, class Sched>
__device__ __forceinline__ void gemm_phase(LAS unsigned char* lds, const Gemm g, const Sched& S, const Epi& E) {
    const int tid = opaque_tid(), wid = __builtin_amdgcn_readfirstlane(tid >> 6), lane = tid & 63, wr = wid >> 2, wc = wid & 3, fr = lane & 15, fq = lane >> 4;
    const int K = g.K, nt = K / BK;
    unsigned voffA[2], voffB[2];
#pragma unroll
    for (int i = 0; i < 2; ++i) { int R, C; stage_rc(tid * 16 + i * 8192, R, C);
        voffA[i] = (unsigned)(R * g.lda + C) * 2u; voffB[i] = (unsigned)(R * g.ldb + C) * 2u; }
    const size_t kstep = (size_t)(BK * 2);
    const size_t hstepA = (size_t)HALF * g.lda * 2, hstepB = (size_t)HALF * g.ldb * 2;
    const size_t tstepA = 2 * hstepA, tstepB = 2 * hstepB;
    const unsigned ldsw = (unsigned)wid * 1024u;
    const int aoff = lds_byte(wr * 64 + fr, fq * 8), boff = lds_byte(wc * 32 + fr, fq * 8);
#define PG8_SA(b, h) (((b) * 2 + (h)) * HTB)
#define PG8_SB(b, h) ((4 + (b) * 2 + (h)) * HTB)
#define PG8_STAGE(bufoff, gbase, voff) do { _Pragma("unroll") for (int _i = 0; _i < 2; ++_i) \
        __builtin_amdgcn_global_load_lds((const unsigned*)((const char*)(gbase) + (voff)[_i]), (LAS unsigned*)(lds + (bufoff) + ldsw + _i * 8192), 16, 0, 0); } while (0)
#define PG8_LDA(dst, b, h) do { _Pragma("unroll") for (int m = 0; m < 4; ++m) _Pragma("unroll") for (int k = 0; k < 2; ++k) dst[m][k] = *(const LAS bf16x8*)(lds + PG8_SA(b, h) + aoff + m * 2048 + k * 1024); } while (0)
#define PG8_LDB(dst, b, h) do { _Pragma("unroll") for (int n = 0; n < 2; ++n) _Pragma("unroll") for (int k = 0; k < 2; ++k) dst[n][k] = *(const LAS bf16x8*)(lds + PG8_SB(b, h) + boff + n * 2048 + k * 1024); } while (0)
#define PG8_MMA(ai, bj, At, Bt) do { __builtin_amdgcn_s_setprio(1); _Pragma("unroll") for (int m = 0; m < 4; ++m) _Pragma("unroll") for (int n = 0; n < 2; ++n) _Pragma("unroll") for (int k = 0; k < 2; ++k) \
        acc[ai][bj][m][n] = __builtin_amdgcn_mfma_f32_16x16x32_bf16(Bt[n][k], At[m][k], acc[ai][bj][m][n], 0, 0, 0); __builtin_amdgcn_s_setprio(0); } while (0)
#define PG8_WAIT_V(n) asm volatile("s_waitcnt vmcnt(" #n ")" ::: "memory")
#define PG8_WAIT_L(n) asm volatile("s_waitcnt lgkmcnt(" #n ")" ::: "memory")
#define PG8_BAR __builtin_amdgcn_s_barrier()
#define PG8_SCHED __builtin_amdgcn_sched_barrier(0)
    Unit cur, nxt; int ui = 0;
    if (!S.next(0, cur)) return;
    f32x4 acc[2][2][4][2];
#pragma unroll
    for (int a = 0; a < 2; ++a)
#pragma unroll
        for (int b = 0; b < 2; ++b)
#pragma unroll
            for (int m = 0; m < 4; ++m)
#pragma unroll
                for (int n = 0; n < 2; ++n) acc[a][b][m][n] = (f32x4){0.f, 0.f, 0.f, 0.f};
    bf16x8 At[4][2], B0[2][2], B1[2][2];
    const char* cA = (const char*)g.A + (size_t)cur.pm * tstepA; const char* cB = (const char*)g.Bt + (size_t)cur.pn * tstepB;
    PG8_STAGE(PG8_SB(0, 0), cB, voffB); PG8_STAGE(PG8_SA(0, 0), cA, voffA); PG8_STAGE(PG8_SB(0, 1), cB + hstepB, voffB); PG8_STAGE(PG8_SA(0, 1), cA + hstepA, voffA);
    if (wr == 1) PG8_BAR;
    PG8_WAIT_V(4); PG8_BAR;
    PG8_STAGE(PG8_SB(1, 0), cB + kstep, voffB); PG8_STAGE(PG8_SA(1, 0), cA + kstep, voffA); PG8_STAGE(PG8_SB(1, 1), cB + hstepB + kstep, voffB);
    PG8_WAIT_V(6); PG8_BAR;
    for (;;) {
        const bool has_next = S.next(ui + 1, nxt);
        const char* nA = has_next ? (const char*)g.A + (size_t)nxt.pm * tstepA : cA; const char* nB = has_next ? (const char*)g.Bt + (size_t)nxt.pn * tstepB : cB;
        for (int t = 0; t < nt; t += 2) {
            const bool last = (t == nt - 2);
            const char* a1 = cA + (size_t)(t + 1) * kstep;
            const char* a2 = last ? nA : cA + (size_t)(t + 2) * kstep; const char* b2 = last ? nB : cB + (size_t)(t + 2) * kstep;
            const char* a3 = a2 + kstep; const char* b3 = b2 + kstep;
            PG8_LDB(B0, 0, 0); PG8_SCHED; PG8_LDA(At, 0, 0); PG8_STAGE(PG8_SA(1, 1), a1 + hstepA, voffA);
            PG8_WAIT_L(8); PG8_BAR; PG8_WAIT_L(0); PG8_MMA(0, 0, At, B0); PG8_BAR; PG8_SCHED;
            PG8_LDB(B1, 0, 1); PG8_STAGE(PG8_SB(0, 0), b2, voffB);
            PG8_BAR; PG8_WAIT_L(0); PG8_MMA(0, 1, At, B1); PG8_BAR;
            PG8_LDA(At, 0, 1); PG8_STAGE(PG8_SA(0, 0), a2, voffA);
            PG8_BAR; PG8_WAIT_L(0); PG8_MMA(1, 0, At, B0); PG8_BAR; PG8_SCHED;
            PG8_STAGE(PG8_SB(0, 1), b2 + hstepB, voffB);
            PG8_WAIT_V(6); PG8_BAR; PG8_MMA(1, 1, At, B1); PG8_BAR;
            PG8_LDB(B0, 1, 0); PG8_SCHED; PG8_LDA(At, 1, 0); PG8_STAGE(PG8_SA(0, 1), a2 + hstepA, voffA);
            PG8_WAIT_L(8); PG8_BAR; PG8_WAIT_L(0); PG8_MMA(0, 0, At, B0); PG8_BAR; PG8_SCHED;
            PG8_LDB(B1, 1, 1); PG8_STAGE(PG8_SB(1, 0), b3, voffB);
            PG8_BAR; PG8_WAIT_L(0); PG8_MMA(0, 1, At, B1); PG8_BAR;
            PG8_LDA(At, 1, 1); PG8_STAGE(PG8_SA(1, 0), a3, voffA);
            PG8_BAR; PG8_WAIT_L(0); PG8_MMA(1, 0, At, B0); PG8_BAR; PG8_SCHED;
            PG8_STAGE(PG8_SB(1, 1), b3 + hstepB, voffB);
            PG8_WAIT_V(6); PG8_BAR; PG8_MMA(1, 1, At, B1); PG8_BAR;
        }
        E(acc, cur, wr, wc, fr, fq);
        if (!has_next) break;
#pragma unroll
        for (int a = 0; a < 2; ++a)
#pragma unroll
            for (int b = 0; b < 2; ++b)
#pragma unroll
                for (int m = 0; m < 4; ++m)
#pragma unroll
                    for (int n = 0; n < 2; ++n) acc[a][b][m][n] = (f32x4){0.f, 0.f, 0.f, 0.f};
        cur = nxt; cA = nA; cB = nB; ++ui;
    }
    PG8_WAIT_V(0);
    if (wr == 0) PG8_BAR;
    PG8_BAR;
#undef PG8_SA
#undef PG8_SB
#undef PG8_STAGE
#undef PG8_LDA
#undef PG8_LDB
#undef PG8_MMA
#undef PG8_WAIT_V
#undef PG8_WAIT_L
#undef PG8_BAR
#undef PG8_SCHED
}
}

typedef __attribute__((address_space(1))) float gf32;
typedef __attribute__((address_space(1))) const float gcf32;
typedef __attribute__((address_space(1))) bf16_t gbf16;
typedef __attribute__((address_space(1))) f32x4 gf32x4;
typedef __attribute__((address_space(1))) const f32x4 gcf32x4;
typedef __attribute__((address_space(1))) u32x2 gu32x2;
__device__ __forceinline__ void rows_rstd(const float* ssq, int row0, int fq, float (&r8)[2][4]) {
    f32x4 pv[2][4];
#pragma unroll
    for (int ai = 0; ai < 2; ++ai)
#pragma unroll
        for (int m = 0; m < 4; ++m) pv[ai][m] = *(gcf32x4*)(ssq + (size_t)(row0 + ai * 128 + m * 16) * 16 + 4 * fq);
#pragma unroll
    for (int ai = 0; ai < 2; ++ai)
#pragma unroll
        for (int m = 0; m < 4; ++m) {
            float sm = (pv[ai][m][0] + pv[ai][m][1]) + (pv[ai][m][2] + pv[ai][m][3]);
            sm = fq_sum(sm);
            r8[ai][m] = rsqrtf(sm * (1.0f / DM) + EPS);
        }
}
struct EpiSwiGLU {
    bf16_t* act; const float* ssq;
    __device__ __forceinline__ void operator()(const f32x4 (&acc)[2][2][4][2], const pg8::Unit& u, int wr, int wc, int fr, int fq) const {
        const int row0 = u.pm * 256 + wr * 64 + fr, col0 = u.pn * 128 + wc * 32 + 8 * fq;
        float r8[2][4];
        rows_rstd(ssq, row0, fq, r8);
#pragma unroll
        for (int ai = 0; ai < 2; ++ai)
#pragma unroll
            for (int m = 0; m < 4; ++m) {
                const int row = row0 + ai * 128 + m * 16;
                const float r = r8[ai][m];
                float o[8];
#pragma unroll
                for (int n = 0; n < 2; ++n) {
                    const f32x4 a1 = acc[ai][0][m][n] * r, a3 = acc[ai][1][m][n] * r;
#pragma unroll
                    for (int j = 0; j < 4; ++j) o[4 * n + j] = a1[j] * __builtin_amdgcn_rcpf(1.0f + __expf(-a1[j])) * a3[j];
                }
                u32x4 w; w.x = cvt_pk_bf16(o[0], o[1]); w.y = cvt_pk_bf16(o[2], o[3]); w.z = cvt_pk_bf16(o[4], o[5]); w.w = cvt_pk_bf16(o[6], o[7]);
                *(GAS u32x4*)(act + (size_t)row * DFF + col0) = w;
            }
    }
};
struct EpiResid {
    const float* resid; float* out; bf16_t* hb; float* ssq_next; float scale;
    __device__ __forceinline__ void load2(f32x4 (&rs)[2][2][2], int row0, int col0, int ai, int mp) const {
#pragma unroll
        for (int mm = 0; mm < 2; ++mm)
#pragma unroll
            for (int bj = 0; bj < 2; ++bj)
#pragma unroll
                for (int n = 0; n < 2; ++n)
                    rs[mm][bj][n] = *(gcf32x4*)(resid + (size_t)(row0 + ai * 128 + (2 * mp + mm) * 16) * DM + col0 + bj * 128 + n * 4);
    }
    __device__ __forceinline__ void operator()(const f32x4 (&acc)[2][2][4][2], const pg8::Unit& u, int wr, int wc, int fr, int fq) const {
        const int row0 = u.pm * 256 + wr * 64 + fr, col0 = u.pn * 256 + wc * 32 + 8 * fq;
        f32x4 rsA[2][2][2], rsB[2][2][2];
        load2(rsA, row0, col0, 0, 0);
#pragma unroll
        for (int bt = 0; bt < 4; ++bt) {
            const int ai = bt >> 1, mp = bt & 1;
            if (bt < 3) { if (bt & 1) load2(rsA, row0, col0, (bt + 1) >> 1, (bt + 1) & 1); else load2(rsB, row0, col0, (bt + 1) >> 1, (bt + 1) & 1); }
#pragma unroll
            for (int mm = 0; mm < 2; ++mm) {
                const int m = 2 * mp + mm, row = row0 + ai * 128 + m * 16;
                const size_t off = (size_t)row * DM + col0;
                float ss = 0.f;
#pragma unroll
                for (int bj = 0; bj < 2; ++bj) {
                    const f32x4 r0 = (bt & 1) ? rsB[mm][bj][0] : rsA[mm][bj][0], r1 = (bt & 1) ? rsB[mm][bj][1] : rsA[mm][bj][1];
                    const f32x4 v0 = r0 + acc[ai][bj][m][0] * scale, v1 = r1 + acc[ai][bj][m][1] * scale;
                    *(gf32x4*)(out + off + bj * 128) = v0;
                    *(gf32x4*)(out + off + bj * 128 + 4) = v1;
                    u32x4 w; w.x = cvt_pk_bf16(v0[0], v0[1]); w.y = cvt_pk_bf16(v0[2], v0[3]); w.z = cvt_pk_bf16(v1[0], v1[1]); w.w = cvt_pk_bf16(v1[2], v1[3]);
                    *(GAS u32x4*)(hb + off + bj * 128) = w;
                    ss += ((v0[0] * v0[0] + v0[1] * v0[1]) + (v0[2] * v0[2] + v0[3] * v0[3])) + ((v1[0] * v1[0] + v1[1] * v1[1]) + (v1[2] * v1[2] + v1[3] * v1[3]));
                }
                ss = fq_sum(ss);
                if (fq == 0) *(gf32*)(ssq_next + (size_t)row * 16 + u.pn * 4 + wc) = ss;
            }
            asm volatile("" ::: "memory");
        }
    }
};
struct EpiWin {
    bf16_t* U; bf16_t* kcmp; bf16_t* vcmp; float* gates; const float* ssq;
    __device__ __forceinline__ void operator()(const f32x4 (&acc)[2][2][4][2], const pg8::Unit& u, int wr, int wc, int fr, int fq) const {
        const int row0 = u.pm * 256 + wr * 64 + fr;
        float r8[2][4];
        rows_rstd(ssq, row0, fq, r8);
#pragma unroll
        for (int bj = 0; bj < 2; ++bj) {
            const int c0 = u.pn * 256 + bj * 128 + wc * 32;
            if (c0 >= 2848) continue;
            const float sc = (c0 < 512) ? 0.125f * 1.4426950408889634f : ((c0 >= 2048 && c0 < 2304) ? 0.125f : 1.0f);
            const int cl = 8 * fq;
#pragma unroll
            for (int ai = 0; ai < 2; ++ai)
#pragma unroll
                for (int m = 0; m < 4; ++m) {
                    const int row = row0 + ai * 128 + m * 16;
                    const float r = r8[ai][m] * sc;
                    const f32x4 v0 = acc[ai][bj][m][0] * r, v1 = acc[ai][bj][m][1] * r;
                    if (c0 == 2816) { *(gf32x4*)(gates + (size_t)row * 32 + cl) = v0; *(gf32x4*)(gates + (size_t)row * 32 + cl + 4) = v1; }
                    else {
                        u32x4 w; w.x = cvt_pk_bf16(v0[0], v0[1]); w.y = cvt_pk_bf16(v0[2], v0[3]); w.z = cvt_pk_bf16(v1[0], v1[1]); w.w = cvt_pk_bf16(v1[2], v1[3]);
                        if (c0 >= 512 && c0 < 768) {
                            const int cc = c0 - 512 + cl;
                            const int gg = (cc >> 6) & 1, d = cc & 63;
                            bf16_t* dst = (cc < 128 ? kcmp : vcmp) + ((size_t)(((row >> 11) * 2 + gg) * 2048 + (row & 2047))) * 64 + d;
                            *(GAS u32x4*)dst = w;
                        } else {
                            *(GAS u32x4*)(U + (size_t)row * UW + c0 + cl) = w;
                        }
                    }
                }
        }
    }
};
struct EpiCmp {
    float* part;
    __device__ __forceinline__ void operator()(const f32x4 (&acc)[2][2][4][2], const pg8::Unit& u, int wr, int wc, int fr, int fq) const {
        const int row0 = u.pm * 256 + wr * 64 + fr, col0 = wc * 32 + 8 * fq;
#pragma unroll
        for (int ai = 0; ai < 2; ++ai)
#pragma unroll
            for (int m = 0; m < 4; ++m) {
                const int row = row0 + ai * 128 + m * 16;
#pragma unroll
                for (int bj = 0; bj < 2; ++bj)
#pragma unroll
                    for (int n = 0; n < 2; ++n) *(gf32x4*)(part + (size_t)row * 256 + col0 + bj * 128 + n * 4) = acc[ai][bj][m][n];
            }
    }
};

__device__ __forceinline__ int winmap(int n) {
    if (n < 1280) return n;
    if (n < 2560) return n + 24;
    if (n < 2816) return n + 32;
    if (n < 2840) return 1280 + (n - 2816);
    if (n < 2844) return 2584 + (n - 2840);
    if (n < 2848) return 2588 + (n - 2844);
    return -1;
}
struct TrTile { const float* colp; const float* gain; bf16_t* dst; int ld, K, k0, n0; };
__device__ __forceinline__ void tr_decode(const Params& p, int idx, int tid, TrTile& t) {
    constexpr int TPL = 1376;
    const int l = idx / TPL; int r = idx % TPL;
    int m, ntile, ktile, K;
    if (r < 352) { m = 0; ntile = r % 22; ktile = r / 22; K = DM; }
    else if (r < 528) { r -= 352; m = 1; ntile = r % 4; ktile = r / 4; K = DFF; }
    else if (r < 880) { r -= 528; m = 2; ntile = r % 22; ktile = r / 22; K = DM; }
    else if (r < 1056) { r -= 880; m = 3; ntile = r % 4; ktile = r / 4; K = DFF; }
    else if (r < 1248) { r -= 1056; m = 4; ntile = r % 12; ktile = r / 12; K = DM; }
    else if (r < 1312) { r -= 1248; m = 5; ntile = r % 4; ktile = r / 4; K = DM; }
    else if (r < 1344) { r -= 1312; m = 6; ntile = 0; ktile = r; K = 2048; }
    else { r -= 1344; m = 7; ntile = 0; ktile = r; K = 2048; }
    t.K = K; t.k0 = ktile * 64; t.n0 = ntile * 256; t.colp = nullptr; t.gain = nullptr; t.ld = 0;
    const int npp = t.n0 + 4 * ((tid >> 3));
    const int np = (npp & ~31) + 8 * ((npp & 15) >> 2) + 4 * ((npp >> 4) & 1);
    unsigned char* wl = ws_of(p) + WS_W + (size_t)l * LAYER_W;
    if (m == 0 || m == 2) {
        const int pb = np >> 8, w = np & 255;
        const float* src = (w < 128) ? in_of(p, m == 0 ? 2 : 25) : in_of(p, m == 0 ? 3 : 26);
        t.colp = src + (size_t)l * DM * DFF + pb * 128 + (w & 127); t.ld = DFF; t.gain = in_of(p, m == 0 ? 1 : 24) + l * DM;
        t.dst = (bf16_t*)(wl + (m == 0 ? LO_W13A : LO_W13B));
    } else if (m == 1 || m == 3) {
        t.colp = in_of(p, m == 1 ? 4 : 27) + (size_t)l * DFF * DM + np; t.ld = DM;
        t.dst = (bf16_t*)(wl + (m == 1 ? LO_W2A : LO_W2B));
    } else if (m == 4) {
        const int sc = winmap(np);
        if (sc >= 0) t.colp = in_of(p, 6) + (size_t)l * DM * DIN + sc;
        t.ld = DIN; t.gain = in_of(p, 5) + l * DM;
        t.dst = (bf16_t*)(wl + LO_WIN);
    } else if (m == 5) {
        t.colp = in_of(p, 23) + (size_t)l * DM * DM + np; t.ld = DM;
        t.dst = (bf16_t*)(wl + LO_WOUT);
    } else {
        t.colp = in_of(p, m == 6 ? 8 : 11) + (size_t)l * 2048 * 256 + np; t.ld = 256;
        t.dst = (bf16_t*)(wl + (m == 6 ? LO_CW1K : LO_CW1V));
    }
}
__device__ __forceinline__ void tr_load(const TrTile& t, int tid, f32x4 (&v)[8]) {
    const int kc = (tid & 7);
#pragma unroll
    for (int e = 0; e < 8; ++e) {
        const int k = t.k0 + 8 * kc + e;
        f32x4 x = (f32x4){0.f, 0.f, 0.f, 0.f};
        if (t.colp) { x = *(const f32x4*)(t.colp + (size_t)k * t.ld); if (t.gain) x = x * t.gain[k]; }
        v[e] = x;
    }
}
__device__ void prologue(const Params& p, LAS unsigned char* lds, int bid, int G) {
    const int tid = opaque_tid();
    LAS float* tile = (LAS float*)lds;
    {
        constexpr int N_TR = 4 * 1376;
        int it = bid;
        TrTile t; f32x4 v[8];
        if (it < N_TR) { tr_decode(p, it, tid, t); tr_load(t, tid, v); }
        while (it < N_TR) {
            bf16_t* dst = t.dst + (size_t)(t.n0 + 4 * ((tid >> 3))) * t.K + t.k0 + 8 * ((tid & 7));
            const int K = t.K;
            u32x4 o[4];
#pragma unroll
            for (int q = 0; q < 4; ++q) { o[q].x = cvt_pk_bf16(v[0][q], v[1][q]); o[q].y = cvt_pk_bf16(v[2][q], v[3][q]); o[q].z = cvt_pk_bf16(v[4][q], v[5][q]); o[q].w = cvt_pk_bf16(v[6][q], v[7][q]); }
            const int nx = it + G;
            if (nx < N_TR) { tr_decode(p, nx, tid, t); tr_load(t, tid, v); }
#pragma unroll
            for (int q = 0; q < 4; ++q) *(u32x4*)(dst + (size_t)q * K) = o[q];
            it = nx;
        }
    }
    constexpr int N_BIAS = 256, N_XROW = T_ / 16, N_LW = 32;
    for (int it = bid; it < N_BIAS + N_XROW + N_LW; it += G) {
        if (it >= N_BIAS + N_XROW) {
            const int q = it - N_BIAS - N_XROW, ln = q >> 1, gate = q & 1;
            const float* W = in_of(p, gate ? 17 : 15) + (size_t)ln * 4096;
            bf16_t* WT = (bf16_t*)(ws_of(p) + WS_LRUWT) + (size_t)q * 4096;
#pragma unroll
            for (int rr = 0; rr < 8; ++rr) { const int idx = tid + rr * NTHREADS, d = idx >> 6, c = idx & 63; WT[idx] = f2bf(W[c * 64 + d]); }
        } else if (it < N_BIAS) {
            const int lkv = it >> 5, part = it & 31, l = lkv >> 1, kv = lkv & 1;
            const float* pos = in_of(p, kv ? 10 : 7) + (size_t)l * 2048;
            const float* w1 = in_of(p, kv ? 11 : 8) + (size_t)l * 2048 * 256;
            const int j = tid & 255, half = tid >> 8;
            float sacc = 0.f;
            const int kb = part * 64 + half * 32;
            for (int k = kb; k < kb + 32; k += 8) {
                float a[8];
#pragma unroll
                for (int q = 0; q < 8; ++q) a[q] = w1[(size_t)(k + q) * 256 + j];
#pragma unroll
                for (int q = 0; q < 8; ++q) sacc += pos[k + q] * a[q];
            }
            tile[tid] = sacc;
            __syncthreads();
            if (tid < 256) ((float*)(ws_of(p) + WS_CBP))[(size_t)it * 256 + tid] = tile[tid] + tile[tid + 256];
            __syncthreads();
        } else {
            const int row0 = (it - N_BIAS) * 16 + (tid >> 6) * 2, lane = tid & 63;
            f32x4 xv[2][4];
#pragma unroll
            for (int rq = 0; rq < 2; ++rq)
#pragma unroll
                for (int i = 0; i < 4; ++i) xv[rq][i] = *(const f32x4*)(in_of(p, 0) + (size_t)(row0 + rq) * DM + i * 256 + lane * 4);
#pragma unroll
            for (int rq = 0; rq < 2; ++rq) {
                const int row = row0 + rq;
                bf16_t* hb = (bf16_t*)(ws_of(p) + WS_HB) + (size_t)row * DM;
                float ss = 0.f;
#pragma unroll
                for (int i = 0; i < 4; ++i) {
                    const f32x4 v = xv[rq][i];
                    ss += (v[0] * v[0] + v[1] * v[1]) + (v[2] * v[2] + v[3] * v[3]);
                    u32x2 w; w.x = cvt_pk_bf16(v[0], v[1]); w.y = cvt_pk_bf16(v[2], v[3]);
                    *(u32x2*)(hb + i * 256 + lane * 4) = w;
                }
                ss = wave_sum(ss);
                if (lane < 16) ((float*)(ws_of(p) + WS_SSQ))[(size_t)row * 16 + lane] = (lane == 0) ? ss : 0.f;
            }
        }
    }
}

__device__ void lru_x_item(const Params& p, int l, int b, int n, int ck, LAS unsigned char* lds) {
    const int tid = opaque_tid(), lane = tid & 63, w = __builtin_amdgcn_readfirstlane(tid >> 6), fr = lane & 15, fq = lane >> 4;
    LAS float* xs = (LAS float*)lds;
    LAS float* xc = (LAS float*)(lds + 17152);
    LAS bf16_t* xb = (LAS bf16_t*)(lds + 33536);
    LAS bf16_t* wt = (LAS bf16_t*)(lds + 42752);
    LAS float* pre = (LAS float*)(lds + 61184);
    LAS float* segA = (LAS float*)(lds + 93952);
    LAS float* segH = segA + 512;
    const bf16_t* U = (const bf16_t*)(ws_of(p) + WS_U);
    const int t0 = ck * 64, rowbase = b * SEQ;
    {
        u32x4 xv[2];
#pragma unroll
        for (int rr = 0; rr < 2; ++rr) {
            const int idx = tid + rr * NTHREADS, tt = idx >> 3, ch = idx & 7, t = t0 - 3 + tt;
            xv[rr] = (u32x4){0u, 0u, 0u, 0u};
            if (idx < 67 * 8 && t >= 0) xv[rr] = *(const u32x4*)(U + (size_t)(rowbase + t) * UW + 1280 + n * 64 + ch * 8);
        }
#pragma unroll
        for (int rr = 0; rr < 2; ++rr) {
            const int idx = tid + rr * NTHREADS, tt = idx >> 3, ch = idx & 7;
            if (idx < 67 * 8) {
                f32x4 lo, hi;
                lo[0] = __uint_as_float(xv[rr][0] << 16); lo[1] = __uint_as_float(xv[rr][0] & 0xffff0000u); lo[2] = __uint_as_float(xv[rr][1] << 16); lo[3] = __uint_as_float(xv[rr][1] & 0xffff0000u);
                hi[0] = __uint_as_float(xv[rr][2] << 16); hi[1] = __uint_as_float(xv[rr][2] & 0xffff0000u); hi[2] = __uint_as_float(xv[rr][3] << 16); hi[3] = __uint_as_float(xv[rr][3] & 0xffff0000u);
                *(LAS f32x4*)(xs + tt * 64 + ch * 8) = lo; *(LAS f32x4*)(xs + tt * 64 + ch * 8 + 4) = hi;
            }
        }
    }
    {
        const bf16_t* WT = (const bf16_t*)(ws_of(p) + WS_LRUWT) + (size_t)((l * 4 + n) * 2) * 4096;
#pragma unroll
        for (int rr = 0; rr < 2; ++rr) {
            const int idx = tid + rr * NTHREADS, row = idx >> 3, ch = idx & 7;
            *(LAS u32x4*)(wt + row * 72 + ch * 8) = *(const u32x4*)(WT + row * 64 + ch * 8);
        }
    }
    __syncthreads();
    {
        const float* cw = in_of(p, 13) + (size_t)l * 4 * 256 + n * 64; const float* cb = in_of(p, 14) + l * 256 + n * 64;
        const int c = tid & 63;
        const float w0 = cw[c], w1 = cw[256 + c], w2 = cw[512 + c], w3 = cw[768 + c], bc = cb[c];
#pragma unroll
        for (int k = 0; k < 8; ++k) {
            const int t = (tid >> 6) + 8 * k;
            const float v = bc + xs[t * 64 + c] * w0 + xs[(t + 1) * 64 + c] * w1 + xs[(t + 2) * 64 + c] * w2 + xs[(t + 3) * 64 + c] * w3;
            xc[t * 64 + c] = v; xb[t * 72 + c] = f2bf(v);
        }
    }
    __syncthreads();
    {
        const int tt = w & 3, gate = w >> 2;
        bf16x8 xa[2];
#pragma unroll
        for (int ks = 0; ks < 2; ++ks) xa[ks] = *(const LAS bf16x8*)(xb + (16 * tt + fr) * 72 + 32 * ks + 8 * fq);
        const float* bias = in_of(p, gate ? 18 : 16) + (l * 4 + n) * 64;
#pragma unroll
        for (int dt = 0; dt < 4; ++dt) {
            f32x4 acc = (f32x4){0.f, 0.f, 0.f, 0.f};
#pragma unroll
            for (int ks = 0; ks < 2; ++ks) {
                const bf16x8 wb = *(const LAS bf16x8*)(wt + (gate * 64 + 16 * dt + fr) * 72 + 32 * ks + 8 * fq);
                acc = __builtin_amdgcn_mfma_f32_16x16x32_bf16(xa[ks], wb, acc, 0, 0, 0);
            }
            const float bv = bias[16 * dt + fr];
#pragma unroll
            for (int i = 0; i < 4; ++i) pre[(gate * 64 + 16 * tt + 4 * fq + i) * 64 + 16 * dt + fr] = acc[i] + bv;
        }
    }
    __syncthreads();
    const int d = tid & 63, tq = tid >> 6;
    const float lam = in_of(p, 19)[l * 256 + n * 64 + d];
    const float sp = log1pf(expf(-lam));
    float hl[8], cl[8];
    float h = 0.f, ca = 1.f;
#pragma unroll
    for (int i = 0; i < 8; ++i) {
        const float r = __builtin_amdgcn_rcpf(1.0f + __expf(-pre[(tq * 8 + i) * 64 + d])), ii = __builtin_amdgcn_rcpf(1.0f + __expf(-pre[(64 + tq * 8 + i) * 64 + d]));
        const float la = -8.0f * r * sp;
        const float a = __expf(la);
        const float uu = __builtin_amdgcn_sqrtf(fmaxf(1.0f - a * a, 0.f)) * (ii * xc[(tq * 8 + i) * 64 + d]);
        h = a * h + uu; ca *= a; hl[i] = h; cl[i] = ca;
    }
    segA[tq * 64 + d] = ca; segH[tq * 64 + d] = h;
    __syncthreads();
    float cin_h = 0.f, cin_a = 1.f;
    for (int sgi = 0; sgi < tq; ++sgi) { const float sa = segA[sgi * 64 + d]; cin_h = sa * cin_h + segH[sgi * 64 + d]; cin_a *= sa; }
    float* LH = (float*)(ws_of(p) + WS_LRUH); float* LA = (float*)(ws_of(p) + WS_LRUA);
#pragma unroll
    for (int i = 0; i < 8; ++i) {
        const size_t o = (size_t)(rowbase + t0 + tq * 8 + i) * 256 + n * 64 + d;
        LH[o] = hl[i] + cl[i] * cin_h; LA[o] = cl[i] * cin_a;
    }
    __syncthreads();
}

__device__ __forceinline__ float logsigmoidf_(float x) { return fminf(x, 0.f) - log1pf(expf(-fabsf(x))); }

__device__ __forceinline__ int vt_off(int d, int key, int pitch) {
    const int kc = key >> 3;
    return d * pitch + ((((kc ^ (d >> 3)) & 7) | (kc & ~7)) << 3) + (key & 7);
}
__device__ void ml_x_item(const Params& p, int l, int bh, int ck, LAS unsigned char* lds) {
    const int tid = opaque_tid(), lane = tid & 63, w = __builtin_amdgcn_readfirstlane(tid >> 6), fr = lane & 15, fq = lane >> 4;
    const int b = bh >> 2, hh = bh & 3;
    LAS bf16_t* KwT = (LAS bf16_t*)lds;
    LAS bf16_t* VT = (LAS bf16_t*)(lds + 9216);
    LAS float* wks = (LAS float*)(lds + 20736);
    const bf16_t* U = (const bf16_t*)(ws_of(p) + WS_U);
    const float* GT = (const float*)(ws_of(p) + WS_GATES);
    const int rowbase = b * SEQ + ck * 64;
    if (tid < 64) {
        const float ig = GT[(size_t)(rowbase + lane) * 32 + 24 + hh] + in_of(p, 20)[l * 4 + hh];
        const float fp = GT[(size_t)(rowbase + lane) * 32 + 28 + hh] + in_of(p, 21)[l * 4 + hh];
        float a = logsigmoidf_(fp);
#pragma unroll
        for (int o = 1; o < 64; o <<= 1) { const float t = __shfl_up(a, o); if (lane >= o) a += t; }
        const float A = __shfl(a, 63);
        const float wend = A - a + ig;
        const float mu = wave_max(wend);
        wks[lane] = expf(wend - mu);
        if (lane == 0) { ((float*)(ws_of(p) + WS_MLMU))[bh * 32 + ck] = mu; ((float*)(ws_of(p) + WS_MLAT))[bh * 32 + ck] = A; }
    }
    const int srow = tid >> 3, sch = tid & 7;
    const bf16_t* src = U + (size_t)(rowbase + srow) * UW + hh * 64 + sch * 8;
    const u32x4 kk = *(const u32x4*)(src + 2048);
    {
        const u32x4 vv = *(const u32x4*)(src + 2304);
#pragma unroll
        for (int e = 0; e < 4; ++e) {
            VT[vt_off(sch * 8 + 2 * e, srow, 72)] = (bf16_t)(vv[e] & 0xffffu);
            VT[vt_off(sch * 8 + 2 * e + 1, srow, 72)] = (bf16_t)(vv[e] >> 16);
        }
        for (int idx = tid; idx < 16 * 72; idx += NTHREADS) VT[64 * 72 + idx] = (idx < 72) ? (bf16_t)0x3f80 : (bf16_t)0;
    }
    __syncthreads();
    {
        const float wk = wks[srow];
#pragma unroll
        for (int e = 0; e < 4; ++e) {
            KwT[vt_off(sch * 8 + 2 * e, srow, 72)] = f2bf(wk * __uint_as_float(kk[e] << 16));
            KwT[vt_off(sch * 8 + 2 * e + 1, srow, 72)] = f2bf(wk * __uint_as_float(kk[e] & 0xffff0000u));
        }
    }
    __syncthreads();
    {
        const int dt = w & 3, hf = w >> 2;
        bf16x8 ka[2];
#pragma unroll
        for (int ks = 0; ks < 2; ++ks) ka[ks] = *(const LAS bf16x8*)(KwT + vt_off(16 * dt + fr, 32 * ks + 8 * fq, 72));
        float* C = (float*)(ws_of(p) + WS_MLC) + (size_t)(bh * 32 + ck) * 4096;
#pragma unroll
        for (int ee = 0; ee < 2; ++ee) {
            const int et = 2 * hf + ee;
            f32x4 acc = (f32x4){0.f, 0.f, 0.f, 0.f};
#pragma unroll
            for (int ks = 0; ks < 2; ++ks) {
                const bf16x8 vb = *(const LAS bf16x8*)(VT + vt_off(16 * et + fr, 32 * ks + 8 * fq, 72));
                acc = __builtin_amdgcn_mfma_f32_16x16x32_bf16(ka[ks], vb, acc, 0, 0, 0);
            }
#pragma unroll
            for (int i = 0; i < 4; ++i) C[(16 * dt + 4 * fq + i) * 64 + 16 * et + fr] = acc[i];
        }
        if (hf == 0) {
            f32x4 acc = (f32x4){0.f, 0.f, 0.f, 0.f};
#pragma unroll
            for (int ks = 0; ks < 2; ++ks) {
                const bf16x8 vb = *(const LAS bf16x8*)(VT + (64 + fr) * 72 + 32 * ks + 8 * fq);
                acc = __builtin_amdgcn_mfma_f32_16x16x32_bf16(ka[ks], vb, acc, 0, 0, 0);
            }
            if (fr == 0) {
#pragma unroll
                for (int i = 0; i < 4; ++i) ((float*)(ws_of(p) + WS_MLN))[(size_t)(bh * 32 + ck) * 64 + 16 * dt + 4 * fq + i] = acc[i];
            }
        }
    }
    __syncthreads();
}

__device__ void phase_m2(const Params& p, int l, int cls, LAS unsigned char* lds, int bid, int G) {
    const int tid = opaque_tid();
    constexpr int N_KC = 128, N_LC = 4, N_MC = 256, N_MN = 4, TOTAL = N_KC + N_LC + N_MC + N_MN;
    for (int it = bid; it < TOTAL; it += G) {
        if (it < N_KC) {
            if (!(cls & 1)) continue;
            const int kv = it >> 6, r0 = (it & 63) * 32;
            LAS float* hid = (LAS float*)lds;
            LAS float* w2s = hid + 32 * 256;
            const float* part = (const float*)(ws_of(p) + WS_HID) + (size_t)(kv * 2048 + r0) * 256;
            const float* cb = (const float*)(ws_of(p) + WS_CBIAS) + (l * 2 + kv) * 256;
            const float* w2 = in_of(p, kv ? 12 : 9) + (size_t)l * 256 * 64;
            f32x4 pr[4][4];
#pragma unroll
            for (int rr = 0; rr < 4; ++rr) {
                const int idx = tid + rr * NTHREADS, row = idx >> 6, j4 = (idx & 63) * 4;
#pragma unroll
                for (int kp = 0; kp < 4; ++kp) pr[rr][kp] = *(const f32x4*)(part + (size_t)kp * 2 * 2048 * 256 + row * 256 + j4);
            }
#pragma unroll
            for (int rr = 0; rr < 4; ++rr) {
                const int idx = tid + rr * NTHREADS, row = idx >> 6, j4 = (idx & 63) * 4;
                f32x4 hv = *(const f32x4*)(cb + j4);
#pragma unroll
                for (int kp = 0; kp < 4; ++kp) hv = hv + pr[rr][kp];
#pragma unroll
                for (int q = 0; q < 4; ++q) hv[q] = hv[q] * __builtin_amdgcn_rcpf(1.0f + __expf(-hv[q]));
                *(LAS f32x4*)(hid + row * 256 + j4) = hv;
            }
#pragma unroll
            for (int rr = 0; rr < 8; ++rr) { const int idx = tid + rr * NTHREADS; *(LAS f32x4*)(w2s + idx * 4) = *(const f32x4*)(w2 + idx * 4); }
            __syncthreads();
            {
                const int d = tid & 63, rq = tid >> 6;
                float acc[4] = {0.f, 0.f, 0.f, 0.f};
                for (int j = 0; j < 256; j += 4) {
                    float wv[4];
#pragma unroll
                    for (int q = 0; q < 4; ++q) wv[q] = w2s[(j + q) * 64 + d];
#pragma unroll
                    for (int i = 0; i < 4; ++i) {
                        const f32x4 hv = *(const LAS f32x4*)(hid + (rq * 4 + i) * 256 + j);
#pragma unroll
                        for (int q = 0; q < 4; ++q) acc[i] += hv[q] * wv[q];
                    }
                }
                bf16_t* KCo = (bf16_t*)(ws_of(p) + WS_KC);
#pragma unroll
                for (int i = 0; i < 4; ++i) {
                    const int r = r0 + rq * 4 + i;
                    KCo[(size_t)(kv * 2048 + r) * 64 + d] = f2bf(((r & 127) == 127) ? 0.f : acc[i]);
                }
            }
            __syncthreads();
        } else if (it < N_KC + N_LC) {
            if (!(cls & 2)) continue;
            const int idx = (it - N_KC) * NTHREADS + tid;
            const int b = idx >> 8, ch = idx & 255;
            const float* LH = (const float*)(ws_of(p) + WS_LRUH); const float* LA = (const float*)(ws_of(p) + WS_LRUA);
            float* LC = (float*)(ws_of(p) + WS_LRUC);
            float la[32], lh[32];
#pragma unroll
            for (int ck = 0; ck < 32; ++ck) { const size_t o = (size_t)(b * SEQ + ck * 64 + 63) * 256 + ch; la[ck] = LA[o]; lh[ck] = LH[o]; }
            float carry = 0.f;
#pragma unroll
            for (int ck = 0; ck < 32; ++ck) { LC[(b * 32 + ck) * 256 + ch] = carry; carry = la[ck] * carry + lh[ck]; }
        } else {
            if (!(cls & 4)) continue;
            const bool isn = it >= N_KC + N_LC + N_MC;
            const int idx = (it - N_KC - N_LC - (isn ? N_MC : 0)) * NTHREADS + tid;
            const int bh = isn ? (idx >> 6) : (idx >> 12), de = isn ? (idx & 63) : (idx & 4095);
            const int esz = isn ? 64 : 4096;
            float* buf = (float*)(ws_of(p) + (isn ? WS_MLN : WS_MLC)) + (size_t)bh * 32 * esz + de;
            const float* MU = (const float*)(ws_of(p) + WS_MLMU) + bh * 32; const float* AT = (const float*)(ws_of(p) + WS_MLAT) + bh * 32;
            float* MP = (float*)(ws_of(p) + WS_MLMP) + bh * 32;
            float dc[32];
#pragma unroll
            for (int ck = 0; ck < 32; ++ck) dc[ck] = buf[(size_t)ck * esz];
            float C = 0.f, m = 0.f;
#pragma unroll
            for (int ck = 0; ck < 32; ++ck) {
                buf[(size_t)ck * esz] = C;
                if (!isn && de == 0) MP[ck] = m;
                const float at = AT[ck], mu = MU[ck];
                const float mn = fmaxf(at + m, mu);
                C = expf(at + m - mn) * C + expf(mu - mn) * dc[ck];
                m = mn;
            }
        }
    }
}

__device__ __forceinline__ float gelu_tanh(float x) { const float u = 0.7978845608028654f * (x + 0.044715f * x * x * x); return 0.5f * x * (1.0f + tanhf(u)); }

__device__ void lru_y_item(const Params& p, int l, int item) {
    const int tid = opaque_tid(), lane = tid & 63;
    const float* LH = (const float*)(ws_of(p) + WS_LRUH); const float* LA = (const float*)(ws_of(p) + WS_LRUA); const float* LC = (const float*)(ws_of(p) + WS_LRUC);
    const bf16_t* U = (const bf16_t*)(ws_of(p) + WS_U);
    const float* hn = in_of(p, 22) + l * 1024;
    bf16_t* HD = (bf16_t*)(ws_of(p) + WS_HEADS);
    const int pair0 = item * 128 + (tid >> 6) * 16;
    float lh[16], la[16], lc[16], gg[16];
    float gn[4];
#pragma unroll
    for (int n = 0; n < 4; ++n) gn[n] = hn[(8 + n) * 64 + lane];
#pragma unroll
    for (int q = 0; q < 16; ++q) {
        const int pair = pair0 + q, row = pair >> 2, n = pair & 3, ch = n * 64 + lane;
        lh[q] = LH[(size_t)row * 256 + ch]; la[q] = LA[(size_t)row * 256 + ch];
        lc[q] = LC[((row >> 11) * 32 + ((row & 2047) >> 6)) * 256 + ch];
        gg[q] = bf2f(U[(size_t)row * UW + 1536 + ch]);
    }
#pragma unroll
    for (int q = 0; q < 16; ++q) {
        const int pair = pair0 + q, row = pair >> 2, n = pair & 3;
        const float h = lh[q] + la[q] * lc[q];
        const float y = h * gelu_tanh(gg[q]);
        const float ss = wave_sum(y * y);
        HD[(size_t)row * DM + (8 + n) * 64 + lane] = f2bf(y * rsqrtf(ss * (1.0f / 64.0f) + EPS) * gn[q & 3]);
    }
}

__device__ __forceinline__ int vt_lane(int fr, int fq, int pitch) { return fr * pitch + ((((fq >> 1) ^ (fr >> 3)) & 1) << 3) + ((fq & 1) << 2); }
__device__ __forceinline__ constexpr int vt_cst(int dt, int kc2, int pitch) { return dt * 16 * pitch + ((((kc2 ^ (2 * dt)) & 6) | (kc2 & ~7)) << 3); }
__device__ void ml_y_item(const Params& p, int l, int bh, int ck, LAS unsigned char* lds) {
    const int tid = opaque_tid(), lane = tid & 63, w = __builtin_amdgcn_readfirstlane(tid >> 6), fr = lane & 15, fq = lane >> 4;
    const int b = bh >> 2, hh = bh & 3;
    LAS bf16_t* Ql = (LAS bf16_t*)lds;
    LAS bf16_t* Kl = (LAS bf16_t*)(lds + 9216);
    LAS bf16_t* Vt = (LAS bf16_t*)(lds + 18432);
    LAS bf16_t* Ct = (LAS bf16_t*)(lds + 27648);
    LAS bf16_t* Wl = (LAS bf16_t*)(lds + 39168);
    LAS float* as_ = (LAS float*)(lds + 57600);
    LAS float* bs_ = as_ + 64;
    LAS float* Ms_ = bs_ + 64;
    LAS float* ssl = Ms_ + 64;
    const bf16_t* U = (const bf16_t*)(ws_of(p) + WS_U);
    const float* GT = (const float*)(ws_of(p) + WS_GATES);
    const int rowbase = b * SEQ + ck * 64;
    const float mprev = ((const float*)(ws_of(p) + WS_MLMP))[bh * 32 + ck];
    if (tid < 64) {
        const float ig = GT[(size_t)(rowbase + lane) * 32 + 24 + hh] + in_of(p, 20)[l * 4 + hh];
        const float fp = GT[(size_t)(rowbase + lane) * 32 + 28 + hh] + in_of(p, 21)[l * 4 + hh];
        float a = logsigmoidf_(fp);
#pragma unroll
        for (int o = 1; o < 64; o <<= 1) { const float t = __shfl_up(a, o); if (lane >= o) a += t; }
        const float bb = ig - a;
        float pm = bb;
#pragma unroll
        for (int o = 1; o < 64; o <<= 1) { const float t = __shfl_up(pm, o); if (lane >= o) pm = fmaxf(pm, t); }
        as_[lane] = a; bs_[lane] = bb; Ms_[lane] = fmaxf(mprev, pm);
        Ct[64 * 72 + lane] = f2bf(((const float*)(ws_of(p) + WS_MLN))[(size_t)(bh * 32 + ck) * 64 + lane]);
    }
    {
        const int row = tid >> 3, ch = tid & 7;
        const bf16_t* src = U + (size_t)(rowbase + row) * UW + hh * 64 + ch * 8;
        *(LAS u32x4*)(Ql + row * 72 + ch * 8) = *(const u32x4*)(src + 1792);
        *(LAS u32x4*)(Kl + row * 72 + ch * 8) = *(const u32x4*)(src + 2048);
        const u32x4 vv = *(const u32x4*)(src + 2304);
#pragma unroll
        for (int e = 0; e < 4; ++e) {
            Vt[vt_off(ch * 8 + 2 * e, row, 72)] = (bf16_t)(vv[e] & 0xffffu);
            Vt[vt_off(ch * 8 + 2 * e + 1, row, 72)] = (bf16_t)(vv[e] >> 16);
        }
        const float* C = (const float*)(ws_of(p) + WS_MLC) + (size_t)(bh * 32 + ck) * 4096;
#pragma unroll
        for (int rr = 0; rr < 2; ++rr) {
            const int idx = tid + rr * NTHREADS, d = idx >> 4, e4 = (idx & 15) * 4;
            const f32x4 c = *(const f32x4*)(C + d * 64 + e4);
#pragma unroll
            for (int i = 0; i < 4; ++i) Ct[(e4 + i) * 72 + d] = f2bf(c[i]);
        }
        for (int idx = tid; idx < 15 * 72; idx += NTHREADS) Ct[65 * 72 + idx] = 0;
    }
    __syncthreads();
    const int jt = w & 3, hf = w >> 2;
    bf16_t opre[2][4];
#pragma unroll
    for (int i = 0; i < 4; ++i)
#pragma unroll
        for (int ee = 0; ee < 2; ++ee) opre[ee][i] = U[(size_t)(rowbase + 16 * jt + 4 * fq + i) * UW + 2560 + hh * 64 + 16 * (2 * hf + ee) + fr];
    bf16x8 qa[2];
#pragma unroll
    for (int ks = 0; ks < 2; ++ks) qa[ks] = *(const LAS bf16x8*)(Ql + (16 * jt + fr) * 72 + 32 * ks + 8 * fq);
    f32x4 sacc[4];
#pragma unroll
    for (int st = 0; st < 4; ++st) {
        const bf16x8 k0 = *(const LAS bf16x8*)(Kl + (16 * st + fr) * 72 + 8 * fq), k1 = *(const LAS bf16x8*)(Kl + (16 * st + fr) * 72 + 32 + 8 * fq);
        sacc[st] = __builtin_amdgcn_mfma_f32_16x16x32_bf16(qa[0], k0, (f32x4){0.f, 0.f, 0.f, 0.f}, 0, 0, 0);
        sacc[st] = __builtin_amdgcn_mfma_f32_16x16x32_bf16(qa[1], k1, sacc[st], 0, 0, 0);
    }
    float sw[4], Mj[4];
    LAS bf16_t* Ww = Wl + w * (16 * 72);
#pragma unroll
    for (int i = 0; i < 4; ++i) {
        const int j = 16 * jt + 4 * fq + i;
        Mj[i] = Ms_[j];
        float acc = 0.f;
#pragma unroll
        for (int st = 0; st < 4; ++st) {
            const int sidx = 16 * st + fr;
            const float wv = (sidx <= j) ? __expf(bs_[sidx] - Mj[i]) * sacc[st][i] : 0.f;
            acc += wv;
            Ww[(4 * fq + i) * 72 + sidx] = f2bf(wv);
        }
        acc += __shfl_xor(acc, 1); acc += __shfl_xor(acc, 2); acc += __shfl_xor(acc, 4); acc += __shfl_xor(acc, 8);
        sw[i] = acc;
    }
    asm volatile("s_waitcnt lgkmcnt(0)" ::: "memory");
    bf16x8 wa[2];
#pragma unroll
    for (int ks = 0; ks < 2; ++ks) wa[ks] = *(const LAS bf16x8*)(Ww + fr * 72 + 32 * ks + 8 * fq);
    f32x4 acc1[2], acc2[2], accn;
#pragma unroll
    for (int ee = 0; ee < 2; ++ee) {
        const int et = 2 * hf + ee;
        acc1[ee] = (f32x4){0.f, 0.f, 0.f, 0.f}; acc2[ee] = (f32x4){0.f, 0.f, 0.f, 0.f};
#pragma unroll
        for (int ks = 0; ks < 2; ++ks) {
            const bf16x8 cf = *(const LAS bf16x8*)(Ct + (16 * et + fr) * 72 + 32 * ks + 8 * fq);
            const bf16x8 vf = *(const LAS bf16x8*)(Vt + vt_off(16 * et + fr, 32 * ks + 8 * fq, 72));
            acc1[ee] = __builtin_amdgcn_mfma_f32_16x16x32_bf16(qa[ks], cf, acc1[ee], 0, 0, 0);
            acc2[ee] = __builtin_amdgcn_mfma_f32_16x16x32_bf16(wa[ks], vf, acc2[ee], 0, 0, 0);
        }
    }
    accn = (f32x4){0.f, 0.f, 0.f, 0.f};
#pragma unroll
    for (int ks = 0; ks < 2; ++ks) {
        const bf16x8 cf = *(const LAS bf16x8*)(Ct + (64 + fr) * 72 + 32 * ks + 8 * fq);
        accn = __builtin_amdgcn_mfma_f32_16x16x32_bf16(qa[ks], cf, accn, 0, 0, 0);
    }
    float ov[2][4];
#pragma unroll
    for (int i = 0; i < 4; ++i) {
        const int j = 16 * jt + 4 * fq + i;
        const float qn = __shfl(accn[i], lane & 48);
        const float inter = expf(mprev - Mj[i]);
        const float den = inter * qn + sw[i];
        const float lim = expf(-(as_[j] + Mj[i]));
        const float inv = 1.0f / fmaxf(fabsf(den), lim);
        float ssp = 0.f;
#pragma unroll
        for (int ee = 0; ee < 2; ++ee) {
            const int e = 16 * (2 * hf + ee) + fr;
            const float hv = (inter * acc1[ee][i] + acc2[ee][i]) * inv;
            const float o = sigmoidf_(bf2f(opre[ee][i])) * hv;
            ov[ee][i] = o; ssp += o * o;
        }
        ssp += __shfl_xor(ssp, 1); ssp += __shfl_xor(ssp, 2); ssp += __shfl_xor(ssp, 4); ssp += __shfl_xor(ssp, 8);
        if (fr == 0) ssl[w * 16 + 4 * fq + i] = ssp;
    }
    __syncthreads();
    {
        bf16_t* HD = (bf16_t*)(ws_of(p) + WS_HEADS);
        const float* hn = in_of(p, 22) + l * 1024 + (12 + hh) * 64;
#pragma unroll
        for (int i = 0; i < 4; ++i) {
            const int j = 16 * jt + 4 * fq + i;
            const float tot = ssl[jt * 16 + 4 * fq + i] + ssl[(jt + 4) * 16 + 4 * fq + i];
            const float rs = rsqrtf(tot * (1.0f / 64.0f) + EPS);
#pragma unroll
            for (int ee = 0; ee < 2; ++ee) {
                const int e = 16 * (2 * hf + ee) + fr;
                HD[(size_t)(rowbase + j) * DM + (12 + hh) * 64 + e] = f2bf(ov[ee][i] * rs * hn[e]);
            }
        }
    }
    __syncthreads();
}

__device__ __forceinline__ bf16x8 pack8(const f32x4 lo, const f32x4 hi) {
    u32x4 r; r.x = cvt_pk_bf16(lo[0], lo[1]); r.y = cvt_pk_bf16(lo[2], lo[3]); r.z = cvt_pk_bf16(hi[0], hi[1]); r.w = cvt_pk_bf16(hi[2], hi[3]);
    return __builtin_bit_cast(bf16x8, r);
}
__device__ __forceinline__ bf16x8 join8(const u32x2 lo, const u32x2 hi) { u32x4 r; r.x = lo.x; r.y = lo.y; r.z = hi.x; r.w = hi.y; return __builtin_bit_cast(bf16x8, r); }
__device__ void nsa_item(const Params& p, int l, int b, int g, int qb, LAS unsigned char* lds, int mode = 0) {
    int tid = opaque_tid(), w = __builtin_amdgcn_readfirstlane(tid >> 6), lane = tid & 63, fr = lane & 15, fq = lane >> 4;
    LAS bf16_t* Kc = (LAS bf16_t*)lds;
    LAS bf16_t* Vc = (LAS bf16_t*)(lds + 18432);
    LAS bf16_t* Pl = (LAS bf16_t*)(lds + 36864);
    LAS float* impl = (LAS float*)(lds + 106496);
    LAS unsigned* selm = (LAS unsigned*)(lds + 114688);
    LAS int* steps = (LAS int*)(lds + 114944);
    const bf16_t* U = (const bf16_t*)(ws_of(p) + WS_U);
    const int bg = b * 2 + g, rowbase = b * SEQ;
    const int head = 4 * g + (w >> 1);
    const float sl2 = exp2f(-(float)(head + 1)) * 1.4426950408889634f;
    const int tw0 = qb * 64 + (w & 1) * 32;
    bf16x8 qf[2][2];
#pragma unroll
    for (int mt = 0; mt < 2; ++mt)
#pragma unroll
        for (int ks = 0; ks < 2; ++ks)
            qf[mt][ks] = *(const bf16x8*)(U + (size_t)(rowbase + tw0 + mt * 16 + fr) * UW + head * 64 + ks * 32 + fq * 8);
    const float* GT = (const float*)(ws_of(p) + WS_GATES);
    float gpre[2][3];
#pragma unroll
    for (int mt = 0; mt < 2; ++mt)
#pragma unroll
        for (int q = 0; q < 3; ++q) gpre[mt][q] = GT[(size_t)(rowbase + tw0 + mt * 16 + fr) * 32 + head * 3 + q];
    f32x4 y[2][4];
    {
        LAS float* impM = (LAS float*)Pl;
        LAS float* impT = impM + 4 * 64 * 33;
        const bf16_t* KC = (const bf16_t*)(ws_of(p) + WS_KC) + (size_t)bg * 128 * 64;
        const bf16_t* VC = KC + (size_t)2048 * 64;
        u32x4 kvr[2], vvr[2];
#pragma unroll
        for (int rr = 0; rr < 2; ++rr) { const int idx = tid + rr * NTHREADS; kvr[rr] = *(const u32x4*)(KC + idx * 8); vvr[rr] = *(const u32x4*)(VC + idx * 8); }
#pragma unroll
        for (int rr = 0; rr < 2; ++rr) {
            const int idx = tid + rr * NTHREADS, key = idx >> 3, ch = idx & 7;
            const u32x4 kv = kvr[rr];
            const u32x4 vv = vvr[rr];
            *(LAS u32x4*)(Kc + key * 72 + ch * 8) = kv;
#pragma unroll
            for (int e = 0; e < 4; ++e) {
                Vc[vt_off(ch * 8 + 2 * e, key, 136)] = (bf16_t)(vv[e] & 0xffffu);
                Vc[vt_off(ch * 8 + 2 * e + 1, key, 136)] = (bf16_t)(vv[e] >> 16);
            }
        }
        __syncthreads();
        const int vl136 = vt_lane(fr, fq, 136);
#pragma unroll
        for (int mt = 0; mt < 2; ++mt) {
            const int t = tw0 + mt * 16 + fr;
            f32x4 s[8];
#pragma unroll
            for (int nt = 0; nt < 8; ++nt) {
                const bf16x8 k0 = *(const LAS bf16x8*)(Kc + (16 * nt + fr) * 72 + fq * 8), k1 = *(const LAS bf16x8*)(Kc + (16 * nt + fr) * 72 + 32 + fq * 8);
                s[nt] = __builtin_amdgcn_mfma_f32_16x16x32_bf16(k0, qf[mt][0], (f32x4){0.f, 0.f, 0.f, 0.f}, 0, 0, 0);
                s[nt] = __builtin_amdgcn_mfma_f32_16x16x32_bf16(k1, qf[mt][1], s[nt], 0, 0, 0);
            }
            float mx = NEGF;
#pragma unroll
            for (int nt = 0; nt < 8; ++nt)
#pragma unroll
                for (int i = 0; i < 4; ++i) {
                    const int n = 16 * nt + 4 * fq + i, cend = 16 * n + 31;
                    const bool valid = (t >= cend) && (n < 127);
                    const float sv = valid ? fmaf(sl2, (float)cend, s[nt][i]) : NEGF;
                    s[nt][i] = sv; mx = fmaxf(mx, sv);
                }
            mx = fq_max(mx);
            const float ms = (mx < -1e29f) ? 0.f : mx;
            float sum = 0.f;
#pragma unroll
            for (int nt = 0; nt < 8; ++nt)
#pragma unroll
                for (int i = 0; i < 4; ++i) { const float pv = __builtin_amdgcn_exp2f(s[nt][i] - ms); s[nt][i] = pv; sum += pv; }
            sum = fq_sum(sum);
            const float inv = sum > 0.f ? 1.0f / sum : 0.f;
            {
                LAS float* mrow_ = impM + ((w >> 1) * 64 + (w & 1) * 32 + mt * 16 + fr) * 33 + fq;
                LAS float* trow_ = impT + ((w >> 1) * 64 + (w & 1) * 32 + mt * 16 + fr) * 33 + fq + 1;
#pragma unroll
                for (int nt = 0; nt < 8; ++nt) {
                    s[nt] = s[nt] * inv;
                    mrow_[4 * nt] = (s[nt][0] + s[nt][1]) + (s[nt][2] + s[nt][3]);
                    trow_[4 * nt] = s[nt][3];
                }
            }
            f32x4 oc[4];
#pragma unroll
            for (int dt = 0; dt < 4; ++dt) oc[dt] = (f32x4){0.f, 0.f, 0.f, 0.f};
#pragma unroll
            for (int ks2 = 0; ks2 < 4; ++ks2) {
                const bf16x8 pb = pack8(s[2 * ks2], s[2 * ks2 + 1]);
#pragma unroll
                for (int dt = 0; dt < 4; ++dt) {
                    const u32x2 lo = *(const LAS u32x2*)(Vc + vl136 + vt_cst(dt, 4 * ks2, 136));
                    const u32x2 hi = *(const LAS u32x2*)(Vc + vl136 + vt_cst(dt, 4 * ks2 + 2, 136));
                    oc[dt] = __builtin_amdgcn_mfma_f32_16x16x32_bf16(join8(lo, hi), pb, oc[dt], 0, 0, 0);
                }
            }
            const float g0 = sigmoidf_(gpre[mt][0]);
#pragma unroll
            for (int dt = 0; dt < 4; ++dt) y[mt][dt] = oc[dt] * g0;
        }
        if (tid < 256) impT[tid * 33] = 0.f;
        __syncthreads();
#pragma unroll 1
        for (int rr = 0; rr < 4; ++rr) {
            const int idx = tid + rr * NTHREADS, tau = idx >> 5, j = idx & 31;
            float mine = 0.f;
#pragma unroll
            for (int hh = 0; hh < 4; ++hh) mine += impM[(hh * 64 + tau) * 33 + j] + impT[(hh * 64 + tau) * 33 + j];
            bool sel;
            if (qb < 16) sel = (j <= qb);
            else {
                const bool forced = (j == 0) || (j == qb) || (j == qb - 1);
                const bool cand = (j >= 1) && (j <= qb - 2);
                int rank = 0;
#pragma unroll
                for (int jp = 1; jp < 30; ++jp) {
                    const float o = __shfl(mine, (lane & 32) + jp);
                    rank += (jp <= qb - 2 && (o > mine || (o == mine && jp < j))) ? 1 : 0;
                }
                sel = forced || (cand && rank < 13);
            }
            const unsigned long long bal = __ballot(sel);
            if ((lane & 31) == 0) selm[tau] = (lane < 32) ? (unsigned)bal : (unsigned)(bal >> 32);
        }
        __syncthreads();
        if (tid < 64) {
            unsigned m = selm[tid], uni = m, all = m;
#pragma unroll
            for (int o = 32; o >= 1; o >>= 1) { uni |= __shfl_xor(uni, o); all &= __shfl_xor(all, o); }
            uni &= (qb >= 31) ? 0xffffffffu : ((2u << qb) - 1u);
            const int nsel = __popc(uni);
            const int kb = tid;
            if (kb <= qb && ((uni >> kb) & 1u)) {
                const int pos = __popc(uni & ((1u << kb) - 1u));
                steps[1 + pos] = ((((all >> kb) & 1u) && kb < qb) ? 4096 : 0) | (1 << 8) | kb;
            }
            const int kb0 = (qb - 8 < 0) ? 0 : qb - 8;
            if (kb >= kb0 && kb <= qb) steps[1 + nsel + (kb - kb0)] = ((kb > qb - 8 && kb < qb) ? 4096 : 0) | (2 << 8) | kb;
            if (tid == 0) steps[0] = nsel + (qb - kb0 + 1);
        }
        __syncthreads();
    }
    if (mode == 1) { asm volatile("" :: "v"(y[0][0][0]), "v"(y[1][3][3])); __syncthreads(); return; }
    tid = opaque_tid(); w = __builtin_amdgcn_readfirstlane(tid >> 6); lane = tid & 63; fr = lane & 15; fq = lane >> 4;
    unsigned smask[2];
#pragma unroll
    for (int mt = 0; mt < 2; ++mt) smask[mt] = selm[(w & 1) * 32 + mt * 16 + fr];
    const int nsteps = __builtin_amdgcn_readfirstlane(steps[0]);
    const int mystep = steps[1 + (lane < 48 ? lane : 47)];
#define NSA_ST(k) __builtin_amdgcn_readlane(mystep, (k))
    float mrow[2], lrow[2];
    f32x4 oacc[2][4];
#pragma unroll
    for (int mt = 0; mt < 2; ++mt) {
        mrow[mt] = NEGF; lrow[mt] = 0.f;
#pragma unroll
        for (int dt = 0; dt < 4; ++dt) oacc[mt][dt] = (f32x4){0.f, 0.f, 0.f, 0.f};
    }
    const int skey = tid >> 3, sch = tid & 7;
    const int vl72 = vt_lane(fr, fq, 72);
    const int vsw = vt_off(sch * 8, skey, 72);
    bf16x8 kx[4], qx;
    {
        const float sh = bf2f(f2bf(sl2)), slo = sl2 - sh;
        u32x4 t = (u32x4){0u, 0u, 0u, 0u};
        if (fq == 0) t.x = cvt_pk_bf16(sh, slo);
        qx = __builtin_bit_cast(bf16x8, t);
#pragma unroll
        for (int nt = 0; nt < 4; ++nt) {
            u32x4 k = (u32x4){0u, 0u, 0u, 0u};
            const float r = (float)(16 * nt + fr);
            if (fq == 0) k.x = cvt_pk_bf16(r, r);
            kx[nt] = __builtin_bit_cast(bf16x8, k);
        }
    }
    const bf16_t* Ubase = U + (size_t)(rowbase + skey) * UW + g * 64 + sch * 8;
#define NSA_SRC(st_) (Ubase + (size_t)((st_) & 255) * 64 * UW + ((((st_) >> 8) & 15) == 1 ? 768 : 1024))
#define NSA_STAGE(buf_, kr_, vr_) do { \
        *(LAS u32x4*)(Kc + (buf_) * (64 * 72) + skey * 72 + sch * 8) = kr_; \
        LAS bf16_t* _vn = Vc + (buf_) * (64 * 72) + vsw; \
        _Pragma("unroll") for (int e = 0; e < 4; ++e) { _vn[(2 * e) * 72] = (bf16_t)(vr_[e] & 0xffffu); _vn[(2 * e + 1) * 72] = (bf16_t)(vr_[e] >> 16); } } while (0)
    u32x4 kregA, vregA;
    {
        const bf16_t* src = NSA_SRC(NSA_ST(0));
        kregA = *(const u32x4*)src; vregA = *(const u32x4*)(src + 128);
        NSA_STAGE(0, kregA, vregA);
    }
    if (nsteps > 1) { const bf16_t* src = NSA_SRC(NSA_ST(1)); kregA = *(const u32x4*)src; vregA = *(const u32x4*)(src + 128); }
    __syncthreads();
    int curkind = 1;
#define NSA_STEP(si, kX, vX) do { \
        const int st = NSA_ST(si), kind = (st >> 8) & 15, kb = st & 255; \
        const bool nomask = (st & 4096) != 0; \
        LAS bf16_t* Kl = Kc + ((si) & 1) * (64 * 72); \
        LAS bf16_t* Vt = Vc + ((si) & 1) * (64 * 72); \
        if (kind != curkind) { \
            _Pragma("unroll") for (int mt = 0; mt < 2; ++mt) { \
                float lt = lrow[mt]; \
                lt = fq_sum(lt); \
                const float sc = sigmoidf_(gpre[mt][1]) / lt; \
                _Pragma("unroll") for (int dt = 0; dt < 4; ++dt) { y[mt][dt] += oacc[mt][dt] * sc; oacc[mt][dt] = (f32x4){0.f, 0.f, 0.f, 0.f}; } \
                mrow[mt] = NEGF; lrow[mt] = 0.f; \
            } \
            curkind = kind; \
        } \
        const float Bs = sl2 * (float)(kb * 64); \
        int kbi = kb * 64 + 4 * fq; \
        asm volatile("" : "+v"(kbi)); \
        f32x4 s[2][4]; \
        _Pragma("unroll") for (int nt = 0; nt < 4; ++nt) { \
            const bf16x8 k0 = *(const LAS bf16x8*)(Kl + (16 * nt + fr) * 72 + fq * 8), k1 = *(const LAS bf16x8*)(Kl + (16 * nt + fr) * 72 + 32 + fq * 8); \
            _Pragma("unroll") for (int mt = 0; mt < 2; ++mt) { \
                s[mt][nt] = __builtin_amdgcn_mfma_f32_16x16x32_bf16(k0, qf[mt][0], (f32x4){0.f, 0.f, 0.f, 0.f}, 0, 0, 0); \
                s[mt][nt] = __builtin_amdgcn_mfma_f32_16x16x32_bf16(k1, qf[mt][1], s[mt][nt], 0, 0, 0); \
                s[mt][nt] = __builtin_amdgcn_mfma_f32_16x16x32_bf16(kx[nt], qx, s[mt][nt], 0, 0, 0); \
            } \
        } \
        bf16x8 pb[2][2]; \
        _Pragma("unroll") for (int mt = 0; mt < 2; ++mt) { \
            float mx = NEGF; \
            if (nomask) { \
                _Pragma("unroll") for (int nt = 0; nt < 4; ++nt) \
                    _Pragma("unroll") for (int i = 0; i < 4; ++i) mx = fmaxf(mx, s[mt][nt][i]); \
            } else { \
                const int t = tw0 + mt * 16 + fr; \
                const bool rowok = (kind == 1) ? (((smask[mt] >> kb) & 1u) != 0u) : true; \
                _Pragma("unroll") for (int nt = 0; nt < 4; ++nt) \
                    _Pragma("unroll") for (int i = 0; i < 4; ++i) { \
                        const int dist = t - (kbi + 16 * nt + i); \
                        const bool valid = rowok && dist >= 0 && (kind == 1 || dist < 512); \
                        const float sv = valid ? s[mt][nt][i] : NEGF; \
                        s[mt][nt][i] = sv; mx = fmaxf(mx, sv); \
                    } \
            } \
            mx = fq_max(mx) + Bs; \
            const float mn = fmaxf(mrow[mt], mx); \
            const float alpha = __builtin_amdgcn_exp2f(mrow[mt] - mn); \
            mrow[mt] = mn; \
            const float ms = ((mn < -1e29f) ? 0.f : mn) - Bs; \
            float ls = 0.f; \
            _Pragma("unroll") for (int nt = 0; nt < 4; ++nt) \
                _Pragma("unroll") for (int i = 0; i < 4; ++i) { const float pv = __builtin_amdgcn_exp2f(s[mt][nt][i] - ms); s[mt][nt][i] = pv; ls += pv; } \
            lrow[mt] = lrow[mt] * alpha + ls; \
            _Pragma("unroll") for (int dt = 0; dt < 4; ++dt) oacc[mt][dt] = oacc[mt][dt] * alpha; \
            pb[mt][0] = pack8(s[mt][0], s[mt][1]); pb[mt][1] = pack8(s[mt][2], s[mt][3]); \
        } \
        _Pragma("unroll") for (int ks2 = 0; ks2 < 2; ++ks2) \
            _Pragma("unroll") for (int dt = 0; dt < 4; ++dt) { \
                const u32x2 lo = *(const LAS u32x2*)(Vt + vl72 + vt_cst(dt, 4 * ks2, 72)); \
                const u32x2 hi = *(const LAS u32x2*)(Vt + vl72 + vt_cst(dt, 4 * ks2 + 2, 72)); \
                const bf16x8 va = join8(lo, hi); \
                _Pragma("unroll") for (int mt = 0; mt < 2; ++mt) oacc[mt][dt] = __builtin_amdgcn_mfma_f32_16x16x32_bf16(va, pb[mt][ks2], oacc[mt][dt], 0, 0, 0); \
            } \
        if ((si) + 1 < nsteps) NSA_STAGE(((si) + 1) & 1, kX, vX); \
        if ((si) + 2 < nsteps) { const bf16_t* src = NSA_SRC(NSA_ST((si) + 2)); kX = *(const u32x4*)src; vX = *(const u32x4*)(src + 128); } \
        __syncthreads(); \
    } while (0)
    for (int si = 0; si < nsteps; ++si) {
        NSA_STEP(si, kregA, vregA);
    }
#undef NSA_STEP
#undef NSA_ST
#undef NSA_STAGE
#undef NSA_SRC
    tid = opaque_tid(); lane = tid & 63; fr = lane & 15; fq = lane >> 4;
    {
        const float* hn = in_of(p, 22) + l * 1024 + head * 64;
        bf16_t* HD = (bf16_t*)(ws_of(p) + WS_HEADS);
        f32x4 gnv[4];
#pragma unroll
        for (int dt = 0; dt < 4; ++dt) gnv[dt] = *(const f32x4*)(hn + 16 * dt + 4 * fq);
#pragma unroll
        for (int mt = 0; mt < 2; ++mt) {
            const int t = tw0 + mt * 16 + fr;
            float lt = lrow[mt];
            lt = fq_sum(lt);
            const float sc = sigmoidf_(gpre[mt][2]) / lt;
            float ss = 0.f;
            f32x4 yy[4];
#pragma unroll
            for (int dt = 0; dt < 4; ++dt) { yy[dt] = y[mt][dt] + oacc[mt][dt] * sc; ss += (yy[dt][0] * yy[dt][0] + yy[dt][1] * yy[dt][1]) + (yy[dt][2] * yy[dt][2] + yy[dt][3] * yy[dt][3]); }
            ss = fq_sum(ss);
            const float rs = rsqrtf(ss * (1.0f / 64.0f) + EPS);
#pragma unroll
            for (int dt = 0; dt < 4; ++dt) {
                const f32x4 gn = gnv[dt];
                const f32x4 o = yy[dt] * rs * gn;
                u32x2 pk; pk.x = cvt_pk_bf16(o[0], o[1]); pk.y = cvt_pk_bf16(o[2], o[3]);
                *(u32x2*)(HD + (size_t)(rowbase + t) * DM + head * 64 + 16 * dt + 4 * fq) = pk;
            }
        }
    }
    __syncthreads();
}

#define XB_TMO      128
#define XB_XCNT(j)  (256  + 64 * (j))
#define XB_XSUB(j)  (1280 + 64 * (j))
#define XB_XGEN(j)  (2304 + 64 * (j))
#define XB_TOP      3328
#define XB_TOPGEN   3392
#define XCD_BAR_WORDS 3456
#define XB_SPIN_CAP (1u << 22)
__device__ __forceinline__ unsigned xb_ld(unsigned* p)              { return __hip_atomic_load(p, __ATOMIC_RELAXED, __HIP_MEMORY_SCOPE_AGENT); }
__device__ __forceinline__ unsigned xb_add(unsigned* p, unsigned v) { return __hip_atomic_fetch_add(p, v, __ATOMIC_RELAXED, __HIP_MEMORY_SCOPE_AGENT); }
__device__ __forceinline__ unsigned xb_xcc_id() { return (unsigned)__builtin_amdgcn_s_getreg((3 << 11) | 20) & 0xFu; }
#define XB_SPIN(cond, bar) do { unsigned _sp = 0; while (cond) { __builtin_amdgcn_s_sleep(1); \
    if ((++_sp & 255u) == 0u) { if (xb_ld(&(bar)[XB_TMO])) break; if (_sp > XB_SPIN_CAP) { atomicAdd(&(bar)[XB_TMO], 1u); break; } } } } while (0)
struct XcdBarrier { unsigned* bar; unsigned x; volatile LAS unsigned* st; };
__device__ __forceinline__ XcdBarrier xcd_barrier_post(unsigned* bar, volatile LAS unsigned* st) {
    XcdBarrier b; b.bar = bar; b.x = xb_xcc_id(); b.st = st;
    if (threadIdx.x == 0) (void)xb_add(&bar[XB_XCNT(b.x)], 1u);
    return b;
}
__device__ __forceinline__ void xcd_barrier_complete(unsigned* bar, unsigned x, unsigned& nloc, unsigned& nx) {
    const unsigned G = gridDim.x * gridDim.y * gridDim.z;
    unsigned sum, cnt, mine, sp = 0u;
    for (;;) {
        sum = 0u; cnt = 0u; mine = 0u;
#pragma unroll
        for (unsigned j = 0; j < 16; ++j) { const unsigned c = xb_ld(&bar[XB_XCNT(j)]); sum += c; cnt += (c > 0u) ? 1u : 0u; mine = (j == x) ? c : mine; }
        if (sum == G) break;
        __builtin_amdgcn_s_sleep(1);
        if ((++sp & 255u) == 0u) { if (xb_ld(&bar[XB_TMO])) break; if (sp > XB_SPIN_CAP) { atomicAdd(&bar[XB_TMO], 1u); break; } }
    }
    nloc = mine > 0u ? mine : 1u; nx = cnt > 0u ? cnt : 1u;
}
__device__ __forceinline__ void xcd_barrier(const XcdBarrier& b) {
    asm volatile("s_waitcnt vmcnt(0)" ::: "memory");
    __syncthreads();
    if (threadIdx.x == 0) {
        unsigned* bar = b.bar;
        __builtin_amdgcn_s_waitcnt(0);
        unsigned nloc = b.st[0], nx = b.st[1];
        if (nloc == 0u) { xcd_barrier_complete(bar, b.x, nloc, nx); b.st[0] = nloc; b.st[1] = nx; }
        const unsigned old = xb_add(&bar[XB_XSUB(b.x)], 1u);
        const unsigned gen = old / nloc;
        if (old + 1u == (gen + 1u) * nloc) {
            __builtin_amdgcn_fence(__ATOMIC_RELEASE, "agent");
            asm volatile("s_waitcnt vmcnt(0)" ::: "memory");
            const unsigned og = xb_add(&bar[XB_TOP], 1u);
            const unsigned tg = og / nx;
            if (og + 1u == (tg + 1u) * nx) xb_add(&bar[XB_TOPGEN], 1u);
            else XB_SPIN(xb_ld(&bar[XB_TOPGEN]) == tg, bar);
            __builtin_amdgcn_fence(__ATOMIC_ACQUIRE, "agent");
            xb_add(&bar[XB_XGEN(b.x)], 1u);
            asm volatile("s_waitcnt vmcnt(0)" ::: "memory");
        } else {
            XB_SPIN(xb_ld(&bar[XB_XGEN(b.x)]) == gen, bar);
            __builtin_amdgcn_fence(__ATOMIC_ACQUIRE, "agent");
            asm volatile("s_waitcnt vmcnt(0)" ::: "memory");
        }
    }
    __syncthreads();
}

__global__ void __launch_bounds__(NTHREADS) hymba_fwd(Params p) {
    extern __shared__ __attribute__((aligned(16))) unsigned char lds_raw[];
    LAS unsigned char* lds = (LAS unsigned char*)lds_raw;
    cg::grid_group grid = cg::this_grid();
    volatile LAS unsigned* xbw = (volatile LAS unsigned*)(lds + LDS_BYTES - 16);
    if (threadIdx.x < 4) xbw[threadIdx.x] = 0u;
    __syncthreads();
    XcdBarrier xbar = xcd_barrier_post((unsigned*)(ws_of(p) + WS_BAR), xbw);
    if (p.ph_hi - p.ph_lo > 1) grid.sync();
    for (int ph = p.ph_lo; ph < p.ph_hi; ++ph) {
        int G = gridDim.x, bid = blockIdx.x;
        asm volatile("" : "+s"(G), "+s"(bid));
        const int tpx = opaque_tid();
        if (ph == 0) {
            if (PHEN(0)) prologue(p, lds, bid, G);
            if (REP_SUB == 100) { __syncthreads(); prologue(p, lds, bid, G); }
        } else if (ph == 37) { if (PHEN(10)) {
            const float* ssq = (const float*)(ws_of(p) + WS_SSQ) + (size_t)(12 & 1) * T_ * 16;
            float* outp = out_of(p);
            const f32x4 gn = *(const f32x4*)(in_of(p, 28) + (tpx & 255) * 4);
            for (int it = bid; it < T_ / 8; it += G) {
                f32x4 v[4]; float r[4];
#pragma unroll
                for (int q = 0; q < 4; ++q) {
                    const int row = it * 8 + q * 2 + (tpx >> 8);
                    v[q] = *(const f32x4*)(outp + (size_t)row * DM + (tpx & 255) * 4);
                    r[q] = row_rstd(ssq, row);
                }
#pragma unroll
                for (int q = 0; q < 4; ++q) {
                    const int row = it * 8 + q * 2 + (tpx >> 8);
                    *(f32x4*)(outp + (size_t)row * DM + (tpx & 255) * 4) = v[q] * r[q] * gn;
                }
            } }
        } else {
            const int l = (ph - 1) / 9, sub = (ph - 1) % 9;
            unsigned char* wl = ws_of(p) + WS_W + (size_t)l * LAYER_W;
            float* ssq = (float*)(ws_of(p) + WS_SSQ);
            bf16_t* HB = (bf16_t*)(ws_of(p) + WS_HB);
            bf16_t* UB = (bf16_t*)(ws_of(p) + WS_U);
            if (PHEN(1) && (sub == 0 || sub == 7)) {
                const bool second = sub == 7;
                pg8::Gemm g{HB, (const bf16_t*)(wl + (second ? LO_W13B : LO_W13A)), T_, NUP, DM, DM, DM};
                pg8::StaticOrder S; S.init(T_, NUP, G, bid);
                EpiSwiGLU E{UB, ssq + (size_t)((3 * l + (second ? 2 : 0)) & 1) * T_ * 16};
                pg8::gemm_phase(lds, g, S, E);
                if (REP_SUB == 0) { __syncthreads(); pg8::gemm_phase(lds, g, S, E); }
            } else if (PHEN(2) && (sub == 1 || sub == 8 || sub == 6)) {
                const bool wout = sub == 6, second = sub == 8;
                pg8::Gemm g;
                if (wout) g = pg8::Gemm{(const bf16_t*)(ws_of(p) + WS_HEADS), (const bf16_t*)(wl + LO_WOUT), T_, DM, DM, DM, DM};
                else g = pg8::Gemm{UB, (const bf16_t*)(wl + (second ? LO_W2B : LO_W2A)), T_, DM, DFF, DFF, DFF};
                pg8::StaticOrder S; S.init(T_, DM, G, bid);
                const float* resid = (l == 0 && sub == 1) ? in_of(p, 0) : out_of(p);
                const int nxt = 3 * l + (sub == 1 ? 1 : (sub == 6 ? 2 : 3));
                EpiResid E{resid, out_of(p), HB, ssq + (size_t)(nxt & 1) * T_ * 16, wout ? 1.0f : 0.5f};
                pg8::gemm_phase(lds, g, S, E);
                if (REP_SUB == 1) { __syncthreads(); EpiResid E2{out_of(p), out_of(p), HB, ssq + (size_t)(nxt & 1) * T_ * 16, 0.0f}; pg8::gemm_phase(lds, g, S, E2); }
            } else if (PHEN(3) && sub == 2) {
                if (bid < 2 && tpx < 256) {
                    const float* cbp = (const float*)(ws_of(p) + WS_CBP) + (size_t)((l * 2 + bid) * 32) * 256 + tpx;
                    float sb = 0.f;
#pragma unroll
                    for (int q = 0; q < 32; ++q) sb += cbp[q * 256];
                    ((float*)(ws_of(p) + WS_CBIAS))[(l * 2 + bid) * 256 + tpx] = sb;
                }
                pg8::Gemm g{HB, (const bf16_t*)(wl + LO_WIN), T_, NINP, DM, DM, DM};
                pg8::StaticOrder S; S.init(T_, NINP, G, bid);
                EpiWin E{UB, (bf16_t*)(ws_of(p) + WS_KCMP), (bf16_t*)(ws_of(p) + WS_VCMP), (float*)(ws_of(p) + WS_GATES), ssq + (size_t)((3 * l + 1) & 1) * T_ * 16};
                pg8::gemm_phase(lds, g, S, E);
                if (REP_SUB == 2) { __syncthreads(); pg8::gemm_phase(lds, g, S, E); }
            } else if (sub == 3) {
                const int ngemm = 64;
                for (int rep = 0; rep < (REP_SUB == 3 ? 2 : 1); ++rep) {
                const int cls = rep == 0 ? 7 : REP_CLASS;
                if (rep) __syncthreads();
                if (G > ngemm) {
                    if (bid < ngemm) { if (PHEN(4) && (cls & 1)) {
                        const int kp = bid >> 4, kv = (bid >> 3) & 1;
                        pg8::Gemm g{(const bf16_t*)(ws_of(p) + (kv ? WS_VCMP : WS_KCMP)) + kp * 512, (const bf16_t*)(wl + (kv ? LO_CW1V : LO_CW1K)) + kp * 512, 2048, 256, 512, 1024, 2048};
                        pg8::SingleUnit S{bid & 7};
                        EpiCmp E{(float*)(ws_of(p) + WS_HID) + (size_t)(kp * 2 + kv) * 2048 * 256};
                        pg8::gemm_phase(lds, g, S, E); }
                    }
                    if (PHEN(5)) {
                        const bool gb = bid < ngemm;
                        const int i0 = gb ? 1728 + bid : bid - ngemm, i1 = gb ? 2048 : 1728, st = gb ? ngemm : G - ngemm;
                        for (int it = i0; it < i1; it += st) {
                            if (it < 1024) { if (cls & 2) lru_x_item(p, l, it >> 7, (it >> 5) & 3, it & 31, lds); }
                            else if (cls & 4) ml_x_item(p, l, (it - 1024) >> 5, it & 31, lds);
                        }
                    }
                }
                }
            } else if (PHEN(6) && sub == 4) {
                phase_m2(p, l, 7, lds, bid, G);
                if (REP_SUB == 4) { __syncthreads(); phase_m2(p, l, REP_CLASS, lds, bid, G); }
            } else if (sub == 5) {
                for (int rep = 0; rep < (REP_SUB == 5 ? 2 : 1); ++rep) {
                const int cls = rep == 0 ? 7 : REP_CLASS;
                if (rep) __syncthreads();
                for (int it = bid; it < 512 + 1024 + 512; it += G) {
                    if (it < 512) { if (PHEN(7) && (cls & 1)) {
                        const int qb = it < 256 ? 31 - (it >> 4) : ((it - 256) >> 4), bg = it & 15;
                        nsa_item(p, l, bg >> 1, bg & 1, qb, lds, (rep == 1 && REP_CLASS == 9) ? 1 : 0); }
                    } else if (it < 1536) {
                        if (PHEN(8) && (cls & 2)) ml_y_item(p, l, (it - 512) >> 5, (it - 512) & 31, lds);
                    } else {
                        if (PHEN(9) && (cls & 4)) lru_y_item(p, l, it - 1536);
                    }
                }
                }
            }
        }
        if (ph + 1 < p.ph_hi) {
            xcd_barrier(xbar);
            if (REP_SUB == 200) xcd_barrier(xbar);
        }
    }
}

extern "C" void kernel_launch(void* const* d_in, const int* in_sizes, int n_in, void* d_out, int out_size, void* d_ws, size_t ws_size, hipStream_t stream) {
    static int grid = 0;
    if (grid == 0) {
        if (n_in != 29 || out_size != T_ * DM || ws_size < WS_END) { fprintf(stderr, "kernel_launch: unexpected shapes (n_in %d out %d ws %zu need %zu)\n", n_in, out_size, ws_size, (size_t)WS_END); grid = -1; return; }
        int dev = 0, cus = 0, per_cu = 0;
        hipGetDevice(&dev);
        hipDeviceGetAttribute(&cus, hipDeviceAttributeMultiprocessorCount, dev);
        hipFuncSetAttribute((const void*)hymba_fwd, hipFuncAttributeMaxDynamicSharedMemorySize, LDS_BYTES);
        hipOccupancyMaxActiveBlocksPerMultiprocessor(&per_cu, (const void*)hymba_fwd, NTHREADS, LDS_BYTES);
        if (per_cu < 1) { fprintf(stderr, "kernel_launch: occupancy query says %d blocks per CU\n", per_cu); per_cu = 1; }
        (void)hipGetLastError();
        grid = cus;
    }
    if (grid < 0) return;
    Params p{};
    for (int i = 0; i < 29; ++i) p.in[i] = (const float*)d_in[i];
    p.out = (float*)d_out; p.ws = (unsigned char*)d_ws;
#if ONE_LAUNCH
    (void)hipMemsetAsync((unsigned char*)d_ws + WS_BAR, 0, 16384, stream);
    p.ph_lo = 0; p.ph_hi = 38;
    void* args[] = {&p};
    hipError_t e = hipLaunchCooperativeKernel((const void*)hymba_fwd, dim3(grid), dim3(NTHREADS), args, LDS_BYTES, stream);
    if (e != hipSuccess) fprintf(stderr, "cooperative launch failed: %s (grid %d)\n", hipGetErrorString(e), grid);
#else
    for (int ph = 0; ph < 38; ++ph) {
        p.ph_lo = ph; p.ph_hi = ph + 1;
        hipLaunchKernelGGL(hymba_fwd, dim3(grid), dim3(NTHREADS), LDS_BYTES, stream, p);
    }
#endif
}
```

```cpp
#include <hip/hip_runtime.h>
#include <hip/hip_cooperative_groups.h>
#include <cstdio>
namespace cg = cooperative_groups;

#define LAS __attribute__((address_space(3)))
typedef unsigned short bf16_t;
typedef short bf16x8 __attribute__((ext_vector_type(8)));
typedef float f32x4 __attribute__((ext_vector_type(4)));
typedef float f32x2 __attribute__((ext_vector_type(2)));
typedef unsigned u32x4 __attribute__((ext_vector_type(4)));
typedef unsigned u32x2 __attribute__((ext_vector_type(2)));

#ifndef ONE_LAUNCH
#define ONE_LAUNCH 1
#endif
#ifndef PHMASK
#define PHMASK 0xFFFF
#endif
#define PHEN(k) ((PHMASK >> (k)) & 1)
#ifndef REP_SUB
#define REP_SUB -1
#endif
#ifndef REP_CLASS
#define REP_CLASS 7
#endif

constexpr int T_ = 16384, SEQ = 2048, DM = 1024, DFF = 2816, NUP = 5632, NINP = 3072, UW = 2816, DIN = 2848;
constexpr float EPS = 1e-6f;
constexpr float NEGF = -1e30f;
constexpr int NTHREADS = 512;
constexpr int LDS_BYTES = 147456;

constexpr size_t SZ_W13T = (size_t)NUP * DM * 2, SZ_W2T = (size_t)DM * DFF * 2, SZ_WINT = (size_t)NINP * DM * 2, SZ_WOUTT = (size_t)DM * DM * 2, SZ_CW1T = (size_t)256 * 2048 * 2;
constexpr size_t LO_W13A = 0, LO_W2A = LO_W13A + SZ_W13T, LO_W13B = LO_W2A + SZ_W2T, LO_W2B = LO_W13B + SZ_W13T, LO_WIN = LO_W2B + SZ_W2T, LO_WOUT = LO_WIN + SZ_WINT,
                 LO_CW1K = LO_WOUT + SZ_WOUTT, LO_CW1V = LO_CW1K + SZ_CW1T, LAYER_W = LO_CW1V + SZ_CW1T;
constexpr size_t WS_W = 0;
constexpr size_t WS_HB = WS_W + 4 * LAYER_W;
constexpr size_t WS_U = WS_HB + (size_t)T_ * DM * 2;
constexpr size_t WS_HEADS = WS_U + (size_t)T_ * UW * 2;
constexpr size_t SZ_CMPIN = (size_t)16 * 2048 * 64 * 2 + 4096;
constexpr size_t WS_KCMP = WS_HEADS + (size_t)T_ * DM * 2;
constexpr size_t WS_VCMP = WS_KCMP + SZ_CMPIN;
constexpr size_t WS_HID = WS_VCMP + SZ_CMPIN;
constexpr size_t WS_KC = WS_HID + (size_t)4 * 2 * 2048 * 256 * 4;
constexpr size_t WS_GATES = WS_KC + (size_t)2 * 2048 * 64 * 2;
constexpr size_t WS_SSQ = WS_GATES + (size_t)T_ * 32 * 4;
constexpr size_t WS_CBIAS = WS_SSQ + (size_t)2 * T_ * 16 * 4;
constexpr size_t WS_LRUH = WS_CBIAS + 8192;
constexpr size_t WS_LRUA = WS_LRUH + (size_t)T_ * 256 * 4;
constexpr size_t WS_LRUC = WS_LRUA + (size_t)T_ * 256 * 4;
constexpr size_t WS_MLC = WS_LRUC + (size_t)8 * 32 * 256 * 4;
constexpr size_t WS_MLN = WS_MLC + (size_t)1024 * 4096 * 4;
constexpr size_t WS_MLMU = WS_MLN + (size_t)1024 * 64 * 4;
constexpr size_t WS_MLAT = WS_MLMU + 4096;
constexpr size_t WS_MLMP = WS_MLAT + 4096;
constexpr size_t WS_CBP = WS_MLMP + 4096;
constexpr size_t WS_LRUWT = WS_CBP + 262144;
constexpr size_t WS_BAR = WS_LRUWT + 262144;
constexpr size_t WS_END = WS_BAR + 16384;
static_assert(WS_END <= 425365632ull, "workspace too large");
static_assert(LAYER_W % 256 == 0 && WS_HB % 256 == 0 && WS_U % 256 == 0 && WS_KCMP % 256 == 0 && WS_VCMP % 256 == 0 && WS_HID % 256 == 0, "align");

struct Params {
    const float* in[29];
    float* out;
    unsigned char* ws;
    int ph_lo, ph_hi;
};
static_assert(sizeof(Params) == 256, "Params has padding");
#define GAS __attribute__((address_space(1)))
__device__ __forceinline__ unsigned char* ws_of(const Params& p) { unsigned long long w = (unsigned long long)p.ws; asm volatile("" : "+s"(w)); return (unsigned char*)(GAS unsigned char*)w; }
__device__ __forceinline__ float* out_of(const Params& p) { unsigned long long w = (unsigned long long)p.out; asm volatile("" : "+s"(w)); return (float*)(GAS float*)w; }
__device__ __forceinline__ const float* in_of(const Params& p, int i) { unsigned long long w = (unsigned long long)p.in[i]; asm volatile("" : "+s"(w)); return (const float*)(GAS const float*)w; }
__device__ __forceinline__ unsigned cvt_pk_bf16(float lo, float hi) { unsigned r; asm volatile("v_cvt_pk_bf16_f32 %0, %1, %2" : "=v"(r) : "v"(lo), "v"(hi)); return r; }
__device__ __forceinline__ bf16_t f2bf(float f) { return (bf16_t)(cvt_pk_bf16(f, 0.f) & 0xffffu); }
__device__ __forceinline__ float bf2f(bf16_t b) { return __uint_as_float(((unsigned)b) << 16); }
__device__ __forceinline__ float sigmoidf_(float x) { return 1.0f / (1.0f + __expf(-x)); }
__device__ __forceinline__ int opaque_tid() { int x = threadIdx.x; asm volatile("" : "+v"(x)); return x; }
__device__ __forceinline__ float row_rstd(const float* part, int row) {
    const f32x4 a = *(const f32x4*)(part + (size_t)row * 16), b = *(const f32x4*)(part + (size_t)row * 16 + 4), c = *(const f32x4*)(part + (size_t)row * 16 + 8), d = *(const f32x4*)(part + (size_t)row * 16 + 12);
    const float s = (((a[0] + a[1]) + (a[2] + a[3])) + ((b[0] + b[1]) + (b[2] + b[3]))) + (((c[0] + c[1]) + (c[2] + c[3])) + ((d[0] + d[1]) + (d[2] + d[3])));
    return rsqrtf(s * (1.0f / DM) + EPS);
}
__device__ __forceinline__ float fq_max(float x) {
    auto a = __builtin_amdgcn_permlane16_swap(__float_as_uint(x), __float_as_uint(x), false, false);
    const float m = fmaxf(__uint_as_float(a[0]), __uint_as_float(a[1]));
    auto b = __builtin_amdgcn_permlane32_swap(__float_as_uint(m), __float_as_uint(m), false, false);
    return fmaxf(__uint_as_float(b[0]), __uint_as_float(b[1]));
}
__device__ __forceinline__ float fq_sum(float x) {
    auto a = __builtin_amdgcn_permlane16_swap(__float_as_uint(x), __float_as_uint(x), false, false);
    const float m = __uint_as_float(a[0]) + __uint_as_float(a[1]);
    auto b = __builtin_amdgcn_permlane32_swap(__float_as_uint(m), __float_as_uint(m), false, false);
    return __uint_as_float(b[0]) + __uint_as_float(b[1]);
}
__device__ __forceinline__ float wave_sum(float v) {
#pragma unroll
    for (int o = 32; o >= 1; o >>= 1) v += __shfl_xor(v, o);
    return v;
}
__device__ __forceinline__ float wave_max(float v) {
#pragma unroll
    for (int o = 32; o >= 1; o >>= 1) v = fmaxf(v, __shfl_xor(v, o));
    return v;
}

namespace pg8 {
constexpr int BM = 256, BK = 64, HALF = 128, HTB = HALF * BK * 2, STAGE_BYTES = 8 * HTB, NXCD = 8, WGM = 8;
__device__ __forceinline__ int lds_byte(int r, int c) { const int st = (r >> 4) * 2 + (c >> 5), rr = r & 15, cc = c & 31, ob = rr * 64 + cc * 2; return st * 1024 + (ob ^ (((ob >> 9) & 1) << 5)); }
__device__ __forceinline__ void stage_rc(int b, int& R, int& C) { const int st = b / 1024, sb = b % 1024, swz = sb ^ (((sb >> 9) & 1) << 5); R = (st >> 1) * 16 + swz / 64; C = (st & 1) * 32 + (swz % 64) / 2; }

struct Unit { int pm, pn; };
struct Gemm { const bf16_t* A; const bf16_t* Bt; int M, N, K, lda, ldb; };

struct StaticOrder {
    int nM, nN, nwg, G, c;
    __device__ void init(int M, int N, int G_, int c_) { nM = M / BM; nN = N / BM; nwg = nM * nN; G = G_; c = c_; }
    __device__ bool next(int i, Unit& u) const {
        const long L = (long)i * G + c; if (L >= nwg) return false;
        int wgid = (int)L; { const int q = nwg / NXCD, r = nwg % NXCD, xcd = wgid % NXCD, off = wgid / NXCD; wgid = (xcd < r ? xcd * (q + 1) : r * (q + 1) + (xcd - r) * q) + off; }
        const int nig = WGM * nN, gid = wgid / nig, fm = gid * WGM, gsz = (nM - fm) < WGM ? (nM - fm) : WGM;
        u.pm = fm + ((wgid % nig) % gsz); u.pn = (wgid % nig) / gsz; return true;
    }
};
struct SingleUnit {
    int pm;
    __device__ bool next(int i, Unit& u) const { if (i != 0 || pm < 0) return false; u.pm = pm; u.pn = 0; return true; }
};

template <class Epi, class Sched>
__device__ __forceinline__ void gemm_phase(LAS unsigned char* lds, const Gemm g, const Sched& S, const Epi& E) {
    const int tid = opaque_tid(), wid = __builtin_amdgcn_readfirstlane(tid >> 6), lane = tid & 63, wr = wid >> 2, wc = wid & 3, fr = lane & 15, fq = lane >> 4;
    const int K = g.K, nt = K / BK;
    unsigned voffA[2], voffB[2];
#pragma unroll
    for (int i = 0; i < 2; ++i) { int R, C; stage_rc(tid * 16 + i * 8192, R, C);
        voffA[i] = (unsigned)(R * g.lda + C) * 2u; voffB[i] = (unsigned)(R * g.ldb + C) * 2u; }
    const size_t kstep = (size_t)(BK * 2);
    const size_t hstepA = (size_t)HALF * g.lda * 2, hstepB = (size_t)HALF * g.ldb * 2;
    const size_t tstepA = 2 * hstepA, tstepB = 2 * hstepB;
    const unsigned ldsw = (unsigned)wid * 1024u;
    const int aoff = lds_byte(wr * 64 + fr, fq * 8), boff = lds_byte(wc * 32 + fr, fq * 8);
#define PG8_SA(b, h) (((b) * 2 + (h)) * HTB)
#define PG8_SB(b, h) ((4 + (b) * 2 + (h)) * HTB)
#define PG8_STAGE(bufoff, gbase, voff) do { _Pragma("unroll") for (int _i = 0; _i < 2; ++_i) \
        __builtin_amdgcn_global_load_lds((const unsigned*)((const char*)(gbase) + (voff)[_i]), (LAS unsigned*)(lds + (bufoff) + ldsw + _i * 8192), 16, 0, 0); } while (0)
#define PG8_LDA(dst, b, h) do { _Pragma("unroll") for (int m = 0; m < 4; ++m) _Pragma("unroll") for (int k = 0; k < 2; ++k) dst[m][k] = *(const LAS bf16x8*)(lds + PG8_SA(b, h) + aoff + m * 2048 + k * 1024); } while (0)
#define PG8_LDB(dst, b, h) do { _Pragma("unroll") for (int n = 0; n < 2; ++n) _Pragma("unroll") for (int k = 0; k < 2; ++k) dst[n][k] = *(const LAS bf16x8*)(lds + PG8_SB(b, h) + boff + n * 2048 + k * 1024); } while (0)
#define PG8_MMA(ai, bj, At, Bt) do { __builtin_amdgcn_s_setprio(1); _Pragma("unroll") for (int m = 0; m < 4; ++m) _Pragma("unroll") for (int n = 0; n < 2; ++n) _Pragma("unroll") for (int k = 0; k < 2; ++k) \
        acc[ai][bj][m][n] = __builtin_amdgcn_mfma_f32_16x16x32_bf16(Bt[n][k], At[m][k], acc[ai][bj][m][n], 0, 0, 0); __builtin_amdgcn_s_setprio(0); } while (0)
#define PG8_WAIT_V(n) asm volatile("s_waitcnt vmcnt(" #n ")" ::: "memory")
#define PG8_WAIT_L(n) asm volatile("s_waitcnt lgkmcnt(" #n ")" ::: "memory")
#define PG8_BAR __builtin_amdgcn_s_barrier()
#define PG8_SCHED __builtin_amdgcn_sched_barrier(0)
    Unit cur, nxt; int ui = 0;
    if (!S.next(0, cur)) return;
    f32x4 acc[2][2][4][2];
#pragma unroll
    for (int a = 0; a < 2; ++a)
#pragma unroll
        for (int b = 0; b < 2; ++b)
#pragma unroll
            for (int m = 0; m < 4; ++m)
#pragma unroll
                for (int n = 0; n < 2; ++n) acc[a][b][m][n] = (f32x4){0.f, 0.f, 0.f, 0.f};
    bf16x8 At[4][2], B0[2][2], B1[2][2];
    const char* cA = (const char*)g.A + (size_t)cur.pm * tstepA; const char* cB = (const char*)g.Bt + (size_t)cur.pn * tstepB;
    PG8_STAGE(PG8_SB(0, 0), cB, voffB); PG8_STAGE(PG8_SA(0, 0), cA, voffA); PG8_STAGE(PG8_SB(0, 1), cB + hstepB, voffB); PG8_STAGE(PG8_SA(0, 1), cA + hstepA, voffA);
    if (wr == 1) PG8_BAR;
    PG8_WAIT_V(4); PG8_BAR;
    PG8_STAGE(PG8_SB(1, 0), cB + kstep, voffB); PG8_STAGE(PG8_SA(1, 0), cA + kstep, voffA); PG8_STAGE(PG8_SB(1, 1), cB + hstepB + kstep, voffB);
    PG8_WAIT_V(6); PG8_BAR;
    for (;;) {
        const bool has_next = S.next(ui + 1, nxt);
        const char* nA = has_next ? (const char*)g.A + (size_t)nxt.pm * tstepA : cA; const char* nB = has_next ? (const char*)g.Bt + (size_t)nxt.pn * tstepB : cB;
        for (int t = 0; t < nt; t += 2) {
            const bool last = (t == nt - 2);
            const char* a1 = cA + (size_t)(t + 1) * kstep;
            const char* a2 = last ? nA : cA + (size_t)(t + 2) * kstep; const char* b2 = last ? nB : cB + (size_t)(t + 2) * kstep;
            const char* a3 = a2 + kstep; const char* b3 = b2 + kstep;
            PG8_LDB(B0, 0, 0); PG8_SCHED; PG8_LDA(At, 0, 0); PG8_STAGE(PG8_SA(1, 1), a1 + hstepA, voffA);
            PG8_WAIT_L(8); PG8_BAR; PG8_WAIT_L(0); PG8_MMA(0, 0, At, B0); PG8_BAR; PG8_SCHED;
            PG8_LDB(B1, 0, 1); PG8_STAGE(PG8_SB(0, 0), b2, voffB);
            PG8_BAR; PG8_WAIT_L(0); PG8_MMA(0, 1, At, B1); PG8_BAR;
            PG8_LDA(At, 0, 1); PG8_STAGE(PG8_SA(0, 0), a2, voffA);
            PG8_BAR; PG8_WAIT_L(0); PG8_MMA(1, 0, At, B0); PG8_BAR; PG8_SCHED;
            PG8_STAGE(PG8_SB(0, 1), b2 + hstepB, voffB);
            PG8_WAIT_V(6); PG8_BAR; PG8_MMA(1, 1, At, B1); PG8_BAR;
            PG8_LDB(B0, 1, 0); PG8_SCHED; PG8_LDA(At, 1, 0); PG8_STAGE(PG8_SA(0, 1), a2 + hstepA, voffA);
            PG8_WAIT_L(8); PG8_BAR; PG8_WAIT_L(0); PG8_MMA(0, 0, At, B0); PG8_BAR; PG8_SCHED;
            PG8_LDB(B1, 1, 1); PG8_STAGE(PG8_SB(1, 0), b3, voffB);
            PG8_BAR; PG8_WAIT_L(0); PG8_MMA(0, 1, At, B1); PG8_BAR;
            PG8_LDA(At, 1, 1); PG8_STAGE(PG8_SA(1, 0), a3, voffA);
            PG8_BAR; PG8_WAIT_L(0); PG8_MMA(1, 0, At, B0); PG8_BAR; PG8_SCHED;
            PG8_STAGE(PG8_SB(1, 1), b3 + hstepB, voffB);
            PG8_WAIT_V(6); PG8_BAR; PG8_MMA(1, 1, At, B1); PG8_BAR;
        }
        E(acc, cur, wr, wc, fr, fq);
        if (!has_next) break;
#pragma unroll
        for (int a = 0; a < 2; ++a)
#pragma unroll
            for (int b = 0; b < 2; ++b)
#pragma unroll
                for (int m = 0; m < 4; ++m)
#pragma unroll
                    for (int n = 0; n < 2; ++n) acc[a][b][m][n] = (f32x4){0.f, 0.f, 0.f, 0.f};
        cur = nxt; cA = nA; cB = nB; ++ui;
    }
    PG8_WAIT_V(0);
    if (wr == 0) PG8_BAR;
    PG8_BAR;
#undef PG8_SA
#undef PG8_SB
#undef PG8_STAGE
#undef PG8_LDA
#undef PG8_LDB
#undef PG8_MMA
#undef PG8_WAIT_V
#undef PG8_WAIT_L
#undef PG8_BAR
#undef PG8_SCHED
}
}

typedef __attribute__((address_space(1))) float gf32;
typedef __attribute__((address_space(1))) const float gcf32;
typedef __attribute__((address_space(1))) bf16_t gbf16;
typedef __attribute__((address_space(1))) f32x4 gf32x4;
typedef __attribute__((address_space(1))) const f32x4 gcf32x4;
typedef __attribute__((address_space(1))) u32x2 gu32x2;
__device__ __forceinline__ void rows_rstd(const float* ssq, int row0, int fq, float (&r8)[2][4]) {
    f32x4 pv[2][4];
#pragma unroll
    for (int ai = 0; ai < 2; ++ai)
#pragma unroll
        for (int m = 0; m < 4; ++m) pv[ai][m] = *(gcf32x4*)(ssq + (size_t)(row0 + ai * 128 + m * 16) * 16 + 4 * fq);
#pragma unroll
    for (int ai = 0; ai < 2; ++ai)
#pragma unroll
        for (int m = 0; m < 4; ++m) {
            float sm = (pv[ai][m][0] + pv[ai][m][1]) + (pv[ai][m][2] + pv[ai][m][3]);
            sm = fq_sum(sm);
            r8[ai][m] = rsqrtf(sm * (1.0f / DM) + EPS);
        }
}
struct EpiSwiGLU {
    bf16_t* act; const float* ssq;
    __device__ __forceinline__ void operator()(const f32x4 (&acc)[2][2][4][2], const pg8::Unit& u, int wr, int wc, int fr, int fq) const {
        const int row0 = u.pm * 256 + wr * 64 + fr, col0 = u.pn * 128 + wc * 32 + 8 * fq;
        float r8[2][4];
        rows_rstd(ssq, row0, fq, r8);
#pragma unroll
        for (int ai = 0; ai < 2; ++ai)
#pragma unroll
            for (int m = 0; m < 4; ++m) {
                const int row = row0 + ai * 128 + m * 16;
                const float r = r8[ai][m];
                float o[8];
#pragma unroll
                for (int n = 0; n < 2; ++n) {
                    const f32x4 a1 = acc[ai][0][m][n] * r, a3 = acc[ai][1][m][n] * r;
#pragma unroll
                    for (int j = 0; j < 4; ++j) o[4 * n + j] = a1[j] * __builtin_amdgcn_rcpf(1.0f + __expf(-a1[j])) * a3[j];
                }
                u32x4 w; w.x = cvt_pk_bf16(o[0], o[1]); w.y = cvt_pk_bf16(o[2], o[3]); w.z = cvt_pk_bf16(o[4], o[5]); w.w = cvt_pk_bf16(o[6], o[7]);
                *(GAS u32x4*)(act + (size_t)row * DFF + col0) = w;
            }
    }
};
struct EpiResid {
    const float* resid; float* out; bf16_t* hb; float* ssq_next; float scale;
    __device__ __forceinline__ void load2(f32x4 (&rs)[2][2][2], int row0, int col0, int ai, int mp) const {
#pragma unroll
        for (int mm = 0; mm < 2; ++mm)
#pragma unroll
            for (int bj = 0; bj < 2; ++bj)
#pragma unroll
                for (int n = 0; n < 2; ++n)
                    rs[mm][bj][n] = *(gcf32x4*)(resid + (size_t)(row0 + ai * 128 + (2 * mp + mm) * 16) * DM + col0 + bj * 128 + n * 4);
    }
    __device__ __forceinline__ void operator()(const f32x4 (&acc)[2][2][4][2], const pg8::Unit& u, int wr, int wc, int fr, int fq) const {
        const int row0 = u.pm * 256 + wr * 64 + fr, col0 = u.pn * 256 + wc * 32 + 8 * fq;
        f32x4 rsA[2][2][2], rsB[2][2][2];
        load2(rsA, row0, col0, 0, 0);
#pragma unroll
        for (int bt = 0; bt < 4; ++bt) {
            const int ai = bt >> 1, mp = bt & 1;
            if (bt < 3) { if (bt & 1) load2(rsA, row0, col0, (bt + 1) >> 1, (bt + 1) & 1); else load2(rsB, row0, col0, (bt + 1) >> 1, (bt + 1) & 1); }
#pragma unroll
            for (int mm = 0; mm < 2; ++mm) {
                const int m = 2 * mp + mm, row = row0 + ai * 128 + m * 16;
                const size_t off = (size_t)row * DM + col0;
                float ss = 0.f;
#pragma unroll
                for (int bj = 0; bj < 2; ++bj) {
                    const f32x4 r0 = (bt & 1) ? rsB[mm][bj][0] : rsA[mm][bj][0], r1 = (bt & 1) ? rsB[mm][bj][1] : rsA[mm][bj][1];
                    const f32x4 v0 = r0 + acc[ai][bj][m][0] * scale, v1 = r1 + acc[ai][bj][m][1] * scale;
                    *(gf32x4*)(out + off + bj * 128) = v0;
                    *(gf32x4*)(out + off + bj * 128 + 4) = v1;
                    u32x4 w; w.x = cvt_pk_bf16(v0[0], v0[1]); w.y = cvt_pk_bf16(v0[2], v0[3]); w.z = cvt_pk_bf16(v1[0], v1[1]); w.w = cvt_pk_bf16(v1[2], v1[3]);
                    *(GAS u32x4*)(hb + off + bj * 128) = w;
                    ss += ((v0[0] * v0[0] + v0[1] * v0[1]) + (v0[2] * v0[2] + v0[3] * v0[3])) + ((v1[0] * v1[0] + v1[1] * v1[1]) + (v1[2] * v1[2] + v1[3] * v1[3]));
                }
                ss = fq_sum(ss);
                if (fq == 0) *(gf32*)(ssq_next + (size_t)row * 16 + u.pn * 4 + wc) = ss;
            }
            asm volatile("" ::: "memory");
        }
    }
};
struct EpiWin {
    bf16_t* U; bf16_t* kcmp; bf16_t* vcmp; float* gates; const float* ssq;
    __device__ __forceinline__ void operator()(const f32x4 (&acc)[2][2][4][2], const pg8::Unit& u, int wr, int wc, int fr, int fq) const {
        const int row0 = u.pm * 256 + wr * 64 + fr;
        float r8[2][4];
        rows_rstd(ssq, row0, fq, r8);
#pragma unroll
        for (int bj = 0; bj < 2; ++bj) {
            const int c0 = u.pn * 256 + bj * 128 + wc * 32;
            if (c0 >= 2848) continue;
            const float sc = (c0 < 512) ? 0.125f * 1.4426950408889634f : ((c0 >= 2048 && c0 < 2304) ? 0.125f : 1.0f);
            const int cl = 8 * fq;
#pragma unroll
            for (int ai = 0; ai < 2; ++ai)
#pragma unroll
                for (int m = 0; m < 4; ++m) {
                    const int row = row0 + ai * 128 + m * 16;
                    const float r = r8[ai][m] * sc;
                    const f32x4 v0 = acc[ai][bj][m][0] * r, v1 = acc[ai][bj][m][1] * r;
                    if (c0 == 2816) { *(gf32x4*)(gates + (size_t)row * 32 + cl) = v0; *(gf32x4*)(gates + (size_t)row * 32 + cl + 4) = v1; }
                    else {
                        u32x4 w; w.x = cvt_pk_bf16(v0[0], v0[1]); w.y = cvt_pk_bf16(v0[2], v0[3]); w.z = cvt_pk_bf16(v1[0], v1[1]); w.w = cvt_pk_bf16(v1[2], v1[3]);
                        if (c0 >= 512 && c0 < 768) {
                            const int cc = c0 - 512 + cl;
                            const int gg = (cc >> 6) & 1, d = cc & 63;
                            bf16_t* dst = (cc < 128 ? kcmp : vcmp) + ((size_t)(((row >> 11) * 2 + gg) * 2048 + (row & 2047))) * 64 + d;
                            *(GAS u32x4*)dst = w;
                        } else {
                            *(GAS u32x4*)(U + (size_t)row * UW + c0 + cl) = w;
                        }
                    }
                }
        }
    }
};
struct EpiCmp {
    float* part;
    __device__ __forceinline__ void operator()(const f32x4 (&acc)[2][2][4][2], const pg8::Unit& u, int wr, int wc, int fr, int fq) const {
        const int row0 = u.pm * 256 + wr * 64 + fr, col0 = wc * 32 + 8 * fq;
#pragma unroll
        for (int ai = 0; ai < 2; ++ai)
#pragma unroll
            for (int m = 0; m < 4; ++m) {
                const int row = row0 + ai * 128 + m * 16;
#pragma unroll
                for (int bj = 0; bj < 2; ++bj)
#pragma unroll
                    for (int n = 0; n < 2; ++n) *(gf32x4*)(part + (size_t)row * 256 + col0 + bj * 128 + n * 4) = acc[ai][bj][m][n];
            }
    }
};

__device__ __forceinline__ int winmap(int n) {
    if (n < 1280) return n;
    if (n < 2560) return n + 24;
    if (n < 2816) return n + 32;
    if (n < 2840) return 1280 + (n - 2816);
    if (n < 2844) return 2584 + (n - 2840);
    if (n < 2848) return 2588 + (n - 2844);
    return -1;
}
struct TrTile { const float* colp; const float* gain; bf16_t* dst; int ld, K, k0, n0; };
__device__ __forceinline__ void tr_decode(const Params& p, int idx, int tid, TrTile& t) {
    constexpr int TPL = 1376;
    const int l = idx / TPL; int r = idx % TPL;
    int m, ntile, ktile, K;
    if (r < 352) { m = 0; ntile = r % 22; ktile = r / 22; K = DM; }
    else if (r < 528) { r -= 352; m = 1; ntile = r % 4; ktile = r / 4; K = DFF; }
    else if (r < 880) { r -= 528; m = 2; ntile = r % 22; ktile = r / 22; K = DM; }
    else if (r < 1056) { r -= 880; m = 3; ntile = r % 4; ktile = r / 4; K = DFF; }
    else if (r < 1248) { r -= 1056; m = 4; ntile = r % 12; ktile = r / 12; K = DM; }
    else if (r < 1312) { r -= 1248; m = 5; ntile = r % 4; ktile = r / 4; K = DM; }
    else if (r < 1344) { r -= 1312; m = 6; ntile = 0; ktile = r; K = 2048; }
    else { r -= 1344; m = 7; ntile = 0; ktile = r; K = 2048; }
    t.K = K; t.k0 = ktile * 64; t.n0 = ntile * 256; t.colp = nullptr; t.gain = nullptr; t.ld = 0;
    const int npp = t.n0 + 4 * ((tid >> 3));
    const int np = (npp & ~31) + 8 * ((npp & 15) >> 2) + 4 * ((npp >> 4) & 1);
    unsigned char* wl = ws_of(p) + WS_W + (size_t)l * LAYER_W;
    if (m == 0 || m == 2) {
        const int pb = np >> 8, w = np & 255;
        const float* src = (w < 128) ? in_of(p, m == 0 ? 2 : 25) : in_of(p, m == 0 ? 3 : 26);
        t.colp = src + (size_t)l * DM * DFF + pb * 128 + (w & 127); t.ld = DFF; t.gain = in_of(p, m == 0 ? 1 : 24) + l * DM;
        t.dst = (bf16_t*)(wl + (m == 0 ? LO_W13A : LO_W13B));
    } else if (m == 1 || m == 3) {
        t.colp = in_of(p, m == 1 ? 4 : 27) + (size_t)l * DFF * DM + np; t.ld = DM;
        t.dst = (bf16_t*)(wl + (m == 1 ? LO_W2A : LO_W2B));
    } else if (m == 4) {
        const int sc = winmap(np);
        if (sc >= 0) t.colp = in_of(p, 6) + (size_t)l * DM * DIN + sc;
        t.ld = DIN; t.gain = in_of(p, 5) + l * DM;
        t.dst = (bf16_t*)(wl + LO_WIN);
    } else if (m == 5) {
        t.colp = in_of(p, 23) + (size_t)l * DM * DM + np; t.ld = DM;
        t.dst = (bf16_t*)(wl + LO_WOUT);
    } else {
        t.colp = in_of(p, m == 6 ? 8 : 11) + (size_t)l * 2048 * 256 + np; t.ld = 256;
        t.dst = (bf16_t*)(wl + (m == 6 ? LO_CW1K : LO_CW1V));
    }
}
__device__ __forceinline__ void tr_load(const TrTile& t, int tid, f32x4 (&v)[8], float (&gv)[8]) {
    const int kc = (tid & 7);
#pragma unroll
    for (int e = 0; e < 8; ++e) {
        const int k = t.k0 + 8 * kc + e;
        v[e] = (f32x4){0.f, 0.f, 0.f, 0.f}; gv[e] = 1.0f;
        if (t.colp) { v[e] = *(const f32x4*)(t.colp + (size_t)k * t.ld); if (t.gain) gv[e] = t.gain[k]; }
    }
}
__device__ void prologue(const Params& p, LAS unsigned char* lds, int bid, int G) {
    const int tid = opaque_tid();
    LAS float* tile = (LAS float*)lds;
    {
        constexpr int N_TR = 4 * 1376;
        int it = bid;
        TrTile t; f32x4 v[8]; float gv[8];
        if (it < N_TR) { tr_decode(p, it, tid, t); tr_load(t, tid, v, gv); }
        while (it < N_TR) {
            bf16_t* dst = t.dst + (size_t)(t.n0 + 4 * ((tid >> 3))) * t.K + t.k0 + 8 * ((tid & 7));
            const int K = t.K;
            u32x4 o[4];
#pragma unroll
            for (int q = 0; q < 4; ++q) { o[q].x = cvt_pk_bf16(v[0][q] * gv[0], v[1][q] * gv[1]); o[q].y = cvt_pk_bf16(v[2][q] * gv[2], v[3][q] * gv[3]); o[q].z = cvt_pk_bf16(v[4][q] * gv[4], v[5][q] * gv[5]); o[q].w = cvt_pk_bf16(v[6][q] * gv[6], v[7][q] * gv[7]); }
            const int nx = it + G;
            if (nx < N_TR) { tr_decode(p, nx, tid, t); tr_load(t, tid, v, gv); }
#pragma unroll
            for (int q = 0; q < 4; ++q) *(u32x4*)(dst + (size_t)q * K) = o[q];
            it = nx;
        }
    }
    constexpr int N_BIAS = 256, N_XROW = T_ / 16, N_LW = 32;
    for (int it = bid; it < N_BIAS + N_XROW + N_LW; it += G) {
        if (it >= N_BIAS + N_XROW) {
            const int q = it - N_BIAS - N_XROW, ln = q >> 1, gate = q & 1;
            const float* W = in_of(p, gate ? 17 : 15) + (size_t)ln * 4096;
            bf16_t* WT = (bf16_t*)(ws_of(p) + WS_LRUWT) + (size_t)q * 4096;
            float wv[8];
#pragma unroll
            for (int rr = 0; rr < 8; ++rr) { const int idx = tid + rr * NTHREADS, d = idx >> 6, c = idx & 63; wv[rr] = W[c * 64 + d]; }
#pragma unroll
            for (int rr = 0; rr < 8; ++rr) WT[tid + rr * NTHREADS] = f2bf(wv[rr]);
        } else if (it < N_BIAS) {
            const int lkv = it >> 5, part = it & 31, l = lkv >> 1, kv = lkv & 1;
            const float* pos = in_of(p, kv ? 10 : 7) + (size_t)l * 2048;
            const float* w1 = in_of(p, kv ? 11 : 8) + (size_t)l * 2048 * 256;
            const int j = tid & 255, half = tid >> 8;
            float sacc = 0.f;
            const int kb = part * 64 + half * 32;
            for (int k = kb; k < kb + 32; k += 8) {
                float a[8];
#pragma unroll
                for (int q = 0; q < 8; ++q) a[q] = w1[(size_t)(k + q) * 256 + j];
#pragma unroll
                for (int q = 0; q < 8; ++q) sacc += pos[k + q] * a[q];
            }
            tile[tid] = sacc;
            __syncthreads();
            if (tid < 256) ((float*)(ws_of(p) + WS_CBP))[(size_t)it * 256 + tid] = tile[tid] + tile[tid + 256];
            __syncthreads();
        } else {
            const int row0 = (it - N_BIAS) * 16 + (tid >> 6) * 2, lane = tid & 63;
            f32x4 xv[2][4];
#pragma unroll
            for (int rq = 0; rq < 2; ++rq)
#pragma unroll
                for (int i = 0; i < 4; ++i) xv[rq][i] = *(const f32x4*)(in_of(p, 0) + (size_t)(row0 + rq) * DM + i * 256 + lane * 4);
#pragma unroll
            for (int rq = 0; rq < 2; ++rq) {
                const int row = row0 + rq;
                bf16_t* hb = (bf16_t*)(ws_of(p) + WS_HB) + (size_t)row * DM;
                float ss = 0.f;
#pragma unroll
                for (int i = 0; i < 4; ++i) {
                    const f32x4 v = xv[rq][i];
                    ss += (v[0] * v[0] + v[1] * v[1]) + (v[2] * v[2] + v[3] * v[3]);
                    u32x2 w; w.x = cvt_pk_bf16(v[0], v[1]); w.y = cvt_pk_bf16(v[2], v[3]);
                    *(u32x2*)(hb + i * 256 + lane * 4) = w;
                }
                ss = wave_sum(ss);
                if (lane < 16) ((float*)(ws_of(p) + WS_SSQ))[(size_t)row * 16 + lane] = (lane == 0) ? ss : 0.f;
            }
        }
    }
}

__device__ void lru_x_item(const Params& p, int l, int b, int n, int ck, LAS unsigned char* lds) {
    const int tid = opaque_tid(), lane = tid & 63, w = __builtin_amdgcn_readfirstlane(tid >> 6), fr = lane & 15, fq = lane >> 4;
    LAS float* xs = (LAS float*)lds;
    LAS float* xc = (LAS float*)(lds + 17152);
    LAS bf16_t* xb = (LAS bf16_t*)(lds + 33536);
    LAS bf16_t* wt = (LAS bf16_t*)(lds + 42752);
    LAS float* pre = (LAS float*)(lds + 61184);
    LAS float* segA = (LAS float*)(lds + 93952);
    LAS float* segH = segA + 512;
    const bf16_t* U = (const bf16_t*)(ws_of(p) + WS_U);
    const int t0 = ck * 64, rowbase = b * SEQ;
    {
        u32x4 xv[2];
#pragma unroll
        for (int rr = 0; rr < 2; ++rr) {
            const int idx = tid + rr * NTHREADS, tt = idx >> 3, ch = idx & 7, t = t0 - 3 + tt;
            xv[rr] = (u32x4){0u, 0u, 0u, 0u};
            if (idx < 67 * 8 && t >= 0) xv[rr] = *(const u32x4*)(U + (size_t)(rowbase + t) * UW + 1280 + n * 64 + ch * 8);
        }
#pragma unroll
        for (int rr = 0; rr < 2; ++rr) {
            const int idx = tid + rr * NTHREADS, tt = idx >> 3, ch = idx & 7;
            if (idx < 67 * 8) {
                f32x4 lo, hi;
                lo[0] = __uint_as_float(xv[rr][0] << 16); lo[1] = __uint_as_float(xv[rr][0] & 0xffff0000u); lo[2] = __uint_as_float(xv[rr][1] << 16); lo[3] = __uint_as_float(xv[rr][1] & 0xffff0000u);
                hi[0] = __uint_as_float(xv[rr][2] << 16); hi[1] = __uint_as_float(xv[rr][2] & 0xffff0000u); hi[2] = __uint_as_float(xv[rr][3] << 16); hi[3] = __uint_as_float(xv[rr][3] & 0xffff0000u);
                *(LAS f32x4*)(xs + tt * 64 + ch * 8) = lo; *(LAS f32x4*)(xs + tt * 64 + ch * 8 + 4) = hi;
            }
        }
    }
    {
        const bf16_t* WT = (const bf16_t*)(ws_of(p) + WS_LRUWT) + (size_t)((l * 4 + n) * 2) * 4096;
#pragma unroll
        for (int rr = 0; rr < 2; ++rr) {
            const int idx = tid + rr * NTHREADS, row = idx >> 3, ch = idx & 7;
            *(LAS u32x4*)(wt + row * 72 + ch * 8) = *(const u32x4*)(WT + row * 64 + ch * 8);
        }
    }
    __syncthreads();
    {
        const float* cw = in_of(p, 13) + (size_t)l * 4 * 256 + n * 64; const float* cb = in_of(p, 14) + l * 256 + n * 64;
        const int c = tid & 63;
        const float w0 = cw[c], w1 = cw[256 + c], w2 = cw[512 + c], w3 = cw[768 + c], bc = cb[c];
#pragma unroll
        for (int k = 0; k < 8; ++k) {
            const int t = (tid >> 6) + 8 * k;
            const float v = bc + xs[t * 64 + c] * w0 + xs[(t + 1) * 64 + c] * w1 + xs[(t + 2) * 64 + c] * w2 + xs[(t + 3) * 64 + c] * w3;
            xc[t * 64 + c] = v; xb[t * 72 + c] = f2bf(v);
        }
    }
    __syncthreads();
    {
        const int tt = w & 3, gate = w >> 2;
        bf16x8 xa[2];
#pragma unroll
        for (int ks = 0; ks < 2; ++ks) xa[ks] = *(const LAS bf16x8*)(xb + (16 * tt + fr) * 72 + 32 * ks + 8 * fq);
        const float* bias = in_of(p, gate ? 18 : 16) + (l * 4 + n) * 64;
#pragma unroll
        for (int dt = 0; dt < 4; ++dt) {
            f32x4 acc = (f32x4){0.f, 0.f, 0.f, 0.f};
#pragma unroll
            for (int ks = 0; ks < 2; ++ks) {
                const bf16x8 wb = *(const LAS bf16x8*)(wt + (gate * 64 + 16 * dt + fr) * 72 + 32 * ks + 8 * fq);
                acc = __builtin_amdgcn_mfma_f32_16x16x32_bf16(xa[ks], wb, acc, 0, 0, 0);
            }
            const float bv = bias[16 * dt + fr];
#pragma unroll
            for (int i = 0; i < 4; ++i) pre[(gate * 64 + 16 * tt + 4 * fq + i) * 64 + 16 * dt + fr] = acc[i] + bv;
        }
    }
    __syncthreads();
    const int d = tid & 63, tq = tid >> 6;
    const float lam = in_of(p, 19)[l * 256 + n * 64 + d];
    const float sp = log1pf(expf(-lam));
    float hl[8], cl[8];
    float h = 0.f, ca = 1.f;
#pragma unroll
    for (int i = 0; i < 8; ++i) {
        const float r = __builtin_amdgcn_rcpf(1.0f + __expf(-pre[(tq * 8 + i) * 64 + d])), ii = __builtin_amdgcn_rcpf(1.0f + __expf(-pre[(64 + tq * 8 + i) * 64 + d]));
        const float la = -8.0f * r * sp;
        const float a = __expf(la);
        const float uu = __builtin_amdgcn_sqrtf(fmaxf(1.0f - a * a, 0.f)) * (ii * xc[(tq * 8 + i) * 64 + d]);
        h = a * h + uu; ca *= a; hl[i] = h; cl[i] = ca;
    }
    segA[tq * 64 + d] = ca; segH[tq * 64 + d] = h;
    __syncthreads();
    float cin_h = 0.f, cin_a = 1.f;
    for (int sgi = 0; sgi < tq; ++sgi) { const float sa = segA[sgi * 64 + d]; cin_h = sa * cin_h + segH[sgi * 64 + d]; cin_a *= sa; }
    float* LH = (float*)(ws_of(p) + WS_LRUH); float* LA = (float*)(ws_of(p) + WS_LRUA);
#pragma unroll
    for (int i = 0; i < 8; ++i) {
        const size_t o = (size_t)(rowbase + t0 + tq * 8 + i) * 256 + n * 64 + d;
        LH[o] = hl[i] + cl[i] * cin_h; LA[o] = cl[i] * cin_a;
    }
    __syncthreads();
}

__device__ __forceinline__ float logsigmoidf_(float x) { return fminf(x, 0.f) - log1pf(expf(-fabsf(x))); }

__device__ __forceinline__ int vt_off(int d, int key, int pitch) {
    const int kc = key >> 3;
    return d * pitch + ((((kc ^ (d >> 3)) & 7) | (kc & ~7)) << 3) + (key & 7);
}
__device__ void ml_x_item(const Params& p, int l, int bh, int ck, LAS unsigned char* lds) {
    const int tid = opaque_tid(), lane = tid & 63, w = __builtin_amdgcn_readfirstlane(tid >> 6), fr = lane & 15, fq = lane >> 4;
    const int b = bh >> 2, hh = bh & 3;
    LAS bf16_t* KwT = (LAS bf16_t*)lds;
    LAS bf16_t* VT = (LAS bf16_t*)(lds + 9216);
    LAS float* wks = (LAS float*)(lds + 20736);
    const bf16_t* U = (const bf16_t*)(ws_of(p) + WS_U);
    const float* GT = (const float*)(ws_of(p) + WS_GATES);
    const int rowbase = b * SEQ + ck * 64;
    if (tid < 64) {
        const float ig = GT[(size_t)(rowbase + lane) * 32 + 24 + hh] + in_of(p, 20)[l * 4 + hh];
        const float fp = GT[(size_t)(rowbase + lane) * 32 + 28 + hh] + in_of(p, 21)[l * 4 + hh];
        float a = logsigmoidf_(fp);
#pragma unroll
        for (int o = 1; o < 64; o <<= 1) { const float t = __shfl_up(a, o); if (lane >= o) a += t; }
        const float A = __shfl(a, 63);
        const float wend = A - a + ig;
        const float mu = wave_max(wend);
        wks[lane] = expf(wend - mu);
        if (lane == 0) { ((float*)(ws_of(p) + WS_MLMU))[bh * 32 + ck] = mu; ((float*)(ws_of(p) + WS_MLAT))[bh * 32 + ck] = A; }
    }
    const int srow = tid >> 3, sch = tid & 7;
    const bf16_t* src = U + (size_t)(rowbase + srow) * UW + hh * 64 + sch * 8;
    const u32x4 kk = *(const u32x4*)(src + 2048);
    {
        const u32x4 vv = *(const u32x4*)(src + 2304);
#pragma unroll
        for (int e = 0; e < 4; ++e) {
            VT[vt_off(sch * 8 + 2 * e, srow, 72)] = (bf16_t)(vv[e] & 0xffffu);
            VT[vt_off(sch * 8 + 2 * e + 1, srow, 72)] = (bf16_t)(vv[e] >> 16);
        }
        for (int idx = tid; idx < 16 * 72; idx += NTHREADS) VT[64 * 72 + idx] = (idx < 72) ? (bf16_t)0x3f80 : (bf16_t)0;
    }
    __syncthreads();
    {
        const float wk = wks[srow];
#pragma unroll
        for (int e = 0; e < 4; ++e) {
            KwT[vt_off(sch * 8 + 2 * e, srow, 72)] = f2bf(wk * __uint_as_float(kk[e] << 16));
            KwT[vt_off(sch * 8 + 2 * e + 1, srow, 72)] = f2bf(wk * __uint_as_float(kk[e] & 0xffff0000u));
        }
    }
    __syncthreads();
    {
        const int dt = w & 3, hf = w >> 2;
        bf16x8 ka[2];
#pragma unroll
        for (int ks = 0; ks < 2; ++ks) ka[ks] = *(const LAS bf16x8*)(KwT + vt_off(16 * dt + fr, 32 * ks + 8 * fq, 72));
        float* C = (float*)(ws_of(p) + WS_MLC) + (size_t)(bh * 32 + ck) * 4096;
#pragma unroll
        for (int ee = 0; ee < 2; ++ee) {
            const int et = 2 * hf + ee;
            f32x4 acc = (f32x4){0.f, 0.f, 0.f, 0.f};
#pragma unroll
            for (int ks = 0; ks < 2; ++ks) {
                const bf16x8 vb = *(const LAS bf16x8*)(VT + vt_off(16 * et + fr, 32 * ks + 8 * fq, 72));
                acc = __builtin_amdgcn_mfma_f32_16x16x32_bf16(ka[ks], vb, acc, 0, 0, 0);
            }
#pragma unroll
            for (int i = 0; i < 4; ++i) C[(16 * dt + 4 * fq + i) * 64 + 16 * et + fr] = acc[i];
        }
        if (hf == 0) {
            f32x4 acc = (f32x4){0.f, 0.f, 0.f, 0.f};
#pragma unroll
            for (int ks = 0; ks < 2; ++ks) {
                const bf16x8 vb = *(const LAS bf16x8*)(VT + (64 + fr) * 72 + 32 * ks + 8 * fq);
                acc = __builtin_amdgcn_mfma_f32_16x16x32_bf16(ka[ks], vb, acc, 0, 0, 0);
            }
            if (fr == 0) {
#pragma unroll
                for (int i = 0; i < 4; ++i) ((float*)(ws_of(p) + WS_MLN))[(size_t)(bh * 32 + ck) * 64 + 16 * dt + 4 * fq + i] = acc[i];
            }
        }
    }
    __syncthreads();
}

__device__ void phase_m2(const Params& p, int l, int cls, LAS unsigned char* lds, int bid, int G) {
    const int tid = opaque_tid();
    constexpr int N_KC = 128, N_LC = 4, N_MC = 256, N_MN = 4, TOTAL = N_KC + N_LC + N_MC + N_MN;
    for (int it = bid; it < TOTAL; it += G) {
        if (it < N_KC) {
            if (!(cls & 1)) continue;
            const int kv = it >> 6, r0 = (it & 63) * 32;
            LAS float* hid = (LAS float*)lds;
            LAS float* w2s = hid + 32 * 256;
            const float* part = (const float*)(ws_of(p) + WS_HID) + (size_t)(kv * 2048 + r0) * 256;
            const float* cb = (const float*)(ws_of(p) + WS_CBIAS) + (l * 2 + kv) * 256;
            const float* w2 = in_of(p, kv ? 12 : 9) + (size_t)l * 256 * 64;
            f32x4 pr[4][4];
#pragma unroll
            for (int rr = 0; rr < 4; ++rr) {
                const int idx = tid + rr * NTHREADS, row = idx >> 6, j4 = (idx & 63) * 4;
#pragma unroll
                for (int kp = 0; kp < 4; ++kp) pr[rr][kp] = *(const f32x4*)(part + (size_t)kp * 2 * 2048 * 256 + row * 256 + j4);
            }
#pragma unroll
            for (int rr = 0; rr < 4; ++rr) {
                const int idx = tid + rr * NTHREADS, row = idx >> 6, j4 = (idx & 63) * 4;
                f32x4 hv = *(const f32x4*)(cb + j4);
#pragma unroll
                for (int kp = 0; kp < 4; ++kp) hv = hv + pr[rr][kp];
#pragma unroll
                for (int q = 0; q < 4; ++q) hv[q] = hv[q] * __builtin_amdgcn_rcpf(1.0f + __expf(-hv[q]));
                *(LAS f32x4*)(hid + row * 256 + j4) = hv;
            }
#pragma unroll
            for (int rr = 0; rr < 8; ++rr) { const int idx = tid + rr * NTHREADS; *(LAS f32x4*)(w2s + idx * 4) = *(const f32x4*)(w2 + idx * 4); }
            __syncthreads();
            {
                const int d = tid & 63, rq = tid >> 6;
                float acc[4] = {0.f, 0.f, 0.f, 0.f};
                for (int j = 0; j < 256; j += 4) {
                    float wv[4];
#pragma unroll
                    for (int q = 0; q < 4; ++q) wv[q] = w2s[(j + q) * 64 + d];
#pragma unroll
                    for (int i = 0; i < 4; ++i) {
                        const f32x4 hv = *(const LAS f32x4*)(hid + (rq * 4 + i) * 256 + j);
#pragma unroll
                        for (int q = 0; q < 4; ++q) acc[i] += hv[q] * wv[q];
                    }
                }
                bf16_t* KCo = (bf16_t*)(ws_of(p) + WS_KC);
#pragma unroll
                for (int i = 0; i < 4; ++i) {
                    const int r = r0 + rq * 4 + i;
                    KCo[(size_t)(kv * 2048 + r) * 64 + d] = f2bf(((r & 127) == 127) ? 0.f : acc[i]);
                }
            }
            __syncthreads();
        } else if (it < N_KC + N_LC) {
            if (!(cls & 2)) continue;
            const int idx = (it - N_KC) * NTHREADS + tid;
            const int b = idx >> 8, ch = idx & 255;
            const float* LH = (const float*)(ws_of(p) + WS_LRUH); const float* LA = (const float*)(ws_of(p) + WS_LRUA);
            float* LC = (float*)(ws_of(p) + WS_LRUC);
            float la[32], lh[32];
#pragma unroll
            for (int ck = 0; ck < 32; ++ck) { const size_t o = (size_t)(b * SEQ + ck * 64 + 63) * 256 + ch; la[ck] = LA[o]; lh[ck] = LH[o]; }
            float carry = 0.f;
#pragma unroll
            for (int ck = 0; ck < 32; ++ck) { LC[(b * 32 + ck) * 256 + ch] = carry; carry = la[ck] * carry + lh[ck]; }
        } else {
            if (!(cls & 4)) continue;
            const bool isn = it >= N_KC + N_LC + N_MC;
            const int idx = (it - N_KC - N_LC - (isn ? N_MC : 0)) * NTHREADS + tid;
            const int bh = isn ? (idx >> 6) : (idx >> 12), de = isn ? (idx & 63) : (idx & 4095);
            const int esz = isn ? 64 : 4096;
            float* buf = (float*)(ws_of(p) + (isn ? WS_MLN : WS_MLC)) + (size_t)bh * 32 * esz + de;
            const float* MU = (const float*)(ws_of(p) + WS_MLMU) + bh * 32; const float* AT = (const float*)(ws_of(p) + WS_MLAT) + bh * 32;
            float* MP = (float*)(ws_of(p) + WS_MLMP) + bh * 32;
            float dc[32];
#pragma unroll
            for (int ck = 0; ck < 32; ++ck) dc[ck] = buf[(size_t)ck * esz];
            float C = 0.f, m = 0.f;
#pragma unroll
            for (int ck = 0; ck < 32; ++ck) {
                buf[(size_t)ck * esz] = C;
                if (!isn && de == 0) MP[ck] = m;
                const float at = AT[ck], mu = MU[ck];
                const float mn = fmaxf(at + m, mu);
                C = expf(at + m - mn) * C + expf(mu - mn) * dc[ck];
                m = mn;
            }
        }
    }
}

__device__ __forceinline__ float gelu_tanh(float x) { const float u = 0.7978845608028654f * (x + 0.044715f * x * x * x); return 0.5f * x * (1.0f + tanhf(u)); }

__device__ void lru_y_item(const Params& p, int l, int item) {
    const int tid = opaque_tid(), lane = tid & 63;
    const float* LH = (const float*)(ws_of(p) + WS_LRUH); const float* LA = (const float*)(ws_of(p) + WS_LRUA); const float* LC = (const float*)(ws_of(p) + WS_LRUC);
    const bf16_t* U = (const bf16_t*)(ws_of(p) + WS_U);
    const float* hn = in_of(p, 22) + l * 1024;
    bf16_t* HD = (bf16_t*)(ws_of(p) + WS_HEADS);
    const int pair0 = item * 128 + (tid >> 6) * 16;
    float lh[16], la[16], lc[16]; bf16_t gg[16];
    float gn[4];
#pragma unroll
    for (int n = 0; n < 4; ++n) gn[n] = hn[(8 + n) * 64 + lane];
#pragma unroll
    for (int q = 0; q < 16; ++q) {
        const int pair = pair0 + q, row = pair >> 2, n = pair & 3, ch = n * 64 + lane;
        lh[q] = LH[(size_t)row * 256 + ch]; la[q] = LA[(size_t)row * 256 + ch];
        lc[q] = LC[((row >> 11) * 32 + ((row & 2047) >> 6)) * 256 + ch];
        gg[q] = U[(size_t)row * UW + 1536 + ch];
    }
#pragma unroll
    for (int q = 0; q < 16; ++q) {
        const int pair = pair0 + q, row = pair >> 2, n = pair & 3;
        const float h = lh[q] + la[q] * lc[q];
        const float y = h * gelu_tanh(bf2f(gg[q]));
        const float ss = wave_sum(y * y);
        HD[(size_t)row * DM + (8 + n) * 64 + lane] = f2bf(y * rsqrtf(ss * (1.0f / 64.0f) + EPS) * gn[q & 3]);
    }
}

__device__ __forceinline__ int vt_lane(int fr, int fq, int pitch) { return fr * pitch + ((((fq >> 1) ^ (fr >> 3)) & 1) << 3) + ((fq & 1) << 2); }
__device__ __forceinline__ constexpr int vt_cst(int dt, int kc2, int pitch) { return dt * 16 * pitch + ((((kc2 ^ (2 * dt)) & 6) | (kc2 & ~7)) << 3); }
__device__ void ml_y_item(const Params& p, int l, int bh, int ck, LAS unsigned char* lds) {
    const int tid = opaque_tid(), lane = tid & 63, w = __builtin_amdgcn_readfirstlane(tid >> 6), fr = lane & 15, fq = lane >> 4;
    const int b = bh >> 2, hh = bh & 3;
    LAS bf16_t* Ql = (LAS bf16_t*)lds;
    LAS bf16_t* Kl = (LAS bf16_t*)(lds + 9216);
    LAS bf16_t* Vt = (LAS bf16_t*)(lds + 18432);
    LAS bf16_t* Ct = (LAS bf16_t*)(lds + 27648);
    LAS bf16_t* Wl = (LAS bf16_t*)(lds + 39168);
    LAS float* as_ = (LAS float*)(lds + 57600);
    LAS float* bs_ = as_ + 64;
    LAS float* Ms_ = bs_ + 64;
    LAS float* ssl = Ms_ + 64;
    const bf16_t* U = (const bf16_t*)(ws_of(p) + WS_U);
    const float* GT = (const float*)(ws_of(p) + WS_GATES);
    const int rowbase = b * SEQ + ck * 64;
    const float mprev = ((const float*)(ws_of(p) + WS_MLMP))[bh * 32 + ck];
    if (tid < 64) {
        const float ig = GT[(size_t)(rowbase + lane) * 32 + 24 + hh] + in_of(p, 20)[l * 4 + hh];
        const float fp = GT[(size_t)(rowbase + lane) * 32 + 28 + hh] + in_of(p, 21)[l * 4 + hh];
        float a = logsigmoidf_(fp);
#pragma unroll
        for (int o = 1; o < 64; o <<= 1) { const float t = __shfl_up(a, o); if (lane >= o) a += t; }
        const float bb = ig - a;
        float pm = bb;
#pragma unroll
        for (int o = 1; o < 64; o <<= 1) { const float t = __shfl_up(pm, o); if (lane >= o) pm = fmaxf(pm, t); }
        as_[lane] = a; bs_[lane] = bb; Ms_[lane] = fmaxf(mprev, pm);
        Ct[64 * 72 + lane] = f2bf(((const float*)(ws_of(p) + WS_MLN))[(size_t)(bh * 32 + ck) * 64 + lane]);
    }
    {
        const int row = tid >> 3, ch = tid & 7;
        const bf16_t* src = U + (size_t)(rowbase + row) * UW + hh * 64 + ch * 8;
        *(LAS u32x4*)(Ql + row * 72 + ch * 8) = *(const u32x4*)(src + 1792);
        *(LAS u32x4*)(Kl + row * 72 + ch * 8) = *(const u32x4*)(src + 2048);
        const u32x4 vv = *(const u32x4*)(src + 2304);
#pragma unroll
        for (int e = 0; e < 4; ++e) {
            Vt[vt_off(ch * 8 + 2 * e, row, 72)] = (bf16_t)(vv[e] & 0xffffu);
            Vt[vt_off(ch * 8 + 2 * e + 1, row, 72)] = (bf16_t)(vv[e] >> 16);
        }
        const float* C = (const float*)(ws_of(p) + WS_MLC) + (size_t)(bh * 32 + ck) * 4096;
#pragma unroll
        for (int rr = 0; rr < 2; ++rr) {
            const int idx = tid + rr * NTHREADS, d = idx >> 4, e4 = (idx & 15) * 4;
            const f32x4 c = *(const f32x4*)(C + d * 64 + e4);
#pragma unroll
            for (int i = 0; i < 4; ++i) Ct[(e4 + i) * 72 + d] = f2bf(c[i]);
        }
        for (int idx = tid; idx < 15 * 72; idx += NTHREADS) Ct[65 * 72 + idx] = 0;
    }
    __syncthreads();
    const int jt = w & 3, hf = w >> 2;
    bf16_t opre[2][4];
#pragma unroll
    for (int i = 0; i < 4; ++i)
#pragma unroll
        for (int ee = 0; ee < 2; ++ee) opre[ee][i] = U[(size_t)(rowbase + 16 * jt + 4 * fq + i) * UW + 2560 + hh * 64 + 16 * (2 * hf + ee) + fr];
    bf16x8 qa[2];
#pragma unroll
    for (int ks = 0; ks < 2; ++ks) qa[ks] = *(const LAS bf16x8*)(Ql + (16 * jt + fr) * 72 + 32 * ks + 8 * fq);
    f32x4 sacc[4];
#pragma unroll
    for (int st = 0; st < 4; ++st) {
        const bf16x8 k0 = *(const LAS bf16x8*)(Kl + (16 * st + fr) * 72 + 8 * fq), k1 = *(const LAS bf16x8*)(Kl + (16 * st + fr) * 72 + 32 + 8 * fq);
        sacc[st] = __builtin_amdgcn_mfma_f32_16x16x32_bf16(qa[0], k0, (f32x4){0.f, 0.f, 0.f, 0.f}, 0, 0, 0);
        sacc[st] = __builtin_amdgcn_mfma_f32_16x16x32_bf16(qa[1], k1, sacc[st], 0, 0, 0);
    }
    float sw[4], Mj[4];
    LAS bf16_t* Ww = Wl + w * (16 * 72);
#pragma unroll
    for (int i = 0; i < 4; ++i) {
        const int j = 16 * jt + 4 * fq + i;
        Mj[i] = Ms_[j];
        float acc = 0.f;
#pragma unroll
        for (int st = 0; st < 4; ++st) {
            const int sidx = 16 * st + fr;
            const float wv = (sidx <= j) ? __expf(bs_[sidx] - Mj[i]) * sacc[st][i] : 0.f;
            acc += wv;
            Ww[(4 * fq + i) * 72 + sidx] = f2bf(wv);
        }
        acc += __shfl_xor(acc, 1); acc += __shfl_xor(acc, 2); acc += __shfl_xor(acc, 4); acc += __shfl_xor(acc, 8);
        sw[i] = acc;
    }
    asm volatile("s_waitcnt lgkmcnt(0)" ::: "memory");
    bf16x8 wa[2];
#pragma unroll
    for (int ks = 0; ks < 2; ++ks) wa[ks] = *(const LAS bf16x8*)(Ww + fr * 72 + 32 * ks + 8 * fq);
    f32x4 acc1[2], acc2[2], accn;
#pragma unroll
    for (int ee = 0; ee < 2; ++ee) {
        const int et = 2 * hf + ee;
        acc1[ee] = (f32x4){0.f, 0.f, 0.f, 0.f}; acc2[ee] = (f32x4){0.f, 0.f, 0.f, 0.f};
#pragma unroll
        for (int ks = 0; ks < 2; ++ks) {
            const bf16x8 cf = *(const LAS bf16x8*)(Ct + (16 * et + fr) * 72 + 32 * ks + 8 * fq);
            const bf16x8 vf = *(const LAS bf16x8*)(Vt + vt_off(16 * et + fr, 32 * ks + 8 * fq, 72));
            acc1[ee] = __builtin_amdgcn_mfma_f32_16x16x32_bf16(qa[ks], cf, acc1[ee], 0, 0, 0);
            acc2[ee] = __builtin_amdgcn_mfma_f32_16x16x32_bf16(wa[ks], vf, acc2[ee], 0, 0, 0);
        }
    }
    accn = (f32x4){0.f, 0.f, 0.f, 0.f};
#pragma unroll
    for (int ks = 0; ks < 2; ++ks) {
        const bf16x8 cf = *(const LAS bf16x8*)(Ct + (64 + fr) * 72 + 32 * ks + 8 * fq);
        accn = __builtin_amdgcn_mfma_f32_16x16x32_bf16(qa[ks], cf, accn, 0, 0, 0);
    }
    float ov[2][4];
#pragma unroll
    for (int i = 0; i < 4; ++i) {
        const int j = 16 * jt + 4 * fq + i;
        const float qn = __shfl(accn[i], lane & 48);
        const float inter = expf(mprev - Mj[i]);
        const float den = inter * qn + sw[i];
        const float lim = expf(-(as_[j] + Mj[i]));
        const float inv = 1.0f / fmaxf(fabsf(den), lim);
        float ssp = 0.f;
#pragma unroll
        for (int ee = 0; ee < 2; ++ee) {
            const int e = 16 * (2 * hf + ee) + fr;
            const float hv = (inter * acc1[ee][i] + acc2[ee][i]) * inv;
            const float o = sigmoidf_(bf2f(opre[ee][i])) * hv;
            ov[ee][i] = o; ssp += o * o;
        }
        ssp += __shfl_xor(ssp, 1); ssp += __shfl_xor(ssp, 2); ssp += __shfl_xor(ssp, 4); ssp += __shfl_xor(ssp, 8);
        if (fr == 0) ssl[w * 16 + 4 * fq + i] = ssp;
    }
    __syncthreads();
    {
        bf16_t* HD = (bf16_t*)(ws_of(p) + WS_HEADS);
        const float* hn = in_of(p, 22) + l * 1024 + (12 + hh) * 64;
#pragma unroll
        for (int i = 0; i < 4; ++i) {
            const int j = 16 * jt + 4 * fq + i;
            const float tot = ssl[jt * 16 + 4 * fq + i] + ssl[(jt + 4) * 16 + 4 * fq + i];
            const float rs = rsqrtf(tot * (1.0f / 64.0f) + EPS);
#pragma unroll
            for (int ee = 0; ee < 2; ++ee) {
                const int e = 16 * (2 * hf + ee) + fr;
                HD[(size_t)(rowbase + j) * DM + (12 + hh) * 64 + e] = f2bf(ov[ee][i] * rs * hn[e]);
            }
        }
    }
    __syncthreads();
}

__device__ __forceinline__ bf16x8 pack8(const f32x4 lo, const f32x4 hi) {
    u32x4 r; r.x = cvt_pk_bf16(lo[0], lo[1]); r.y = cvt_pk_bf16(lo[2], lo[3]); r.z = cvt_pk_bf16(hi[0], hi[1]); r.w = cvt_pk_bf16(hi[2], hi[3]);
    return __builtin_bit_cast(bf16x8, r);
}
__device__ __forceinline__ bf16x8 join8(const u32x2 lo, const u32x2 hi) { u32x4 r; r.x = lo.x; r.y = lo.y; r.z = hi.x; r.w = hi.y; return __builtin_bit_cast(bf16x8, r); }
__device__ void nsa_item(const Params& p, int l, int b, int g, int qb, LAS unsigned char* lds, int mode = 0) {
    int tid = opaque_tid(), w = __builtin_amdgcn_readfirstlane(tid >> 6), lane = tid & 63, fr = lane & 15, fq = lane >> 4;
    LAS bf16_t* Kc = (LAS bf16_t*)lds;
    LAS bf16_t* Vc = (LAS bf16_t*)(lds + 18432);
    LAS bf16_t* Pl = (LAS bf16_t*)(lds + 36864);
    LAS float* impl = (LAS float*)(lds + 106496);
    LAS unsigned* selm = (LAS unsigned*)(lds + 114688);
    LAS int* steps = (LAS int*)(lds + 114944);
    const bf16_t* U = (const bf16_t*)(ws_of(p) + WS_U);
    const int bg = b * 2 + g, rowbase = b * SEQ;
    const int head = 4 * g + (w >> 1);
    const float sl2 = exp2f(-(float)(head + 1)) * 1.4426950408889634f;
    const int tw0 = qb * 64 + (w & 1) * 32;
    bf16x8 qf[2][2];
#pragma unroll
    for (int mt = 0; mt < 2; ++mt)
#pragma unroll
        for (int ks = 0; ks < 2; ++ks)
            qf[mt][ks] = *(const bf16x8*)(U + (size_t)(rowbase + tw0 + mt * 16 + fr) * UW + head * 64 + ks * 32 + fq * 8);
    const float* GT = (const float*)(ws_of(p) + WS_GATES);
    float gpre[2][3];
#pragma unroll
    for (int mt = 0; mt < 2; ++mt)
#pragma unroll
        for (int q = 0; q < 3; ++q) gpre[mt][q] = GT[(size_t)(rowbase + tw0 + mt * 16 + fr) * 32 + head * 3 + q];
    f32x4 y[2][4];
    {
        LAS float* impM = (LAS float*)Pl;
        LAS float* impT = impM + 4 * 64 * 33;
        const bf16_t* KC = (const bf16_t*)(ws_of(p) + WS_KC) + (size_t)bg * 128 * 64;
        const bf16_t* VC = KC + (size_t)2048 * 64;
        u32x4 kvr[2], vvr[2];
#pragma unroll
        for (int rr = 0; rr < 2; ++rr) { const int idx = tid + rr * NTHREADS; kvr[rr] = *(const u32x4*)(KC + idx * 8); vvr[rr] = *(const u32x4*)(VC + idx * 8); }
#pragma unroll
        for (int rr = 0; rr < 2; ++rr) {
            const int idx = tid + rr * NTHREADS, key = idx >> 3, ch = idx & 7;
            const u32x4 kv = kvr[rr];
            const u32x4 vv = vvr[rr];
            *(LAS u32x4*)(Kc + key * 72 + ch * 8) = kv;
#pragma unroll
            for (int e = 0; e < 4; ++e) {
                Vc[vt_off(ch * 8 + 2 * e, key, 136)] = (bf16_t)(vv[e] & 0xffffu);
                Vc[vt_off(ch * 8 + 2 * e + 1, key, 136)] = (bf16_t)(vv[e] >> 16);
            }
        }
        __syncthreads();
        const int vl136 = vt_lane(fr, fq, 136);
#pragma unroll
        for (int mt = 0; mt < 2; ++mt) {
            const int t = tw0 + mt * 16 + fr;
            f32x4 s[8];
#pragma unroll
            for (int nt = 0; nt < 8; ++nt) {
                const bf16x8 k0 = *(const LAS bf16x8*)(Kc + (16 * nt + fr) * 72 + fq * 8), k1 = *(const LAS bf16x8*)(Kc + (16 * nt + fr) * 72 + 32 + fq * 8);
                s[nt] = __builtin_amdgcn_mfma_f32_16x16x32_bf16(k0, qf[mt][0], (f32x4){0.f, 0.f, 0.f, 0.f}, 0, 0, 0);
                s[nt] = __builtin_amdgcn_mfma_f32_16x16x32_bf16(k1, qf[mt][1], s[nt], 0, 0, 0);
            }
            float mx = NEGF;
#pragma unroll
            for (int nt = 0; nt < 8; ++nt)
#pragma unroll
                for (int i = 0; i < 4; ++i) {
                    const int n = 16 * nt + 4 * fq + i, cend = 16 * n + 31;
                    const bool valid = (t >= cend) && (n < 127);
                    const float sv = valid ? fmaf(sl2, (float)cend, s[nt][i]) : NEGF;
                    s[nt][i] = sv; mx = fmaxf(mx, sv);
                }
            mx = fq_max(mx);
            const float ms = (mx < -1e29f) ? 0.f : mx;
            float sum = 0.f;
#pragma unroll
            for (int nt = 0; nt < 8; ++nt)
#pragma unroll
                for (int i = 0; i < 4; ++i) { const float pv = __builtin_amdgcn_exp2f(s[nt][i] - ms); s[nt][i] = pv; sum += pv; }
            sum = fq_sum(sum);
            const float inv = sum > 0.f ? 1.0f / sum : 0.f;
            {
                LAS float* mrow_ = impM + ((w >> 1) * 64 + (w & 1) * 32 + mt * 16 + fr) * 33 + fq;
                LAS float* trow_ = impT + ((w >> 1) * 64 + (w & 1) * 32 + mt * 16 + fr) * 33 + fq + 1;
#pragma unroll
                for (int nt = 0; nt < 8; ++nt) {
                    s[nt] = s[nt] * inv;
                    mrow_[4 * nt] = (s[nt][0] + s[nt][1]) + (s[nt][2] + s[nt][3]);
                    trow_[4 * nt] = s[nt][3];
                }
            }
            f32x4 oc[4];
#pragma unroll
            for (int dt = 0; dt < 4; ++dt) oc[dt] = (f32x4){0.f, 0.f, 0.f, 0.f};
#pragma unroll
            for (int ks2 = 0; ks2 < 4; ++ks2) {
                const bf16x8 pb = pack8(s[2 * ks2], s[2 * ks2 + 1]);
#pragma unroll
                for (int dt = 0; dt < 4; ++dt) {
                    const u32x2 lo = *(const LAS u32x2*)(Vc + vl136 + vt_cst(dt, 4 * ks2, 136));
                    const u32x2 hi = *(const LAS u32x2*)(Vc + vl136 + vt_cst(dt, 4 * ks2 + 2, 136));
                    oc[dt] = __builtin_amdgcn_mfma_f32_16x16x32_bf16(join8(lo, hi), pb, oc[dt], 0, 0, 0);
                }
            }
            const float g0 = sigmoidf_(gpre[mt][0]);
#pragma unroll
            for (int dt = 0; dt < 4; ++dt) y[mt][dt] = oc[dt] * g0;
        }
        if (tid < 256) impT[tid * 33] = 0.f;
        __syncthreads();
#pragma unroll 1
        for (int rr = 0; rr < 4; ++rr) {
            const int idx = tid + rr * NTHREADS, tau = idx >> 5, j = idx & 31;
            float mine = 0.f;
#pragma unroll
            for (int hh = 0; hh < 4; ++hh) mine += impM[(hh * 64 + tau) * 33 + j] + impT[(hh * 64 + tau) * 33 + j];
            bool sel;
            if (qb < 16) sel = (j <= qb);
            else {
                const bool forced = (j == 0) || (j == qb) || (j == qb - 1);
                const bool cand = (j >= 1) && (j <= qb - 2);
                int rank = 0;
#pragma unroll
                for (int jp = 1; jp < 30; ++jp) {
                    const float o = __shfl(mine, (lane & 32) + jp);
                    rank += (jp <= qb - 2 && (o > mine || (o == mine && jp < j))) ? 1 : 0;
                }
                sel = forced || (cand && rank < 13);
            }
            const unsigned long long bal = __ballot(sel);
            if ((lane & 31) == 0) selm[tau] = (lane < 32) ? (unsigned)bal : (unsigned)(bal >> 32);
        }
        __syncthreads();
        if (tid < 64) {
            unsigned m = selm[tid], uni = m, all = m;
#pragma unroll
            for (int o = 32; o >= 1; o >>= 1) { uni |= __shfl_xor(uni, o); all &= __shfl_xor(all, o); }
            uni &= (qb >= 31) ? 0xffffffffu : ((2u << qb) - 1u);
            const int nsel = __popc(uni);
            const int kb = tid;
            if (kb <= qb && ((uni >> kb) & 1u)) {
                const int pos = __popc(uni & ((1u << kb) - 1u));
                steps[1 + pos] = ((((all >> kb) & 1u) && kb < qb) ? 4096 : 0) | (1 << 8) | kb;
            }
            const int kb0 = (qb - 8 < 0) ? 0 : qb - 8;
            if (kb >= kb0 && kb <= qb) steps[1 + nsel + (kb - kb0)] = ((kb > qb - 8 && kb < qb) ? 4096 : 0) | (2 << 8) | kb;
            if (tid == 0) steps[0] = nsel + (qb - kb0 + 1);
        }
        __syncthreads();
    }
    if (mode == 1) { asm volatile("" :: "v"(y[0][0][0]), "v"(y[1][3][3])); __syncthreads(); return; }
    tid = opaque_tid(); w = __builtin_amdgcn_readfirstlane(tid >> 6); lane = tid & 63; fr = lane & 15; fq = lane >> 4;
    unsigned smask[2];
#pragma unroll
    for (int mt = 0; mt < 2; ++mt) smask[mt] = selm[(w & 1) * 32 + mt * 16 + fr];
    const int nsteps = __builtin_amdgcn_readfirstlane(steps[0]);
    const int mystep = steps[1 + (lane < 48 ? lane : 47)];
#define NSA_ST(k) __builtin_amdgcn_readlane(mystep, (k))
    float mrow[2], lrow[2];
    f32x4 oacc[2][4];
#pragma unroll
    for (int mt = 0; mt < 2; ++mt) {
        mrow[mt] = NEGF; lrow[mt] = 0.f;
#pragma unroll
        for (int dt = 0; dt < 4; ++dt) oacc[mt][dt] = (f32x4){0.f, 0.f, 0.f, 0.f};
    }
    const int skey = tid >> 3, sch = tid & 7;
    const int vl72 = vt_lane(fr, fq, 72);
    const int vsw = vt_off(sch * 8, skey, 72);
    bf16x8 kx[4], qx;
    {
        const float sh = bf2f(f2bf(sl2)), slo = sl2 - sh;
        u32x4 t = (u32x4){0u, 0u, 0u, 0u};
        if (fq == 0) t.x = cvt_pk_bf16(sh, slo);
        qx = __builtin_bit_cast(bf16x8, t);
#pragma unroll
        for (int nt = 0; nt < 4; ++nt) {
            u32x4 k = (u32x4){0u, 0u, 0u, 0u};
            const float r = (float)(16 * nt + fr);
            if (fq == 0) k.x = cvt_pk_bf16(r, r);
            kx[nt] = __builtin_bit_cast(bf16x8, k);
        }
    }
    const bf16_t* Ubase = U + (size_t)(rowbase + skey) * UW + g * 64 + sch * 8;
#define NSA_SRC(st_) (Ubase + (size_t)((st_) & 255) * 64 * UW + ((((st_) >> 8) & 15) == 1 ? 768 : 1024))
#define NSA_STAGE(buf_, kr_, vr_) do { \
        *(LAS u32x4*)(Kc + (buf_) * (64 * 72) + skey * 72 + sch * 8) = kr_; \
        LAS bf16_t* _vn = Vc + (buf_) * (64 * 72) + vsw; \
        _Pragma("unroll") for (int e = 0; e < 4; ++e) { _vn[(2 * e) * 72] = (bf16_t)(vr_[e] & 0xffffu); _vn[(2 * e + 1) * 72] = (bf16_t)(vr_[e] >> 16); } } while (0)
    u32x4 kregA, vregA;
    {
        const bf16_t* src = NSA_SRC(NSA_ST(0));
        kregA = *(const u32x4*)src; vregA = *(const u32x4*)(src + 128);
        NSA_STAGE(0, kregA, vregA);
    }
    if (nsteps > 1) { const bf16_t* src = NSA_SRC(NSA_ST(1)); kregA = *(const u32x4*)src; vregA = *(const u32x4*)(src + 128); }
    __syncthreads();
    int curkind = 1;
#define NSA_STEP(si, kX, vX) do { \
        const int st = NSA_ST(si), kind = (st >> 8) & 15, kb = st & 255; \
        const bool nomask = (st & 4096) != 0; \
        LAS bf16_t* Kl = Kc + ((si) & 1) * (64 * 72); \
        LAS bf16_t* Vt = Vc + ((si) & 1) * (64 * 72); \
        if (kind != curkind) { \
            _Pragma("unroll") for (int mt = 0; mt < 2; ++mt) { \
                float lt = lrow[mt]; \
                lt = fq_sum(lt); \
                const float sc = sigmoidf_(gpre[mt][1]) / lt; \
                _Pragma("unroll") for (int dt = 0; dt < 4; ++dt) { y[mt][dt] += oacc[mt][dt] * sc; oacc[mt][dt] = (f32x4){0.f, 0.f, 0.f, 0.f}; } \
                mrow[mt] = NEGF; lrow[mt] = 0.f; \
            } \
            curkind = kind; \
        } \
        const float Bs = sl2 * (float)(kb * 64); \
        int kbi = kb * 64 + 4 * fq; \
        asm volatile("" : "+v"(kbi)); \
        f32x4 s[2][4]; \
        _Pragma("unroll") for (int nt = 0; nt < 4; ++nt) { \
            const bf16x8 k0 = *(const LAS bf16x8*)(Kl + (16 * nt + fr) * 72 + fq * 8), k1 = *(const LAS bf16x8*)(Kl + (16 * nt + fr) * 72 + 32 + fq * 8); \
            _Pragma("unroll") for (int mt = 0; mt < 2; ++mt) { \
                s[mt][nt] = __builtin_amdgcn_mfma_f32_16x16x32_bf16(k0, qf[mt][0], (f32x4){0.f, 0.f, 0.f, 0.f}, 0, 0, 0); \
                s[mt][nt] = __builtin_amdgcn_mfma_f32_16x16x32_bf16(k1, qf[mt][1], s[mt][nt], 0, 0, 0); \
                s[mt][nt] = __builtin_amdgcn_mfma_f32_16x16x32_bf16(kx[nt], qx, s[mt][nt], 0, 0, 0); \
            } \
        } \
        bf16x8 pb[2][2]; \
        _Pragma("unroll") for (int mt = 0; mt < 2; ++mt) { \
            float mx = NEGF; \
            if (nomask) { \
                _Pragma("unroll") for (int nt = 0; nt < 4; ++nt) \
                    _Pragma("unroll") for (int i = 0; i < 4; ++i) mx = fmaxf(mx, s[mt][nt][i]); \
            } else { \
                const int t = tw0 + mt * 16 + fr; \
                const bool rowok = (kind == 1) ? (((smask[mt] >> kb) & 1u) != 0u) : true; \
                _Pragma("unroll") for (int nt = 0; nt < 4; ++nt) \
                    _Pragma("unroll") for (int i = 0; i < 4; ++i) { \
                        const int dist = t - (kbi + 16 * nt + i); \
                        const bool valid = rowok && dist >= 0 && (kind == 1 || dist < 512); \
                        const float sv = valid ? s[mt][nt][i] : NEGF; \
                        s[mt][nt][i] = sv; mx = fmaxf(mx, sv); \
                    } \
            } \
            mx = fq_max(mx) + Bs; \
            const float mn = fmaxf(mrow[mt], mx); \
            const float alpha = __builtin_amdgcn_exp2f(mrow[mt] - mn); \
            mrow[mt] = mn; \
            const float ms = ((mn < -1e29f) ? 0.f : mn) - Bs; \
            float ls = 0.f; \
            _Pragma("unroll") for (int nt = 0; nt < 4; ++nt) \
                _Pragma("unroll") for (int i = 0; i < 4; ++i) { const float pv = __builtin_amdgcn_exp2f(s[mt][nt][i] - ms); s[mt][nt][i] = pv; ls += pv; } \
            lrow[mt] = lrow[mt] * alpha + ls; \
            _Pragma("unroll") for (int dt = 0; dt < 4; ++dt) oacc[mt][dt] = oacc[mt][dt] * alpha; \
            pb[mt][0] = pack8(s[mt][0], s[mt][1]); pb[mt][1] = pack8(s[mt][2], s[mt][3]); \
        } \
        _Pragma("unroll") for (int ks2 = 0; ks2 < 2; ++ks2) \
            _Pragma("unroll") for (int dt = 0; dt < 4; ++dt) { \
                const u32x2 lo = *(const LAS u32x2*)(Vt + vl72 + vt_cst(dt, 4 * ks2, 72)); \
                const u32x2 hi = *(const LAS u32x2*)(Vt + vl72 + vt_cst(dt, 4 * ks2 + 2, 72)); \
                const bf16x8 va = join8(lo, hi); \
                _Pragma("unroll") for (int mt = 0; mt < 2; ++mt) oacc[mt][dt] = __builtin_amdgcn_mfma_f32_16x16x32_bf16(va, pb[mt][ks2], oacc[mt][dt], 0, 0, 0); \
            } \
        if ((si) + 1 < nsteps) NSA_STAGE(((si) + 1) & 1, kX, vX); \
        if ((si) + 2 < nsteps) { const bf16_t* src = NSA_SRC(NSA_ST((si) + 2)); kX = *(const u32x4*)src; vX = *(const u32x4*)(src + 128); } \
        __syncthreads(); \
    } while (0)
    for (int si = 0; si < nsteps; ++si) {
        NSA_STEP(si, kregA, vregA);
    }
#undef NSA_STEP
#undef NSA_ST
#undef NSA_STAGE
#undef NSA_SRC
    tid = opaque_tid(); lane = tid & 63; fr = lane & 15; fq = lane >> 4;
    {
        const float* hn = in_of(p, 22) + l * 1024 + head * 64;
        bf16_t* HD = (bf16_t*)(ws_of(p) + WS_HEADS);
        f32x4 gnv[4];
#pragma unroll
        for (int dt = 0; dt < 4; ++dt) gnv[dt] = *(const f32x4*)(hn + 16 * dt + 4 * fq);
#pragma unroll
        for (int mt = 0; mt < 2; ++mt) {
            const int t = tw0 + mt * 16 + fr;
            float lt = lrow[mt];
            lt = fq_sum(lt);
            const float sc = sigmoidf_(gpre[mt][2]) / lt;
            float ss = 0.f;
            f32x4 yy[4];
#pragma unroll
            for (int dt = 0; dt < 4; ++dt) { yy[dt] = y[mt][dt] + oacc[mt][dt] * sc; ss += (yy[dt][0] * yy[dt][0] + yy[dt][1] * yy[dt][1]) + (yy[dt][2] * yy[dt][2] + yy[dt][3] * yy[dt][3]); }
            ss = fq_sum(ss);
            const float rs = rsqrtf(ss * (1.0f / 64.0f) + EPS);
#pragma unroll
            for (int dt = 0; dt < 4; ++dt) {
                const f32x4 gn = gnv[dt];
                const f32x4 o = yy[dt] * rs * gn;
                u32x2 pk; pk.x = cvt_pk_bf16(o[0], o[1]); pk.y = cvt_pk_bf16(o[2], o[3]);
                *(u32x2*)(HD + (size_t)(rowbase + t) * DM + head * 64 + 16 * dt + 4 * fq) = pk;
            }
        }
    }
    __syncthreads();
}

#define XB_TMO      128
#define XB_XCNT(j)  (256  + 64 * (j))
#define XB_XSUB(j)  (1280 + 64 * (j))
#define XB_XGEN(j)  (2304 + 64 * (j))
#define XB_TOP      3328
#define XB_TOPGEN   3392
#define XCD_BAR_WORDS 3456
#define XB_SPIN_CAP (1u << 22)
__device__ __forceinline__ unsigned xb_ld(unsigned* p)              { return __hip_atomic_load(p, __ATOMIC_RELAXED, __HIP_MEMORY_SCOPE_AGENT); }
__device__ __forceinline__ unsigned xb_add(unsigned* p, unsigned v) { return __hip_atomic_fetch_add(p, v, __ATOMIC_RELAXED, __HIP_MEMORY_SCOPE_AGENT); }
__device__ __forceinline__ unsigned xb_xcc_id() { return (unsigned)__builtin_amdgcn_s_getreg((3 << 11) | 20) & 0xFu; }
#define XB_SPIN(cond, bar) do { unsigned _sp = 0; while (cond) { __builtin_amdgcn_s_sleep(1); \
    if ((++_sp & 255u) == 0u) { if (xb_ld(&(bar)[XB_TMO])) break; if (_sp > XB_SPIN_CAP) { atomicAdd(&(bar)[XB_TMO], 1u); break; } } } } while (0)
struct XcdBarrier { unsigned* bar; unsigned x; volatile LAS unsigned* st; };
__device__ __forceinline__ XcdBarrier xcd_barrier_post(unsigned* bar, volatile LAS unsigned* st) {
    XcdBarrier b; b.bar = bar; b.x = xb_xcc_id(); b.st = st;
    if (threadIdx.x == 0) (void)xb_add(&bar[XB_XCNT(b.x)], 1u);
    return b;
}
__device__ __forceinline__ void xcd_barrier_complete(unsigned* bar, unsigned x, unsigned& nloc, unsigned& nx) {
    const unsigned G = gridDim.x * gridDim.y * gridDim.z;
    unsigned sum, cnt, mine, sp = 0u;
    for (;;) {
        sum = 0u; cnt = 0u; mine = 0u;
#pragma unroll
        for (unsigned j = 0; j < 16; ++j) { const unsigned c = xb_ld(&bar[XB_XCNT(j)]); sum += c; cnt += (c > 0u) ? 1u : 0u; mine = (j == x) ? c : mine; }
        if (sum == G) break;
        __builtin_amdgcn_s_sleep(1);
        if ((++sp & 255u) == 0u) { if (xb_ld(&bar[XB_TMO])) break; if (sp > XB_SPIN_CAP) { atomicAdd(&bar[XB_TMO], 1u); break; } }
    }
    nloc = mine > 0u ? mine : 1u; nx = cnt > 0u ? cnt : 1u;
}
__device__ __forceinline__ void xcd_barrier(const XcdBarrier& b) {
    asm volatile("s_waitcnt vmcnt(0)" ::: "memory");
    __syncthreads();
    if (threadIdx.x == 0) {
        unsigned* bar = b.bar;
        __builtin_amdgcn_s_waitcnt(0);
        unsigned nloc = b.st[0], nx = b.st[1];
        if (nloc == 0u) { xcd_barrier_complete(bar, b.x, nloc, nx); b.st[0] = nloc; b.st[1] = nx; }
        const unsigned old = xb_add(&bar[XB_XSUB(b.x)], 1u);
        const unsigned gen = old / nloc;
        if (old + 1u == (gen + 1u) * nloc) {
            __builtin_amdgcn_fence(__ATOMIC_RELEASE, "agent");
            asm volatile("s_waitcnt vmcnt(0)" ::: "memory");
            const unsigned og = xb_add(&bar[XB_TOP], 1u);
            const unsigned tg = og / nx;
            if (og + 1u == (tg + 1u) * nx) xb_add(&bar[XB_TOPGEN], 1u);
            else XB_SPIN(xb_ld(&bar[XB_TOPGEN]) == tg, bar);
            __builtin_amdgcn_fence(__ATOMIC_ACQUIRE, "agent");
            xb_add(&bar[XB_XGEN(b.x)], 1u);
            asm volatile("s_waitcnt vmcnt(0)" ::: "memory");
        } else {
            XB_SPIN(xb_ld(&bar[XB_XGEN(b.x)]) == gen, bar);
            __builtin_amdgcn_fence(__ATOMIC_ACQUIRE, "agent");
            asm volatile("s_waitcnt vmcnt(0)" ::: "memory");
        }
    }
    __syncthreads();
}

__global__ void __launch_bounds__(NTHREADS) hymba_fwd(Params p) {
    extern __shared__ __attribute__((aligned(16))) unsigned char lds_raw[];
    LAS unsigned char* lds = (LAS unsigned char*)lds_raw;
    cg::grid_group grid = cg::this_grid();
    volatile LAS unsigned* xbw = (volatile LAS unsigned*)(lds + LDS_BYTES - 16);
    if (threadIdx.x < 4) xbw[threadIdx.x] = 0u;
    __syncthreads();
    XcdBarrier xbar = xcd_barrier_post((unsigned*)(ws_of(p) + WS_BAR), xbw);
    if (p.ph_hi - p.ph_lo > 1) grid.sync();
    for (int ph = p.ph_lo; ph < p.ph_hi; ++ph) {
        int G = gridDim.x, bid = blockIdx.x;
        asm volatile("" : "+s"(G), "+s"(bid));
        const int tpx = opaque_tid();
        if (ph == 0) {
            if (PHEN(0)) prologue(p, lds, bid, G);
            if (REP_SUB == 100) { __syncthreads(); prologue(p, lds, bid, G); }
        } else if (ph == 37) { if (PHEN(10)) {
            const float* ssq = (const float*)(ws_of(p) + WS_SSQ) + (size_t)(12 & 1) * T_ * 16;
            float* outp = out_of(p);
            const f32x4 gn = *(const f32x4*)(in_of(p, 28) + (tpx & 255) * 4);
            for (int it = bid; it < T_ / 8; it += G) {
                f32x4 v[4], pa[4][4];
#pragma unroll
                for (int q = 0; q < 4; ++q) {
                    const int row = it * 8 + q * 2 + (tpx >> 8);
                    v[q] = *(const f32x4*)(outp + (size_t)row * DM + (tpx & 255) * 4);
#pragma unroll
                    for (int k = 0; k < 4; ++k) pa[q][k] = *(const f32x4*)(ssq + (size_t)row * 16 + 4 * k);
                }
#pragma unroll
                for (int q = 0; q < 4; ++q) {
                    const int row = it * 8 + q * 2 + (tpx >> 8);
                    const float sm = (((pa[q][0][0] + pa[q][0][1]) + (pa[q][0][2] + pa[q][0][3])) + ((pa[q][1][0] + pa[q][1][1]) + (pa[q][1][2] + pa[q][1][3]))) + (((pa[q][2][0] + pa[q][2][1]) + (pa[q][2][2] + pa[q][2][3])) + ((pa[q][3][0] + pa[q][3][1]) + (pa[q][3][2] + pa[q][3][3])));
                    const float r = rsqrtf(sm * (1.0f / DM) + EPS);
                    *(f32x4*)(outp + (size_t)row * DM + (tpx & 255) * 4) = v[q] * r * gn;
                }
            } }
        } else {
            const int l = (ph - 1) / 9, sub = (ph - 1) % 9;
            unsigned char* wl = ws_of(p) + WS_W + (size_t)l * LAYER_W;
            float* ssq = (float*)(ws_of(p) + WS_SSQ);
            bf16_t* HB = (bf16_t*)(ws_of(p) + WS_HB);
            bf16_t* UB = (bf16_t*)(ws_of(p) + WS_U);
            if (PHEN(1) && (sub == 0 || sub == 7)) {
                const bool second = sub == 7;
                pg8::Gemm g{HB, (const bf16_t*)(wl + (second ? LO_W13B : LO_W13A)), T_, NUP, DM, DM, DM};
                pg8::StaticOrder S; S.init(T_, NUP, G, bid);
                EpiSwiGLU E{UB, ssq + (size_t)((3 * l + (second ? 2 : 0)) & 1) * T_ * 16};
                pg8::gemm_phase(lds, g, S, E);
                if (REP_SUB == 0) { __syncthreads(); pg8::gemm_phase(lds, g, S, E); }
            } else if (PHEN(2) && (sub == 1 || sub == 8 || sub == 6)) {
                const bool wout = sub == 6, second = sub == 8;
                pg8::Gemm g;
                if (wout) g = pg8::Gemm{(const bf16_t*)(ws_of(p) + WS_HEADS), (const bf16_t*)(wl + LO_WOUT), T_, DM, DM, DM, DM};
                else g = pg8::Gemm{UB, (const bf16_t*)(wl + (second ? LO_W2B : LO_W2A)), T_, DM, DFF, DFF, DFF};
                pg8::StaticOrder S; S.init(T_, DM, G, bid);
                const float* resid = (l == 0 && sub == 1) ? in_of(p, 0) : out_of(p);
                const int nxt = 3 * l + (sub == 1 ? 1 : (sub == 6 ? 2 : 3));
                EpiResid E{resid, out_of(p), HB, ssq + (size_t)(nxt & 1) * T_ * 16, wout ? 1.0f : 0.5f};
                pg8::gemm_phase(lds, g, S, E);
                if (REP_SUB == 1) { __syncthreads(); EpiResid E2{out_of(p), out_of(p), HB, ssq + (size_t)(nxt & 1) * T_ * 16, 0.0f}; pg8::gemm_phase(lds, g, S, E2); }
            } else if (PHEN(3) && sub == 2) {
                if (bid < 2 && tpx < 256) {
                    const float* cbp = (const float*)(ws_of(p) + WS_CBP) + (size_t)((l * 2 + bid) * 32) * 256 + tpx;
                    float sb = 0.f;
#pragma unroll
                    for (int q = 0; q < 32; ++q) sb += cbp[q * 256];
                    ((float*)(ws_of(p) + WS_CBIAS))[(l * 2 + bid) * 256 + tpx] = sb;
                }
                pg8::Gemm g{HB, (const bf16_t*)(wl + LO_WIN), T_, NINP, DM, DM, DM};
                pg8::StaticOrder S; S.init(T_, NINP, G, bid);
                EpiWin E{UB, (bf16_t*)(ws_of(p) + WS_KCMP), (bf16_t*)(ws_of(p) + WS_VCMP), (float*)(ws_of(p) + WS_GATES), ssq + (size_t)((3 * l + 1) & 1) * T_ * 16};
                pg8::gemm_phase(lds, g, S, E);
                if (REP_SUB == 2) { __syncthreads(); pg8::gemm_phase(lds, g, S, E); }
            } else if (sub == 3) {
                const int ngemm = 64;
                for (int rep = 0; rep < (REP_SUB == 3 ? 2 : 1); ++rep) {
                const int cls = rep == 0 ? 7 : REP_CLASS;
                if (rep) __syncthreads();
                if (G > ngemm) {
                    if (bid < ngemm) { if (PHEN(4) && (cls & 1)) {
                        const int kp = bid >> 4, kv = (bid >> 3) & 1;
                        pg8::Gemm g{(const bf16_t*)(ws_of(p) + (kv ? WS_VCMP : WS_KCMP)) + kp * 512, (const bf16_t*)(wl + (kv ? LO_CW1V : LO_CW1K)) + kp * 512, 2048, 256, 512, 1024, 2048};
                        pg8::SingleUnit S{bid & 7};
                        EpiCmp E{(float*)(ws_of(p) + WS_HID) + (size_t)(kp * 2 + kv) * 2048 * 256};
                        pg8::gemm_phase(lds, g, S, E); }
                    }
                    if (PHEN(5)) {
                        const bool gb = bid < ngemm;
                        const int i0 = gb ? 1728 + bid : bid - ngemm, i1 = gb ? 2048 : 1728, st = gb ? ngemm : G - ngemm;
                        for (int it = i0; it < i1; it += st) {
                            if (it < 1024) { if (cls & 2) lru_x_item(p, l, it >> 7, (it >> 5) & 3, it & 31, lds); }
                            else if (cls & 4) ml_x_item(p, l, (it - 1024) >> 5, it & 31, lds);
                        }
                    }
                }
                }
            } else if (PHEN(6) && sub == 4) {
                phase_m2(p, l, 7, lds, bid, G);
                if (REP_SUB == 4) { __syncthreads(); phase_m2(p, l, REP_CLASS, lds, bid, G); }
            } else if (sub == 5) {
                for (int rep = 0; rep < (REP_SUB == 5 ? 2 : 1); ++rep) {
                const int cls = rep == 0 ? 7 : REP_CLASS;
                if (rep) __syncthreads();
                for (int it = bid; it < 512 + 1024 + 512; it += G) {
                    if (it < 512) { if (PHEN(7) && (cls & 1)) {
                        const int qb = it < 256 ? 31 - (it >> 4) : ((it - 256) >> 4), bg = it & 15;
                        nsa_item(p, l, bg >> 1, bg & 1, qb, lds, (rep == 1 && REP_CLASS == 9) ? 1 : 0); }
                    } else if (it < 1536) {
                        if (PHEN(8) && (cls & 2)) ml_y_item(p, l, (it - 512) >> 5, (it - 512) & 31, lds);
                    } else {
                        if (PHEN(9) && (cls & 4)) lru_y_item(p, l, it - 1536);
                    }
                }
                }
            }
        }
        if (ph + 1 < p.ph_hi) {
            xcd_barrier(xbar);
            if (REP_SUB == 200) xcd_barrier(xbar);
        }
    }
}

extern "C" void kernel_launch(void* const* d_in, const int* in_sizes, int n_in, void* d_out, int out_size, void* d_ws, size_t ws_size, hipStream_t stream) {
    static int grid = 0;
    if (grid == 0) {
        if (n_in != 29 || out_size != T_ * DM || ws_size < WS_END) { fprintf(stderr, "kernel_launch: unexpected shapes (n_in %d out %d ws %zu need %zu)\n", n_in, out_size, ws_size, (size_t)WS_END); grid = -1; return; }
        int dev = 0, cus = 0, per_cu = 0;
        hipGetDevice(&dev);
        hipDeviceGetAttribute(&cus, hipDeviceAttributeMultiprocessorCount, dev);
        hipFuncSetAttribute((const void*)hymba_fwd, hipFuncAttributeMaxDynamicSharedMemorySize, LDS_BYTES);
        hipOccupancyMaxActiveBlocksPerMultiprocessor(&per_cu, (const void*)hymba_fwd, NTHREADS, LDS_BYTES);
        if (per_cu < 1) { fprintf(stderr, "kernel_launch: occupancy query says %d blocks per CU\n", per_cu); per_cu = 1; }
        (void)hipGetLastError();
        grid = cus;
    }
    if (grid < 0) return;
    Params p{};
    for (int i = 0; i < 29; ++i) p.in[i] = (const float*)d_in[i];
    p.out = (float*)d_out; p.ws = (unsigned char*)d_ws;
#if ONE_LAUNCH
    (void)hipMemsetAsync((unsigned char*)d_ws + WS_BAR, 0, 16384, stream);
    p.ph_lo = 0; p.ph_hi = 38;
    void* args[] = {&p};
    hipError_t e = hipLaunchCooperativeKernel((const void*)hymba_fwd, dim3(grid), dim3(NTHREADS), args, LDS_BYTES, stream);
    if (e != hipSuccess) fprintf(stderr, "cooperative launch failed: %s (grid %d)\n", hipGetErrorString(e), grid);
#else
    for (int ph = 0; ph < 38; ++ph) {
        p.ph_lo = ph; p.ph_hi = ph + 1;
        hipLaunchKernelGGL(hymba_fwd, dim3(grid), dim3(NTHREADS), LDS_BYTES, stream, p);
    }
#endif
}
```

```cpp
#include <hip/hip_runtime.h>
#include <hip/hip_cooperative_groups.h>
#include <cstdio>
namespace cg = cooperative_groups;

#define LAS __attribute__((address_space(3)))
typedef unsigned short bf16_t;
typedef short bf16x8 __attribute__((ext_vector_type(8)));
typedef float f32x4 __attribute__((ext_vector_type(4)));
typedef float f32x2 __attribute__((ext_vector_type(2)));
typedef unsigned u32x4 __attribute__((ext_vector_type(4)));
typedef unsigned u32x2 __attribute__((ext_vector_type(2)));

#ifndef ONE_LAUNCH
#define ONE_LAUNCH 1
#endif
#ifndef PHMASK
#define PHMASK 0xFFFF
#endif
#define PHEN(k) ((PHMASK >> (k)) & 1)
#ifndef REP_SUB
#define REP_SUB -1
#endif
#ifndef REP_CLASS
#define REP_CLASS 7
#endif

constexpr int T_ = 16384, SEQ = 2048, DM = 1024, DFF = 2816, NUP = 5632, NINP = 3072, UW = 2816, DIN = 2848;
constexpr float EPS = 1e-6f;
constexpr float NEGF = -1e30f;
constexpr int NTHREADS = 512;
constexpr int LDS_BYTES = 147456;

constexpr size_t SZ_W13T = (size_t)NUP * DM * 2, SZ_W2T = (size_t)DM * DFF * 2, SZ_WINT = (size_t)NINP * DM * 2, SZ_WOUTT = (size_t)DM * DM * 2, SZ_CW1T = (size_t)256 * 2048 * 2;
constexpr size_t LO_W13A = 0, LO_W2A = LO_W13A + SZ_W13T, LO_W13B = LO_W2A + SZ_W2T, LO_W2B = LO_W13B + SZ_W13T, LO_WIN = LO_W2B + SZ_W2T, LO_WOUT = LO_WIN + SZ_WINT,
                 LO_CW1K = LO_WOUT + SZ_WOUTT, LO_CW1V = LO_CW1K + SZ_CW1T, LAYER_W = LO_CW1V + SZ_CW1T;
constexpr size_t WS_W = 0;
constexpr size_t WS_HB = WS_W + 4 * LAYER_W;
constexpr size_t WS_U = WS_HB + (size_t)T_ * DM * 2;
constexpr size_t WS_HEADS = WS_U + (size_t)T_ * UW * 2;
constexpr size_t SZ_CMPIN = (size_t)16 * 2048 * 64 * 2 + 4096;
constexpr size_t WS_KCMP = WS_HEADS + (size_t)T_ * DM * 2;
constexpr size_t WS_VCMP = WS_KCMP + SZ_CMPIN;
constexpr size_t WS_HID = WS_VCMP + SZ_CMPIN;
constexpr size_t WS_KC = WS_HID + (size_t)4 * 2 * 2048 * 256 * 4;
constexpr size_t WS_GATES = WS_KC + (size_t)2 * 2048 * 64 * 2;
constexpr size_t WS_SSQ = WS_GATES + (size_t)T_ * 32 * 4;
constexpr size_t WS_CBIAS = WS_SSQ + (size_t)2 * T_ * 16 * 4;
constexpr size_t WS_LRUH = WS_CBIAS + 8192;
constexpr size_t WS_LRUA = WS_LRUH + (size_t)T_ * 256 * 4;
constexpr size_t WS_LRUC = WS_LRUA + (size_t)T_ * 256 * 4;
constexpr size_t WS_MLC = WS_LRUC + (size_t)8 * 32 * 256 * 4;
constexpr size_t WS_MLN = WS_MLC + (size_t)1024 * 4096 * 4;
constexpr size_t WS_MLMU = WS_MLN + (size_t)1024 * 64 * 4;
constexpr size_t WS_MLAT = WS_MLMU + 4096;
constexpr size_t WS_MLMP = WS_MLAT + 4096;
constexpr size_t WS_CBP = WS_MLMP + 4096;
constexpr size_t WS_LRUWT = WS_CBP + 262144;
constexpr size_t WS_BAR = WS_LRUWT + 262144;
constexpr size_t WS_END = WS_BAR + 16384;
static_assert(WS_END <= 425365632ull, "workspace too large");
static_assert(LAYER_W % 256 == 0 && WS_HB % 256 == 0 && WS_U % 256 == 0 && WS_KCMP % 256 == 0 && WS_VCMP % 256 == 0 && WS_HID % 256 == 0, "align");

struct Params {
    const float* in[29];
    float* out;
    unsigned char* ws;
    int ph_lo, ph_hi;
};
static_assert(sizeof(Params) == 256, "Params has padding");
#define GAS __attribute__((address_space(1)))
__device__ __forceinline__ unsigned char* ws_of(const Params& p) { unsigned long long w = (unsigned long long)p.ws; asm volatile("" : "+s"(w)); return (unsigned char*)(GAS unsigned char*)w; }
__device__ __forceinline__ float* out_of(const Params& p) { unsigned long long w = (unsigned long long)p.out; asm volatile("" : "+s"(w)); return (float*)(GAS float*)w; }
__device__ __forceinline__ const float* in_of(const Params& p, int i) { unsigned long long w = (unsigned long long)p.in[i]; asm volatile("" : "+s"(w)); return (const float*)(GAS const float*)w; }
__device__ __forceinline__ unsigned cvt_pk_bf16(float lo, float hi) { unsigned r; asm volatile("v_cvt_pk_bf16_f32 %0, %1, %2" : "=v"(r) : "v"(lo), "v"(hi)); return r; }
__device__ __forceinline__ bf16_t f2bf(float f) { return (bf16_t)(cvt_pk_bf16(f, 0.f) & 0xffffu); }
__device__ __forceinline__ float bf2f(bf16_t b) { return __uint_as_float(((unsigned)b) << 16); }
__device__ __forceinline__ float sigmoidf_(float x) { return 1.0f / (1.0f + __expf(-x)); }
__device__ __forceinline__ int opaque_tid() { int x = threadIdx.x; asm volatile("" : "+v"(x)); return x; }
__device__ __forceinline__ float row_rstd(const float* part, int row) {
    const f32x4 a = *(const f32x4*)(part + (size_t)row * 16), b = *(const f32x4*)(part + (size_t)row * 16 + 4), c = *(const f32x4*)(part + (size_t)row * 16 + 8), d = *(const f32x4*)(part + (size_t)row * 16 + 12);
    const float s = (((a[0] + a[1]) + (a[2] + a[3])) + ((b[0] + b[1]) + (b[2] + b[3]))) + (((c[0] + c[1]) + (c[2] + c[3])) + ((d[0] + d[1]) + (d[2] + d[3])));
    return rsqrtf(s * (1.0f / DM) + EPS);
}
__device__ __forceinline__ float fq_max(float x) {
    auto a = __builtin_amdgcn_permlane16_swap(__float_as_uint(x), __float_as_uint(x), false, false);
    const float m = fmaxf(__uint_as_float(a[0]), __uint_as_float(a[1]));
    auto b = __builtin_amdgcn_permlane32_swap(__float_as_uint(m), __float_as_uint(m), false, false);
    return fmaxf(__uint_as_float(b[0]), __uint_as_float(b[1]));
}
__device__ __forceinline__ float fq_sum(float x) {
    auto a = __builtin_amdgcn_permlane16_swap(__float_as_uint(x), __float_as_uint(x), false, false);
    const float m = __uint_as_float(a[0]) + __uint_as_float(a[1]);
    auto b = __builtin_amdgcn_permlane32_swap(__float_as_uint(m), __float_as_uint(m), false, false);
    return __uint_as_float(b[0]) + __uint_as_float(b[1]);
}
__device__ __forceinline__ float wave_sum(float v) {
#pragma unroll
    for (int o = 32; o >= 1; o >>= 1) v += __shfl_xor(v, o);
    return v;
}
__device__ __forceinline__ float wave_max(float v) {
#pragma unroll
    for (int o = 32; o >= 1; o >>= 1) v = fmaxf(v, __shfl_xor(v, o));
    return v;
}

namespace pg8 {
constexpr int BM = 256, BK = 64, HALF = 128, HTB = HALF * BK * 2, STAGE_BYTES = 8 * HTB, NXCD = 8, WGM = 8;
__device__ __forceinline__ int lds_byte(int r, int c) { const int st = (r >> 4) * 2 + (c >> 5), rr = r & 15, cc = c & 31, ob = rr * 64 + cc * 2; return st * 1024 + (ob ^ (((ob >> 9) & 1) << 5)); }
__device__ __forceinline__ void stage_rc(int b, int& R, int& C) { const int st = b / 1024, sb = b % 1024, swz = sb ^ (((sb >> 9) & 1) << 5); R = (st >> 1) * 16 + swz / 64; C = (st & 1) * 32 + (swz % 64) / 2; }

struct Unit { int pm, pn; };
struct Gemm { const bf16_t* A; const bf16_t* Bt; int M, N, K, lda, ldb; };

struct StaticOrder {
    int nM, nN, nwg, G, c;
    __device__ void init(int M, int N, int G_, int c_) { nM = M / BM; nN = N / BM; nwg = nM * nN; G = G_; c = c_; }
    __device__ bool next(int i, Unit& u) const {
        const long L = (long)i * G + c; if (L >= nwg) return false;
        int wgid = (int)L; { const int q = nwg / NXCD, r = nwg % NXCD, xcd = wgid % NXCD, off = wgid / NXCD; wgid = (xcd < r ? xcd * (q + 1) : r * (q + 1) + (xcd - r) * q) + off; }
        const int nig = WGM * nN, gid = wgid / nig, fm = gid * WGM, gsz = (nM - fm) < WGM ? (nM - fm) : WGM;
        u.pm = fm + ((wgid % nig) % gsz); u.pn = (wgid % nig) / gsz; return true;
    }
};
struct SingleUnit {
    int pm;
    __device__ bool next(int i, Unit& u) const { if (i != 0 || pm < 0) return false; u.pm = pm; u.pn = 0; return true; }
};

template <class Epi, class Sched>
__device__ __forceinline__ void gemm_phase(LAS unsigned char* lds, const Gemm g, const Sched& S, const Epi& E) {
    const int tid = opaque_tid(), wid = __builtin_amdgcn_readfirstlane(tid >> 6), lane = tid & 63, wr = wid >> 2, wc = wid & 3, fr = lane & 15, fq = lane >> 4;
    const int K = g.K, nt = K / BK;
    unsigned voffA[2], voffB[2];
#pragma unroll
    for (int i = 0; i < 2; ++i) { int R, C; stage_rc(tid * 16 + i * 8192, R, C);
        voffA[i] = (unsigned)(R * g.lda + C) * 2u; voffB[i] = (unsigned)(R * g.ldb + C) * 2u; }
    const size_t kstep = (size_t)(BK * 2);
    const size_t hstepA = (size_t)HALF * g.lda * 2, hstepB = (size_t)HALF * g.ldb * 2;
    const size_t tstepA = 2 * hstepA, tstepB = 2 * hstepB;
    const unsigned ldsw = (unsigned)wid * 1024u;
    const int aoff = lds_byte(wr * 64 + fr, fq * 8), boff = lds_byte(wc * 32 + fr, fq * 8);
#define PG8_SA(b, h) (((b) * 2 + (h)) * HTB)
#define PG8_SB(b, h) ((4 + (b) * 2 + (h)) * HTB)
#define PG8_STAGE(bufoff, gbase, voff) do { _Pragma("unroll") for (int _i = 0; _i < 2; ++_i) \
        __builtin_amdgcn_global_load_lds((const unsigned*)((const char*)(gbase) + (voff)[_i]), (LAS unsigned*)(lds + (bufoff) + ldsw + _i * 8192), 16, 0, 0); } while (0)
#define PG8_LDA(dst, b, h) do { _Pragma("unroll") for (int m = 0; m < 4; ++m) _Pragma("unroll") for (int k = 0; k < 2; ++k) dst[m][k] = *(const LAS bf16x8*)(lds + PG8_SA(b, h) + aoff + m * 2048 + k * 1024); } while (0)
#define PG8_LDB(dst, b, h) do { _Pragma("unroll") for (int n = 0; n < 2; ++n) _Pragma("unroll") for (int k = 0; k < 2; ++k) dst[n][k] = *(const LAS bf16x8*)(lds + PG8_SB(b, h) + boff + n * 2048 + k * 1024); } while (0)
#define PG8_MMA(ai, bj, At, Bt) do { __builtin_amdgcn_s_setprio(1); _Pragma("unroll") for (int m = 0; m < 4; ++m) _Pragma("unroll") for (int n = 0; n < 2; ++n) _Pragma("unroll") for (int k = 0; k < 2; ++k) \
        acc[ai][bj][m][n] = __builtin_amdgcn_mfma_f32_16x16x32_bf16(Bt[n][k], At[m][k], acc[ai][bj][m][n], 0, 0, 0); __builtin_amdgcn_s_setprio(0); } while (0)
#define PG8_WAIT_V(n) asm volatile("s_waitcnt vmcnt(" #n ")" ::: "memory")
#define PG8_WAIT_L(n) asm volatile("s_waitcnt lgkmcnt(" #n ")" ::: "memory")
#define PG8_BAR __builtin_amdgcn_s_barrier()
#define PG8_SCHED __builtin_amdgcn_sched_barrier(0)
    Unit cur, nxt; int ui = 0;
    if (!S.next(0, cur)) return;
    f32x4 acc[2][2][4][2];
#pragma unroll
    for (int a = 0; a < 2; ++a)
#pragma unroll
        for (int b = 0; b < 2; ++b)
#pragma unroll
            for (int m = 0; m < 4; ++m)
#pragma unroll
                for (int n = 0; n < 2; ++n) acc[a][b][m][n] = (f32x4){0.f, 0.f, 0.f, 0.f};
    bf16x8 At[4][2], B0[2][2], B1[2][2];
    const char* cA = (const char*)g.A + (size_t)cur.pm * tstepA; const char* cB = (const char*)g.Bt + (size_t)cur.pn * tstepB;
    PG8_STAGE(PG8_SB(0, 0), cB, voffB); PG8_STAGE(PG8_SA(0, 0), cA, voffA); PG8_STAGE(PG8_SB(0, 1), cB + hstepB, voffB); PG8_STAGE(PG8_SA(0, 1), cA + hstepA, voffA);
    if (wr == 1) PG8_BAR;
    PG8_WAIT_V(4); PG8_BAR;
    PG8_STAGE(PG8_SB(1, 0), cB + kstep, voffB); PG8_STAGE(PG8_SA(1, 0), cA + kstep, voffA); PG8_STAGE(PG8_SB(1, 1), cB + hstepB + kstep, voffB);
    PG8_WAIT_V(6); PG8_BAR;
    for (;;) {
        const bool has_next = S.next(ui + 1, nxt);
        const char* nA = has_next ? (const char*)g.A + (size_t)nxt.pm * tstepA : cA; const char* nB = has_next ? (const char*)g.Bt + (size_t)nxt.pn * tstepB : cB;
        for (int t = 0; t < nt; t += 2) {
            const bool last = (t == nt - 2);
            const char* a1 = cA + (size_t)(t + 1) * kstep;
            const char* a2 = last ? nA : cA + (size_t)(t + 2) * kstep; const char* b2 = last ? nB : cB + (size_t)(t + 2) * kstep;
            const char* a3 = a2 + kstep; const char* b3 = b2 + kstep;
            PG8_LDB(B0, 0, 0); PG8_SCHED; PG8_LDA(At, 0, 0); PG8_STAGE(PG8_SA(1, 1), a1 + hstepA, voffA);
            PG8_WAIT_L(8); PG8_BAR; PG8_WAIT_L(0); PG8_MMA(0, 0, At, B0); PG8_BAR; PG8_SCHED;
            PG8_LDB(B1, 0, 1); PG8_STAGE(PG8_SB(0, 0), b2, voffB);
            PG8_BAR; PG8_WAIT_L(0); PG8_MMA(0, 1, At, B1); PG8_BAR;
            PG8_LDA(At, 0, 1); PG8_STAGE(PG8_SA(0, 0), a2, voffA);
            PG8_BAR; PG8_WAIT_L(0); PG8_MMA(1, 0, At, B0); PG8_BAR; PG8_SCHED;
            PG8_STAGE(PG8_SB(0, 1), b2 + hstepB, voffB);
            PG8_WAIT_V(6); PG8_BAR; PG8_MMA(1, 1, At, B1); PG8_BAR;
            PG8_LDB(B0, 1, 0); PG8_SCHED; PG8_LDA(At, 1, 0); PG8_STAGE(PG8_SA(0, 1), a2 + hstepA, voffA);
            PG8_WAIT_L(8); PG8_BAR; PG8_WAIT_L(0); PG8_MMA(0, 0, At, B0); PG8_BAR; PG8_SCHED;
            PG8_LDB(B1, 1, 1); PG8_STAGE(PG8_SB(1, 0), b3, voffB);
            PG8_BAR; PG8_WAIT_L(0); PG8_MMA(0, 1, At, B1); PG8_BAR;
            PG8_LDA(At, 1, 1); PG8_STAGE(PG8_SA(1, 0), a3, voffA);
            PG8_BAR; PG8_WAIT_L(0); PG8_MMA(1, 0, At, B0); PG8_BAR; PG8_SCHED;
            PG8_STAGE(PG8_SB(1, 1), b3 + hstepB, voffB);
            PG8_WAIT_V(6); PG8_BAR; PG8_MMA(1, 1, At, B1); PG8_BAR;
        }
        E(acc, cur, wr, wc, fr, fq);
        if (!has_next) break;
#pragma unroll
        for (int a = 0; a < 2; ++a)
#pragma unroll
            for (int b = 0; b < 2; ++b)
#pragma unroll
                for (int m = 0; m < 4; ++m)
#pragma unroll
                    for (int n = 0; n < 2; ++n) acc[a][b][m][n] = (f32x4){0.f, 0.f, 0.f, 0.f};
        cur = nxt; cA = nA; cB = nB; ++ui;
    }
    PG8_WAIT_V(0);
    if (wr == 0) PG8_BAR;
    PG8_BAR;
#undef PG8_SA
#undef PG8_SB
#undef PG8_STAGE
#undef PG8_LDA
#undef PG8_LDB
#undef PG8_MMA
#undef PG8_WAIT_V
#undef PG8_WAIT_L
#undef PG8_BAR
#undef PG8_SCHED
}
}

typedef __attribute__((address_space(1))) float gf32;
typedef __attribute__((address_space(1))) const float gcf32;
typedef __attribute__((address_space(1))) bf16_t gbf16;
typedef __attribute__((address_space(1))) f32x4 gf32x4;
typedef __attribute__((address_space(1))) const f32x4 gcf32x4;
typedef __attribute__((address_space(1))) u32x2 gu32x2;
__device__ __forceinline__ void rows_rstd(const float* ssq, int row0, int fq, float (&r8)[2][4]) {
    f32x4 pv[2][4];
#pragma unroll
    for (int ai = 0; ai < 2; ++ai)
#pragma unroll
        for (int m = 0; m < 4; ++m) pv[ai][m] = *(gcf32x4*)(ssq + (size_t)(row0 + ai * 128 + m * 16) * 16 + 4 * fq);
#pragma unroll
    for (int ai = 0; ai < 2; ++ai)
#pragma unroll
        for (int m = 0; m < 4; ++m) {
            float sm = (pv[ai][m][0] + pv[ai][m][1]) + (pv[ai][m][2] + pv[ai][m][3]);
            sm = fq_sum(sm);
            r8[ai][m] = rsqrtf(sm * (1.0f / DM) + EPS);
        }
}
struct EpiSwiGLU {
    bf16_t* act; const float* ssq;
    __device__ __forceinline__ void operator()(const f32x4 (&acc)[2][2][4][2], const pg8::Unit& u, int wr, int wc, int fr, int fq) const {
        const int row0 = u.pm * 256 + wr * 64 + fr, col0 = u.pn * 128 + wc * 32 + 8 * fq;
        float r8[2][4];
        rows_rstd(ssq, row0, fq, r8);
#pragma unroll
        for (int ai = 0; ai < 2; ++ai)
#pragma unroll
            for (int m = 0; m < 4; ++m) {
                const int row = row0 + ai * 128 + m * 16;
                const float r = r8[ai][m];
                float o[8];
#pragma unroll
                for (int n = 0; n < 2; ++n) {
                    const f32x4 a1 = acc[ai][0][m][n] * r, a3 = acc[ai][1][m][n] * r;
#pragma unroll
                    for (int j = 0; j < 4; ++j) o[4 * n + j] = a1[j] * __builtin_amdgcn_rcpf(1.0f + __expf(-a1[j])) * a3[j];
                }
                u32x4 w; w.x = cvt_pk_bf16(o[0], o[1]); w.y = cvt_pk_bf16(o[2], o[3]); w.z = cvt_pk_bf16(o[4], o[5]); w.w = cvt_pk_bf16(o[6], o[7]);
                *(GAS u32x4*)(act + (size_t)row * DFF + col0) = w;
            }
    }
};
struct EpiResid {
    const float* resid; float* out; bf16_t* hb; float* ssq_next; float scale;
    __device__ __forceinline__ void load2(f32x4 (&rs)[2][2][2], int row0, int col0, int ai, int mp) const {
#pragma unroll
        for (int mm = 0; mm < 2; ++mm)
#pragma unroll
            for (int bj = 0; bj < 2; ++bj)
#pragma unroll
                for (int n = 0; n < 2; ++n)
                    rs[mm][bj][n] = *(gcf32x4*)(resid + (size_t)(row0 + ai * 128 + (2 * mp + mm) * 16) * DM + col0 + bj * 128 + n * 4);
    }
    __device__ __forceinline__ void operator()(const f32x4 (&acc)[2][2][4][2], const pg8::Unit& u, int wr, int wc, int fr, int fq) const {
        const int row0 = u.pm * 256 + wr * 64 + fr, col0 = u.pn * 256 + wc * 32 + 8 * fq;
        f32x4 rsA[2][2][2], rsB[2][2][2];
        load2(rsA, row0, col0, 0, 0);
#pragma unroll
        for (int bt = 0; bt < 4; ++bt) {
            const int ai = bt >> 1, mp = bt & 1;
            if (bt < 3) { if (bt & 1) load2(rsA, row0, col0, (bt + 1) >> 1, (bt + 1) & 1); else load2(rsB, row0, col0, (bt + 1) >> 1, (bt + 1) & 1); }
#pragma unroll
            for (int mm = 0; mm < 2; ++mm) {
                const int m = 2 * mp + mm, row = row0 + ai * 128 + m * 16;
                const size_t off = (size_t)row * DM + col0;
                float ss = 0.f;
#pragma unroll
                for (int bj = 0; bj < 2; ++bj) {
                    const f32x4 r0 = (bt & 1) ? rsB[mm][bj][0] : rsA[mm][bj][0], r1 = (bt & 1) ? rsB[mm][bj][1] : rsA[mm][bj][1];
                    const f32x4 v0 = r0 + acc[ai][bj][m][0] * scale, v1 = r1 + acc[ai][bj][m][1] * scale;
                    *(gf32x4*)(out + off + bj * 128) = v0;
                    *(gf32x4*)(out + off + bj * 128 + 4) = v1;
                    u32x4 w; w.x = cvt_pk_bf16(v0[0], v0[1]); w.y = cvt_pk_bf16(v0[2], v0[3]); w.z = cvt_pk_bf16(v1[0], v1[1]); w.w = cvt_pk_bf16(v1[2], v1[3]);
                    *(GAS u32x4*)(hb + off + bj * 128) = w;
                    ss += ((v0[0] * v0[0] + v0[1] * v0[1]) + (v0[2] * v0[2] + v0[3] * v0[3])) + ((v1[0] * v1[0] + v1[1] * v1[1]) + (v1[2] * v1[2] + v1[3] * v1[3]));
                }
                ss = fq_sum(ss);
                if (fq == 0) *(gf32*)(ssq_next + (size_t)row * 16 + u.pn * 4 + wc) = ss;
            }
            asm volatile("" ::: "memory");
        }
    }
};
struct EpiWin {
    bf16_t* U; bf16_t* kcmp; bf16_t* vcmp; float* gates; const float* ssq;
    __device__ __forceinline__ void operator()(const f32x4 (&acc)[2][2][4][2], const pg8::Unit& u, int wr, int wc, int fr, int fq) const {
        const int row0 = u.pm * 256 + wr * 64 + fr;
        float r8[2][4];
        rows_rstd(ssq, row0, fq, r8);
#pragma unroll
        for (int bj = 0; bj < 2; ++bj) {
            const int c0 = u.pn * 256 + bj * 128 + wc * 32;
            if (c0 >= 2848) continue;
            const float sc = (c0 < 512) ? 0.125f * 1.4426950408889634f : ((c0 >= 2048 && c0 < 2304) ? 0.125f : 1.0f);
            const int cl = 8 * fq;
#pragma unroll
            for (int ai = 0; ai < 2; ++ai)
#pragma unroll
                for (int m = 0; m < 4; ++m) {
                    const int row = row0 + ai * 128 + m * 16;
                    const float r = r8[ai][m] * sc;
                    const f32x4 v0 = acc[ai][bj][m][0] * r, v1 = acc[ai][bj][m][1] * r;
                    if (c0 == 2816) { *(gf32x4*)(gates + (size_t)row * 32 + cl) = v0; *(gf32x4*)(gates + (size_t)row * 32 + cl + 4) = v1; }
                    else {
                        u32x4 w; w.x = cvt_pk_bf16(v0[0], v0[1]); w.y = cvt_pk_bf16(v0[2], v0[3]); w.z = cvt_pk_bf16(v1[0], v1[1]); w.w = cvt_pk_bf16(v1[2], v1[3]);
                        if (c0 >= 512 && c0 < 768) {
                            const int cc = c0 - 512 + cl;
                            const int gg = (cc >> 6) & 1, d = cc & 63;
                            bf16_t* dst = (cc < 128 ? kcmp : vcmp) + ((size_t)(((row >> 11) * 2 + gg) * 2048 + (row & 2047))) * 64 + d;
                            *(GAS u32x4*)dst = w;
                        } else {
                            *(GAS u32x4*)(U + (size_t)row * UW + c0 + cl) = w;
                        }
                    }
                }
        }
    }
};
struct EpiCmp {
    float* part;
    __device__ __forceinline__ void operator()(const f32x4 (&acc)[2][2][4][2], const pg8::Unit& u, int wr, int wc, int fr, int fq) const {
        const int row0 = u.pm * 256 + wr * 64 + fr, col0 = wc * 32 + 8 * fq;
#pragma unroll
        for (int ai = 0; ai < 2; ++ai)
#pragma unroll
            for (int m = 0; m < 4; ++m) {
                const int row = row0 + ai * 128 + m * 16;
#pragma unroll
                for (int bj = 0; bj < 2; ++bj)
#pragma unroll
                    for (int n = 0; n < 2; ++n) *(gf32x4*)(part + (size_t)row * 256 + col0 + bj * 128 + n * 4) = acc[ai][bj][m][n];
            }
    }
};

__device__ __forceinline__ int winmap(int n) {
    if (n < 1280) return n;
    if (n < 2560) return n + 24;
    if (n < 2816) return n + 32;
    if (n < 2840) return 1280 + (n - 2816);
    if (n < 2844) return 2584 + (n - 2840);
    if (n < 2848) return 2588 + (n - 2844);
    return -1;
}
struct TrTile { const float* colp; const float* gain; bf16_t* dst; int ld, K, k0, n0; };
__device__ __forceinline__ void tr_decode(const Params& p, int idx, int tid, TrTile& t) {
    constexpr int TPL = 1376;
    const int l = idx / TPL; int r = idx % TPL;
    int m, ntile, ktile, K;
    if (r < 352) { m = 0; ntile = r % 22; ktile = r / 22; K = DM; }
    else if (r < 528) { r -= 352; m = 1; ntile = r % 4; ktile = r / 4; K = DFF; }
    else if (r < 880) { r -= 528; m = 2; ntile = r % 22; ktile = r / 22; K = DM; }
    else if (r < 1056) { r -= 880; m = 3; ntile = r % 4; ktile = r / 4; K = DFF; }
    else if (r < 1248) { r -= 1056; m = 4; ntile = r % 12; ktile = r / 12; K = DM; }
    else if (r < 1312) { r -= 1248; m = 5; ntile = r % 4; ktile = r / 4; K = DM; }
    else if (r < 1344) { r -= 1312; m = 6; ntile = 0; ktile = r; K = 2048; }
    else { r -= 1344; m = 7; ntile = 0; ktile = r; K = 2048; }
    t.K = K; t.k0 = ktile * 64; t.n0 = ntile * 256; t.colp = nullptr; t.gain = nullptr; t.ld = 0;
    const int npp = t.n0 + 4 * ((tid >> 3));
    const int np = (npp & ~31) + 8 * ((npp & 15) >> 2) + 4 * ((npp >> 4) & 1);
    unsigned char* wl = ws_of(p) + WS_W + (size_t)l * LAYER_W;
    if (m == 0 || m == 2) {
        const int pb = np >> 8, w = np & 255;
        const float* src = (w < 128) ? in_of(p, m == 0 ? 2 : 25) : in_of(p, m == 0 ? 3 : 26);
        t.colp = src + (size_t)l * DM * DFF + pb * 128 + (w & 127); t.ld = DFF; t.gain = in_of(p, m == 0 ? 1 : 24) + l * DM;
        t.dst = (bf16_t*)(wl + (m == 0 ? LO_W13A : LO_W13B));
    } else if (m == 1 || m == 3) {
        t.colp = in_of(p, m == 1 ? 4 : 27) + (size_t)l * DFF * DM + np; t.ld = DM;
        t.dst = (bf16_t*)(wl + (m == 1 ? LO_W2A : LO_W2B));
    } else if (m == 4) {
        const int sc = winmap(np);
        if (sc >= 0) t.colp = in_of(p, 6) + (size_t)l * DM * DIN + sc;
        t.ld = DIN; t.gain = in_of(p, 5) + l * DM;
        t.dst = (bf16_t*)(wl + LO_WIN);
    } else if (m == 5) {
        t.colp = in_of(p, 23) + (size_t)l * DM * DM + np; t.ld = DM;
        t.dst = (bf16_t*)(wl + LO_WOUT);
    } else {
        t.colp = in_of(p, m == 6 ? 8 : 11) + (size_t)l * 2048 * 256 + np; t.ld = 256;
        t.dst = (bf16_t*)(wl + (m == 6 ? LO_CW1K : LO_CW1V));
    }
}
__device__ __forceinline__ void tr_load(const TrTile& t, int tid, f32x4 (&v)[8], float (&gv)[8]) {
    const int kc = (tid & 7);
#pragma unroll
    for (int e = 0; e < 8; ++e) {
        const int k = t.k0 + 8 * kc + e;
        v[e] = (f32x4){0.f, 0.f, 0.f, 0.f}; gv[e] = 1.0f;
        if (t.colp) { v[e] = __builtin_nontemporal_load((const f32x4*)(t.colp + (size_t)k * t.ld)); if (t.gain) gv[e] = t.gain[k]; }
    }
}
__device__ void prologue(const Params& p, LAS unsigned char* lds, int bid, int G) {
    const int tid = opaque_tid();
    LAS float* tile = (LAS float*)lds;
    {
        constexpr int N_TR = 4 * 1376;
        int it = bid;
        TrTile t; f32x4 v[8]; float gv[8];
        if (it < N_TR) { tr_decode(p, it, tid, t); tr_load(t, tid, v, gv); }
        while (it < N_TR) {
            bf16_t* dst = t.dst + (size_t)(t.n0 + 4 * ((tid >> 3))) * t.K + t.k0 + 8 * ((tid & 7));
            const int K = t.K;
            u32x4 o[4];
#pragma unroll
            for (int q = 0; q < 4; ++q) { o[q].x = cvt_pk_bf16(v[0][q] * gv[0], v[1][q] * gv[1]); o[q].y = cvt_pk_bf16(v[2][q] * gv[2], v[3][q] * gv[3]); o[q].z = cvt_pk_bf16(v[4][q] * gv[4], v[5][q] * gv[5]); o[q].w = cvt_pk_bf16(v[6][q] * gv[6], v[7][q] * gv[7]); }
            const int nx = it + G;
            if (nx < N_TR) { tr_decode(p, nx, tid, t); tr_load(t, tid, v, gv); }
#pragma unroll
            for (int q = 0; q < 4; ++q) *(u32x4*)(dst + (size_t)q * K) = o[q];
            it = nx;
        }
    }
    constexpr int N_BIAS = 256, N_XROW = T_ / 16, N_LW = 32;
    for (int it = bid; it < N_BIAS + N_XROW + N_LW; it += G) {
        if (it >= N_BIAS + N_XROW) {
            const int q = it - N_BIAS - N_XROW, ln = q >> 1, gate = q & 1;
            const float* W = in_of(p, gate ? 17 : 15) + (size_t)ln * 4096;
            bf16_t* WT = (bf16_t*)(ws_of(p) + WS_LRUWT) + (size_t)q * 4096;
            float wv[8];
#pragma unroll
            for (int rr = 0; rr < 8; ++rr) { const int idx = tid + rr * NTHREADS, d = idx >> 6, c = idx & 63; wv[rr] = W[c * 64 + d]; }
#pragma unroll
            for (int rr = 0; rr < 8; ++rr) WT[tid + rr * NTHREADS] = f2bf(wv[rr]);
        } else if (it < N_BIAS) {
            const int lkv = it >> 5, part = it & 31, l = lkv >> 1, kv = lkv & 1;
            const float* pos = in_of(p, kv ? 10 : 7) + (size_t)l * 2048;
            const float* w1 = in_of(p, kv ? 11 : 8) + (size_t)l * 2048 * 256;
            const int j = tid & 255, half = tid >> 8;
            float sacc = 0.f;
            const int kb = part * 64 + half * 32;
            for (int k = kb; k < kb + 32; k += 8) {
                float a[8];
#pragma unroll
                for (int q = 0; q < 8; ++q) a[q] = w1[(size_t)(k + q) * 256 + j];
#pragma unroll
                for (int q = 0; q < 8; ++q) sacc += pos[k + q] * a[q];
            }
            tile[tid] = sacc;
            __syncthreads();
            if (tid < 256) ((float*)(ws_of(p) + WS_CBP))[(size_t)it * 256 + tid] = tile[tid] + tile[tid + 256];
            __syncthreads();
        } else {
            const int row0 = (it - N_BIAS) * 16 + (tid >> 6) * 2, lane = tid & 63;
            f32x4 xv[2][4];
#pragma unroll
            for (int rq = 0; rq < 2; ++rq)
#pragma unroll
                for (int i = 0; i < 4; ++i) xv[rq][i] = *(const f32x4*)(in_of(p, 0) + (size_t)(row0 + rq) * DM + i * 256 + lane * 4);
#pragma unroll
            for (int rq = 0; rq < 2; ++rq) {
                const int row = row0 + rq;
                bf16_t* hb = (bf16_t*)(ws_of(p) + WS_HB) + (size_t)row * DM;
                float ss = 0.f;
#pragma unroll
                for (int i = 0; i < 4; ++i) {
                    const f32x4 v = xv[rq][i];
                    ss += (v[0] * v[0] + v[1] * v[1]) + (v[2] * v[2] + v[3] * v[3]);
                    u32x2 w; w.x = cvt_pk_bf16(v[0], v[1]); w.y = cvt_pk_bf16(v[2], v[3]);
                    *(u32x2*)(hb + i * 256 + lane * 4) = w;
                }
                ss = wave_sum(ss);
                if (lane < 16) ((float*)(ws_of(p) + WS_SSQ))[(size_t)row * 16 + lane] = (lane == 0) ? ss : 0.f;
            }
        }
    }
}

__device__ void lru_x_item(const Params& p, int l, int b, int n, int ck, LAS unsigned char* lds) {
    const int tid = opaque_tid(), lane = tid & 63, w = __builtin_amdgcn_readfirstlane(tid >> 6), fr = lane & 15, fq = lane >> 4;
    LAS float* xs = (LAS float*)lds;
    LAS float* xc = (LAS float*)(lds + 17152);
    LAS bf16_t* xb = (LAS bf16_t*)(lds + 33536);
    LAS bf16_t* wt = (LAS bf16_t*)(lds + 42752);
    LAS float* pre = (LAS float*)(lds + 61184);
    LAS float* segA = (LAS float*)(lds + 93952);
    LAS float* segH = segA + 512;
    const bf16_t* U = (const bf16_t*)(ws_of(p) + WS_U);
    const int t0 = ck * 64, rowbase = b * SEQ;
    {
        u32x4 xv[2];
#pragma unroll
        for (int rr = 0; rr < 2; ++rr) {
            const int idx = tid + rr * NTHREADS, tt = idx >> 3, ch = idx & 7, t = t0 - 3 + tt;
            xv[rr] = (u32x4){0u, 0u, 0u, 0u};
            if (idx < 67 * 8 && t >= 0) xv[rr] = *(const u32x4*)(U + (size_t)(rowbase + t) * UW + 1280 + n * 64 + ch * 8);
        }
#pragma unroll
        for (int rr = 0; rr < 2; ++rr) {
            const int idx = tid + rr * NTHREADS, tt = idx >> 3, ch = idx & 7;
            if (idx < 67 * 8) {
                f32x4 lo, hi;
                lo[0] = __uint_as_float(xv[rr][0] << 16); lo[1] = __uint_as_float(xv[rr][0] & 0xffff0000u); lo[2] = __uint_as_float(xv[rr][1] << 16); lo[3] = __uint_as_float(xv[rr][1] & 0xffff0000u);
                hi[0] = __uint_as_float(xv[rr][2] << 16); hi[1] = __uint_as_float(xv[rr][2] & 0xffff0000u); hi[2] = __uint_as_float(xv[rr][3] << 16); hi[3] = __uint_as_float(xv[rr][3] & 0xffff0000u);
                *(LAS f32x4*)(xs + tt * 64 + ch * 8) = lo; *(LAS f32x4*)(xs + tt * 64 + ch * 8 + 4) = hi;
            }
        }
    }
    {
        const bf16_t* WT = (const bf16_t*)(ws_of(p) + WS_LRUWT) + (size_t)((l * 4 + n) * 2) * 4096;
#pragma unroll
        for (int rr = 0; rr < 2; ++rr) {
            const int idx = tid + rr * NTHREADS, row = idx >> 3, ch = idx & 7;
            *(LAS u32x4*)(wt + row * 72 + ch * 8) = *(const u32x4*)(WT + row * 64 + ch * 8);
        }
    }
    __syncthreads();
    {
        const float* cw = in_of(p, 13) + (size_t)l * 4 * 256 + n * 64; const float* cb = in_of(p, 14) + l * 256 + n * 64;
        const int c = tid & 63;
        const float w0 = cw[c], w1 = cw[256 + c], w2 = cw[512 + c], w3 = cw[768 + c], bc = cb[c];
#pragma unroll
        for (int k = 0; k < 8; ++k) {
            const int t = (tid >> 6) + 8 * k;
            const float v = bc + xs[t * 64 + c] * w0 + xs[(t + 1) * 64 + c] * w1 + xs[(t + 2) * 64 + c] * w2 + xs[(t + 3) * 64 + c] * w3;
            xc[t * 64 + c] = v; xb[t * 72 + c] = f2bf(v);
        }
    }
    __syncthreads();
    {
        const int tt = w & 3, gate = w >> 2;
        bf16x8 xa[2];
#pragma unroll
        for (int ks = 0; ks < 2; ++ks) xa[ks] = *(const LAS bf16x8*)(xb + (16 * tt + fr) * 72 + 32 * ks + 8 * fq);
        const float* bias = in_of(p, gate ? 18 : 16) + (l * 4 + n) * 64;
#pragma unroll
        for (int dt = 0; dt < 4; ++dt) {
            f32x4 acc = (f32x4){0.f, 0.f, 0.f, 0.f};
#pragma unroll
            for (int ks = 0; ks < 2; ++ks) {
                const bf16x8 wb = *(const LAS bf16x8*)(wt + (gate * 64 + 16 * dt + fr) * 72 + 32 * ks + 8 * fq);
                acc = __builtin_amdgcn_mfma_f32_16x16x32_bf16(xa[ks], wb, acc, 0, 0, 0);
            }
            const float bv = bias[16 * dt + fr];
#pragma unroll
            for (int i = 0; i < 4; ++i) pre[(gate * 64 + 16 * tt + 4 * fq + i) * 64 + 16 * dt + fr] = acc[i] + bv;
        }
    }
    __syncthreads();
    const int d = tid & 63, tq = tid >> 6;
    const float lam = in_of(p, 19)[l * 256 + n * 64 + d];
    const float sp = log1pf(expf(-lam));
    float hl[8], cl[8];
    float h = 0.f, ca = 1.f;
#pragma unroll
    for (int i = 0; i < 8; ++i) {
        const float r = __builtin_amdgcn_rcpf(1.0f + __expf(-pre[(tq * 8 + i) * 64 + d])), ii = __builtin_amdgcn_rcpf(1.0f + __expf(-pre[(64 + tq * 8 + i) * 64 + d]));
        const float la = -8.0f * r * sp;
        const float a = __expf(la);
        const float uu = __builtin_amdgcn_sqrtf(fmaxf(1.0f - a * a, 0.f)) * (ii * xc[(tq * 8 + i) * 64 + d]);
        h = a * h + uu; ca *= a; hl[i] = h; cl[i] = ca;
    }
    segA[tq * 64 + d] = ca; segH[tq * 64 + d] = h;
    __syncthreads();
    float cin_h = 0.f, cin_a = 1.f;
    for (int sgi = 0; sgi < tq; ++sgi) { const float sa = segA[sgi * 64 + d]; cin_h = sa * cin_h + segH[sgi * 64 + d]; cin_a *= sa; }
    float* LH = (float*)(ws_of(p) + WS_LRUH); float* LA = (float*)(ws_of(p) + WS_LRUA);
#pragma unroll
    for (int i = 0; i < 8; ++i) {
        const size_t o = (size_t)(rowbase + t0 + tq * 8 + i) * 256 + n * 64 + d;
        LH[o] = hl[i] + cl[i] * cin_h; LA[o] = cl[i] * cin_a;
    }
    __syncthreads();
}

__device__ __forceinline__ float logsigmoidf_(float x) { return fminf(x, 0.f) - log1pf(expf(-fabsf(x))); }

__device__ __forceinline__ int vt_off(int d, int key, int pitch) {
    const int kc = key >> 3;
    return d * pitch + ((((kc ^ (d >> 3)) & 7) | (kc & ~7)) << 3) + (key & 7);
}
__device__ void ml_x_item(const Params& p, int l, int bh, int ck, LAS unsigned char* lds) {
    const int tid = opaque_tid(), lane = tid & 63, w = __builtin_amdgcn_readfirstlane(tid >> 6), fr = lane & 15, fq = lane >> 4;
    const int b = bh >> 2, hh = bh & 3;
    LAS bf16_t* KwT = (LAS bf16_t*)lds;
    LAS bf16_t* VT = (LAS bf16_t*)(lds + 9216);
    LAS float* wks = (LAS float*)(lds + 20736);
    const bf16_t* U = (const bf16_t*)(ws_of(p) + WS_U);
    const float* GT = (const float*)(ws_of(p) + WS_GATES);
    const int rowbase = b * SEQ + ck * 64;
    if (tid < 64) {
        const float ig = GT[(size_t)(rowbase + lane) * 32 + 24 + hh] + in_of(p, 20)[l * 4 + hh];
        const float fp = GT[(size_t)(rowbase + lane) * 32 + 28 + hh] + in_of(p, 21)[l * 4 + hh];
        float a = logsigmoidf_(fp);
#pragma unroll
        for (int o = 1; o < 64; o <<= 1) { const float t = __shfl_up(a, o); if (lane >= o) a += t; }
        const float A = __shfl(a, 63);
        const float wend = A - a + ig;
        const float mu = wave_max(wend);
        wks[lane] = expf(wend - mu);
        if (lane == 0) { ((float*)(ws_of(p) + WS_MLMU))[bh * 32 + ck] = mu; ((float*)(ws_of(p) + WS_MLAT))[bh * 32 + ck] = A; }
    }
    const int srow = tid >> 3, sch = tid & 7;
    const bf16_t* src = U + (size_t)(rowbase + srow) * UW + hh * 64 + sch * 8;
    const u32x4 kk = *(const u32x4*)(src + 2048);
    {
        const u32x4 vv = *(const u32x4*)(src + 2304);
#pragma unroll
        for (int e = 0; e < 4; ++e) {
            VT[vt_off(sch * 8 + 2 * e, srow, 72)] = (bf16_t)(vv[e] & 0xffffu);
            VT[vt_off(sch * 8 + 2 * e + 1, srow, 72)] = (bf16_t)(vv[e] >> 16);
        }
        for (int idx = tid; idx < 16 * 72; idx += NTHREADS) VT[64 * 72 + idx] = (idx < 72) ? (bf16_t)0x3f80 : (bf16_t)0;
    }
    __syncthreads();
    {
        const float wk = wks[srow];
#pragma unroll
        for (int e = 0; e < 4; ++e) {
            KwT[vt_off(sch * 8 + 2 * e, srow, 72)] = f2bf(wk * __uint_as_float(kk[e] << 16));
            KwT[vt_off(sch * 8 + 2 * e + 1, srow, 72)] = f2bf(wk * __uint_as_float(kk[e] & 0xffff0000u));
        }
    }
    __syncthreads();
    {
        const int dt = w & 3, hf = w >> 2;
        bf16x8 ka[2];
#pragma unroll
        for (int ks = 0; ks < 2; ++ks) ka[ks] = *(const LAS bf16x8*)(KwT + vt_off(16 * dt + fr, 32 * ks + 8 * fq, 72));
        float* C = (float*)(ws_of(p) + WS_MLC) + (size_t)(bh * 32 + ck) * 4096;
#pragma unroll
        for (int ee = 0; ee < 2; ++ee) {
            const int et = 2 * hf + ee;
            f32x4 acc = (f32x4){0.f, 0.f, 0.f, 0.f};
#pragma unroll
            for (int ks = 0; ks < 2; ++ks) {
                const bf16x8 vb = *(const LAS bf16x8*)(VT + vt_off(16 * et + fr, 32 * ks + 8 * fq, 72));
                acc = __builtin_amdgcn_mfma_f32_16x16x32_bf16(ka[ks], vb, acc, 0, 0, 0);
            }
#pragma unroll
            for (int i = 0; i < 4; ++i) C[(16 * dt + 4 * fq + i) * 64 + 16 * et + fr] = acc[i];
        }
        if (hf == 0) {
            f32x4 acc = (f32x4){0.f, 0.f, 0.f, 0.f};
#pragma unroll
            for (int ks = 0; ks < 2; ++ks) {
                const bf16x8 vb = *(const LAS bf16x8*)(VT + (64 + fr) * 72 + 32 * ks + 8 * fq);
                acc = __builtin_amdgcn_mfma_f32_16x16x32_bf16(ka[ks], vb, acc, 0, 0, 0);
            }
            if (fr == 0) {
#pragma unroll
                for (int i = 0; i < 4; ++i) ((float*)(ws_of(p) + WS_MLN))[(size_t)(bh * 32 + ck) * 64 + 16 * dt + 4 * fq + i] = acc[i];
            }
        }
    }
    __syncthreads();
}

__device__ void phase_m2(const Params& p, int l, int cls, LAS unsigned char* lds, int bid, int G) {
    const int tid = opaque_tid();
    constexpr int N_KC = 128, N_LC = 4, N_MC = 256, N_MN = 4, TOTAL = N_KC + N_LC + N_MC + N_MN;
    for (int it = bid; it < TOTAL; it += G) {
        if (it < N_KC) {
            if (!(cls & 1)) continue;
            const int kv = it >> 6, r0 = (it & 63) * 32;
            LAS float* hid = (LAS float*)lds;
            LAS float* w2s = hid + 32 * 256;
            const float* part = (const float*)(ws_of(p) + WS_HID) + (size_t)(kv * 2048 + r0) * 256;
            const float* cb = (const float*)(ws_of(p) + WS_CBIAS) + (l * 2 + kv) * 256;
            const float* w2 = in_of(p, kv ? 12 : 9) + (size_t)l * 256 * 64;
            f32x4 pr[4][4];
#pragma unroll
            for (int rr = 0; rr < 4; ++rr) {
                const int idx = tid + rr * NTHREADS, row = idx >> 6, j4 = (idx & 63) * 4;
#pragma unroll
                for (int kp = 0; kp < 4; ++kp) pr[rr][kp] = *(const f32x4*)(part + (size_t)kp * 2 * 2048 * 256 + row * 256 + j4);
            }
#pragma unroll
            for (int rr = 0; rr < 4; ++rr) {
                const int idx = tid + rr * NTHREADS, row = idx >> 6, j4 = (idx & 63) * 4;
                f32x4 hv = *(const f32x4*)(cb + j4);
#pragma unroll
                for (int kp = 0; kp < 4; ++kp) hv = hv + pr[rr][kp];
#pragma unroll
                for (int q = 0; q < 4; ++q) hv[q] = hv[q] * __builtin_amdgcn_rcpf(1.0f + __expf(-hv[q]));
                *(LAS f32x4*)(hid + row * 256 + j4) = hv;
            }
#pragma unroll
            for (int rr = 0; rr < 8; ++rr) { const int idx = tid + rr * NTHREADS; *(LAS f32x4*)(w2s + idx * 4) = *(const f32x4*)(w2 + idx * 4); }
            __syncthreads();
            {
                const int d = tid & 63, rq = tid >> 6;
                float acc[4] = {0.f, 0.f, 0.f, 0.f};
                for (int j = 0; j < 256; j += 4) {
                    float wv[4];
#pragma unroll
                    for (int q = 0; q < 4; ++q) wv[q] = w2s[(j + q) * 64 + d];
#pragma unroll
                    for (int i = 0; i < 4; ++i) {
                        const f32x4 hv = *(const LAS f32x4*)(hid + (rq * 4 + i) * 256 + j);
#pragma unroll
                        for (int q = 0; q < 4; ++q) acc[i] += hv[q] * wv[q];
                    }
                }
                bf16_t* KCo = (bf16_t*)(ws_of(p) + WS_KC);
#pragma unroll
                for (int i = 0; i < 4; ++i) {
                    const int r = r0 + rq * 4 + i;
                    KCo[(size_t)(kv * 2048 + r) * 64 + d] = f2bf(((r & 127) == 127) ? 0.f : acc[i]);
                }
            }
            __syncthreads();
        } else if (it < N_KC + N_LC) {
            if (!(cls & 2)) continue;
            const int idx = (it - N_KC) * NTHREADS + tid;
            const int b = idx >> 8, ch = idx & 255;
            const float* LH = (const float*)(ws_of(p) + WS_LRUH); const float* LA = (const float*)(ws_of(p) + WS_LRUA);
            float* LC = (float*)(ws_of(p) + WS_LRUC);
            float la[32], lh[32];
#pragma unroll
            for (int ck = 0; ck < 32; ++ck) { const size_t o = (size_t)(b * SEQ + ck * 64 + 63) * 256 + ch; la[ck] = LA[o]; lh[ck] = LH[o]; }
            float carry = 0.f;
#pragma unroll
            for (int ck = 0; ck < 32; ++ck) { LC[(b * 32 + ck) * 256 + ch] = carry; carry = la[ck] * carry + lh[ck]; }
        } else {
            if (!(cls & 4)) continue;
            const bool isn = it >= N_KC + N_LC + N_MC;
            const int idx = (it - N_KC - N_LC - (isn ? N_MC : 0)) * NTHREADS + tid;
            const int bh = isn ? (idx >> 6) : (idx >> 12), de = isn ? (idx & 63) : (idx & 4095);
            const int esz = isn ? 64 : 4096;
            float* buf = (float*)(ws_of(p) + (isn ? WS_MLN : WS_MLC)) + (size_t)bh * 32 * esz + de;
            const float* MU = (const float*)(ws_of(p) + WS_MLMU) + bh * 32; const float* AT = (const float*)(ws_of(p) + WS_MLAT) + bh * 32;
            float* MP = (float*)(ws_of(p) + WS_MLMP) + bh * 32;
            float dc[32];
#pragma unroll
            for (int ck = 0; ck < 32; ++ck) dc[ck] = buf[(size_t)ck * esz];
            float C = 0.f, m = 0.f;
#pragma unroll
            for (int ck = 0; ck < 32; ++ck) {
                buf[(size_t)ck * esz] = C;
                if (!isn && de == 0) MP[ck] = m;
                const float at = AT[ck], mu = MU[ck];
                const float mn = fmaxf(at + m, mu);
                C = expf(at + m - mn) * C + expf(mu - mn) * dc[ck];
                m = mn;
            }
        }
    }
}

__device__ __forceinline__ float gelu_tanh(float x) { const float u = 0.7978845608028654f * (x + 0.044715f * x * x * x); return 0.5f * x * (1.0f + tanhf(u)); }

__device__ void lru_y_item(const Params& p, int l, int item) {
    const int tid = opaque_tid(), lane = tid & 63;
    const float* LH = (const float*)(ws_of(p) + WS_LRUH); const float* LA = (const float*)(ws_of(p) + WS_LRUA); const float* LC = (const float*)(ws_of(p) + WS_LRUC);
    const bf16_t* U = (const bf16_t*)(ws_of(p) + WS_U);
    const float* hn = in_of(p, 22) + l * 1024;
    bf16_t* HD = (bf16_t*)(ws_of(p) + WS_HEADS);
    const int pair0 = item * 128 + (tid >> 6) * 16;
    float lh[16], la[16], lc[16]; bf16_t gg[16];
    float gn[4];
#pragma unroll
    for (int n = 0; n < 4; ++n) gn[n] = hn[(8 + n) * 64 + lane];
#pragma unroll
    for (int q = 0; q < 16; ++q) {
        const int pair = pair0 + q, row = pair >> 2, n = pair & 3, ch = n * 64 + lane;
        lh[q] = LH[(size_t)row * 256 + ch]; la[q] = LA[(size_t)row * 256 + ch];
        lc[q] = LC[((row >> 11) * 32 + ((row & 2047) >> 6)) * 256 + ch];
        gg[q] = U[(size_t)row * UW + 1536 + ch];
    }
#pragma unroll
    for (int q = 0; q < 16; ++q) {
        const int pair = pair0 + q, row = pair >> 2, n = pair & 3;
        const float h = lh[q] + la[q] * lc[q];
        const float y = h * gelu_tanh(bf2f(gg[q]));
        const float ss = wave_sum(y * y);
        HD[(size_t)row * DM + (8 + n) * 64 + lane] = f2bf(y * rsqrtf(ss * (1.0f / 64.0f) + EPS) * gn[q & 3]);
    }
}

__device__ __forceinline__ int vt_lane(int fr, int fq, int pitch) { return fr * pitch + ((((fq >> 1) ^ (fr >> 3)) & 1) << 3) + ((fq & 1) << 2); }
__device__ __forceinline__ constexpr int vt_cst(int dt, int kc2, int pitch) { return dt * 16 * pitch + ((((kc2 ^ (2 * dt)) & 6) | (kc2 & ~7)) << 3); }
__device__ void ml_y_item(const Params& p, int l, int bh, int ck, LAS unsigned char* lds) {
    const int tid = opaque_tid(), lane = tid & 63, w = __builtin_amdgcn_readfirstlane(tid >> 6), fr = lane & 15, fq = lane >> 4;
    const int b = bh >> 2, hh = bh & 3;
    LAS bf16_t* Ql = (LAS bf16_t*)lds;
    LAS bf16_t* Kl = (LAS bf16_t*)(lds + 9216);
    LAS bf16_t* Vt = (LAS bf16_t*)(lds + 18432);
    LAS bf16_t* Ct = (LAS bf16_t*)(lds + 27648);
    LAS bf16_t* Wl = (LAS bf16_t*)(lds + 39168);
    LAS float* as_ = (LAS float*)(lds + 57600);
    LAS float* bs_ = as_ + 64;
    LAS float* Ms_ = bs_ + 64;
    LAS float* ssl = Ms_ + 64;
    const bf16_t* U = (const bf16_t*)(ws_of(p) + WS_U);
    const float* GT = (const float*)(ws_of(p) + WS_GATES);
    const int rowbase = b * SEQ + ck * 64;
    const float mprev = ((const float*)(ws_of(p) + WS_MLMP))[bh * 32 + ck];
    if (tid < 64) {
        const float ig = GT[(size_t)(rowbase + lane) * 32 + 24 + hh] + in_of(p, 20)[l * 4 + hh];
        const float fp = GT[(size_t)(rowbase + lane) * 32 + 28 + hh] + in_of(p, 21)[l * 4 + hh];
        float a = logsigmoidf_(fp);
#pragma unroll
        for (int o = 1; o < 64; o <<= 1) { const float t = __shfl_up(a, o); if (lane >= o) a += t; }
        const float bb = ig - a;
        float pm = bb;
#pragma unroll
        for (int o = 1; o < 64; o <<= 1) { const float t = __shfl_up(pm, o); if (lane >= o) pm = fmaxf(pm, t); }
        as_[lane] = a; bs_[lane] = bb; Ms_[lane] = fmaxf(mprev, pm);
        Ct[64 * 72 + lane] = f2bf(((const float*)(ws_of(p) + WS_MLN))[(size_t)(bh * 32 + ck) * 64 + lane]);
    }
    {
        const int row = tid >> 3, ch = tid & 7;
        const bf16_t* src = U + (size_t)(rowbase + row) * UW + hh * 64 + ch * 8;
        *(LAS u32x4*)(Ql + row * 72 + ch * 8) = *(const u32x4*)(src + 1792);
        *(LAS u32x4*)(Kl + row * 72 + ch * 8) = *(const u32x4*)(src + 2048);
        const u32x4 vv = *(const u32x4*)(src + 2304);
#pragma unroll
        for (int e = 0; e < 4; ++e) {
            Vt[vt_off(ch * 8 + 2 * e, row, 72)] = (bf16_t)(vv[e] & 0xffffu);
            Vt[vt_off(ch * 8 + 2 * e + 1, row, 72)] = (bf16_t)(vv[e] >> 16);
        }
        const float* C = (const float*)(ws_of(p) + WS_MLC) + (size_t)(bh * 32 + ck) * 4096;
#pragma unroll
        for (int rr = 0; rr < 2; ++rr) {
            const int idx = tid + rr * NTHREADS, d = idx >> 4, e4 = (idx & 15) * 4;
            const f32x4 c = *(const f32x4*)(C + d * 64 + e4);
#pragma unroll
            for (int i = 0; i < 4; ++i) Ct[(e4 + i) * 72 + d] = f2bf(c[i]);
        }
        for (int idx = tid; idx < 15 * 72; idx += NTHREADS) Ct[65 * 72 + idx] = 0;
    }
    __syncthreads();
    const int jt = w & 3, hf = w >> 2;
    bf16_t opre[2][4];
#pragma unroll
    for (int i = 0; i < 4; ++i)
#pragma unroll
        for (int ee = 0; ee < 2; ++ee) opre[ee][i] = U[(size_t)(rowbase + 16 * jt + 4 * fq + i) * UW + 2560 + hh * 64 + 16 * (2 * hf + ee) + fr];
    bf16x8 qa[2];
#pragma unroll
    for (int ks = 0; ks < 2; ++ks) qa[ks] = *(const LAS bf16x8*)(Ql + (16 * jt + fr) * 72 + 32 * ks + 8 * fq);
    f32x4 sacc[4];
#pragma unroll
    for (int st = 0; st < 4; ++st) {
        const bf16x8 k0 = *(const LAS bf16x8*)(Kl + (16 * st + fr) * 72 + 8 * fq), k1 = *(const LAS bf16x8*)(Kl + (16 * st + fr) * 72 + 32 + 8 * fq);
        sacc[st] = __builtin_amdgcn_mfma_f32_16x16x32_bf16(qa[0], k0, (f32x4){0.f, 0.f, 0.f, 0.f}, 0, 0, 0);
        sacc[st] = __builtin_amdgcn_mfma_f32_16x16x32_bf16(qa[1], k1, sacc[st], 0, 0, 0);
    }
    float sw[4], Mj[4];
    LAS bf16_t* Ww = Wl + w * (16 * 72);
#pragma unroll
    for (int i = 0; i < 4; ++i) {
        const int j = 16 * jt + 4 * fq + i;
        Mj[i] = Ms_[j];
        float acc = 0.f;
#pragma unroll
        for (int st = 0; st < 4; ++st) {
            const int sidx = 16 * st + fr;
            const float wv = (sidx <= j) ? __expf(bs_[sidx] - Mj[i]) * sacc[st][i] : 0.f;
            acc += wv;
            Ww[(4 * fq + i) * 72 + sidx] = f2bf(wv);
        }
        acc += __shfl_xor(acc, 1); acc += __shfl_xor(acc, 2); acc += __shfl_xor(acc, 4); acc += __shfl_xor(acc, 8);
        sw[i] = acc;
    }
    asm volatile("s_waitcnt lgkmcnt(0)" ::: "memory");
    bf16x8 wa[2];
#pragma unroll
    for (int ks = 0; ks < 2; ++ks) wa[ks] = *(const LAS bf16x8*)(Ww + fr * 72 + 32 * ks + 8 * fq);
    f32x4 acc1[2], acc2[2], accn;
#pragma unroll
    for (int ee = 0; ee < 2; ++ee) {
        const int et = 2 * hf + ee;
        acc1[ee] = (f32x4){0.f, 0.f, 0.f, 0.f}; acc2[ee] = (f32x4){0.f, 0.f, 0.f, 0.f};
#pragma unroll
        for (int ks = 0; ks < 2; ++ks) {
            const bf16x8 cf = *(const LAS bf16x8*)(Ct + (16 * et + fr) * 72 + 32 * ks + 8 * fq);
            const bf16x8 vf = *(const LAS bf16x8*)(Vt + vt_off(16 * et + fr, 32 * ks + 8 * fq, 72));
            acc1[ee] = __builtin_amdgcn_mfma_f32_16x16x32_bf16(qa[ks], cf, acc1[ee], 0, 0, 0);
            acc2[ee] = __builtin_amdgcn_mfma_f32_16x16x32_bf16(wa[ks], vf, acc2[ee], 0, 0, 0);
        }
    }
    accn = (f32x4){0.f, 0.f, 0.f, 0.f};
#pragma unroll
    for (int ks = 0; ks < 2; ++ks) {
        const bf16x8 cf = *(const LAS bf16x8*)(Ct + (64 + fr) * 72 + 32 * ks + 8 * fq);
        accn = __builtin_amdgcn_mfma_f32_16x16x32_bf16(qa[ks], cf, accn, 0, 0, 0);
    }
    float ov[2][4];
#pragma unroll
    for (int i = 0; i < 4; ++i) {
        const int j = 16 * jt + 4 * fq + i;
        const float qn = __shfl(accn[i], lane & 48);
        const float inter = expf(mprev - Mj[i]);
        const float den = inter * qn + sw[i];
        const float lim = expf(-(as_[j] + Mj[i]));
        const float inv = 1.0f / fmaxf(fabsf(den), lim);
        float ssp = 0.f;
#pragma unroll
        for (int ee = 0; ee < 2; ++ee) {
            const int e = 16 * (2 * hf + ee) + fr;
            const float hv = (inter * acc1[ee][i] + acc2[ee][i]) * inv;
            const float o = sigmoidf_(bf2f(opre[ee][i])) * hv;
            ov[ee][i] = o; ssp += o * o;
        }
        ssp += __shfl_xor(ssp, 1); ssp += __shfl_xor(ssp, 2); ssp += __shfl_xor(ssp, 4); ssp += __shfl_xor(ssp, 8);
        if (fr == 0) ssl[w * 16 + 4 * fq + i] = ssp;
    }
    __syncthreads();
    {
        bf16_t* HD = (bf16_t*)(ws_of(p) + WS_HEADS);
        const float* hn = in_of(p, 22) + l * 1024 + (12 + hh) * 64;
#pragma unroll
        for (int i = 0; i < 4; ++i) {
            const int j = 16 * jt + 4 * fq + i;
            const float tot = ssl[jt * 16 + 4 * fq + i] + ssl[(jt + 4) * 16 + 4 * fq + i];
            const float rs = rsqrtf(tot * (1.0f / 64.0f) + EPS);
#pragma unroll
            for (int ee = 0; ee < 2; ++ee) {
                const int e = 16 * (2 * hf + ee) + fr;
                HD[(size_t)(rowbase + j) * DM + (12 + hh) * 64 + e] = f2bf(ov[ee][i] * rs * hn[e]);
            }
        }
    }
    __syncthreads();
}

__device__ __forceinline__ bf16x8 pack8(const f32x4 lo, const f32x4 hi) {
    u32x4 r; r.x = cvt_pk_bf16(lo[0], lo[1]); r.y = cvt_pk_bf16(lo[2], lo[3]); r.z = cvt_pk_bf16(hi[0], hi[1]); r.w = cvt_pk_bf16(hi[2], hi[3]);
    return __builtin_bit_cast(bf16x8, r);
}
__device__ __forceinline__ bf16x8 join8(const u32x2 lo, const u32x2 hi) { u32x4 r; r.x = lo.x; r.y = lo.y; r.z = hi.x; r.w = hi.y; return __builtin_bit_cast(bf16x8, r); }
__device__ void nsa_item(const Params& p, int l, int b, int g, int qb, LAS unsigned char* lds, int mode = 0) {
    int tid = opaque_tid(), w = __builtin_amdgcn_readfirstlane(tid >> 6), lane = tid & 63, fr = lane & 15, fq = lane >> 4;
    LAS bf16_t* Kc = (LAS bf16_t*)lds;
    LAS bf16_t* Vc = (LAS bf16_t*)(lds + 18432);
    LAS bf16_t* Pl = (LAS bf16_t*)(lds + 36864);
    LAS float* impl = (LAS float*)(lds + 106496);
    LAS unsigned* selm = (LAS unsigned*)(lds + 114688);
    LAS int* steps = (LAS int*)(lds + 114944);
    const bf16_t* U = (const bf16_t*)(ws_of(p) + WS_U);
    const int bg = b * 2 + g, rowbase = b * SEQ;
    const int head = 4 * g + (w >> 1);
    const float sl2 = exp2f(-(float)(head + 1)) * 1.4426950408889634f;
    const int tw0 = qb * 64 + (w & 1) * 32;
    bf16x8 qf[2][2];
#pragma unroll
    for (int mt = 0; mt < 2; ++mt)
#pragma unroll
        for (int ks = 0; ks < 2; ++ks)
            qf[mt][ks] = *(const bf16x8*)(U + (size_t)(rowbase + tw0 + mt * 16 + fr) * UW + head * 64 + ks * 32 + fq * 8);
    const float* GT = (const float*)(ws_of(p) + WS_GATES);
    float gpre[2][3];
#pragma unroll
    for (int mt = 0; mt < 2; ++mt)
#pragma unroll
        for (int q = 0; q < 3; ++q) gpre[mt][q] = GT[(size_t)(rowbase + tw0 + mt * 16 + fr) * 32 + head * 3 + q];
    f32x4 y[2][4];
    {
        LAS float* impM = (LAS float*)Pl;
        LAS float* impT = impM + 4 * 64 * 33;
        const bf16_t* KC = (const bf16_t*)(ws_of(p) + WS_KC) + (size_t)bg * 128 * 64;
        const bf16_t* VC = KC + (size_t)2048 * 64;
        u32x4 kvr[2], vvr[2];
#pragma unroll
        for (int rr = 0; rr < 2; ++rr) { const int idx = tid + rr * NTHREADS; kvr[rr] = *(const u32x4*)(KC + idx * 8); vvr[rr] = *(const u32x4*)(VC + idx * 8); }
#pragma unroll
        for (int rr = 0; rr < 2; ++rr) {
            const int idx = tid + rr * NTHREADS, key = idx >> 3, ch = idx & 7;
            const u32x4 kv = kvr[rr];
            const u32x4 vv = vvr[rr];
            *(LAS u32x4*)(Kc + key * 72 + ch * 8) = kv;
#pragma unroll
            for (int e = 0; e < 4; ++e) {
                Vc[vt_off(ch * 8 + 2 * e, key, 136)] = (bf16_t)(vv[e] & 0xffffu);
                Vc[vt_off(ch * 8 + 2 * e + 1, key, 136)] = (bf16_t)(vv[e] >> 16);
            }
        }
        __syncthreads();
        const int vl136 = vt_lane(fr, fq, 136);
#pragma unroll
        for (int mt = 0; mt < 2; ++mt) {
            const int t = tw0 + mt * 16 + fr;
            f32x4 s[8];
#pragma unroll
            for (int nt = 0; nt < 8; ++nt) {
                const bf16x8 k0 = *(const LAS bf16x8*)(Kc + (16 * nt + fr) * 72 + fq * 8), k1 = *(const LAS bf16x8*)(Kc + (16 * nt + fr) * 72 + 32 + fq * 8);
                s[nt] = __builtin_amdgcn_mfma_f32_16x16x32_bf16(k0, qf[mt][0], (f32x4){0.f, 0.f, 0.f, 0.f}, 0, 0, 0);
                s[nt] = __builtin_amdgcn_mfma_f32_16x16x32_bf16(k1, qf[mt][1], s[nt], 0, 0, 0);
            }
            float mx = NEGF;
#pragma unroll
            for (int nt = 0; nt < 8; ++nt)
#pragma unroll
                for (int i = 0; i < 4; ++i) {
                    const int n = 16 * nt + 4 * fq + i, cend = 16 * n + 31;
                    const bool valid = (t >= cend) && (n < 127);
                    const float sv = valid ? fmaf(sl2, (float)cend, s[nt][i]) : NEGF;
                    s[nt][i] = sv; mx = fmaxf(mx, sv);
                }
            mx = fq_max(mx);
            const float ms = (mx < -1e29f) ? 0.f : mx;
            float sum = 0.f;
#pragma unroll
            for (int nt = 0; nt < 8; ++nt)
#pragma unroll
                for (int i = 0; i < 4; ++i) { const float pv = __builtin_amdgcn_exp2f(s[nt][i] - ms); s[nt][i] = pv; sum += pv; }
            sum = fq_sum(sum);
            const float inv = sum > 0.f ? 1.0f / sum : 0.f;
            {
                LAS float* mrow_ = impM + ((w >> 1) * 64 + (w & 1) * 32 + mt * 16 + fr) * 33 + fq;
                LAS float* trow_ = impT + ((w >> 1) * 64 + (w & 1) * 32 + mt * 16 + fr) * 33 + fq + 1;
#pragma unroll
                for (int nt = 0; nt < 8; ++nt) {
                    s[nt] = s[nt] * inv;
                    mrow_[4 * nt] = (s[nt][0] + s[nt][1]) + (s[nt][2] + s[nt][3]);
                    trow_[4 * nt] = s[nt][3];
                }
            }
            f32x4 oc[4];
#pragma unroll
            for (int dt = 0; dt < 4; ++dt) oc[dt] = (f32x4){0.f, 0.f, 0.f, 0.f};
#pragma unroll
            for (int ks2 = 0; ks2 < 4; ++ks2) {
                const bf16x8 pb = pack8(s[2 * ks2], s[2 * ks2 + 1]);
#pragma unroll
                for (int dt = 0; dt < 4; ++dt) {
                    const u32x2 lo = *(const LAS u32x2*)(Vc + vl136 + vt_cst(dt, 4 * ks2, 136));
                    const u32x2 hi = *(const LAS u32x2*)(Vc + vl136 + vt_cst(dt, 4 * ks2 + 2, 136));
                    oc[dt] = __builtin_amdgcn_mfma_f32_16x16x32_bf16(join8(lo, hi), pb, oc[dt], 0, 0, 0);
                }
            }
            const float g0 = sigmoidf_(gpre[mt][0]);
#pragma unroll
            for (int dt = 0; dt < 4; ++dt) y[mt][dt] = oc[dt] * g0;
        }
        if (tid < 256) impT[tid * 33] = 0.f;
        __syncthreads();
#pragma unroll 1
        for (int rr = 0; rr < 4; ++rr) {
            const int idx = tid + rr * NTHREADS, tau = idx >> 5, j = idx & 31;
            float mine = 0.f;
#pragma unroll
            for (int hh = 0; hh < 4; ++hh) mine += impM[(hh * 64 + tau) * 33 + j] + impT[(hh * 64 + tau) * 33 + j];
            bool sel;
            if (qb < 16) sel = (j <= qb);
            else {
                const bool forced = (j == 0) || (j == qb) || (j == qb - 1);
                const bool cand = (j >= 1) && (j <= qb - 2);
                int rank = 0;
#pragma unroll
                for (int jp = 1; jp < 30; ++jp) {
                    const float o = __shfl(mine, (lane & 32) + jp);
                    rank += (jp <= qb - 2 && (o > mine || (o == mine && jp < j))) ? 1 : 0;
                }
                sel = forced || (cand && rank < 13);
            }
            const unsigned long long bal = __ballot(sel);
            if ((lane & 31) == 0) selm[tau] = (lane < 32) ? (unsigned)bal : (unsigned)(bal >> 32);
        }
        __syncthreads();
        if (tid < 64) {
            unsigned m = selm[tid], uni = m, all = m;
#pragma unroll
            for (int o = 32; o >= 1; o >>= 1) { uni |= __shfl_xor(uni, o); all &= __shfl_xor(all, o); }
            uni &= (qb >= 31) ? 0xffffffffu : ((2u << qb) - 1u);
            const int nsel = __popc(uni);
            const int kb = tid;
            if (kb <= qb && ((uni >> kb) & 1u)) {
                const int pos = __popc(uni & ((1u << kb) - 1u));
                steps[1 + pos] = ((((all >> kb) & 1u) && kb < qb) ? 4096 : 0) | (1 << 8) | kb;
            }
            const int kb0 = (qb - 8 < 0) ? 0 : qb - 8;
            if (kb >= kb0 && kb <= qb) steps[1 + nsel + (kb - kb0)] = ((kb > qb - 8 && kb < qb) ? 4096 : 0) | (2 << 8) | kb;
            if (tid == 0) steps[0] = nsel + (qb - kb0 + 1);
        }
        __syncthreads();
    }
    if (mode == 1) { asm volatile("" :: "v"(y[0][0][0]), "v"(y[1][3][3])); __syncthreads(); return; }
    tid = opaque_tid(); w = __builtin_amdgcn_readfirstlane(tid >> 6); lane = tid & 63; fr = lane & 15; fq = lane >> 4;
    unsigned smask[2];
#pragma unroll
    for (int mt = 0; mt < 2; ++mt) smask[mt] = selm[(w & 1) * 32 + mt * 16 + fr];
    const int nsteps = __builtin_amdgcn_readfirstlane(steps[0]);
    const int mystep = steps[1 + (lane < 48 ? lane : 47)];
#define NSA_ST(k) __builtin_amdgcn_readlane(mystep, (k))
    float mrow[2], lrow[2];
    f32x4 oacc[2][4];
#pragma unroll
    for (int mt = 0; mt < 2; ++mt) {
        mrow[mt] = NEGF; lrow[mt] = 0.f;
#pragma unroll
        for (int dt = 0; dt < 4; ++dt) oacc[mt][dt] = (f32x4){0.f, 0.f, 0.f, 0.f};
    }
    const int skey = tid >> 3, sch = tid & 7;
    const int vl72 = vt_lane(fr, fq, 72);
    const int vsw = vt_off(sch * 8, skey, 72);
    bf16x8 kx[4], qx;
    {
        const float sh = bf2f(f2bf(sl2)), slo = sl2 - sh;
        u32x4 t = (u32x4){0u, 0u, 0u, 0u};
        if (fq == 0) t.x = cvt_pk_bf16(sh, slo);
        qx = __builtin_bit_cast(bf16x8, t);
#pragma unroll
        for (int nt = 0; nt < 4; ++nt) {
            u32x4 k = (u32x4){0u, 0u, 0u, 0u};
            const float r = (float)(16 * nt + fr);
            if (fq == 0) k.x = cvt_pk_bf16(r, r);
            kx[nt] = __builtin_bit_cast(bf16x8, k);
        }
    }
    const bf16_t* Ubase = U + (size_t)(rowbase + skey) * UW + g * 64 + sch * 8;
#define NSA_SRC(st_) (Ubase + (size_t)((st_) & 255) * 64 * UW + ((((st_) >> 8) & 15) == 1 ? 768 : 1024))
#define NSA_STAGE(buf_, kr_, vr_) do { \
        *(LAS u32x4*)(Kc + (buf_) * (64 * 72) + skey * 72 + sch * 8) = kr_; \
        LAS bf16_t* _vn = Vc + (buf_) * (64 * 72) + vsw; \
        _Pragma("unroll") for (int e = 0; e < 4; ++e) { _vn[(2 * e) * 72] = (bf16_t)(vr_[e] & 0xffffu); _vn[(2 * e + 1) * 72] = (bf16_t)(vr_[e] >> 16); } } while (0)
    u32x4 kregA, vregA;
    {
        const bf16_t* src = NSA_SRC(NSA_ST(0));
        kregA = *(const u32x4*)src; vregA = *(const u32x4*)(src + 128);
        NSA_STAGE(0, kregA, vregA);
    }
    if (nsteps > 1) { const bf16_t* src = NSA_SRC(NSA_ST(1)); kregA = *(const u32x4*)src; vregA = *(const u32x4*)(src + 128); }
    __syncthreads();
    int curkind = 1;
#define NSA_STEP(si, kX, vX) do { \
        const int st = NSA_ST(si), kind = (st >> 8) & 15, kb = st & 255; \
        const bool nomask = (st & 4096) != 0; \
        LAS bf16_t* Kl = Kc + ((si) & 1) * (64 * 72); \
        LAS bf16_t* Vt = Vc + ((si) & 1) * (64 * 72); \
        if (kind != curkind) { \
            _Pragma("unroll") for (int mt = 0; mt < 2; ++mt) { \
                float lt = lrow[mt]; \
                lt = fq_sum(lt); \
                const float sc = sigmoidf_(gpre[mt][1]) / lt; \
                _Pragma("unroll") for (int dt = 0; dt < 4; ++dt) { y[mt][dt] += oacc[mt][dt] * sc; oacc[mt][dt] = (f32x4){0.f, 0.f, 0.f, 0.f}; } \
                mrow[mt] = NEGF; lrow[mt] = 0.f; \
            } \
            curkind = kind; \
        } \
        const float Bs = sl2 * (float)(kb * 64); \
        int kbi = kb * 64 + 4 * fq; \
        asm volatile("" : "+v"(kbi)); \
        f32x4 s[2][4]; \
        _Pragma("unroll") for (int nt = 0; nt < 4; ++nt) { \
            const bf16x8 k0 = *(const LAS bf16x8*)(Kl + (16 * nt + fr) * 72 + fq * 8), k1 = *(const LAS bf16x8*)(Kl + (16 * nt + fr) * 72 + 32 + fq * 8); \
            _Pragma("unroll") for (int mt = 0; mt < 2; ++mt) { \
                s[mt][nt] = __builtin_amdgcn_mfma_f32_16x16x32_bf16(k0, qf[mt][0], (f32x4){0.f, 0.f, 0.f, 0.f}, 0, 0, 0); \
                s[mt][nt] = __builtin_amdgcn_mfma_f32_16x16x32_bf16(k1, qf[mt][1], s[mt][nt], 0, 0, 0); \
                s[mt][nt] = __builtin_amdgcn_mfma_f32_16x16x32_bf16(kx[nt], qx, s[mt][nt], 0, 0, 0); \
            } \
        } \
        bf16x8 pb[2][2]; \
        _Pragma("unroll") for (int mt = 0; mt < 2; ++mt) { \
            float mx = NEGF; \
            if (nomask) { \
                _Pragma("unroll") for (int nt = 0; nt < 4; ++nt) \
                    _Pragma("unroll") for (int i = 0; i < 4; ++i) mx = fmaxf(mx, s[mt][nt][i]); \
            } else { \
                const int t = tw0 + mt * 16 + fr; \
                const bool rowok = (kind == 1) ? (((smask[mt] >> kb) & 1u) != 0u) : true; \
                _Pragma("unroll") for (int nt = 0; nt < 4; ++nt) \
                    _Pragma("unroll") for (int i = 0; i < 4; ++i) { \
                        const int dist = t - (kbi + 16 * nt + i); \
                        const bool valid = rowok && dist >= 0 && (kind == 1 || dist < 512); \
                        const float sv = valid ? s[mt][nt][i] : NEGF; \
                        s[mt][nt][i] = sv; mx = fmaxf(mx, sv); \
                    } \
            } \
            mx = fq_max(mx) + Bs; \
            const float mn = fmaxf(mrow[mt], mx); \
            const float alpha = __builtin_amdgcn_exp2f(mrow[mt] - mn); \
            mrow[mt] = mn; \
            const float ms = ((mn < -1e29f) ? 0.f : mn) - Bs; \
            float ls = 0.f; \
            _Pragma("unroll") for (int nt = 0; nt < 4; ++nt) \
                _Pragma("unroll") for (int i = 0; i < 4; ++i) { const float pv = __builtin_amdgcn_exp2f(s[mt][nt][i] - ms); s[mt][nt][i] = pv; ls += pv; } \
            lrow[mt] = lrow[mt] * alpha + ls; \
            _Pragma("unroll") for (int dt = 0; dt < 4; ++dt) oacc[mt][dt] = oacc[mt][dt] * alpha; \
            pb[mt][0] = pack8(s[mt][0], s[mt][1]); pb[mt][1] = pack8(s[mt][2], s[mt][3]); \
        } \
        _Pragma("unroll") for (int ks2 = 0; ks2 < 2; ++ks2) \
            _Pragma("unroll") for (int dt = 0; dt < 4; ++dt) { \
                const u32x2 lo = *(const LAS u32x2*)(Vt + vl72 + vt_cst(dt, 4 * ks2, 72)); \
                const u32x2 hi = *(const LAS u32x2*)(Vt + vl72 + vt_cst(dt, 4 * ks2 + 2, 72)); \
                const bf16x8 va = join8(lo, hi); \
                _Pragma("unroll") for (int mt = 0; mt < 2; ++mt) oacc[mt][dt] = __builtin_amdgcn_mfma_f32_16x16x32_bf16(va, pb[mt][ks2], oacc[mt][dt], 0, 0, 0); \
            } \
        if ((si) + 1 < nsteps) NSA_STAGE(((si) + 1) & 1, kX, vX); \
        if ((si) + 2 < nsteps) { const bf16_t* src = NSA_SRC(NSA_ST((si) + 2)); kX = *(const u32x4*)src; vX = *(const u32x4*)(src + 128); } \
        __syncthreads(); \
    } while (0)
    for (int si = 0; si < nsteps; ++si) {
        NSA_STEP(si, kregA, vregA);
    }
#undef NSA_STEP
#undef NSA_ST
#undef NSA_STAGE
#undef NSA_SRC
    tid = opaque_tid(); lane = tid & 63; fr = lane & 15; fq = lane >> 4;
    {
        const float* hn = in_of(p, 22) + l * 1024 + head * 64;
        bf16_t* HD = (bf16_t*)(ws_of(p) + WS_HEADS);
        f32x4 gnv[4];
#pragma unroll
        for (int dt = 0; dt < 4; ++dt) gnv[dt] = *(const f32x4*)(hn + 16 * dt + 4 * fq);
#pragma unroll
        for (int mt = 0; mt < 2; ++mt) {
            const int t = tw0 + mt * 16 + fr;
            float lt = lrow[mt];
            lt = fq_sum(lt);
            const float sc = sigmoidf_(gpre[mt][2]) / lt;
            float ss = 0.f;
            f32x4 yy[4];
#pragma unroll
            for (int dt = 0; dt < 4; ++dt) { yy[dt] = y[mt][dt] + oacc[mt][dt] * sc; ss += (yy[dt][0] * yy[dt][0] + yy[dt][1] * yy[dt][1]) + (yy[dt][2] * yy[dt][2] + yy[dt][3] * yy[dt][3]); }
            ss = fq_sum(ss);
            const float rs = rsqrtf(ss * (1.0f / 64.0f) + EPS);
#pragma unroll
            for (int dt = 0; dt < 4; ++dt) {
                const f32x4 gn = gnv[dt];
                const f32x4 o = yy[dt] * rs * gn;
                u32x2 pk; pk.x = cvt_pk_bf16(o[0], o[1]); pk.y = cvt_pk_bf16(o[2], o[3]);
                *(u32x2*)(HD + (size_t)(rowbase + t) * DM + head * 64 + 16 * dt + 4 * fq) = pk;
            }
        }
    }
    __syncthreads();
}

#define XB_TMO      128
#define XB_XCNT(j)  (256  + 64 * (j))
#define XB_XSUB(j)  (1280 + 64 * (j))
#define XB_XGEN(j)  (2304 + 64 * (j))
#define XB_TOP      3328
#define XB_TOPGEN   3392
#define XCD_BAR_WORDS 3456
#define XB_SPIN_CAP (1u << 22)
__device__ __forceinline__ unsigned xb_ld(unsigned* p)              { return __hip_atomic_load(p, __ATOMIC_RELAXED, __HIP_MEMORY_SCOPE_AGENT); }
__device__ __forceinline__ unsigned xb_add(unsigned* p, unsigned v) { return __hip_atomic_fetch_add(p, v, __ATOMIC_RELAXED, __HIP_MEMORY_SCOPE_AGENT); }
__device__ __forceinline__ unsigned xb_xcc_id() { return (unsigned)__builtin_amdgcn_s_getreg((3 << 11) | 20) & 0xFu; }
#define XB_SPIN(cond, bar) do { unsigned _sp = 0; while (cond) { __builtin_amdgcn_s_sleep(1); \
    if ((++_sp & 255u) == 0u) { if (xb_ld(&(bar)[XB_TMO])) break; if (_sp > XB_SPIN_CAP) { atomicAdd(&(bar)[XB_TMO], 1u); break; } } } } while (0)
struct XcdBarrier { unsigned* bar; unsigned x; volatile LAS unsigned* st; };
__device__ __forceinline__ XcdBarrier xcd_barrier_post(unsigned* bar, volatile LAS unsigned* st) {
    XcdBarrier b; b.bar = bar; b.x = xb_xcc_id(); b.st = st;
    if (threadIdx.x == 0) (void)xb_add(&bar[XB_XCNT(b.x)], 1u);
    return b;
}
__device__ __forceinline__ void xcd_barrier_complete(unsigned* bar, unsigned x, unsigned& nloc, unsigned& nx) {
    const unsigned G = gridDim.x * gridDim.y * gridDim.z;
    unsigned sum, cnt, mine, sp = 0u;
    for (;;) {
        sum = 0u; cnt = 0u; mine = 0u;
#pragma unroll
        for (unsigned j = 0; j < 16; ++j) { const unsigned c = xb_ld(&bar[XB_XCNT(j)]); sum += c; cnt += (c > 0u) ? 1u : 0u; mine = (j == x) ? c : mine; }
        if (sum == G) break;
        __builtin_amdgcn_s_sleep(1);
        if ((++sp & 255u) == 0u) { if (xb_ld(&bar[XB_TMO])) break; if (sp > XB_SPIN_CAP) { atomicAdd(&bar[XB_TMO], 1u); break; } }
    }
    nloc = mine > 0u ? mine : 1u; nx = cnt > 0u ? cnt : 1u;
}
__device__ __forceinline__ void xcd_barrier(const XcdBarrier& b) {
    asm volatile("s_waitcnt vmcnt(0)" ::: "memory");
    __syncthreads();
    if (threadIdx.x == 0) {
        unsigned* bar = b.bar;
        __builtin_amdgcn_s_waitcnt(0);
        unsigned nloc = b.st[0], nx = b.st[1];
        if (nloc == 0u) { xcd_barrier_complete(bar, b.x, nloc, nx); b.st[0] = nloc; b.st[1] = nx; }
        const unsigned old = xb_add(&bar[XB_XSUB(b.x)], 1u);
        const unsigned gen = old / nloc;
        if (old + 1u == (gen + 1u) * nloc) {
            __builtin_amdgcn_fence(__ATOMIC_RELEASE, "agent");
            asm volatile("s_waitcnt vmcnt(0)" ::: "memory");
            const unsigned og = xb_add(&bar[XB_TOP], 1u);
            const unsigned tg = og / nx;
            if (og + 1u == (tg + 1u) * nx) xb_add(&bar[XB_TOPGEN], 1u);
            else XB_SPIN(xb_ld(&bar[XB_TOPGEN]) == tg, bar);
            __builtin_amdgcn_fence(__ATOMIC_ACQUIRE, "agent");
            xb_add(&bar[XB_XGEN(b.x)], 1u);
            asm volatile("s_waitcnt vmcnt(0)" ::: "memory");
        } else {
            XB_SPIN(xb_ld(&bar[XB_XGEN(b.x)]) == gen, bar);
            __builtin_amdgcn_fence(__ATOMIC_ACQUIRE, "agent");
            asm volatile("s_waitcnt vmcnt(0)" ::: "memory");
        }
    }
    __syncthreads();
}

__global__ void __launch_bounds__(NTHREADS) hymba_fwd(Params p) {
    extern __shared__ __attribute__((aligned(16))) unsigned char lds_raw[];
    LAS unsigned char* lds = (LAS unsigned char*)lds_raw;
    cg::grid_group grid = cg::this_grid();
    volatile LAS unsigned* xbw = (volatile LAS unsigned*)(lds + LDS_BYTES - 16);
    if (threadIdx.x < 4) xbw[threadIdx.x] = 0u;
    __syncthreads();
    XcdBarrier xbar = xcd_barrier_post((unsigned*)(ws_of(p) + WS_BAR), xbw);
    if (p.ph_hi - p.ph_lo > 1) grid.sync();
    for (int ph = p.ph_lo; ph < p.ph_hi; ++ph) {
        int G = gridDim.x, bid = blockIdx.x;
        asm volatile("" : "+s"(G), "+s"(bid));
        const int tpx = opaque_tid();
        if (ph == 0) {
            if (PHEN(0)) prologue(p, lds, bid, G);
            if (REP_SUB == 100) { __syncthreads(); prologue(p, lds, bid, G); }
        } else if (ph == 37) { if (PHEN(10)) {
            const float* ssq = (const float*)(ws_of(p) + WS_SSQ) + (size_t)(12 & 1) * T_ * 16;
            float* outp = out_of(p);
            const f32x4 gn = *(const f32x4*)(in_of(p, 28) + (tpx & 255) * 4);
            for (int it = bid; it < T_ / 8; it += G) {
                f32x4 v[4], pa[4][4];
#pragma unroll
                for (int q = 0; q < 4; ++q) {
                    const int row = it * 8 + q * 2 + (tpx >> 8);
                    v[q] = *(const f32x4*)(outp + (size_t)row * DM + (tpx & 255) * 4);
#pragma unroll
                    for (int k = 0; k < 4; ++k) pa[q][k] = *(const f32x4*)(ssq + (size_t)row * 16 + 4 * k);
                }
#pragma unroll
                for (int q = 0; q < 4; ++q) {
                    const int row = it * 8 + q * 2 + (tpx >> 8);
                    const float sm = (((pa[q][0][0] + pa[q][0][1]) + (pa[q][0][2] + pa[q][0][3])) + ((pa[q][1][0] + pa[q][1][1]) + (pa[q][1][2] + pa[q][1][3]))) + (((pa[q][2][0] + pa[q][2][1]) + (pa[q][2][2] + pa[q][2][3])) + ((pa[q][3][0] + pa[q][3][1]) + (pa[q][3][2] + pa[q][3][3])));
                    const float r = rsqrtf(sm * (1.0f / DM) + EPS);
                    *(f32x4*)(outp + (size_t)row * DM + (tpx & 255) * 4) = v[q] * r * gn;
                }
            } }
        } else {
            const int l = (ph - 1) / 9, sub = (ph - 1) % 9;
            unsigned char* wl = ws_of(p) + WS_W + (size_t)l * LAYER_W;
            float* ssq = (float*)(ws_of(p) + WS_SSQ);
            bf16_t* HB = (bf16_t*)(ws_of(p) + WS_HB);
            bf16_t* UB = (bf16_t*)(ws_of(p) + WS_U);
            if (PHEN(1) && (sub == 0 || sub == 7)) {
                const bool second = sub == 7;
                pg8::Gemm g{HB, (const bf16_t*)(wl + (second ? LO_W13B : LO_W13A)), T_, NUP, DM, DM, DM};
                pg8::StaticOrder S; S.init(T_, NUP, G, bid);
                EpiSwiGLU E{UB, ssq + (size_t)((3 * l + (second ? 2 : 0)) & 1) * T_ * 16};
                pg8::gemm_phase(lds, g, S, E);
                if (REP_SUB == 0) { __syncthreads(); pg8::gemm_phase(lds, g, S, E); }
            } else if (PHEN(2) && (sub == 1 || sub == 8 || sub == 6)) {
                const bool wout = sub == 6, second = sub == 8;
                pg8::Gemm g;
                if (wout) g = pg8::Gemm{(const bf16_t*)(ws_of(p) + WS_HEADS), (const bf16_t*)(wl + LO_WOUT), T_, DM, DM, DM, DM};
                else g = pg8::Gemm{UB, (const bf16_t*)(wl + (second ? LO_W2B : LO_W2A)), T_, DM, DFF, DFF, DFF};
                pg8::StaticOrder S; S.init(T_, DM, G, bid);
                const float* resid = (l == 0 && sub == 1) ? in_of(p, 0) : out_of(p);
                const int nxt = 3 * l + (sub == 1 ? 1 : (sub == 6 ? 2 : 3));
                EpiResid E{resid, out_of(p), HB, ssq + (size_t)(nxt & 1) * T_ * 16, wout ? 1.0f : 0.5f};
                pg8::gemm_phase(lds, g, S, E);
                if (REP_SUB == 1) { __syncthreads(); EpiResid E2{out_of(p), out_of(p), HB, ssq + (size_t)(nxt & 1) * T_ * 16, 0.0f}; pg8::gemm_phase(lds, g, S, E2); }
            } else if (PHEN(3) && sub == 2) {
                if (bid < 2 && tpx < 256) {
                    const float* cbp = (const float*)(ws_of(p) + WS_CBP) + (size_t)((l * 2 + bid) * 32) * 256 + tpx;
                    float sb = 0.f;
#pragma unroll
                    for (int q = 0; q < 32; ++q) sb += cbp[q * 256];
                    ((float*)(ws_of(p) + WS_CBIAS))[(l * 2 + bid) * 256 + tpx] = sb;
                }
                pg8::Gemm g{HB, (const bf16_t*)(wl + LO_WIN), T_, NINP, DM, DM, DM};
                pg8::StaticOrder S; S.init(T_, NINP, G, bid);
                EpiWin E{UB, (bf16_t*)(ws_of(p) + WS_KCMP), (bf16_t*)(ws_of(p) + WS_VCMP), (float*)(ws_of(p) + WS_GATES), ssq + (size_t)((3 * l + 1) & 1) * T_ * 16};
                pg8::gemm_phase(lds, g, S, E);
                if (REP_SUB == 2) { __syncthreads(); pg8::gemm_phase(lds, g, S, E); }
            } else if (sub == 3) {
                const int ngemm = 64;
                for (int rep = 0; rep < (REP_SUB == 3 ? 2 : 1); ++rep) {
                const int cls = rep == 0 ? 7 : REP_CLASS;
                if (rep) __syncthreads();
                if (G > ngemm) {
                    if (bid < ngemm) { if (PHEN(4) && (cls & 1)) {
                        const int kp = bid >> 4, kv = (bid >> 3) & 1;
                        pg8::Gemm g{(const bf16_t*)(ws_of(p) + (kv ? WS_VCMP : WS_KCMP)) + kp * 512, (const bf16_t*)(wl + (kv ? LO_CW1V : LO_CW1K)) + kp * 512, 2048, 256, 512, 1024, 2048};
                        pg8::SingleUnit S{bid & 7};
                        EpiCmp E{(float*)(ws_of(p) + WS_HID) + (size_t)(kp * 2 + kv) * 2048 * 256};
                        pg8::gemm_phase(lds, g, S, E); }
                    }
                    if (PHEN(5)) {
                        const bool gb = bid < ngemm;
                        const int i0 = gb ? 1728 + bid : bid - ngemm, i1 = gb ? 2048 : 1728, st = gb ? ngemm : G - ngemm;
                        for (int it = i0; it < i1; it += st) {
                            if (it < 1024) { if (cls & 2) lru_x_item(p, l, it >> 7, (it >> 5) & 3, it & 31, lds); }
                            else if (cls & 4) ml_x_item(p, l, (it - 1024) >> 5, it & 31, lds);
                        }
                    }
                }
                }
            } else if (PHEN(6) && sub == 4) {
                phase_m2(p, l, 7, lds, bid, G);
                if (REP_SUB == 4) { __syncthreads(); phase_m2(p, l, REP_CLASS, lds, bid, G); }
            } else if (sub == 5) {
                for (int rep = 0; rep < (REP_SUB == 5 ? 2 : 1); ++rep) {
                const int cls = rep == 0 ? 7 : REP_CLASS;
                if (rep) __syncthreads();
                for (int it = bid; it < 512 + 1024 + 512; it += G) {
                    if (it < 512) { if (PHEN(7) && (cls & 1)) {
                        const int qb = it < 256 ? 31 - (it >> 4) : ((it - 256) >> 4), bg = it & 15;
                        nsa_item(p, l, bg >> 1, bg & 1, qb, lds, (rep == 1 && REP_CLASS == 9) ? 1 : 0); }
                    } else if (it < 1536) {
                        if (PHEN(8) && (cls & 2)) ml_y_item(p, l, (it - 512) >> 5, (it - 512) & 31, lds);
                    } else {
                        if (PHEN(9) && (cls & 4)) lru_y_item(p, l, it - 1536);
                    }
                }
                }
            }
        }
        if (ph + 1 < p.ph_hi) {
            xcd_barrier(xbar);
            if (REP_SUB == 200) xcd_barrier(xbar);
        }
    }
}

extern "C" void kernel_launch(void* const* d_in, const int* in_sizes, int n_in, void* d_out, int out_size, void* d_ws, size_t ws_size, hipStream_t stream) {
    static int grid = 0;
    if (grid == 0) {
        if (n_in != 29 || out_size != T_ * DM || ws_size < WS_END) { fprintf(stderr, "kernel_launch: unexpected shapes (n_in %d out %d ws %zu need %zu)\n", n_in, out_size, ws_size, (size_t)WS_END); grid = -1; return; }
        int dev = 0, cus = 0, per_cu = 0;
        hipGetDevice(&dev);
        hipDeviceGetAttribute(&cus, hipDeviceAttributeMultiprocessorCount, dev);
        hipFuncSetAttribute((const void*)hymba_fwd, hipFuncAttributeMaxDynamicSharedMemorySize, LDS_BYTES);
        hipOccupancyMaxActiveBlocksPerMultiprocessor(&per_cu, (const void*)hymba_fwd, NTHREADS, LDS_BYTES);
        if (per_cu < 1) { fprintf(stderr, "kernel_launch: occupancy query says %d blocks per CU\n", per_cu); per_cu = 1; }
        (void)hipGetLastError();
        grid = cus;
    }
    if (grid < 0) return;
    Params p{};
    for (int i = 0; i < 29; ++i) p.in[i] = (const float*)d_in[i];
    p.out = (float*)d_out; p.ws = (unsigned char*)d_ws;
#if ONE_LAUNCH
    (void)hipMemsetAsync((unsigned char*)d_ws + WS_BAR, 0, 16384, stream);
    p.ph_lo = 0; p.ph_hi = 38;
    void* args[] = {&p};
    hipError_t e = hipLaunchCooperativeKernel((const void*)hymba_fwd, dim3(grid), dim3(NTHREADS), args, LDS_BYTES, stream);
    if (e != hipSuccess) fprintf(stderr, "cooperative launch failed: %s (grid %d)\n", hipGetErrorString(e), grid);
#else
    for (int ph = 0; ph < 38; ++ph) {
        p.ph_lo = ph; p.ph_hi = ph + 1;
        hipLaunchKernelGGL(hymba_fwd, dim3(grid), dim3(NTHREADS), LDS_BYTES, stream, p);
    }
#endif
}
```

```cpp
#include <hip/hip_runtime.h>
#include <hip/hip_cooperative_groups.h>
#include <cstdio>
namespace cg = cooperative_groups;

#define LAS __attribute__((address_space(3)))
typedef unsigned short bf16_t;
typedef short bf16x8 __attribute__((ext_vector_type(8)));
typedef float f32x4 __attribute__((ext_vector_type(4)));
typedef float f32x2 __attribute__((ext_vector_type(2)));
typedef unsigned u32x4 __attribute__((ext_vector_type(4)));
typedef unsigned u32x2 __attribute__((ext_vector_type(2)));

#ifndef ONE_LAUNCH
#define ONE_LAUNCH 1
#endif
#ifndef PHMASK
#define PHMASK 0xFFFF
#endif
#define PHEN(k) ((PHMASK >> (k)) & 1)
#ifndef REP_SUB
#define REP_SUB -1
#endif
#ifndef REP_CLASS
#define REP_CLASS 7
#endif

constexpr int T_ = 16384, SEQ = 2048, DM = 1024, DFF = 2816, NUP = 5632, NINP = 3072, UW = 2816, DIN = 2848;
constexpr float EPS = 1e-6f;
constexpr float NEGF = -1e30f;
constexpr int NTHREADS = 512;
constexpr int LDS_BYTES = 147456;

constexpr size_t SZ_W13T = (size_t)NUP * DM * 2, SZ_W2T = (size_t)DM * DFF * 2, SZ_WINT = (size_t)NINP * DM * 2, SZ_WOUTT = (size_t)DM * DM * 2, SZ_CW1T = (size_t)256 * 2048 * 2;
constexpr size_t LO_W13A = 0, LO_W2A = LO_W13A + SZ_W13T, LO_W13B = LO_W2A + SZ_W2T, LO_W2B = LO_W13B + SZ_W13T, LO_WIN = LO_W2B + SZ_W2T, LO_WOUT = LO_WIN + SZ_WINT,
                 LO_CW1K = LO_WOUT + SZ_WOUTT, LO_CW1V = LO_CW1K + SZ_CW1T, LAYER_W = LO_CW1V + SZ_CW1T;
constexpr size_t WS_W = 0;
constexpr size_t WS_HB = WS_W + 4 * LAYER_W;
constexpr size_t WS_U = WS_HB + (size_t)T_ * DM * 2;
constexpr size_t WS_HEADS = WS_U + (size_t)T_ * UW * 2;
constexpr size_t SZ_CMPIN = (size_t)16 * 2048 * 64 * 2 + 4096;
constexpr size_t WS_KCMP = WS_HEADS + (size_t)T_ * DM * 2;
constexpr size_t WS_VCMP = WS_KCMP + SZ_CMPIN;
constexpr size_t WS_HID = WS_VCMP + SZ_CMPIN;
constexpr size_t WS_KC = WS_HID + (size_t)4 * 2 * 2048 * 256 * 4;
constexpr size_t WS_GATES = WS_KC + (size_t)2 * 2048 * 64 * 2;
constexpr size_t WS_SSQ = WS_GATES + (size_t)T_ * 32 * 4;
constexpr size_t WS_CBIAS = WS_SSQ + (size_t)2 * T_ * 16 * 4;
constexpr size_t WS_LRUH = WS_CBIAS + 8192;
constexpr size_t WS_LRUA = WS_LRUH + (size_t)T_ * 256 * 4;
constexpr size_t WS_LRUC = WS_LRUA + (size_t)T_ * 256 * 4;
constexpr size_t WS_MLC = WS_LRUC + (size_t)8 * 32 * 256 * 4;
constexpr size_t WS_MLN = WS_MLC + (size_t)1024 * 4096 * 4;
constexpr size_t WS_MLMU = WS_MLN + (size_t)1024 * 64 * 4;
constexpr size_t WS_MLAT = WS_MLMU + 4096;
constexpr size_t WS_MLMP = WS_MLAT + 4096;
constexpr size_t WS_CBP = WS_MLMP + 4096;
constexpr size_t WS_LRUWT = WS_CBP + 262144;
constexpr size_t WS_BAR = WS_LRUWT + 262144;
constexpr size_t WS_END = WS_BAR + 16384;
static_assert(WS_END <= 425365632ull, "workspace too large");
static_assert(LAYER_W % 256 == 0 && WS_HB % 256 == 0 && WS_U % 256 == 0 && WS_KCMP % 256 == 0 && WS_VCMP % 256 == 0 && WS_HID % 256 == 0, "align");

struct Params {
    const float* in[29];
    float* out;
    unsigned char* ws;
    int ph_lo, ph_hi;
};
static_assert(sizeof(Params) == 256, "Params has padding");
#define GAS __attribute__((address_space(1)))
__device__ __forceinline__ unsigned char* ws_of(const Params& p) { unsigned long long w = (unsigned long long)p.ws; asm volatile("" : "+s"(w)); return (unsigned char*)(GAS unsigned char*)w; }
__device__ __forceinline__ float* out_of(const Params& p) { unsigned long long w = (unsigned long long)p.out; asm volatile("" : "+s"(w)); return (float*)(GAS float*)w; }
__device__ __forceinline__ const float* in_of(const Params& p, int i) { unsigned long long w = (unsigned long long)p.in[i]; asm volatile("" : "+s"(w)); return (const float*)(GAS const float*)w; }
__device__ __forceinline__ unsigned cvt_pk_bf16(float lo, float hi) { unsigned r; asm volatile("v_cvt_pk_bf16_f32 %0, %1, %2" : "=v"(r) : "v"(lo), "v"(hi)); return r; }
__device__ __forceinline__ bf16_t f2bf(float f) { return (bf16_t)(cvt_pk_bf16(f, 0.f) & 0xffffu); }
__device__ __forceinline__ float bf2f(bf16_t b) { return __uint_as_float(((unsigned)b) << 16); }
__device__ __forceinline__ float sigmoidf_(float x) { return 1.0f / (1.0f + __expf(-x)); }
__device__ __forceinline__ int opaque_tid() { int x = threadIdx.x; asm volatile("" : "+v"(x)); return x; }
__device__ __forceinline__ float row_rstd(const float* part, int row) {
    const f32x4 a = *(const f32x4*)(part + (size_t)row * 16), b = *(const f32x4*)(part + (size_t)row * 16 + 4), c = *(const f32x4*)(part + (size_t)row * 16 + 8), d = *(const f32x4*)(part + (size_t)row * 16 + 12);
    const float s = (((a[0] + a[1]) + (a[2] + a[3])) + ((b[0] + b[1]) + (b[2] + b[3]))) + (((c[0] + c[1]) + (c[2] + c[3])) + ((d[0] + d[1]) + (d[2] + d[3])));
    return rsqrtf(s * (1.0f / DM) + EPS);
}
__device__ __forceinline__ float fq_max(float x) {
    auto a = __builtin_amdgcn_permlane16_swap(__float_as_uint(x), __float_as_uint(x), false, false);
    const float m = fmaxf(__uint_as_float(a[0]), __uint_as_float(a[1]));
    auto b = __builtin_amdgcn_permlane32_swap(__float_as_uint(m), __float_as_uint(m), false, false);
    return fmaxf(__uint_as_float(b[0]), __uint_as_float(b[1]));
}
__device__ __forceinline__ float fq_sum(float x) {
    auto a = __builtin_amdgcn_permlane16_swap(__float_as_uint(x), __float_as_uint(x), false, false);
    const float m = __uint_as_float(a[0]) + __uint_as_float(a[1]);
    auto b = __builtin_amdgcn_permlane32_swap(__float_as_uint(m), __float_as_uint(m), false, false);
    return __uint_as_float(b[0]) + __uint_as_float(b[1]);
}
__device__ __forceinline__ float wave_sum(float v) {
#pragma unroll
    for (int o = 32; o >= 1; o >>= 1) v += __shfl_xor(v, o);
    return v;
}
__device__ __forceinline__ float wave_max(float v) {
#pragma unroll
    for (int o = 32; o >= 1; o >>= 1) v = fmaxf(v, __shfl_xor(v, o));
    return v;
}

namespace pg8 {
constexpr int BM = 256, BK = 64, HALF = 128, HTB = HALF * BK * 2, STAGE_BYTES = 8 * HTB, NXCD = 8, WGM = 8;
__device__ __forceinline__ int lds_byte(int r, int c) { const int st = (r >> 4) * 2 + (c >> 5), rr = r & 15, cc = c & 31, ob = rr * 64 + cc * 2; return st * 1024 + (ob ^ (((ob >> 9) & 1) << 5)); }
__device__ __forceinline__ void stage_rc(int b, int& R, int& C) { const int st = b / 1024, sb = b % 1024, swz = sb ^ (((sb >> 9) & 1) << 5); R = (st >> 1) * 16 + swz / 64; C = (st & 1) * 32 + (swz % 64) / 2; }

struct Unit { int pm, pn; };
struct Gemm { const bf16_t* A; const bf16_t* Bt; int M, N, K, lda, ldb; };

struct StaticOrder {
    int nM, nN, nwg, G, c;
    __device__ void init(int M, int N, int G_, int c_) { nM = M / BM; nN = N / BM; nwg = nM * nN; G = G_; c = c_; }
    __device__ bool next(int i, Unit& u) const {
        const long L = (long)i * G + c; if (L >= nwg) return false;
        int wgid = (int)L; { const int q = nwg / NXCD, r = nwg % NXCD, xcd = wgid % NXCD, off = wgid / NXCD; wgid = (xcd < r ? xcd * (q + 1) : r * (q + 1) + (xcd - r) * q) + off; }
        const int nig = WGM * nN, gid = wgid / nig, fm = gid * WGM, gsz = (nM - fm) < WGM ? (nM - fm) : WGM;
        u.pm = fm + ((wgid % nig) % gsz); u.pn = (wgid % nig) / gsz; return true;
    }
};
struct SingleUnit {
    int pm;
    __device__ bool next(int i, Unit& u) const { if (i != 0 || pm < 0) return false; u.pm = pm; u.pn = 0; return true; }
};

template <class Epi, class Sched>
__device__ __forceinline__ void gemm_phase(LAS unsigned char* lds, const Gemm g, const Sched& S, const Epi& E) {
    const int tid = opaque_tid(), wid = __builtin_amdgcn_readfirstlane(tid >> 6), lane = tid & 63, wr = wid >> 2, wc = wid & 3, fr = lane & 15, fq = lane >> 4;
    const int K = g.K, nt = K / BK;
    unsigned voffA[2], voffB[2];
#pragma unroll
    for (int i = 0; i < 2; ++i) { int R, C; stage_rc(tid * 16 + i * 8192, R, C);
        voffA[i] = (unsigned)(R * g.lda + C) * 2u; voffB[i] = (unsigned)(R * g.ldb + C) * 2u; }
    const size_t kstep = (size_t)(BK * 2);
    const size_t hstepA = (size_t)HALF * g.lda * 2, hstepB = (size_t)HALF * g.ldb * 2;
    const size_t tstepA = 2 * hstepA, tstepB = 2 * hstepB;
    const unsigned ldsw = (unsigned)wid * 1024u;
    const int aoff = lds_byte(wr * 64 + fr, fq * 8), boff = lds_byte(wc * 32 + fr, fq * 8);
#define PG8_SA(b, h) (((b) * 2 + (h)) * HTB)
#define PG8_SB(b, h) ((4 + (b) * 2 + (h)) * HTB)
#define PG8_STAGE(bufoff, gbase, voff) do { _Pragma("unroll") for (int _i = 0; _i < 2; ++_i) \
        __builtin_amdgcn_global_load_lds((const unsigned*)((const char*)(gbase) + (voff)[_i]), (LAS unsigned*)(lds + (bufoff) + ldsw + _i * 8192), 16, 0, 0); } while (0)
#define PG8_LDA(dst, b, h) do { _Pragma("unroll") for (int m = 0; m < 4; ++m) _Pragma("unroll") for (int k = 0; k < 2; ++k) dst[m][k] = *(const LAS bf16x8*)(lds + PG8_SA(b, h) + aoff + m * 2048 + k * 1024); } while (0)
#define PG8_LDB(dst, b, h) do { _Pragma("unroll") for (int n = 0; n < 2; ++n) _Pragma("unroll") for (int k = 0; k < 2; ++k) dst[n][k] = *(const LAS bf16x8*)(lds + PG8_SB(b, h) + boff + n * 2048 + k * 1024); } while (0)
#define PG8_MMA(ai, bj, At, Bt) do { __builtin_amdgcn_s_setprio(1); _Pragma("unroll") for (int m = 0; m < 4; ++m) _Pragma("unroll") for (int n = 0; n < 2; ++n) _Pragma("unroll") for (int k = 0; k < 2; ++k) \
        acc[ai][bj][m][n] = __builtin_amdgcn_mfma_f32_16x16x32_bf16(Bt[n][k], At[m][k], acc[ai][bj][m][n], 0, 0, 0); __builtin_amdgcn_s_setprio(0); } while (0)
#define PG8_WAIT_V(n) asm volatile("s_waitcnt vmcnt(" #n ")" ::: "memory")
#define PG8_WAIT_L(n) asm volatile("s_waitcnt lgkmcnt(" #n ")" ::: "memory")
#define PG8_BAR __builtin_amdgcn_s_barrier()
#define PG8_SCHED __builtin_amdgcn_sched_barrier(0)
    Unit cur, nxt; int ui = 0;
    if (!S.next(0, cur)) return;
    f32x4 acc[2][2][4][2];
#pragma unroll
    for (int a = 0; a < 2; ++a)
#pragma unroll
        for (int b = 0; b < 2; ++b)
#pragma unroll
            for (int m = 0; m < 4; ++m)
#pragma unroll
                for (int n = 0; n < 2; ++n) acc[a][b][m][n] = (f32x4){0.f, 0.f, 0.f, 0.f};
    bf16x8 At[4][2], B0[2][2], B1[2][2];
    const char* cA = (const char*)g.A + (size_t)cur.pm * tstepA; const char* cB = (const char*)g.Bt + (size_t)cur.pn * tstepB;
    PG8_STAGE(PG8_SB(0, 0), cB, voffB); PG8_STAGE(PG8_SA(0, 0), cA, voffA); PG8_STAGE(PG8_SB(0, 1), cB + hstepB, voffB); PG8_STAGE(PG8_SA(0, 1), cA + hstepA, voffA);
    if (wr == 1) PG8_BAR;
    PG8_WAIT_V(4); PG8_BAR;
    PG8_STAGE(PG8_SB(1, 0), cB + kstep, voffB); PG8_STAGE(PG8_SA(1, 0), cA + kstep, voffA); PG8_STAGE(PG8_SB(1, 1), cB + hstepB + kstep, voffB);
    PG8_WAIT_V(6); PG8_BAR;
    for (;;) {
        const bool has_next = S.next(ui + 1, nxt);
        const char* nA = has_next ? (const char*)g.A + (size_t)nxt.pm * tstepA : cA; const char* nB = has_next ? (const char*)g.Bt + (size_t)nxt.pn * tstepB : cB;
        for (int t = 0; t < nt; t += 2) {
            const bool last = (t == nt - 2);
            const char* a1 = cA + (size_t)(t + 1) * kstep;
            const char* a2 = last ? nA : cA + (size_t)(t + 2) * kstep; const char* b2 = last ? nB : cB + (size_t)(t + 2) * kstep;
            const char* a3 = a2 + kstep; const char* b3 = b2 + kstep;
            PG8_LDB(B0, 0, 0); PG8_SCHED; PG8_LDA(At, 0, 0); PG8_STAGE(PG8_SA(1, 1), a1 + hstepA, voffA);
            PG8_WAIT_L(8); PG8_BAR; PG8_WAIT_L(0); PG8_MMA(0, 0, At, B0); PG8_BAR; PG8_SCHED;
            PG8_LDB(B1, 0, 1); PG8_STAGE(PG8_SB(0, 0), b2, voffB);
            PG8_BAR; PG8_WAIT_L(0); PG8_MMA(0, 1, At, B1); PG8_BAR;
            PG8_LDA(At, 0, 1); PG8_STAGE(PG8_SA(0, 0), a2, voffA);
            PG8_BAR; PG8_WAIT_L(0); PG8_MMA(1, 0, At, B0); PG8_BAR; PG8_SCHED;
            PG8_STAGE(PG8_SB(0, 1), b2 + hstepB, voffB);
            PG8_WAIT_V(6); PG8_BAR; PG8_MMA(1, 1, At, B1); PG8_BAR;
            PG8_LDB(B0, 1, 0); PG8_SCHED; PG8_LDA(At, 1, 0); PG8_STAGE(PG8_SA(0, 1), a2 + hstepA, voffA);
            PG8_WAIT_L(8); PG8_BAR; PG8_WAIT_L(0); PG8_MMA(0, 0, At, B0); PG8_BAR; PG8_SCHED;
            PG8_LDB(B1, 1, 1); PG8_STAGE(PG8_SB(1, 0), b3, voffB);
            PG8_BAR; PG8_WAIT_L(0); PG8_MMA(0, 1, At, B1); PG8_BAR;
            PG8_LDA(At, 1, 1); PG8_STAGE(PG8_SA(1, 0), a3, voffA);
            PG8_BAR; PG8_WAIT_L(0); PG8_MMA(1, 0, At, B0); PG8_BAR; PG8_SCHED;
            PG8_STAGE(PG8_SB(1, 1), b3 + hstepB, voffB);
            PG8_WAIT_V(6); PG8_BAR; PG8_MMA(1, 1, At, B1); PG8_BAR;
        }
        E(acc, cur, wr, wc, fr, fq);
        if (!has_next) break;
#pragma unroll
        for (int a = 0; a < 2; ++a)
#pragma unroll
            for (int b = 0; b < 2; ++b)
#pragma unroll
                for (int m = 0; m < 4; ++m)
#pragma unroll
                    for (int n = 0; n < 2; ++n) acc[a][b][m][n] = (f32x4){0.f, 0.f, 0.f, 0.f};
        cur = nxt; cA = nA; cB = nB; ++ui;
    }
    PG8_WAIT_V(0);
    if (wr == 0) PG8_BAR;
    PG8_BAR;
#undef PG8_SA
#undef PG8_SB
#undef PG8_STAGE
#undef PG8_LDA
#undef PG8_LDB
#undef PG8_MMA
#undef PG8_WAIT_V
#undef PG8_WAIT_L
#undef PG8_BAR
#undef PG8_SCHED
}
}

typedef __attribute__((address_space(1))) float gf32;
typedef __attribute__((address_space(1))) const float gcf32;
typedef __attribute__((address_space(1))) bf16_t gbf16;
typedef __attribute__((address_space(1))) f32x4 gf32x4;
typedef __attribute__((address_space(1))) const f32x4 gcf32x4;
typedef __attribute__((address_space(1))) u32x2 gu32x2;
__device__ __forceinline__ void rows_rstd(const float* ssq, int row0, int fq, float (&r8)[2][4]) {
    f32x4 pv[2][4];
#pragma unroll
    for (int ai = 0; ai < 2; ++ai)
#pragma unroll
        for (int m = 0; m < 4; ++m) pv[ai][m] = *(gcf32x4*)(ssq + (size_t)(row0 + ai * 128 + m * 16) * 16 + 4 * fq);
#pragma unroll
    for (int ai = 0; ai < 2; ++ai)
#pragma unroll
        for (int m = 0; m < 4; ++m) {
            float sm = (pv[ai][m][0] + pv[ai][m][1]) + (pv[ai][m][2] + pv[ai][m][3]);
            sm = fq_sum(sm);
            r8[ai][m] = rsqrtf(sm * (1.0f / DM) + EPS);
        }
}
struct EpiSwiGLU {
    bf16_t* act; const float* ssq;
    __device__ __forceinline__ void operator()(const f32x4 (&acc)[2][2][4][2], const pg8::Unit& u, int wr, int wc, int fr, int fq) const {
        const int row0 = u.pm * 256 + wr * 64 + fr, col0 = u.pn * 128 + wc * 32 + 8 * fq;
        float r8[2][4];
        rows_rstd(ssq, row0, fq, r8);
#pragma unroll
        for (int ai = 0; ai < 2; ++ai)
#pragma unroll
            for (int m = 0; m < 4; ++m) {
                const int row = row0 + ai * 128 + m * 16;
                const float r = r8[ai][m];
                float o[8];
#pragma unroll
                for (int n = 0; n < 2; ++n) {
                    const f32x4 a1 = acc[ai][0][m][n] * r, a3 = acc[ai][1][m][n] * r;
#pragma unroll
                    for (int j = 0; j < 4; ++j) o[4 * n + j] = a1[j] * __builtin_amdgcn_rcpf(1.0f + __expf(-a1[j])) * a3[j];
                }
                u32x4 w; w.x = cvt_pk_bf16(o[0], o[1]); w.y = cvt_pk_bf16(o[2], o[3]); w.z = cvt_pk_bf16(o[4], o[5]); w.w = cvt_pk_bf16(o[6], o[7]);
                *(GAS u32x4*)(act + (size_t)row * DFF + col0) = w;
            }
    }
};
struct EpiResid {
    const float* resid; float* out; bf16_t* hb; float* ssq_next; float scale;
    __device__ __forceinline__ void load2(f32x4 (&rs)[2][2][2], int row0, int col0, int ai, int mp) const {
#pragma unroll
        for (int mm = 0; mm < 2; ++mm)
#pragma unroll
            for (int bj = 0; bj < 2; ++bj)
#pragma unroll
                for (int n = 0; n < 2; ++n)
                    rs[mm][bj][n] = *(gcf32x4*)(resid + (size_t)(row0 + ai * 128 + (2 * mp + mm) * 16) * DM + col0 + bj * 128 + n * 4);
    }
    __device__ __forceinline__ void operator()(const f32x4 (&acc)[2][2][4][2], const pg8::Unit& u, int wr, int wc, int fr, int fq) const {
        const int row0 = u.pm * 256 + wr * 64 + fr, col0 = u.pn * 256 + wc * 32 + 8 * fq;
        f32x4 rsA[2][2][2], rsB[2][2][2];
        load2(rsA, row0, col0, 0, 0);
#pragma unroll
        for (int bt = 0; bt < 4; ++bt) {
            const int ai = bt >> 1, mp = bt & 1;
            if (bt < 3) { if (bt & 1) load2(rsA, row0, col0, (bt + 1) >> 1, (bt + 1) & 1); else load2(rsB, row0, col0, (bt + 1) >> 1, (bt + 1) & 1); }
#pragma unroll
            for (int mm = 0; mm < 2; ++mm) {
                const int m = 2 * mp + mm, row = row0 + ai * 128 + m * 16;
                const size_t off = (size_t)row * DM + col0;
                float ss = 0.f;
#pragma unroll
                for (int bj = 0; bj < 2; ++bj) {
                    const f32x4 r0 = (bt & 1) ? rsB[mm][bj][0] : rsA[mm][bj][0], r1 = (bt & 1) ? rsB[mm][bj][1] : rsA[mm][bj][1];
                    const f32x4 v0 = r0 + acc[ai][bj][m][0] * scale, v1 = r1 + acc[ai][bj][m][1] * scale;
                    *(gf32x4*)(out + off + bj * 128) = v0;
                    *(gf32x4*)(out + off + bj * 128 + 4) = v1;
                    u32x4 w; w.x = cvt_pk_bf16(v0[0], v0[1]); w.y = cvt_pk_bf16(v0[2], v0[3]); w.z = cvt_pk_bf16(v1[0], v1[1]); w.w = cvt_pk_bf16(v1[2], v1[3]);
                    *(GAS u32x4*)(hb + off + bj * 128) = w;
                    ss += ((v0[0] * v0[0] + v0[1] * v0[1]) + (v0[2] * v0[2] + v0[3] * v0[3])) + ((v1[0] * v1[0] + v1[1] * v1[1]) + (v1[2] * v1[2] + v1[3] * v1[3]));
                }
                ss = fq_sum(ss);
                if (fq == 0) *(gf32*)(ssq_next + (size_t)row * 16 + u.pn * 4 + wc) = ss;
            }
            asm volatile("" ::: "memory");
        }
    }
};
struct EpiWin {
    bf16_t* U; bf16_t* kcmp; bf16_t* vcmp; float* gates; const float* ssq;
    __device__ __forceinline__ void operator()(const f32x4 (&acc)[2][2][4][2], const pg8::Unit& u, int wr, int wc, int fr, int fq) const {
        const int row0 = u.pm * 256 + wr * 64 + fr;
        float r8[2][4];
        rows_rstd(ssq, row0, fq, r8);
#pragma unroll
        for (int bj = 0; bj < 2; ++bj) {
            const int c0 = u.pn * 256 + bj * 128 + wc * 32;
            if (c0 >= 2848) continue;
            const float sc = (c0 < 512) ? 0.125f * 1.4426950408889634f : ((c0 >= 2048 && c0 < 2304) ? 0.125f : 1.0f);
            const int cl = 8 * fq;
#pragma unroll
            for (int ai = 0; ai < 2; ++ai)
#pragma unroll
                for (int m = 0; m < 4; ++m) {
                    const int row = row0 + ai * 128 + m * 16;
                    const float r = r8[ai][m] * sc;
                    const f32x4 v0 = acc[ai][bj][m][0] * r, v1 = acc[ai][bj][m][1] * r;
                    if (c0 == 2816) { *(gf32x4*)(gates + (size_t)row * 32 + cl) = v0; *(gf32x4*)(gates + (size_t)row * 32 + cl + 4) = v1; }
                    else {
                        u32x4 w; w.x = cvt_pk_bf16(v0[0], v0[1]); w.y = cvt_pk_bf16(v0[2], v0[3]); w.z = cvt_pk_bf16(v1[0], v1[1]); w.w = cvt_pk_bf16(v1[2], v1[3]);
                        if (c0 >= 512 && c0 < 768) {
                            const int cc = c0 - 512 + cl;
                            const int gg = (cc >> 6) & 1, d = cc & 63;
                            bf16_t* dst = (cc < 128 ? kcmp : vcmp) + ((size_t)(((row >> 11) * 2 + gg) * 2048 + (row & 2047))) * 64 + d;
                            *(GAS u32x4*)dst = w;
                        } else {
                            *(GAS u32x4*)(U + (size_t)row * UW + c0 + cl) = w;
                        }
                    }
                }
        }
    }
};
struct EpiCmp {
    float* part;
    __device__ __forceinline__ void operator()(const f32x4 (&acc)[2][2][4][2], const pg8::Unit& u, int wr, int wc, int fr, int fq) const {
        const int row0 = u.pm * 256 + wr * 64 + fr, col0 = wc * 32 + 8 * fq;
#pragma unroll
        for (int ai = 0; ai < 2; ++ai)
#pragma unroll
            for (int m = 0; m < 4; ++m) {
                const int row = row0 + ai * 128 + m * 16;
#pragma unroll
                for (int bj = 0; bj < 2; ++bj)
#pragma unroll
                    for (int n = 0; n < 2; ++n) *(gf32x4*)(part + (size_t)row * 256 + col0 + bj * 128 + n * 4) = acc[ai][bj][m][n];
            }
    }
};

__device__ __forceinline__ int winmap(int n) {
    if (n < 1280) return n;
    if (n < 2560) return n + 24;
    if (n < 2816) return n + 32;
    if (n < 2840) return 1280 + (n - 2816);
    if (n < 2844) return 2584 + (n - 2840);
    if (n < 2848) return 2588 + (n - 2844);
    return -1;
}
struct TrTile { const float* colp; const float* gain; bf16_t* dst; int ld, K, k0, n0; };
__device__ __forceinline__ void tr_decode(const Params& p, int idx, int tid, TrTile& t) {
    constexpr int TPL = 1376;
    const int l = idx / TPL; int r = idx % TPL;
    int m, ntile, ktile, K;
    if (r < 352) { m = 0; ntile = r % 22; ktile = r / 22; K = DM; }
    else if (r < 528) { r -= 352; m = 1; ntile = r % 4; ktile = r / 4; K = DFF; }
    else if (r < 880) { r -= 528; m = 2; ntile = r % 22; ktile = r / 22; K = DM; }
    else if (r < 1056) { r -= 880; m = 3; ntile = r % 4; ktile = r / 4; K = DFF; }
    else if (r < 1248) { r -= 1056; m = 4; ntile = r % 12; ktile = r / 12; K = DM; }
    else if (r < 1312) { r -= 1248; m = 5; ntile = r % 4; ktile = r / 4; K = DM; }
    else if (r < 1344) { r -= 1312; m = 6; ntile = 0; ktile = r; K = 2048; }
    else { r -= 1344; m = 7; ntile = 0; ktile = r; K = 2048; }
    t.K = K; t.k0 = ktile * 64; t.n0 = ntile * 256; t.colp = nullptr; t.gain = nullptr; t.ld = 0;
    const int npp = t.n0 + 4 * ((tid >> 3));
    const int np = (npp & ~31) + 8 * ((npp & 15) >> 2) + 4 * ((npp >> 4) & 1);
    unsigned char* wl = ws_of(p) + WS_W + (size_t)l * LAYER_W;
    if (m == 0 || m == 2) {
        const int pb = np >> 8, w = np & 255;
        const float* src = (w < 128) ? in_of(p, m == 0 ? 2 : 25) : in_of(p, m == 0 ? 3 : 26);
        t.colp = src + (size_t)l * DM * DFF + pb * 128 + (w & 127); t.ld = DFF; t.gain = in_of(p, m == 0 ? 1 : 24) + l * DM;
        t.dst = (bf16_t*)(wl + (m == 0 ? LO_W13A : LO_W13B));
    } else if (m == 1 || m == 3) {
        t.colp = in_of(p, m == 1 ? 4 : 27) + (size_t)l * DFF * DM + np; t.ld = DM;
        t.dst = (bf16_t*)(wl + (m == 1 ? LO_W2A : LO_W2B));
    } else if (m == 4) {
        const int sc = winmap(np);
        if (sc >= 0) t.colp = in_of(p, 6) + (size_t)l * DM * DIN + sc;
        t.ld = DIN; t.gain = in_of(p, 5) + l * DM;
        t.dst = (bf16_t*)(wl + LO_WIN);
    } else if (m == 5) {
        t.colp = in_of(p, 23) + (size_t)l * DM * DM + np; t.ld = DM;
        t.dst = (bf16_t*)(wl + LO_WOUT);
    } else {
        t.colp = in_of(p, m == 6 ? 8 : 11) + (size_t)l * 2048 * 256 + np; t.ld = 256;
        t.dst = (bf16_t*)(wl + (m == 6 ? LO_CW1K : LO_CW1V));
    }
}
__device__ __forceinline__ void tr_load(const TrTile& t, int tid, f32x4 (&v)[8], float (&gv)[8]) {
    const int kc = (tid & 7);
#pragma unroll
    for (int e = 0; e < 8; ++e) {
        const int k = t.k0 + 8 * kc + e;
        v[e] = (f32x4){0.f, 0.f, 0.f, 0.f}; gv[e] = 1.0f;
        if (t.colp) { v[e] = __builtin_nontemporal_load((const f32x4*)(t.colp + (size_t)k * t.ld)); if (t.gain) gv[e] = t.gain[k]; }
    }
}
__device__ void prologue(const Params& p, LAS unsigned char* lds, int bid, int G) {
    const int tid = opaque_tid();
    LAS float* tile = (LAS float*)lds;
    {
        constexpr int N_TR = 4 * 1376;
        int it = bid;
        TrTile t; f32x4 v[8]; float gv[8];
        if (it < N_TR) { tr_decode(p, it, tid, t); tr_load(t, tid, v, gv); }
        while (it < N_TR) {
            bf16_t* dst = t.dst + (size_t)(t.n0 + 4 * ((tid >> 3))) * t.K + t.k0 + 8 * ((tid & 7));
            const int K = t.K;
            u32x4 o[4];
#pragma unroll
            for (int q = 0; q < 4; ++q) { o[q].x = cvt_pk_bf16(v[0][q] * gv[0], v[1][q] * gv[1]); o[q].y = cvt_pk_bf16(v[2][q] * gv[2], v[3][q] * gv[3]); o[q].z = cvt_pk_bf16(v[4][q] * gv[4], v[5][q] * gv[5]); o[q].w = cvt_pk_bf16(v[6][q] * gv[6], v[7][q] * gv[7]); }
            const int nx = it + G;
            if (nx < N_TR) { tr_decode(p, nx, tid, t); tr_load(t, tid, v, gv); }
#pragma unroll
            for (int q = 0; q < 4; ++q) *(u32x4*)(dst + (size_t)q * K) = o[q];
            it = nx;
        }
    }
    constexpr int N_BIAS = 256, N_XROW = T_ / 16, N_LW = 32;
    for (int it = bid; it < N_BIAS + N_XROW + N_LW; it += G) {
        if (it >= N_BIAS + N_XROW) {
            const int q = it - N_BIAS - N_XROW, ln = q >> 1, gate = q & 1;
            const float* W = in_of(p, gate ? 17 : 15) + (size_t)ln * 4096;
            bf16_t* WT = (bf16_t*)(ws_of(p) + WS_LRUWT) + (size_t)q * 4096;
            float wv[8];
#pragma unroll
            for (int rr = 0; rr < 8; ++rr) { const int idx = tid + rr * NTHREADS, d = idx >> 6, c = idx & 63; wv[rr] = W[c * 64 + d]; }
#pragma unroll
            for (int rr = 0; rr < 8; ++rr) WT[tid + rr * NTHREADS] = f2bf(wv[rr]);
        } else if (it < N_BIAS) {
            const int lkv = it >> 5, part = it & 31, l = lkv >> 1, kv = lkv & 1;
            const float* pos = in_of(p, kv ? 10 : 7) + (size_t)l * 2048;
            const float* w1 = in_of(p, kv ? 11 : 8) + (size_t)l * 2048 * 256;
            const int j = tid & 255, half = tid >> 8;
            float sacc = 0.f;
            const int kb = part * 64 + half * 32;
            for (int k = kb; k < kb + 32; k += 8) {
                float a[8];
#pragma unroll
                for (int q = 0; q < 8; ++q) a[q] = w1[(size_t)(k + q) * 256 + j];
#pragma unroll
                for (int q = 0; q < 8; ++q) sacc += pos[k + q] * a[q];
            }
            tile[tid] = sacc;
            __syncthreads();
            if (tid < 256) ((float*)(ws_of(p) + WS_CBP))[(size_t)it * 256 + tid] = tile[tid] + tile[tid + 256];
            __syncthreads();
        } else {
            const int row0 = (it - N_BIAS) * 16 + (tid >> 6) * 2, lane = tid & 63;
            f32x4 xv[2][4];
#pragma unroll
            for (int rq = 0; rq < 2; ++rq)
#pragma unroll
                for (int i = 0; i < 4; ++i) xv[rq][i] = *(const f32x4*)(in_of(p, 0) + (size_t)(row0 + rq) * DM + i * 256 + lane * 4);
#pragma unroll
            for (int rq = 0; rq < 2; ++rq) {
                const int row = row0 + rq;
                bf16_t* hb = (bf16_t*)(ws_of(p) + WS_HB) + (size_t)row * DM;
                float ss = 0.f;
#pragma unroll
                for (int i = 0; i < 4; ++i) {
                    const f32x4 v = xv[rq][i];
                    ss += (v[0] * v[0] + v[1] * v[1]) + (v[2] * v[2] + v[3] * v[3]);
                    u32x2 w; w.x = cvt_pk_bf16(v[0], v[1]); w.y = cvt_pk_bf16(v[2], v[3]);
                    *(u32x2*)(hb + i * 256 + lane * 4) = w;
                }
                ss = wave_sum(ss);
                if (lane < 16) ((float*)(ws_of(p) + WS_SSQ))[(size_t)row * 16 + lane] = (lane == 0) ? ss : 0.f;
            }
        }
    }
}

__device__ void lru_x_item(const Params& p, int l, int b, int n, int ck, LAS unsigned char* lds) {
    const int tid = opaque_tid(), lane = tid & 63, w = __builtin_amdgcn_readfirstlane(tid >> 6), fr = lane & 15, fq = lane >> 4;
    LAS float* xs = (LAS float*)lds;
    LAS float* xc = (LAS float*)(lds + 17152);
    LAS bf16_t* xb = (LAS bf16_t*)(lds + 33536);
    LAS bf16_t* wt = (LAS bf16_t*)(lds + 42752);
    LAS float* pre = (LAS float*)(lds + 61184);
    LAS float* segA = (LAS float*)(lds + 93952);
    LAS float* segH = segA + 512;
    const bf16_t* U = (const bf16_t*)(ws_of(p) + WS_U);
    const int t0 = ck * 64, rowbase = b * SEQ;
    {
        u32x4 xv[2];
#pragma unroll
        for (int rr = 0; rr < 2; ++rr) {
            const int idx = tid + rr * NTHREADS, tt = idx >> 3, ch = idx & 7, t = t0 - 3 + tt;
            xv[rr] = (u32x4){0u, 0u, 0u, 0u};
            if (idx < 67 * 8 && t >= 0) xv[rr] = *(const u32x4*)(U + (size_t)(rowbase + t) * UW + 1280 + n * 64 + ch * 8);
        }
#pragma unroll
        for (int rr = 0; rr < 2; ++rr) {
            const int idx = tid + rr * NTHREADS, tt = idx >> 3, ch = idx & 7;
            if (idx < 67 * 8) {
                f32x4 lo, hi;
                lo[0] = __uint_as_float(xv[rr][0] << 16); lo[1] = __uint_as_float(xv[rr][0] & 0xffff0000u); lo[2] = __uint_as_float(xv[rr][1] << 16); lo[3] = __uint_as_float(xv[rr][1] & 0xffff0000u);
                hi[0] = __uint_as_float(xv[rr][2] << 16); hi[1] = __uint_as_float(xv[rr][2] & 0xffff0000u); hi[2] = __uint_as_float(xv[rr][3] << 16); hi[3] = __uint_as_float(xv[rr][3] & 0xffff0000u);
                *(LAS f32x4*)(xs + tt * 64 + ch * 8) = lo; *(LAS f32x4*)(xs + tt * 64 + ch * 8 + 4) = hi;
            }
        }
    }
    {
        const bf16_t* WT = (const bf16_t*)(ws_of(p) + WS_LRUWT) + (size_t)((l * 4 + n) * 2) * 4096;
#pragma unroll
        for (int rr = 0; rr < 2; ++rr) {
            const int idx = tid + rr * NTHREADS, row = idx >> 3, ch = idx & 7;
            *(LAS u32x4*)(wt + row * 72 + ch * 8) = *(const u32x4*)(WT + row * 64 + ch * 8);
        }
    }
    __syncthreads();
    {
        const float* cw = in_of(p, 13) + (size_t)l * 4 * 256 + n * 64; const float* cb = in_of(p, 14) + l * 256 + n * 64;
        const int c = tid & 63;
        const float w0 = cw[c], w1 = cw[256 + c], w2 = cw[512 + c], w3 = cw[768 + c], bc = cb[c];
#pragma unroll
        for (int k = 0; k < 8; ++k) {
            const int t = (tid >> 6) + 8 * k;
            const float v = bc + xs[t * 64 + c] * w0 + xs[(t + 1) * 64 + c] * w1 + xs[(t + 2) * 64 + c] * w2 + xs[(t + 3) * 64 + c] * w3;
            xc[t * 64 + c] = v; xb[t * 72 + c] = f2bf(v);
        }
    }
    __syncthreads();
    {
        const int tt = w & 3, gate = w >> 2;
        bf16x8 xa[2];
#pragma unroll
        for (int ks = 0; ks < 2; ++ks) xa[ks] = *(const LAS bf16x8*)(xb + (16 * tt + fr) * 72 + 32 * ks + 8 * fq);
        const float* bias = in_of(p, gate ? 18 : 16) + (l * 4 + n) * 64;
#pragma unroll
        for (int dt = 0; dt < 4; ++dt) {
            f32x4 acc = (f32x4){0.f, 0.f, 0.f, 0.f};
#pragma unroll
            for (int ks = 0; ks < 2; ++ks) {
                const bf16x8 wb = *(const LAS bf16x8*)(wt + (gate * 64 + 16 * dt + fr) * 72 + 32 * ks + 8 * fq);
                acc = __builtin_amdgcn_mfma_f32_16x16x32_bf16(xa[ks], wb, acc, 0, 0, 0);
            }
            const float bv = bias[16 * dt + fr];
#pragma unroll
            for (int i = 0; i < 4; ++i) pre[(gate * 64 + 16 * tt + 4 * fq + i) * 64 + 16 * dt + fr] = acc[i] + bv;
        }
    }
    __syncthreads();
    const int d = tid & 63, tq = tid >> 6;
    const float lam = in_of(p, 19)[l * 256 + n * 64 + d];
    const float sp = log1pf(expf(-lam));
    float hl[8], cl[8];
    float h = 0.f, ca = 1.f;
#pragma unroll
    for (int i = 0; i < 8; ++i) {
        const float r = __builtin_amdgcn_rcpf(1.0f + __expf(-pre[(tq * 8 + i) * 64 + d])), ii = __builtin_amdgcn_rcpf(1.0f + __expf(-pre[(64 + tq * 8 + i) * 64 + d]));
        const float la = -8.0f * r * sp;
        const float a = __expf(la);
        const float uu = __builtin_amdgcn_sqrtf(fmaxf(1.0f - a * a, 0.f)) * (ii * xc[(tq * 8 + i) * 64 + d]);
        h = a * h + uu; ca *= a; hl[i] = h; cl[i] = ca;
    }
    segA[tq * 64 + d] = ca; segH[tq * 64 + d] = h;
    __syncthreads();
    float cin_h = 0.f, cin_a = 1.f;
    for (int sgi = 0; sgi < tq; ++sgi) { const float sa = segA[sgi * 64 + d]; cin_h = sa * cin_h + segH[sgi * 64 + d]; cin_a *= sa; }
    float* LH = (float*)(ws_of(p) + WS_LRUH); float* LA = (float*)(ws_of(p) + WS_LRUA);
#pragma unroll
    for (int i = 0; i < 8; ++i) {
        const size_t o = (size_t)(rowbase + t0 + tq * 8 + i) * 256 + n * 64 + d;
        LH[o] = hl[i] + cl[i] * cin_h; LA[o] = cl[i] * cin_a;
    }
    __syncthreads();
}

__device__ __forceinline__ float logsigmoidf_(float x) { return fminf(x, 0.f) - log1pf(expf(-fabsf(x))); }

__device__ __forceinline__ int vt_off(int d, int key, int pitch) {
    const int kc = key >> 3;
    return d * pitch + ((((kc ^ (d >> 3)) & 7) | (kc & ~7)) << 3) + (key & 7);
}
__device__ void ml_x_item(const Params& p, int l, int bh, int ck, LAS unsigned char* lds) {
    const int tid = opaque_tid(), lane = tid & 63, w = __builtin_amdgcn_readfirstlane(tid >> 6), fr = lane & 15, fq = lane >> 4;
    const int b = bh >> 2, hh = bh & 3;
    LAS bf16_t* KwT = (LAS bf16_t*)lds;
    LAS bf16_t* VT = (LAS bf16_t*)(lds + 9216);
    LAS float* wks = (LAS float*)(lds + 20736);
    const bf16_t* U = (const bf16_t*)(ws_of(p) + WS_U);
    const float* GT = (const float*)(ws_of(p) + WS_GATES);
    const int rowbase = b * SEQ + ck * 64;
    if (tid < 64) {
        const float ig = GT[(size_t)(rowbase + lane) * 32 + 24 + hh] + in_of(p, 20)[l * 4 + hh];
        const float fp = GT[(size_t)(rowbase + lane) * 32 + 28 + hh] + in_of(p, 21)[l * 4 + hh];
        float a = logsigmoidf_(fp);
#pragma unroll
        for (int o = 1; o < 64; o <<= 1) { const float t = __shfl_up(a, o); if (lane >= o) a += t; }
        const float A = __shfl(a, 63);
        const float wend = A - a + ig;
        const float mu = wave_max(wend);
        wks[lane] = expf(wend - mu);
        if (lane == 0) { ((float*)(ws_of(p) + WS_MLMU))[bh * 32 + ck] = mu; ((float*)(ws_of(p) + WS_MLAT))[bh * 32 + ck] = A; }
    }
    const int srow = tid >> 3, sch = tid & 7;
    const bf16_t* src = U + (size_t)(rowbase + srow) * UW + hh * 64 + sch * 8;
    const u32x4 kk = *(const u32x4*)(src + 2048);
    {
        const u32x4 vv = *(const u32x4*)(src + 2304);
#pragma unroll
        for (int e = 0; e < 4; ++e) {
            VT[vt_off(sch * 8 + 2 * e, srow, 72)] = (bf16_t)(vv[e] & 0xffffu);
            VT[vt_off(sch * 8 + 2 * e + 1, srow, 72)] = (bf16_t)(vv[e] >> 16);
        }
        for (int idx = tid; idx < 16 * 72; idx += NTHREADS) VT[64 * 72 + idx] = (idx < 72) ? (bf16_t)0x3f80 : (bf16_t)0;
    }
    __syncthreads();
    {
        const float wk = wks[srow];
#pragma unroll
        for (int e = 0; e < 4; ++e) {
            KwT[vt_off(sch * 8 + 2 * e, srow, 72)] = f2bf(wk * __uint_as_float(kk[e] << 16));
            KwT[vt_off(sch * 8 + 2 * e + 1, srow, 72)] = f2bf(wk * __uint_as_float(kk[e] & 0xffff0000u));
        }
    }
    __syncthreads();
    {
        const int dt = w & 3, hf = w >> 2;
        bf16x8 ka[2];
#pragma unroll
        for (int ks = 0; ks < 2; ++ks) ka[ks] = *(const LAS bf16x8*)(KwT + vt_off(16 * dt + fr, 32 * ks + 8 * fq, 72));
        float* C = (float*)(ws_of(p) + WS_MLC) + (size_t)(bh * 32 + ck) * 4096;
#pragma unroll
        for (int ee = 0; ee < 2; ++ee) {
            const int et = 2 * hf + ee;
            f32x4 acc = (f32x4){0.f, 0.f, 0.f, 0.f};
#pragma unroll
            for (int ks = 0; ks < 2; ++ks) {
                const bf16x8 vb = *(const LAS bf16x8*)(VT + vt_off(16 * et + fr, 32 * ks + 8 * fq, 72));
                acc = __builtin_amdgcn_mfma_f32_16x16x32_bf16(ka[ks], vb, acc, 0, 0, 0);
            }
#pragma unroll
            for (int i = 0; i < 4; ++i) C[(16 * dt + 4 * fq + i) * 64 + 16 * et + fr] = acc[i];
        }
        if (hf == 0) {
            f32x4 acc = (f32x4){0.f, 0.f, 0.f, 0.f};
#pragma unroll
            for (int ks = 0; ks < 2; ++ks) {
                const bf16x8 vb = *(const LAS bf16x8*)(VT + (64 + fr) * 72 + 32 * ks + 8 * fq);
                acc = __builtin_amdgcn_mfma_f32_16x16x32_bf16(ka[ks], vb, acc, 0, 0, 0);
            }
            if (fr == 0) {
#pragma unroll
                for (int i = 0; i < 4; ++i) ((float*)(ws_of(p) + WS_MLN))[(size_t)(bh * 32 + ck) * 64 + 16 * dt + 4 * fq + i] = acc[i];
            }
        }
    }
    __syncthreads();
}

__device__ void phase_m2(const Params& p, int l, int cls, LAS unsigned char* lds, int bid, int G) {
    const int tid = opaque_tid();
    constexpr int N_KC = 128, N_LC = 4, N_MC = 256, N_MN = 4, TOTAL = N_KC + N_LC + N_MC + N_MN;
    for (int it = bid; it < TOTAL; it += G) {
        if (it < N_KC) {
            if (!(cls & 1)) continue;
            const int kv = it >> 6, r0 = (it & 63) * 32;
            LAS float* hid = (LAS float*)lds;
            LAS float* w2s = hid + 32 * 256;
            const float* part = (const float*)(ws_of(p) + WS_HID) + (size_t)(kv * 2048 + r0) * 256;
            const float* cb = (const float*)(ws_of(p) + WS_CBIAS) + (l * 2 + kv) * 256;
            const float* w2 = in_of(p, kv ? 12 : 9) + (size_t)l * 256 * 64;
            f32x4 pr[4][4];
#pragma unroll
            for (int rr = 0; rr < 4; ++rr) {
                const int idx = tid + rr * NTHREADS, row = idx >> 6, j4 = (idx & 63) * 4;
#pragma unroll
                for (int kp = 0; kp < 4; ++kp) pr[rr][kp] = *(const f32x4*)(part + (size_t)kp * 2 * 2048 * 256 + row * 256 + j4);
            }
#pragma unroll
            for (int rr = 0; rr < 4; ++rr) {
                const int idx = tid + rr * NTHREADS, row = idx >> 6, j4 = (idx & 63) * 4;
                f32x4 hv = *(const f32x4*)(cb + j4);
#pragma unroll
                for (int kp = 0; kp < 4; ++kp) hv = hv + pr[rr][kp];
#pragma unroll
                for (int q = 0; q < 4; ++q) hv[q] = hv[q] * __builtin_amdgcn_rcpf(1.0f + __expf(-hv[q]));
                *(LAS f32x4*)(hid + row * 256 + j4) = hv;
            }
#pragma unroll
            for (int rr = 0; rr < 8; ++rr) { const int idx = tid + rr * NTHREADS; *(LAS f32x4*)(w2s + idx * 4) = *(const f32x4*)(w2 + idx * 4); }
            __syncthreads();
            {
                const int d = tid & 63, rq = tid >> 6;
                float acc[4] = {0.f, 0.f, 0.f, 0.f};
                for (int j = 0; j < 256; j += 4) {
                    float wv[4];
#pragma unroll
                    for (int q = 0; q < 4; ++q) wv[q] = w2s[(j + q) * 64 + d];
#pragma unroll
                    for (int i = 0; i < 4; ++i) {
                        const f32x4 hv = *(const LAS f32x4*)(hid + (rq * 4 + i) * 256 + j);
#pragma unroll
                        for (int q = 0; q < 4; ++q) acc[i] += hv[q] * wv[q];
                    }
                }
                bf16_t* KCo = (bf16_t*)(ws_of(p) + WS_KC);
#pragma unroll
                for (int i = 0; i < 4; ++i) {
                    const int r = r0 + rq * 4 + i;
                    KCo[(size_t)(kv * 2048 + r) * 64 + d] = f2bf(((r & 127) == 127) ? 0.f : acc[i]);
                }
            }
            __syncthreads();
        } else if (it < N_KC + N_LC) {
            if (!(cls & 2)) continue;
            const int idx = (it - N_KC) * NTHREADS + tid;
            const int b = idx >> 8, ch = idx & 255;
            const float* LH = (const float*)(ws_of(p) + WS_LRUH); const float* LA = (const float*)(ws_of(p) + WS_LRUA);
            float* LC = (float*)(ws_of(p) + WS_LRUC);
            float la[32], lh[32];
#pragma unroll
            for (int ck = 0; ck < 32; ++ck) { const size_t o = (size_t)(b * SEQ + ck * 64 + 63) * 256 + ch; la[ck] = LA[o]; lh[ck] = LH[o]; }
            float carry = 0.f;
#pragma unroll
            for (int ck = 0; ck < 32; ++ck) { LC[(b * 32 + ck) * 256 + ch] = carry; carry = la[ck] * carry + lh[ck]; }
        } else {
            if (!(cls & 4)) continue;
            const bool isn = it >= N_KC + N_LC + N_MC;
            const int idx = (it - N_KC - N_LC - (isn ? N_MC : 0)) * NTHREADS + tid;
            const int bh = isn ? (idx >> 6) : (idx >> 12), de = isn ? (idx & 63) : (idx & 4095);
            const int esz = isn ? 64 : 4096;
            float* buf = (float*)(ws_of(p) + (isn ? WS_MLN : WS_MLC)) + (size_t)bh * 32 * esz + de;
            const float* MU = (const float*)(ws_of(p) + WS_MLMU) + bh * 32; const float* AT = (const float*)(ws_of(p) + WS_MLAT) + bh * 32;
            float* MP = (float*)(ws_of(p) + WS_MLMP) + bh * 32;
            float dc[32];
#pragma unroll
            for (int ck = 0; ck < 32; ++ck) dc[ck] = buf[(size_t)ck * esz];
            float C = 0.f, m = 0.f;
#pragma unroll
            for (int ck = 0; ck < 32; ++ck) {
                buf[(size_t)ck * esz] = C;
                if (!isn && de == 0) MP[ck] = m;
                const float at = AT[ck], mu = MU[ck];
                const float mn = fmaxf(at + m, mu);
                C = expf(at + m - mn) * C + expf(mu - mn) * dc[ck];
                m = mn;
            }
        }
    }
}

__device__ __forceinline__ float gelu_tanh(float x) { const float u = 0.7978845608028654f * (x + 0.044715f * x * x * x); return 0.5f * x * (1.0f + tanhf(u)); }

__device__ void lru_y_item(const Params& p, int l, int item) {
    const int tid = opaque_tid(), lane = tid & 63;
    const float* LH = (const float*)(ws_of(p) + WS_LRUH); const float* LA = (const float*)(ws_of(p) + WS_LRUA); const float* LC = (const float*)(ws_of(p) + WS_LRUC);
    const bf16_t* U = (const bf16_t*)(ws_of(p) + WS_U);
    const float* hn = in_of(p, 22) + l * 1024;
    bf16_t* HD = (bf16_t*)(ws_of(p) + WS_HEADS);
    const int pair0 = item * 128 + (tid >> 6) * 16;
    float lh[16], la[16], lc[16]; bf16_t gg[16];
    float gn[4];
#pragma unroll
    for (int n = 0; n < 4; ++n) gn[n] = hn[(8 + n) * 64 + lane];
#pragma unroll
    for (int q = 0; q < 16; ++q) {
        const int pair = pair0 + q, row = pair >> 2, n = pair & 3, ch = n * 64 + lane;
        lh[q] = LH[(size_t)row * 256 + ch]; la[q] = LA[(size_t)row * 256 + ch];
        lc[q] = LC[((row >> 11) * 32 + ((row & 2047) >> 6)) * 256 + ch];
        gg[q] = U[(size_t)row * UW + 1536 + ch];
    }
#pragma unroll
    for (int q = 0; q < 16; ++q) {
        const int pair = pair0 + q, row = pair >> 2, n = pair & 3;
        const float h = lh[q] + la[q] * lc[q];
        const float y = h * gelu_tanh(bf2f(gg[q]));
        const float ss = wave_sum(y * y);
        HD[(size_t)row * DM + (8 + n) * 64 + lane] = f2bf(y * rsqrtf(ss * (1.0f / 64.0f) + EPS) * gn[q & 3]);
    }
}

__device__ __forceinline__ int vt_lane(int fr, int fq, int pitch) { return fr * pitch + ((((fq >> 1) ^ (fr >> 3)) & 1) << 3) + ((fq & 1) << 2); }
__device__ __forceinline__ constexpr int vt_cst(int dt, int kc2, int pitch) { return dt * 16 * pitch + ((((kc2 ^ (2 * dt)) & 6) | (kc2 & ~7)) << 3); }
__device__ void ml_y_item(const Params& p, int l, int bh, int ck, LAS unsigned char* lds) {
    const int tid = opaque_tid(), lane = tid & 63, w = __builtin_amdgcn_readfirstlane(tid >> 6), fr = lane & 15, fq = lane >> 4;
    const int b = bh >> 2, hh = bh & 3;
    LAS bf16_t* Ql = (LAS bf16_t*)lds;
    LAS bf16_t* Kl = (LAS bf16_t*)(lds + 9216);
    LAS bf16_t* Vt = (LAS bf16_t*)(lds + 18432);
    LAS bf16_t* Ct = (LAS bf16_t*)(lds + 27648);
    LAS bf16_t* Wl = (LAS bf16_t*)(lds + 39168);
    LAS float* as_ = (LAS float*)(lds + 57600);
    LAS float* bs_ = as_ + 64;
    LAS float* Ms_ = bs_ + 64;
    LAS float* ssl = Ms_ + 64;
    const bf16_t* U = (const bf16_t*)(ws_of(p) + WS_U);
    const float* GT = (const float*)(ws_of(p) + WS_GATES);
    const int rowbase = b * SEQ + ck * 64;
    const float mprev = ((const float*)(ws_of(p) + WS_MLMP))[bh * 32 + ck];
    if (tid < 64) {
        const float ig = GT[(size_t)(rowbase + lane) * 32 + 24 + hh] + in_of(p, 20)[l * 4 + hh];
        const float fp = GT[(size_t)(rowbase + lane) * 32 + 28 + hh] + in_of(p, 21)[l * 4 + hh];
        float a = logsigmoidf_(fp);
#pragma unroll
        for (int o = 1; o < 64; o <<= 1) { const float t = __shfl_up(a, o); if (lane >= o) a += t; }
        const float bb = ig - a;
        float pm = bb;
#pragma unroll
        for (int o = 1; o < 64; o <<= 1) { const float t = __shfl_up(pm, o); if (lane >= o) pm = fmaxf(pm, t); }
        as_[lane] = a; bs_[lane] = bb; Ms_[lane] = fmaxf(mprev, pm);
        Ct[64 * 72 + lane] = f2bf(((const float*)(ws_of(p) + WS_MLN))[(size_t)(bh * 32 + ck) * 64 + lane]);
    }
    {
        const int row = tid >> 3, ch = tid & 7;
        const bf16_t* src = U + (size_t)(rowbase + row) * UW + hh * 64 + ch * 8;
        *(LAS u32x4*)(Ql + row * 72 + ch * 8) = *(const u32x4*)(src + 1792);
        *(LAS u32x4*)(Kl + row * 72 + ch * 8) = *(const u32x4*)(src + 2048);
        const u32x4 vv = *(const u32x4*)(src + 2304);
#pragma unroll
        for (int e = 0; e < 4; ++e) {
            Vt[vt_off(ch * 8 + 2 * e, row, 72)] = (bf16_t)(vv[e] & 0xffffu);
            Vt[vt_off(ch * 8 + 2 * e + 1, row, 72)] = (bf16_t)(vv[e] >> 16);
        }
        const float* C = (const float*)(ws_of(p) + WS_MLC) + (size_t)(bh * 32 + ck) * 4096;
#pragma unroll
        for (int rr = 0; rr < 2; ++rr) {
            const int idx = tid + rr * NTHREADS, d = idx >> 4, e4 = (idx & 15) * 4;
            const f32x4 c = *(const f32x4*)(C + d * 64 + e4);
#pragma unroll
            for (int i = 0; i < 4; ++i) Ct[(e4 + i) * 72 + d] = f2bf(c[i]);
        }
        for (int idx = tid; idx < 15 * 72; idx += NTHREADS) Ct[65 * 72 + idx] = 0;
    }
    __syncthreads();
    const int jt = w & 3, hf = w >> 2;
    bf16_t opre[2][4];
#pragma unroll
    for (int i = 0; i < 4; ++i)
#pragma unroll
        for (int ee = 0; ee < 2; ++ee) opre[ee][i] = U[(size_t)(rowbase + 16 * jt + 4 * fq + i) * UW + 2560 + hh * 64 + 16 * (2 * hf + ee) + fr];
    bf16x8 qa[2];
#pragma unroll
    for (int ks = 0; ks < 2; ++ks) qa[ks] = *(const LAS bf16x8*)(Ql + (16 * jt + fr) * 72 + 32 * ks + 8 * fq);
    f32x4 sacc[4];
#pragma unroll
    for (int st = 0; st < 4; ++st) {
        const bf16x8 k0 = *(const LAS bf16x8*)(Kl + (16 * st + fr) * 72 + 8 * fq), k1 = *(const LAS bf16x8*)(Kl + (16 * st + fr) * 72 + 32 + 8 * fq);
        sacc[st] = __builtin_amdgcn_mfma_f32_16x16x32_bf16(qa[0], k0, (f32x4){0.f, 0.f, 0.f, 0.f}, 0, 0, 0);
        sacc[st] = __builtin_amdgcn_mfma_f32_16x16x32_bf16(qa[1], k1, sacc[st], 0, 0, 0);
    }
    float sw[4], Mj[4];
    LAS bf16_t* Ww = Wl + w * (16 * 72);
#pragma unroll
    for (int i = 0; i < 4; ++i) {
        const int j = 16 * jt + 4 * fq + i;
        Mj[i] = Ms_[j];
        float acc = 0.f;
#pragma unroll
        for (int st = 0; st < 4; ++st) {
            const int sidx = 16 * st + fr;
            const float wv = (sidx <= j) ? __expf(bs_[sidx] - Mj[i]) * sacc[st][i] : 0.f;
            acc += wv;
            Ww[(4 * fq + i) * 72 + sidx] = f2bf(wv);
        }
        acc += __shfl_xor(acc, 1); acc += __shfl_xor(acc, 2); acc += __shfl_xor(acc, 4); acc += __shfl_xor(acc, 8);
        sw[i] = acc;
    }
    asm volatile("s_waitcnt lgkmcnt(0)" ::: "memory");
    bf16x8 wa[2];
#pragma unroll
    for (int ks = 0; ks < 2; ++ks) wa[ks] = *(const LAS bf16x8*)(Ww + fr * 72 + 32 * ks + 8 * fq);
    f32x4 acc1[2], acc2[2], accn;
#pragma unroll
    for (int ee = 0; ee < 2; ++ee) {
        const int et = 2 * hf + ee;
        acc1[ee] = (f32x4){0.f, 0.f, 0.f, 0.f}; acc2[ee] = (f32x4){0.f, 0.f, 0.f, 0.f};
#pragma unroll
        for (int ks = 0; ks < 2; ++ks) {
            const bf16x8 cf = *(const LAS bf16x8*)(Ct + (16 * et + fr) * 72 + 32 * ks + 8 * fq);
            const bf16x8 vf = *(const LAS bf16x8*)(Vt + vt_off(16 * et + fr, 32 * ks + 8 * fq, 72));
            acc1[ee] = __builtin_amdgcn_mfma_f32_16x16x32_bf16(qa[ks], cf, acc1[ee], 0, 0, 0);
            acc2[ee] = __builtin_amdgcn_mfma_f32_16x16x32_bf16(wa[ks], vf, acc2[ee], 0, 0, 0);
        }
    }
    accn = (f32x4){0.f, 0.f, 0.f, 0.f};
#pragma unroll
    for (int ks = 0; ks < 2; ++ks) {
        const bf16x8 cf = *(const LAS bf16x8*)(Ct + (64 + fr) * 72 + 32 * ks + 8 * fq);
        accn = __builtin_amdgcn_mfma_f32_16x16x32_bf16(qa[ks], cf, accn, 0, 0, 0);
    }
    float ov[2][4];
#pragma unroll
    for (int i = 0; i < 4; ++i) {
        const int j = 16 * jt + 4 * fq + i;
        const float qn = __shfl(accn[i], lane & 48);
        const float inter = expf(mprev - Mj[i]);
        const float den = inter * qn + sw[i];
        const float lim = expf(-(as_[j] + Mj[i]));
        const float inv = 1.0f / fmaxf(fabsf(den), lim);
        float ssp = 0.f;
#pragma unroll
        for (int ee = 0; ee < 2; ++ee) {
            const int e = 16 * (2 * hf + ee) + fr;
            const float hv = (inter * acc1[ee][i] + acc2[ee][i]) * inv;
            const float o = sigmoidf_(bf2f(opre[ee][i])) * hv;
            ov[ee][i] = o; ssp += o * o;
        }
        ssp += __shfl_xor(ssp, 1); ssp += __shfl_xor(ssp, 2); ssp += __shfl_xor(ssp, 4); ssp += __shfl_xor(ssp, 8);
        if (fr == 0) ssl[w * 16 + 4 * fq + i] = ssp;
    }
    __syncthreads();
    {
        bf16_t* HD = (bf16_t*)(ws_of(p) + WS_HEADS);
        const float* hn = in_of(p, 22) + l * 1024 + (12 + hh) * 64;
#pragma unroll
        for (int i = 0; i < 4; ++i) {
            const int j = 16 * jt + 4 * fq + i;
            const float tot = ssl[jt * 16 + 4 * fq + i] + ssl[(jt + 4) * 16 + 4 * fq + i];
            const float rs = rsqrtf(tot * (1.0f / 64.0f) + EPS);
#pragma unroll
            for (int ee = 0; ee < 2; ++ee) {
                const int e = 16 * (2 * hf + ee) + fr;
                HD[(size_t)(rowbase + j) * DM + (12 + hh) * 64 + e] = f2bf(ov[ee][i] * rs * hn[e]);
            }
        }
    }
    __syncthreads();
}

__device__ __forceinline__ bf16x8 pack8(const f32x4 lo, const f32x4 hi) {
    u32x4 r; r.x = cvt_pk_bf16(lo[0], lo[1]); r.y = cvt_pk_bf16(lo[2], lo[3]); r.z = cvt_pk_bf16(hi[0], hi[1]); r.w = cvt_pk_bf16(hi[2], hi[3]);
    return __builtin_bit_cast(bf16x8, r);
}
__device__ __forceinline__ bf16x8 join8(const u32x2 lo, const u32x2 hi) { u32x4 r; r.x = lo.x; r.y = lo.y; r.z = hi.x; r.w = hi.y; return __builtin_bit_cast(bf16x8, r); }
__device__ void nsa_item(const Params& p, int l, int b, int g, int qb, LAS unsigned char* lds, int mode = 0) {
    int tid = opaque_tid(), w = __builtin_amdgcn_readfirstlane(tid >> 6), lane = tid & 63, fr = lane & 15, fq = lane >> 4;
    LAS bf16_t* Kc = (LAS bf16_t*)lds;
    LAS bf16_t* Vc = (LAS bf16_t*)(lds + 18432);
    LAS bf16_t* Pl = (LAS bf16_t*)(lds + 36864);
    LAS float* impl = (LAS float*)(lds + 106496);
    LAS unsigned* selm = (LAS unsigned*)(lds + 114688);
    LAS int* steps = (LAS int*)(lds + 114944);
    const bf16_t* U = (const bf16_t*)(ws_of(p) + WS_U);
    const int bg = b * 2 + g, rowbase = b * SEQ;
    const int head = 4 * g + (w >> 1);
    const float sl2 = exp2f(-(float)(head + 1)) * 1.4426950408889634f;
    const int tw0 = qb * 64 + (w & 1) * 32;
    bf16x8 qf[2][2];
#pragma unroll
    for (int mt = 0; mt < 2; ++mt)
#pragma unroll
        for (int ks = 0; ks < 2; ++ks)
            qf[mt][ks] = *(const bf16x8*)(U + (size_t)(rowbase + tw0 + mt * 16 + fr) * UW + head * 64 + ks * 32 + fq * 8);
    const float* GT = (const float*)(ws_of(p) + WS_GATES);
    float gpre[2][3];
#pragma unroll
    for (int mt = 0; mt < 2; ++mt)
#pragma unroll
        for (int q = 0; q < 3; ++q) gpre[mt][q] = GT[(size_t)(rowbase + tw0 + mt * 16 + fr) * 32 + head * 3 + q];
    f32x4 y[2][4];
    {
        LAS float* impM = (LAS float*)Pl;
        LAS float* impT = impM + 4 * 64 * 33;
        const bf16_t* KC = (const bf16_t*)(ws_of(p) + WS_KC) + (size_t)bg * 128 * 64;
        const bf16_t* VC = KC + (size_t)2048 * 64;
        u32x4 kvr[2], vvr[2];
#pragma unroll
        for (int rr = 0; rr < 2; ++rr) { const int idx = tid + rr * NTHREADS; kvr[rr] = *(const u32x4*)(KC + idx * 8); vvr[rr] = *(const u32x4*)(VC + idx * 8); }
#pragma unroll
        for (int rr = 0; rr < 2; ++rr) {
            const int idx = tid + rr * NTHREADS, key = idx >> 3, ch = idx & 7;
            const u32x4 kv = kvr[rr];
            const u32x4 vv = vvr[rr];
            *(LAS u32x4*)(Kc + key * 72 + ch * 8) = kv;
#pragma unroll
            for (int e = 0; e < 4; ++e) {
                Vc[vt_off(ch * 8 + 2 * e, key, 136)] = (bf16_t)(vv[e] & 0xffffu);
                Vc[vt_off(ch * 8 + 2 * e + 1, key, 136)] = (bf16_t)(vv[e] >> 16);
            }
        }
        __syncthreads();
        const int vl136 = vt_lane(fr, fq, 136);
#pragma unroll
        for (int mt = 0; mt < 2; ++mt) {
            const int t = tw0 + mt * 16 + fr;
            f32x4 s[8];
#pragma unroll
            for (int nt = 0; nt < 8; ++nt) {
                const bf16x8 k0 = *(const LAS bf16x8*)(Kc + (16 * nt + fr) * 72 + fq * 8), k1 = *(const LAS bf16x8*)(Kc + (16 * nt + fr) * 72 + 32 + fq * 8);
                s[nt] = __builtin_amdgcn_mfma_f32_16x16x32_bf16(k0, qf[mt][0], (f32x4){0.f, 0.f, 0.f, 0.f}, 0, 0, 0);
                s[nt] = __builtin_amdgcn_mfma_f32_16x16x32_bf16(k1, qf[mt][1], s[nt], 0, 0, 0);
            }
            float mx = NEGF;
#pragma unroll
            for (int nt = 0; nt < 8; ++nt)
#pragma unroll
                for (int i = 0; i < 4; ++i) {
                    const int n = 16 * nt + 4 * fq + i, cend = 16 * n + 31;
                    const bool valid = (t >= cend) && (n < 127);
                    const float sv = valid ? fmaf(sl2, (float)cend, s[nt][i]) : NEGF;
                    s[nt][i] = sv; mx = fmaxf(mx, sv);
                }
            mx = fq_max(mx);
            const float ms = (mx < -1e29f) ? 0.f : mx;
            float sum = 0.f;
#pragma unroll
            for (int nt = 0; nt < 8; ++nt)
#pragma unroll
                for (int i = 0; i < 4; ++i) { const float pv = __builtin_amdgcn_exp2f(s[nt][i] - ms); s[nt][i] = pv; sum += pv; }
            sum = fq_sum(sum);
            const float inv = sum > 0.f ? 1.0f / sum : 0.f;
            {
                LAS float* mrow_ = impM + ((w >> 1) * 64 + (w & 1) * 32 + mt * 16 + fr) * 33 + fq;
                LAS float* trow_ = impT + ((w >> 1) * 64 + (w & 1) * 32 + mt * 16 + fr) * 33 + fq + 1;
#pragma unroll
                for (int nt = 0; nt < 8; ++nt) {
                    s[nt] = s[nt] * inv;
                    mrow_[4 * nt] = (s[nt][0] + s[nt][1]) + (s[nt][2] + s[nt][3]);
                    trow_[4 * nt] = s[nt][3];
                }
            }
            f32x4 oc[4];
#pragma unroll
            for (int dt = 0; dt < 4; ++dt) oc[dt] = (f32x4){0.f, 0.f, 0.f, 0.f};
#pragma unroll
            for (int ks2 = 0; ks2 < 4; ++ks2) {
                const bf16x8 pb = pack8(s[2 * ks2], s[2 * ks2 + 1]);
#pragma unroll
                for (int dt = 0; dt < 4; ++dt) {
                    const u32x2 lo = *(const LAS u32x2*)(Vc + vl136 + vt_cst(dt, 4 * ks2, 136));
                    const u32x2 hi = *(const LAS u32x2*)(Vc + vl136 + vt_cst(dt, 4 * ks2 + 2, 136));
                    oc[dt] = __builtin_amdgcn_mfma_f32_16x16x32_bf16(join8(lo, hi), pb, oc[dt], 0, 0, 0);
                }
            }
            const float g0 = sigmoidf_(gpre[mt][0]);
#pragma unroll
            for (int dt = 0; dt < 4; ++dt) y[mt][dt] = oc[dt] * g0;
        }
        if (tid < 256) impT[tid * 33] = 0.f;
        __syncthreads();
#pragma unroll 1
        for (int rr = 0; rr < 4; ++rr) {
            const int idx = tid + rr * NTHREADS, tau = idx >> 5, j = idx & 31;
            float mine = 0.f;
#pragma unroll
            for (int hh = 0; hh < 4; ++hh) mine += impM[(hh * 64 + tau) * 33 + j] + impT[(hh * 64 + tau) * 33 + j];
            bool sel;
            if (qb < 16) sel = (j <= qb);
            else {
                const bool forced = (j == 0) || (j == qb) || (j == qb - 1);
                const bool cand = (j >= 1) && (j <= qb - 2);
                int rank = 0;
#pragma unroll
                for (int jp = 1; jp < 30; ++jp) {
                    const float o = __shfl(mine, (lane & 32) + jp);
                    rank += (jp <= qb - 2 && (o > mine || (o == mine && jp < j))) ? 1 : 0;
                }
                sel = forced || (cand && rank < 13);
            }
            const unsigned long long bal = __ballot(sel);
            if ((lane & 31) == 0) selm[tau] = (lane < 32) ? (unsigned)bal : (unsigned)(bal >> 32);
        }
        __syncthreads();
        if (tid < 64) {
            unsigned m = selm[tid], uni = m, all = m;
#pragma unroll
            for (int o = 32; o >= 1; o >>= 1) { uni |= __shfl_xor(uni, o); all &= __shfl_xor(all, o); }
            uni &= (qb >= 31) ? 0xffffffffu : ((2u << qb) - 1u);
            const int nsel = __popc(uni);
            const int kb = tid;
            if (kb <= qb && ((uni >> kb) & 1u)) {
                const int pos = nsel - 1 - __popc(uni & ((1u << kb) - 1u));
                steps[1 + pos] = ((((all >> kb) & 1u) && kb < qb) ? 4096 : 0) | (1 << 8) | kb;
            }
            const int kb0 = (qb - 8 < 0) ? 0 : qb - 8;
            if (kb >= kb0 && kb <= qb) steps[1 + nsel + (qb - kb)] = ((kb > qb - 8 && kb < qb) ? 4096 : 0) | (2 << 8) | kb;
            if (tid == 0) steps[0] = nsel + (qb - kb0 + 1);
        }
        __syncthreads();
    }
    if (mode == 1) { asm volatile("" :: "v"(y[0][0][0]), "v"(y[1][3][3])); __syncthreads(); return; }
    tid = opaque_tid(); w = __builtin_amdgcn_readfirstlane(tid >> 6); lane = tid & 63; fr = lane & 15; fq = lane >> 4;
    unsigned smask[2];
#pragma unroll
    for (int mt = 0; mt < 2; ++mt) smask[mt] = selm[(w & 1) * 32 + mt * 16 + fr];
    const int nsteps = __builtin_amdgcn_readfirstlane(steps[0]);
    const int mystep = steps[1 + (lane < 48 ? lane : 47)];
#define NSA_ST(k) __builtin_amdgcn_readlane(mystep, (k))
    float mrow[2], lrow[2];
    f32x4 oacc[2][4];
#pragma unroll
    for (int mt = 0; mt < 2; ++mt) {
        mrow[mt] = NEGF; lrow[mt] = 0.f;
#pragma unroll
        for (int dt = 0; dt < 4; ++dt) oacc[mt][dt] = (f32x4){0.f, 0.f, 0.f, 0.f};
    }
    const int skey = tid >> 3, sch = tid & 7;
    const int vl72 = vt_lane(fr, fq, 72);
    const int vsw = vt_off(sch * 8, skey, 72);
    bf16x8 kx[4], qx;
    {
        const float sh = bf2f(f2bf(sl2)), slo = sl2 - sh;
        u32x4 t = (u32x4){0u, 0u, 0u, 0u};
        if (fq == 0) t.x = cvt_pk_bf16(sh, slo);
        qx = __builtin_bit_cast(bf16x8, t);
#pragma unroll
        for (int nt = 0; nt < 4; ++nt) {
            u32x4 k = (u32x4){0u, 0u, 0u, 0u};
            const float r = (float)(16 * nt + fr);
            if (fq == 0) k.x = cvt_pk_bf16(r, r);
            kx[nt] = __builtin_bit_cast(bf16x8, k);
        }
    }
    const bf16_t* Ubase = U + (size_t)(rowbase + skey) * UW + g * 64 + sch * 8;
#define NSA_SRC(st_) (Ubase + (size_t)((st_) & 255) * 64 * UW + ((((st_) >> 8) & 15) == 1 ? 768 : 1024))
#define NSA_STAGE(buf_, kr_, vr_) do { \
        *(LAS u32x4*)(Kc + (buf_) * (64 * 72) + skey * 72 + sch * 8) = kr_; \
        LAS bf16_t* _vn = Vc + (buf_) * (64 * 72) + vsw; \
        _Pragma("unroll") for (int e = 0; e < 4; ++e) { _vn[(2 * e) * 72] = (bf16_t)(vr_[e] & 0xffffu); _vn[(2 * e + 1) * 72] = (bf16_t)(vr_[e] >> 16); } } while (0)
    u32x4 kregA, vregA;
    {
        const bf16_t* src = NSA_SRC(NSA_ST(0));
        kregA = *(const u32x4*)src; vregA = *(const u32x4*)(src + 128);
        NSA_STAGE(0, kregA, vregA);
    }
    if (nsteps > 1) { const bf16_t* src = NSA_SRC(NSA_ST(1)); kregA = *(const u32x4*)src; vregA = *(const u32x4*)(src + 128); }
    __syncthreads();
    int curkind = 1;
#define NSA_STEP(si, kX, vX) do { \
        const int st = NSA_ST(si), kind = (st >> 8) & 15, kb = st & 255; \
        const bool nomask = (st & 4096) != 0; \
        LAS bf16_t* Kl = Kc + ((si) & 1) * (64 * 72); \
        LAS bf16_t* Vt = Vc + ((si) & 1) * (64 * 72); \
        if (kind != curkind) { \
            _Pragma("unroll") for (int mt = 0; mt < 2; ++mt) { \
                float lt = lrow[mt]; \
                lt = fq_sum(lt); \
                const float sc = sigmoidf_(gpre[mt][1]) / lt; \
                _Pragma("unroll") for (int dt = 0; dt < 4; ++dt) { y[mt][dt] += oacc[mt][dt] * sc; oacc[mt][dt] = (f32x4){0.f, 0.f, 0.f, 0.f}; } \
                mrow[mt] = NEGF; lrow[mt] = 0.f; \
            } \
            curkind = kind; \
        } \
        const float Bs = sl2 * (float)(kb * 64); \
        int kbi = kb * 64 + 4 * fq; \
        asm volatile("" : "+v"(kbi)); \
        f32x4 s[2][4]; \
        _Pragma("unroll") for (int nt = 0; nt < 4; ++nt) { \
            const bf16x8 k0 = *(const LAS bf16x8*)(Kl + (16 * nt + fr) * 72 + fq * 8), k1 = *(const LAS bf16x8*)(Kl + (16 * nt + fr) * 72 + 32 + fq * 8); \
            _Pragma("unroll") for (int mt = 0; mt < 2; ++mt) { \
                s[mt][nt] = __builtin_amdgcn_mfma_f32_16x16x32_bf16(k0, qf[mt][0], (f32x4){0.f, 0.f, 0.f, 0.f}, 0, 0, 0); \
                s[mt][nt] = __builtin_amdgcn_mfma_f32_16x16x32_bf16(k1, qf[mt][1], s[mt][nt], 0, 0, 0); \
                s[mt][nt] = __builtin_amdgcn_mfma_f32_16x16x32_bf16(kx[nt], qx, s[mt][nt], 0, 0, 0); \
            } \
        } \
        bf16x8 pb[2][2]; \
        _Pragma("unroll") for (int mt = 0; mt < 2; ++mt) { \
            float mx = NEGF; \
            if (nomask) { \
                _Pragma("unroll") for (int nt = 0; nt < 4; ++nt) \
                    _Pragma("unroll") for (int i = 0; i < 4; ++i) mx = fmaxf(mx, s[mt][nt][i]); \
            } else { \
                const int t = tw0 + mt * 16 + fr; \
                const bool rowok = (kind == 1) ? (((smask[mt] >> kb) & 1u) != 0u) : true; \
                _Pragma("unroll") for (int nt = 0; nt < 4; ++nt) \
                    _Pragma("unroll") for (int i = 0; i < 4; ++i) { \
                        const int dist = t - (kbi + 16 * nt + i); \
                        const bool valid = rowok && dist >= 0 && (kind == 1 || dist < 512); \
                        const float sv = valid ? s[mt][nt][i] : NEGF; \
                        s[mt][nt][i] = sv; mx = fmaxf(mx, sv); \
                    } \
            } \
            mx = fq_max(mx) + Bs; \
            const bool grow = __builtin_amdgcn_ballot_w64(mx > mrow[mt] + 8.0f) != 0ull;     \
            if (grow) { \
                const float mn_ = fmaxf(mrow[mt], mx); \
                const float alpha = __builtin_amdgcn_exp2f(mrow[mt] - mn_); \
                mrow[mt] = mn_; lrow[mt] *= alpha; \
                _Pragma("unroll") for (int dt = 0; dt < 4; ++dt) oacc[mt][dt] = oacc[mt][dt] * alpha; \
            } \
            const float mn = mrow[mt]; \
            const float ms = ((mn < -1e29f) ? 0.f : mn) - Bs; \
            float ls = 0.f; \
            _Pragma("unroll") for (int nt = 0; nt < 4; ++nt) \
                _Pragma("unroll") for (int i = 0; i < 4; ++i) { const float pv = __builtin_amdgcn_exp2f(s[mt][nt][i] - ms); s[mt][nt][i] = pv; ls += pv; } \
            lrow[mt] += ls; \
            pb[mt][0] = pack8(s[mt][0], s[mt][1]); pb[mt][1] = pack8(s[mt][2], s[mt][3]); \
        } \
        _Pragma("unroll") for (int ks2 = 0; ks2 < 2; ++ks2) \
            _Pragma("unroll") for (int dt = 0; dt < 4; ++dt) { \
                const u32x2 lo = *(const LAS u32x2*)(Vt + vl72 + vt_cst(dt, 4 * ks2, 72)); \
                const u32x2 hi = *(const LAS u32x2*)(Vt + vl72 + vt_cst(dt, 4 * ks2 + 2, 72)); \
                const bf16x8 va = join8(lo, hi); \
                _Pragma("unroll") for (int mt = 0; mt < 2; ++mt) oacc[mt][dt] = __builtin_amdgcn_mfma_f32_16x16x32_bf16(va, pb[mt][ks2], oacc[mt][dt], 0, 0, 0); \
            } \
        if ((si) + 1 < nsteps) NSA_STAGE(((si) + 1) & 1, kX, vX); \
        if ((si) + 2 < nsteps) { const bf16_t* src = NSA_SRC(NSA_ST((si) + 2)); kX = *(const u32x4*)src; vX = *(const u32x4*)(src + 128); } \
        __syncthreads(); \
    } while (0)
    for (int si = 0; si < nsteps; ++si) {
        NSA_STEP(si, kregA, vregA);
    }
#undef NSA_STEP
#undef NSA_ST
#undef NSA_STAGE
#undef NSA_SRC
    tid = opaque_tid(); lane = tid & 63; fr = lane & 15; fq = lane >> 4;
    {
        const float* hn = in_of(p, 22) + l * 1024 + head * 64;
        bf16_t* HD = (bf16_t*)(ws_of(p) + WS_HEADS);
        f32x4 gnv[4];
#pragma unroll
        for (int dt = 0; dt < 4; ++dt) gnv[dt] = *(const f32x4*)(hn + 16 * dt + 4 * fq);
#pragma unroll
        for (int mt = 0; mt < 2; ++mt) {
            const int t = tw0 + mt * 16 + fr;
            float lt = lrow[mt];
            lt = fq_sum(lt);
            const float sc = sigmoidf_(gpre[mt][2]) / lt;
            float ss = 0.f;
            f32x4 yy[4];
#pragma unroll
            for (int dt = 0; dt < 4; ++dt) { yy[dt] = y[mt][dt] + oacc[mt][dt] * sc; ss += (yy[dt][0] * yy[dt][0] + yy[dt][1] * yy[dt][1]) + (yy[dt][2] * yy[dt][2] + yy[dt][3] * yy[dt][3]); }
            ss = fq_sum(ss);
            const float rs = rsqrtf(ss * (1.0f / 64.0f) + EPS);
#pragma unroll
            for (int dt = 0; dt < 4; ++dt) {
                const f32x4 gn = gnv[dt];
                const f32x4 o = yy[dt] * rs * gn;
                u32x2 pk; pk.x = cvt_pk_bf16(o[0], o[1]); pk.y = cvt_pk_bf16(o[2], o[3]);
                *(u32x2*)(HD + (size_t)(rowbase + t) * DM + head * 64 + 16 * dt + 4 * fq) = pk;
            }
        }
    }
    __syncthreads();
}

#define XB_TMO      128
#define XB_XCNT(j)  (256  + 64 * (j))
#define XB_XSUB(j)  (1280 + 64 * (j))
#define XB_XGEN(j)  (2304 + 64 * (j))
#define XB_TOP      3328
#define XB_TOPGEN   3392
#define XCD_BAR_WORDS 3456
#define XB_SPIN_CAP (1u << 22)
__device__ __forceinline__ unsigned xb_ld(unsigned* p)              { return __hip_atomic_load(p, __ATOMIC_RELAXED, __HIP_MEMORY_SCOPE_AGENT); }
__device__ __forceinline__ unsigned xb_add(unsigned* p, unsigned v) { return __hip_atomic_fetch_add(p, v, __ATOMIC_RELAXED, __HIP_MEMORY_SCOPE_AGENT); }
__device__ __forceinline__ unsigned xb_xcc_id() { return (unsigned)__builtin_amdgcn_s_getreg((3 << 11) | 20) & 0xFu; }
#define XB_SPIN(cond, bar) do { unsigned _sp = 0; while (cond) { __builtin_amdgcn_s_sleep(1); \
    if ((++_sp & 255u) == 0u) { if (xb_ld(&(bar)[XB_TMO])) break; if (_sp > XB_SPIN_CAP) { atomicAdd(&(bar)[XB_TMO], 1u); break; } } } } while (0)
struct XcdBarrier { unsigned* bar; unsigned x; volatile LAS unsigned* st; };
__device__ __forceinline__ XcdBarrier xcd_barrier_post(unsigned* bar, volatile LAS unsigned* st) {
    XcdBarrier b; b.bar = bar; b.x = xb_xcc_id(); b.st = st;
    if (threadIdx.x == 0) (void)xb_add(&bar[XB_XCNT(b.x)], 1u);
    return b;
}
__device__ __forceinline__ void xcd_barrier_complete(unsigned* bar, unsigned x, unsigned& nloc, unsigned& nx) {
    const unsigned G = gridDim.x * gridDim.y * gridDim.z;
    unsigned sum, cnt, mine, sp = 0u;
    for (;;) {
        sum = 0u; cnt = 0u; mine = 0u;
#pragma unroll
        for (unsigned j = 0; j < 16; ++j) { const unsigned c = xb_ld(&bar[XB_XCNT(j)]); sum += c; cnt += (c > 0u) ? 1u : 0u; mine = (j == x) ? c : mine; }
        if (sum == G) break;
        __builtin_amdgcn_s_sleep(1);
        if ((++sp & 255u) == 0u) { if (xb_ld(&bar[XB_TMO])) break; if (sp > XB_SPIN_CAP) { atomicAdd(&bar[XB_TMO], 1u); break; } }
    }
    nloc = mine > 0u ? mine : 1u; nx = cnt > 0u ? cnt : 1u;
}
__device__ __forceinline__ void xcd_barrier(const XcdBarrier& b) {
    asm volatile("s_waitcnt vmcnt(0)" ::: "memory");
    __syncthreads();
    if (threadIdx.x == 0) {
        unsigned* bar = b.bar;
        __builtin_amdgcn_s_waitcnt(0);
        unsigned nloc = b.st[0], nx = b.st[1];
        if (nloc == 0u) { xcd_barrier_complete(bar, b.x, nloc, nx); b.st[0] = nloc; b.st[1] = nx; }
        const unsigned old = xb_add(&bar[XB_XSUB(b.x)], 1u);
        const unsigned gen = old / nloc;
        if (old + 1u == (gen + 1u) * nloc) {
            __builtin_amdgcn_fence(__ATOMIC_RELEASE, "agent");
            asm volatile("s_waitcnt vmcnt(0)" ::: "memory");
            const unsigned og = xb_add(&bar[XB_TOP], 1u);
            const unsigned tg = og / nx;
            if (og + 1u == (tg + 1u) * nx) xb_add(&bar[XB_TOPGEN], 1u);
            else XB_SPIN(xb_ld(&bar[XB_TOPGEN]) == tg, bar);
            __builtin_amdgcn_fence(__ATOMIC_ACQUIRE, "agent");
            xb_add(&bar[XB_XGEN(b.x)], 1u);
            asm volatile("s_waitcnt vmcnt(0)" ::: "memory");
        } else {
            XB_SPIN(xb_ld(&bar[XB_XGEN(b.x)]) == gen, bar);
            __builtin_amdgcn_fence(__ATOMIC_ACQUIRE, "agent");
            asm volatile("s_waitcnt vmcnt(0)" ::: "memory");
        }
    }
    __syncthreads();
}

__global__ void __launch_bounds__(NTHREADS) hymba_fwd(Params p) {
    extern __shared__ __attribute__((aligned(16))) unsigned char lds_raw[];
    LAS unsigned char* lds = (LAS unsigned char*)lds_raw;
    cg::grid_group grid = cg::this_grid();
    volatile LAS unsigned* xbw = (volatile LAS unsigned*)(lds + LDS_BYTES - 16);
    if (threadIdx.x < 4) xbw[threadIdx.x] = 0u;
    __syncthreads();
    XcdBarrier xbar = xcd_barrier_post((unsigned*)(ws_of(p) + WS_BAR), xbw);
    if (p.ph_hi - p.ph_lo > 1) grid.sync();
    for (int ph = p.ph_lo; ph < p.ph_hi; ++ph) {
        int G = gridDim.x, bid = blockIdx.x;
        asm volatile("" : "+s"(G), "+s"(bid));
        const int tpx = opaque_tid();
        if (ph == 0) {
            if (PHEN(0)) prologue(p, lds, bid, G);
            if (REP_SUB == 100) { __syncthreads(); prologue(p, lds, bid, G); }
        } else if (ph == 37) { if (PHEN(10)) {
            const float* ssq = (const float*)(ws_of(p) + WS_SSQ) + (size_t)(12 & 1) * T_ * 16;
            float* outp = out_of(p);
            const f32x4 gn = *(const f32x4*)(in_of(p, 28) + (tpx & 255) * 4);
            for (int it = bid; it < T_ / 8; it += G) {
                f32x4 v[4], pa[4][4];
#pragma unroll
                for (int q = 0; q < 4; ++q) {
                    const int row = it * 8 + q * 2 + (tpx >> 8);
                    v[q] = *(const f32x4*)(outp + (size_t)row * DM + (tpx & 255) * 4);
#pragma unroll
                    for (int k = 0; k < 4; ++k) pa[q][k] = *(const f32x4*)(ssq + (size_t)row * 16 + 4 * k);
                }
#pragma unroll
                for (int q = 0; q < 4; ++q) {
                    const int row = it * 8 + q * 2 + (tpx >> 8);
                    const float sm = (((pa[q][0][0] + pa[q][0][1]) + (pa[q][0][2] + pa[q][0][3])) + ((pa[q][1][0] + pa[q][1][1]) + (pa[q][1][2] + pa[q][1][3]))) + (((pa[q][2][0] + pa[q][2][1]) + (pa[q][2][2] + pa[q][2][3])) + ((pa[q][3][0] + pa[q][3][1]) + (pa[q][3][2] + pa[q][3][3])));
                    const float r = rsqrtf(sm * (1.0f / DM) + EPS);
                    *(f32x4*)(outp + (size_t)row * DM + (tpx & 255) * 4) = v[q] * r * gn;
                }
            } }
        } else {
            const int l = (ph - 1) / 9, sub = (ph - 1) % 9;
            unsigned char* wl = ws_of(p) + WS_W + (size_t)l * LAYER_W;
            float* ssq = (float*)(ws_of(p) + WS_SSQ);
            bf16_t* HB = (bf16_t*)(ws_of(p) + WS_HB);
            bf16_t* UB = (bf16_t*)(ws_of(p) + WS_U);
            if (PHEN(1) && (sub == 0 || sub == 7)) {
                const bool second = sub == 7;
                pg8::Gemm g{HB, (const bf16_t*)(wl + (second ? LO_W13B : LO_W13A)), T_, NUP, DM, DM, DM};
                pg8::StaticOrder S; S.init(T_, NUP, G, bid);
                EpiSwiGLU E{UB, ssq + (size_t)((3 * l + (second ? 2 : 0)) & 1) * T_ * 16};
                pg8::gemm_phase(lds, g, S, E);
                if (REP_SUB == 0) { __syncthreads(); pg8::gemm_phase(lds, g, S, E); }
            } else if (PHEN(2) && (sub == 1 || sub == 8 || sub == 6)) {
                const bool wout = sub == 6, second = sub == 8;
                pg8::Gemm g;
                if (wout) g = pg8::Gemm{(const bf16_t*)(ws_of(p) + WS_HEADS), (const bf16_t*)(wl + LO_WOUT), T_, DM, DM, DM, DM};
                else g = pg8::Gemm{UB, (const bf16_t*)(wl + (second ? LO_W2B : LO_W2A)), T_, DM, DFF, DFF, DFF};
                pg8::StaticOrder S; S.init(T_, DM, G, bid);
                const float* resid = (l == 0 && sub == 1) ? in_of(p, 0) : out_of(p);
                const int nxt = 3 * l + (sub == 1 ? 1 : (sub == 6 ? 2 : 3));
                EpiResid E{resid, out_of(p), HB, ssq + (size_t)(nxt & 1) * T_ * 16, wout ? 1.0f : 0.5f};
                pg8::gemm_phase(lds, g, S, E);
                if (REP_SUB == 1) { __syncthreads(); EpiResid E2{out_of(p), out_of(p), HB, ssq + (size_t)(nxt & 1) * T_ * 16, 0.0f}; pg8::gemm_phase(lds, g, S, E2); }
            } else if (PHEN(3) && sub == 2) {
                if (bid < 2 && tpx < 256) {
                    const float* cbp = (const float*)(ws_of(p) + WS_CBP) + (size_t)((l * 2 + bid) * 32) * 256 + tpx;
                    float sb = 0.f;
#pragma unroll
                    for (int q = 0; q < 32; ++q) sb += cbp[q * 256];
                    ((float*)(ws_of(p) + WS_CBIAS))[(l * 2 + bid) * 256 + tpx] = sb;
                }
                pg8::Gemm g{HB, (const bf16_t*)(wl + LO_WIN), T_, NINP, DM, DM, DM};
                pg8::StaticOrder S; S.init(T_, NINP, G, bid);
                EpiWin E{UB, (bf16_t*)(ws_of(p) + WS_KCMP), (bf16_t*)(ws_of(p) + WS_VCMP), (float*)(ws_of(p) + WS_GATES), ssq + (size_t)((3 * l + 1) & 1) * T_ * 16};
                pg8::gemm_phase(lds, g, S, E);
                if (REP_SUB == 2) { __syncthreads(); pg8::gemm_phase(lds, g, S, E); }
            } else if (sub == 3) {
                const int ngemm = 64;
                for (int rep = 0; rep < (REP_SUB == 3 ? 2 : 1); ++rep) {
                const int cls = rep == 0 ? 7 : REP_CLASS;
                if (rep) __syncthreads();
                if (G > ngemm) {
                    if (bid < ngemm) { if (PHEN(4) && (cls & 1)) {
                        const int kp = bid >> 4, kv = (bid >> 3) & 1;
                        pg8::Gemm g{(const bf16_t*)(ws_of(p) + (kv ? WS_VCMP : WS_KCMP)) + kp * 512, (const bf16_t*)(wl + (kv ? LO_CW1V : LO_CW1K)) + kp * 512, 2048, 256, 512, 1024, 2048};
                        pg8::SingleUnit S{bid & 7};
                        EpiCmp E{(float*)(ws_of(p) + WS_HID) + (size_t)(kp * 2 + kv) * 2048 * 256};
                        pg8::gemm_phase(lds, g, S, E); }
                    }
                    if (PHEN(5)) {
                        const bool gb = bid < ngemm;
                        const int i0 = gb ? 1728 + bid : bid - ngemm, i1 = gb ? 2048 : 1728, st = gb ? ngemm : G - ngemm;
                        for (int it = i0; it < i1; it += st) {
                            if (it < 1024) { if (cls & 2) lru_x_item(p, l, it >> 7, (it >> 5) & 3, it & 31, lds); }
                            else if (cls & 4) ml_x_item(p, l, (it - 1024) >> 5, it & 31, lds);
                        }
                    }
                }
                }
            } else if (PHEN(6) && sub == 4) {
                phase_m2(p, l, 7, lds, bid, G);
                if (REP_SUB == 4) { __syncthreads(); phase_m2(p, l, REP_CLASS, lds, bid, G); }
            } else if (sub == 5) {
                for (int rep = 0; rep < (REP_SUB == 5 ? 2 : 1); ++rep) {
                const int cls = rep == 0 ? 7 : REP_CLASS;
                if (rep) __syncthreads();
                for (int it = bid; it < 512 + 1024 + 512; it += G) {
                    if (it < 512) { if (PHEN(7) && (cls & 1)) {
                        const int qb = it < 256 ? 31 - (it >> 4) : ((it - 256) >> 4), bg = it & 15;
                        nsa_item(p, l, bg >> 1, bg & 1, qb, lds, (rep == 1 && REP_CLASS == 9) ? 1 : 0); }
                    } else if (it < 1536) {
                        if (PHEN(8) && (cls & 2)) ml_y_item(p, l, (it - 512) >> 5, (it - 512) & 31, lds);
                    } else {
                        if (PHEN(9) && (cls & 4)) lru_y_item(p, l, it - 1536);
                    }
                }
                }
            }
        }
        if (ph + 1 < p.ph_hi) {
            xcd_barrier(xbar);
            if (REP_SUB == 200) xcd_barrier(xbar);
        }
    }
}

extern "C" void kernel_launch(void* const* d_in, const int* in_sizes, int n_in, void* d_out, int out_size, void* d_ws, size_t ws_size, hipStream_t stream) {
    static int grid = 0;
    if (grid == 0) {
        if (n_in != 29 || out_size != T_ * DM || ws_size < WS_END) { fprintf(stderr, "kernel_launch: unexpected shapes (n_in %d out %d ws %zu need %zu)\n", n_in, out_size, ws_size, (size_t)WS_END); grid = -1; return; }
        int dev = 0, cus = 0, per_cu = 0;
        hipGetDevice(&dev);
        hipDeviceGetAttribute(&cus, hipDeviceAttributeMultiprocessorCount, dev);
        hipFuncSetAttribute((const void*)hymba_fwd, hipFuncAttributeMaxDynamicSharedMemorySize, LDS_BYTES);
        hipOccupancyMaxActiveBlocksPerMultiprocessor(&per_cu, (const void*)hymba_fwd, NTHREADS, LDS_BYTES);
        if (per_cu < 1) { fprintf(stderr, "kernel_launch: occupancy query says %d blocks per CU\n", per_cu); per_cu = 1; }
        (void)hipGetLastError();
        grid = cus;
    }
    if (grid < 0) return;
    Params p{};
    for (int i = 0; i < 29; ++i) p.in[i] = (const float*)d_in[i];
    p.out = (float*)d_out; p.ws = (unsigned char*)d_ws;
#if ONE_LAUNCH
    (void)hipMemsetAsync((unsigned char*)d_ws + WS_BAR, 0, 16384, stream);
    p.ph_lo = 0; p.ph_hi = 38;
    void* args[] = {&p};
    hipError_t e = hipLaunchCooperativeKernel((const void*)hymba_fwd, dim3(grid), dim3(NTHREADS), args, LDS_BYTES, stream);
    if (e != hipSuccess) fprintf(stderr, "cooperative launch failed: %s (grid %d)\n", hipGetErrorString(e), grid);
#else
    for (int ph = 0; ph < 38; ++ph) {
        p.ph_lo = ph; p.ph_hi = ph + 1;
        hipLaunchKernelGGL(hymba_fwd, dim3(grid), dim3(NTHREADS), LDS_BYTES, stream, p);
    }
#endif
}
```

```cpp
#include <hip/hip_runtime.h>
#include <hip/hip_cooperative_groups.h>
#include <cstdio>
namespace cg = cooperative_groups;

#define LAS __attribute__((address_space(3)))
typedef unsigned short bf16_t;
typedef short bf16x8 __attribute__((ext_vector_type(8)));
typedef float f32x4 __attribute__((ext_vector_type(4)));
typedef float f32x2 __attribute__((ext_vector_type(2)));
typedef unsigned u32x4 __attribute__((ext_vector_type(4)));
typedef unsigned u32x2 __attribute__((ext_vector_type(2)));

#ifndef ONE_LAUNCH
#define ONE_LAUNCH 1
#endif
#ifndef PHMASK
#define PHMASK 0xFFFF
#endif
#define PHEN(k) ((PHMASK >> (k)) & 1)
#ifndef REP_SUB
#define REP_SUB -1
#endif
#ifndef REP_CLASS
#define REP_CLASS 7
#endif

constexpr int T_ = 16384, SEQ = 2048, DM = 1024, DFF = 2816, NUP = 5632, NINP = 3072, UW = 2816, DIN = 2848;
constexpr float EPS = 1e-6f;
constexpr float NEGF = -1e30f;
constexpr int NTHREADS = 512;
constexpr int LDS_BYTES = 147456;

constexpr size_t SZ_W13T = (size_t)NUP * DM * 2, SZ_W2T = (size_t)DM * DFF * 2, SZ_WINT = (size_t)NINP * DM * 2, SZ_WOUTT = (size_t)DM * DM * 2, SZ_CW1T = (size_t)256 * 2048 * 2;
constexpr size_t LO_W13A = 0, LO_W2A = LO_W13A + SZ_W13T, LO_W13B = LO_W2A + SZ_W2T, LO_W2B = LO_W13B + SZ_W13T, LO_WIN = LO_W2B + SZ_W2T, LO_WOUT = LO_WIN + SZ_WINT,
                 LO_CW1K = LO_WOUT + SZ_WOUTT, LO_CW1V = LO_CW1K + SZ_CW1T, LAYER_W = LO_CW1V + SZ_CW1T;
constexpr size_t WS_W = 0;
constexpr size_t WS_HB = WS_W + 4 * LAYER_W;
constexpr size_t WS_U = WS_HB + (size_t)T_ * DM * 2;
constexpr size_t WS_HEADS = WS_U + (size_t)T_ * UW * 2;
constexpr size_t SZ_CMPIN = (size_t)16 * 2048 * 64 * 2 + 4096;
constexpr size_t WS_KCMP = WS_HEADS + (size_t)T_ * DM * 2;
constexpr size_t WS_VCMP = WS_KCMP + SZ_CMPIN;
constexpr size_t WS_HID = WS_VCMP + SZ_CMPIN;
constexpr size_t WS_KC = WS_HID + (size_t)4 * 2 * 2048 * 256 * 4;
constexpr size_t WS_GATES = WS_KC + (size_t)2 * 2048 * 64 * 2;
constexpr size_t WS_SSQ = WS_GATES + (size_t)T_ * 32 * 4;
constexpr size_t WS_CBIAS = WS_SSQ + (size_t)2 * T_ * 16 * 4;
constexpr size_t WS_LRUH = WS_CBIAS + 8192;
constexpr size_t WS_LRUA = WS_LRUH + (size_t)T_ * 256 * 4;
constexpr size_t WS_LRUC = WS_LRUA + (size_t)T_ * 256 * 4;
constexpr size_t WS_MLC = WS_LRUC + (size_t)8 * 32 * 256 * 4;
constexpr size_t WS_MLN = WS_MLC + (size_t)1024 * 4096 * 4;
constexpr size_t WS_MLMU = WS_MLN + (size_t)1024 * 64 * 4;
constexpr size_t WS_MLAT = WS_MLMU + 4096;
constexpr size_t WS_MLMP = WS_MLAT + 4096;
constexpr size_t WS_CBP = WS_MLMP + 4096;
constexpr size_t WS_LRUWT = WS_CBP + 262144;
constexpr size_t WS_BAR = WS_LRUWT + 262144;
constexpr size_t WS_END = WS_BAR + 16384;
static_assert(WS_END <= 425365632ull, "workspace too large");
static_assert(LAYER_W % 256 == 0 && WS_HB % 256 == 0 && WS_U % 256 == 0 && WS_KCMP % 256 == 0 && WS_VCMP % 256 == 0 && WS_HID % 256 == 0, "align");

struct Params {
    const float* in[29];
    float* out;
    unsigned char* ws;
    int ph_lo, ph_hi;
};
static_assert(sizeof(Params) == 256, "Params has padding");
#define GAS __attribute__((address_space(1)))
__device__ __forceinline__ unsigned char* ws_of(const Params& p) { unsigned long long w = (unsigned long long)p.ws; asm volatile("" : "+s"(w)); return (unsigned char*)(GAS unsigned char*)w; }
__device__ __forceinline__ float* out_of(const Params& p) { unsigned long long w = (unsigned long long)p.out; asm volatile("" : "+s"(w)); return (float*)(GAS float*)w; }
__device__ __forceinline__ const float* in_of(const Params& p, int i) { unsigned long long w = (unsigned long long)p.in[i]; asm volatile("" : "+s"(w)); return (const float*)(GAS const float*)w; }
__device__ __forceinline__ unsigned cvt_pk_bf16(float lo, float hi) { unsigned r; asm volatile("v_cvt_pk_bf16_f32 %0, %1, %2" : "=v"(r) : "v"(lo), "v"(hi)); return r; }
__device__ __forceinline__ bf16_t f2bf(float f) { return (bf16_t)(cvt_pk_bf16(f, 0.f) & 0xffffu); }
__device__ __forceinline__ float bf2f(bf16_t b) { return __uint_as_float(((unsigned)b) << 16); }
__device__ __forceinline__ float sigmoidf_(float x) { return 1.0f / (1.0f + __expf(-x)); }
__device__ __forceinline__ int opaque_tid() { int x = threadIdx.x; asm volatile("" : "+v"(x)); return x; }
__device__ __forceinline__ float row_rstd(const float* part, int row) {
    const f32x4 a = *(const f32x4*)(part + (size_t)row * 16), b = *(const f32x4*)(part + (size_t)row * 16 + 4), c = *(const f32x4*)(part + (size_t)row * 16 + 8), d = *(const f32x4*)(part + (size_t)row * 16 + 12);
    const float s = (((a[0] + a[1]) + (a[2] + a[3])) + ((b[0] + b[1]) + (b[2] + b[3]))) + (((c[0] + c[1]) + (c[2] + c[3])) + ((d[0] + d[1]) + (d[2] + d[3])));
    return rsqrtf(s * (1.0f / DM) + EPS);
}
__device__ __forceinline__ float fq_max(float x) {
    auto a = __builtin_amdgcn_permlane16_swap(__float_as_uint(x), __float_as_uint(x), false, false);
    const float m = fmaxf(__uint_as_float(a[0]), __uint_as_float(a[1]));
    auto b = __builtin_amdgcn_permlane32_swap(__float_as_uint(m), __float_as_uint(m), false, false);
    return fmaxf(__uint_as_float(b[0]), __uint_as_float(b[1]));
}
__device__ __forceinline__ float fq_sum(float x) {
    auto a = __builtin_amdgcn_permlane16_swap(__float_as_uint(x), __float_as_uint(x), false, false);
    const float m = __uint_as_float(a[0]) + __uint_as_float(a[1]);
    auto b = __builtin_amdgcn_permlane32_swap(__float_as_uint(m), __float_as_uint(m), false, false);
    return __uint_as_float(b[0]) + __uint_as_float(b[1]);
}
__device__ __forceinline__ float wave_sum(float v) {
#pragma unroll
    for (int o = 32; o >= 1; o >>= 1) v += __shfl_xor(v, o);
    return v;
}
__device__ __forceinline__ float wave_max(float v) {
#pragma unroll
    for (int o = 32; o >= 1; o >>= 1) v = fmaxf(v, __shfl_xor(v, o));
    return v;
}

namespace pg8 {
constexpr int BM = 256, BK = 64, HALF = 128, HTB = HALF * BK * 2, STAGE_BYTES = 8 * HTB, NXCD = 8, WGM = 8;
__device__ __forceinline__ int lds_byte(int r, int c) { const int st = (r >> 4) * 2 + (c >> 5), rr = r & 15, cc = c & 31, ob = rr * 64 + cc * 2; return st * 1024 + (ob ^ (((ob >> 9) & 1) << 5)); }
__device__ __forceinline__ void stage_rc(int b, int& R, int& C) { const int st = b / 1024, sb = b % 1024, swz = sb ^ (((sb >> 9) & 1) << 5); R = (st >> 1) * 16 + swz / 64; C = (st & 1) * 32 + (swz % 64) / 2; }

struct Unit { int pm, pn; };
struct Gemm { const bf16_t* A; const bf16_t* Bt; int M, N, K, lda, ldb; };

struct StaticOrder {
    int nM, nN, nwg, G, c;
    __device__ void init(int M, int N, int G_, int c_) { nM = M / BM; nN = N / BM; nwg = nM * nN; G = G_; c = c_; }
    __device__ bool next(int i, Unit& u) const {
        const long L = (long)i * G + c; if (L >= nwg) return false;
        int wgid = (int)L; { const int q = nwg / NXCD, r = nwg % NXCD, xcd = wgid % NXCD, off = wgid / NXCD; wgid = (xcd < r ? xcd * (q + 1) : r * (q + 1) + (xcd - r) * q) + off; }
        const int nig = WGM * nN, gid = wgid / nig, fm = gid * WGM, gsz = (nM - fm) < WGM ? (nM - fm) : WGM;
        u.pm = fm + ((wgid % nig) % gsz); u.pn = (wgid % nig) / gsz; return true;
    }
};
struct SingleUnit {
    int pm;
    __device__ bool next(int i, Unit& u) const { if (i != 0 || pm < 0) return false; u.pm = pm; u.pn = 0; return true; }
};

template <class Epi, class Sched>
__device__ __forceinline__ void gemm_phase(LAS unsigned char* lds, const Gemm g, const Sched& S, const Epi& E) {
    const int tid = opaque_tid(), wid = __builtin_amdgcn_readfirstlane(tid >> 6), lane = tid & 63, wr = wid >> 2, wc = wid & 3, fr = lane & 15, fq = lane >> 4;
    const int K = g.K, nt = K / BK;
    unsigned voffA[2], voffB[2];
#pragma unroll
    for (int i = 0; i < 2; ++i) { int R, C; stage_rc(tid * 16 + i * 8192, R, C);
        voffA[i] = (unsigned)(R * g.lda + C) * 2u; voffB[i] = (unsigned)(R * g.ldb + C) * 2u; }
    const size_t kstep = (size_t)(BK * 2);
    const size_t hstepA = (size_t)HALF * g.lda * 2, hstepB = (size_t)HALF * g.ldb * 2;
    const size_t tstepA = 2 * hstepA, tstepB = 2 * hstepB;
    const unsigned ldsw = (unsigned)wid * 1024u;
    const int aoff = lds_byte(wr * 64 + fr, fq * 8), boff = lds_byte(wc * 32 + fr, fq * 8);
#define PG8_SA(b, h) (((b) * 2 + (h)) * HTB)
#define PG8_SB(b, h) ((4 + (b) * 2 + (h)) * HTB)
#define PG8_STAGE(bufoff, gbase, voff) do { _Pragma("unroll") for (int _i = 0; _i < 2; ++_i) \
        __builtin_amdgcn_global_load_lds((const unsigned*)((const char*)(gbase) + (voff)[_i]), (LAS unsigned*)(lds + (bufoff) + ldsw + _i * 8192), 16, 0, 0); } while (0)
#define PG8_LDA(dst, b, h) do { _Pragma("unroll") for (int m = 0; m < 4; ++m) _Pragma("unroll") for (int k = 0; k < 2; ++k) dst[m][k] = *(const LAS bf16x8*)(lds + PG8_SA(b, h) + aoff + m * 2048 + k * 1024); } while (0)
#define PG8_LDB(dst, b, h) do { _Pragma("unroll") for (int n = 0; n < 2; ++n) _Pragma("unroll") for (int k = 0; k < 2; ++k) dst[n][k] = *(const LAS bf16x8*)(lds + PG8_SB(b, h) + boff + n * 2048 + k * 1024); } while (0)
#define PG8_MMA(ai, bj, At, Bt) do { __builtin_amdgcn_s_setprio(1); _Pragma("unroll") for (int m = 0; m < 4; ++m) _Pragma("unroll") for (int n = 0; n < 2; ++n) _Pragma("unroll") for (int k = 0; k < 2; ++k) \
        acc[ai][bj][m][n] = __builtin_amdgcn_mfma_f32_16x16x32_bf16(Bt[n][k], At[m][k], acc[ai][bj][m][n], 0, 0, 0); __builtin_amdgcn_s_setprio(0); } while (0)
#define PG8_WAIT_V(n) asm volatile("s_waitcnt vmcnt(" #n ")" ::: "memory")
#define PG8_WAIT_L(n) asm volatile("s_waitcnt lgkmcnt(" #n ")" ::: "memory")
#define PG8_BAR __builtin_amdgcn_s_barrier()
#define PG8_SCHED __builtin_amdgcn_sched_barrier(0)
    Unit cur, nxt; int ui = 0;
    if (!S.next(0, cur)) return;
    f32x4 acc[2][2][4][2];
#pragma unroll
    for (int a = 0; a < 2; ++a)
#pragma unroll
        for (int b = 0; b < 2; ++b)
#pragma unroll
            for (int m = 0; m < 4; ++m)
#pragma unroll
                for (int n = 0; n < 2; ++n) acc[a][b][m][n] = (f32x4){0.f, 0.f, 0.f, 0.f};
    bf16x8 At[4][2], B0[2][2], B1[2][2];
    const char* cA = (const char*)g.A + (size_t)cur.pm * tstepA; const char* cB = (const char*)g.Bt + (size_t)cur.pn * tstepB;
    PG8_STAGE(PG8_SB(0, 0), cB, voffB); PG8_STAGE(PG8_SA(0, 0), cA, voffA); PG8_STAGE(PG8_SB(0, 1), cB + hstepB, voffB); PG8_STAGE(PG8_SA(0, 1), cA + hstepA, voffA);
    if (wr == 1) PG8_BAR;
    PG8_WAIT_V(4); PG8_BAR;
    PG8_STAGE(PG8_SB(1, 0), cB + kstep, voffB); PG8_STAGE(PG8_SA(1, 0), cA + kstep, voffA); PG8_STAGE(PG8_SB(1, 1), cB + hstepB + kstep, voffB);
    PG8_WAIT_V(6); PG8_BAR;
    for (;;) {
        const bool has_next = S.next(ui + 1, nxt);
        const char* nA = has_next ? (const char*)g.A + (size_t)nxt.pm * tstepA : cA; const char* nB = has_next ? (const char*)g.Bt + (size_t)nxt.pn * tstepB : cB;
        for (int t = 0; t < nt; t += 2) {
            const bool last = (t == nt - 2);
            const char* a1 = cA + (size_t)(t + 1) * kstep;
            const char* a2 = last ? nA : cA + (size_t)(t + 2) * kstep; const char* b2 = last ? nB : cB + (size_t)(t + 2) * kstep;
            const char* a3 = a2 + kstep; const char* b3 = b2 + kstep;
            PG8_LDB(B0, 0, 0); PG8_SCHED; PG8_LDA(At, 0, 0); PG8_STAGE(PG8_SA(1, 1), a1 + hstepA, voffA);
            PG8_WAIT_L(8); PG8_BAR; PG8_WAIT_L(0); PG8_MMA(0, 0, At, B0); PG8_BAR; PG8_SCHED;
            PG8_LDB(B1, 0, 1); PG8_STAGE(PG8_SB(0, 0), b2, voffB);
            PG8_BAR; PG8_WAIT_L(0); PG8_MMA(0, 1, At, B1); PG8_BAR;
            PG8_LDA(At, 0, 1); PG8_STAGE(PG8_SA(0, 0), a2, voffA);
            PG8_BAR; PG8_WAIT_L(0); PG8_MMA(1, 0, At, B0); PG8_BAR; PG8_SCHED;
            PG8_STAGE(PG8_SB(0, 1), b2 + hstepB, voffB);
            PG8_WAIT_V(6); PG8_BAR; PG8_MMA(1, 1, At, B1); PG8_BAR;
            PG8_LDB(B0, 1, 0); PG8_SCHED; PG8_LDA(At, 1, 0); PG8_STAGE(PG8_SA(0, 1), a2 + hstepA, voffA);
            PG8_WAIT_L(8); PG8_BAR; PG8_WAIT_L(0); PG8_MMA(0, 0, At, B0); PG8_BAR; PG8_SCHED;
            PG8_LDB(B1, 1, 1); PG8_STAGE(PG8_SB(1, 0), b3, voffB);
            PG8_BAR; PG8_WAIT_L(0); PG8_MMA(0, 1, At, B1); PG8_BAR;
            PG8_LDA(At, 1, 1); PG8_STAGE(PG8_SA(1, 0), a3, voffA);
            PG8_BAR; PG8_WAIT_L(0); PG8_MMA(1, 0, At, B0); PG8_BAR; PG8_SCHED;
            PG8_STAGE(PG8_SB(1, 1), b3 + hstepB, voffB);
            PG8_WAIT_V(6); PG8_BAR; PG8_MMA(1, 1, At, B1); PG8_BAR;
        }
        E(acc, cur, wr, wc, fr, fq);
        if (!has_next) break;
#pragma unroll
        for (int a = 0; a < 2; ++a)
#pragma unroll
            for (int b = 0; b < 2; ++b)
#pragma unroll
                for (int m = 0; m < 4; ++m)
#pragma unroll
                    for (int n = 0; n < 2; ++n) acc[a][b][m][n] = (f32x4){0.f, 0.f, 0.f, 0.f};
        cur = nxt; cA = nA; cB = nB; ++ui;
    }
    PG8_WAIT_V(0);
    if (wr == 0) PG8_BAR;
    PG8_BAR;
#undef PG8_SA
#undef PG8_SB
#undef PG8_STAGE
#undef PG8_LDA
#undef PG8_LDB
#undef PG8_MMA
#undef PG8_WAIT_V
#undef PG8_WAIT_L
#undef PG8_BAR
#undef PG8_SCHED
}
}

typedef __attribute__((address_space(1))) float gf32;
typedef __attribute__((address_space(1))) const float gcf32;
typedef __attribute__((address_space(1))) bf16_t gbf16;
typedef __attribute__((address_space(1))) f32x4 gf32x4;
typedef __attribute__((address_space(1))) const f32x4 gcf32x4;
typedef __attribute__((address_space(1))) u32x2 gu32x2;
__device__ __forceinline__ void rows_rstd(const float* ssq, int row0, int fq, float (&r8)[2][4]) {
    f32x4 pv[2][4];
#pragma unroll
    for (int ai = 0; ai < 2; ++ai)
#pragma unroll
        for (int m = 0; m < 4; ++m) pv[ai][m] = *(gcf32x4*)(ssq + (size_t)(row0 + ai * 128 + m * 16) * 16 + 4 * fq);
#pragma unroll
    for (int ai = 0; ai < 2; ++ai)
#pragma unroll
        for (int m = 0; m < 4; ++m) {
            float sm = (pv[ai][m][0] + pv[ai][m][1]) + (pv[ai][m][2] + pv[ai][m][3]);
            sm = fq_sum(sm);
            r8[ai][m] = rsqrtf(sm * (1.0f / DM) + EPS);
        }
}
struct EpiSwiGLU {
    bf16_t* act; const float* ssq;
    __device__ __forceinline__ void operator()(const f32x4 (&acc)[2][2][4][2], const pg8::Unit& u, int wr, int wc, int fr, int fq) const {
        const int row0 = u.pm * 256 + wr * 64 + fr, col0 = u.pn * 128 + wc * 32 + 8 * fq;
        float r8[2][4];
        rows_rstd(ssq, row0, fq, r8);
#pragma unroll
        for (int ai = 0; ai < 2; ++ai)
#pragma unroll
            for (int m = 0; m < 4; ++m) {
                const int row = row0 + ai * 128 + m * 16;
                const float r = r8[ai][m];
                float o[8];
#pragma unroll
                for (int n = 0; n < 2; ++n) {
                    const f32x4 a1 = acc[ai][0][m][n] * r, a3 = acc[ai][1][m][n] * r;
#pragma unroll
                    for (int j = 0; j < 4; ++j) o[4 * n + j] = a1[j] * __builtin_amdgcn_rcpf(1.0f + __expf(-a1[j])) * a3[j];
                }
                u32x4 w; w.x = cvt_pk_bf16(o[0], o[1]); w.y = cvt_pk_bf16(o[2], o[3]); w.z = cvt_pk_bf16(o[4], o[5]); w.w = cvt_pk_bf16(o[6], o[7]);
                *(GAS u32x4*)(act + (size_t)row * DFF + col0) = w;
            }
    }
};
struct EpiResid {
    const float* resid; float* out; bf16_t* hb; float* ssq_next; float scale;
    __device__ __forceinline__ void load2(f32x4 (&rs)[2][2][2], int row0, int col0, int ai, int mp) const {
#pragma unroll
        for (int mm = 0; mm < 2; ++mm)
#pragma unroll
            for (int bj = 0; bj < 2; ++bj)
#pragma unroll
                for (int n = 0; n < 2; ++n)
                    rs[mm][bj][n] = *(gcf32x4*)(resid + (size_t)(row0 + ai * 128 + (2 * mp + mm) * 16) * DM + col0 + bj * 128 + n * 4);
    }
    __device__ __forceinline__ void operator()(const f32x4 (&acc)[2][2][4][2], const pg8::Unit& u, int wr, int wc, int fr, int fq) const {
        const int row0 = u.pm * 256 + wr * 64 + fr, col0 = u.pn * 256 + wc * 32 + 8 * fq;
        f32x4 rsA[2][2][2], rsB[2][2][2];
        load2(rsA, row0, col0, 0, 0);
#pragma unroll
        for (int bt = 0; bt < 4; ++bt) {
            const int ai = bt >> 1, mp = bt & 1;
            if (bt < 3) { if (bt & 1) load2(rsA, row0, col0, (bt + 1) >> 1, (bt + 1) & 1); else load2(rsB, row0, col0, (bt + 1) >> 1, (bt + 1) & 1); }
#pragma unroll
            for (int mm = 0; mm < 2; ++mm) {
                const int m = 2 * mp + mm, row = row0 + ai * 128 + m * 16;
                const size_t off = (size_t)row * DM + col0;
                float ss = 0.f;
#pragma unroll
                for (int bj = 0; bj < 2; ++bj) {
                    const f32x4 r0 = (bt & 1) ? rsB[mm][bj][0] : rsA[mm][bj][0], r1 = (bt & 1) ? rsB[mm][bj][1] : rsA[mm][bj][1];
                    const f32x4 v0 = r0 + acc[ai][bj][m][0] * scale, v1 = r1 + acc[ai][bj][m][1] * scale;
                    *(gf32x4*)(out + off + bj * 128) = v0;
                    *(gf32x4*)(out + off + bj * 128 + 4) = v1;
                    u32x4 w; w.x = cvt_pk_bf16(v0[0], v0[1]); w.y = cvt_pk_bf16(v0[2], v0[3]); w.z = cvt_pk_bf16(v1[0], v1[1]); w.w = cvt_pk_bf16(v1[2], v1[3]);
                    *(GAS u32x4*)(hb + off + bj * 128) = w;
                    ss += ((v0[0] * v0[0] + v0[1] * v0[1]) + (v0[2] * v0[2] + v0[3] * v0[3])) + ((v1[0] * v1[0] + v1[1] * v1[1]) + (v1[2] * v1[2] + v1[3] * v1[3]));
                }
                ss = fq_sum(ss);
                if (fq == 0) *(gf32*)(ssq_next + (size_t)row * 16 + u.pn * 4 + wc) = ss;
            }
            asm volatile("" ::: "memory");
        }
    }
};
struct EpiWin {
    bf16_t* U; bf16_t* kcmp; bf16_t* vcmp; float* gates; const float* ssq;
    __device__ __forceinline__ void operator()(const f32x4 (&acc)[2][2][4][2], const pg8::Unit& u, int wr, int wc, int fr, int fq) const {
        const int row0 = u.pm * 256 + wr * 64 + fr;
        float r8[2][4];
        rows_rstd(ssq, row0, fq, r8);
#pragma unroll
        for (int bj = 0; bj < 2; ++bj) {
            const int c0 = u.pn * 256 + bj * 128 + wc * 32;
            if (c0 >= 2848) continue;
            const float sc = (c0 < 512) ? 0.125f * 1.4426950408889634f : ((c0 >= 2048 && c0 < 2304) ? 0.125f : 1.0f);
            const int cl = 8 * fq;
#pragma unroll
            for (int ai = 0; ai < 2; ++ai)
#pragma unroll
                for (int m = 0; m < 4; ++m) {
                    const int row = row0 + ai * 128 + m * 16;
                    const float r = r8[ai][m] * sc;
                    const f32x4 v0 = acc[ai][bj][m][0] * r, v1 = acc[ai][bj][m][1] * r;
                    if (c0 == 2816) { *(gf32x4*)(gates + (size_t)row * 32 + cl) = v0; *(gf32x4*)(gates + (size_t)row * 32 + cl + 4) = v1; }
                    else {
                        u32x4 w; w.x = cvt_pk_bf16(v0[0], v0[1]); w.y = cvt_pk_bf16(v0[2], v0[3]); w.z = cvt_pk_bf16(v1[0], v1[1]); w.w = cvt_pk_bf16(v1[2], v1[3]);
                        if (c0 >= 512 && c0 < 768) {
                            const int cc = c0 - 512 + cl;
                            const int gg = (cc >> 6) & 1, d = cc & 63;
                            bf16_t* dst = (cc < 128 ? kcmp : vcmp) + ((size_t)(((row >> 11) * 2 + gg) * 2048 + (row & 2047))) * 64 + d;
                            *(GAS u32x4*)dst = w;
                        } else {
                            *(GAS u32x4*)(U + (size_t)row * UW + c0 + cl) = w;
                        }
                    }
                }
        }
    }
};
struct EpiCmp {
    float* part;
    __device__ __forceinline__ void operator()(const f32x4 (&acc)[2][2][4][2], const pg8::Unit& u, int wr, int wc, int fr, int fq) const {
        const int row0 = u.pm * 256 + wr * 64 + fr, col0 = wc * 32 + 8 * fq;
#pragma unroll
        for (int ai = 0; ai < 2; ++ai)
#pragma unroll
            for (int m = 0; m < 4; ++m) {
                const int row = row0 + ai * 128 + m * 16;
#pragma unroll
                for (int bj = 0; bj < 2; ++bj)
#pragma unroll
                    for (int n = 0; n < 2; ++n) *(gf32x4*)(part + (size_t)row * 256 + col0 + bj * 128 + n * 4) = acc[ai][bj][m][n];
            }
    }
};

__device__ __forceinline__ int winmap(int n) {
    if (n < 1280) return n;
    if (n < 2560) return n + 24;
    if (n < 2816) return n + 32;
    if (n < 2840) return 1280 + (n - 2816);
    if (n < 2844) return 2584 + (n - 2840);
    if (n < 2848) return 2588 + (n - 2844);
    return -1;
}
struct TrTile { const float* colp; const float* gain; bf16_t* dst; int ld, K, k0, n0; };
__device__ __forceinline__ void tr_decode(const Params& p, int idx, int tid, TrTile& t) {
    constexpr int TPL = 1376;
    const int l = idx / TPL; int r = idx % TPL;
    int m, ntile, ktile, K;
    if (r < 352) { m = 0; ntile = r % 22; ktile = r / 22; K = DM; }
    else if (r < 528) { r -= 352; m = 1; ntile = r % 4; ktile = r / 4; K = DFF; }
    else if (r < 880) { r -= 528; m = 2; ntile = r % 22; ktile = r / 22; K = DM; }
    else if (r < 1056) { r -= 880; m = 3; ntile = r % 4; ktile = r / 4; K = DFF; }
    else if (r < 1248) { r -= 1056; m = 4; ntile = r % 12; ktile = r / 12; K = DM; }
    else if (r < 1312) { r -= 1248; m = 5; ntile = r % 4; ktile = r / 4; K = DM; }
    else if (r < 1344) { r -= 1312; m = 6; ntile = 0; ktile = r; K = 2048; }
    else { r -= 1344; m = 7; ntile = 0; ktile = r; K = 2048; }
    t.K = K; t.k0 = ktile * 64; t.n0 = ntile * 256; t.colp = nullptr; t.gain = nullptr; t.ld = 0;
    const int npp = t.n0 + 4 * ((tid >> 3));
    const int np = (npp & ~31) + 8 * ((npp & 15) >> 2) + 4 * ((npp >> 4) & 1);
    unsigned char* wl = ws_of(p) + WS_W + (size_t)l * LAYER_W;
    if (m == 0 || m == 2) {
        const int pb = np >> 8, w = np & 255;
        const float* src = (w < 128) ? in_of(p, m == 0 ? 2 : 25) : in_of(p, m == 0 ? 3 : 26);
        t.colp = src + (size_t)l * DM * DFF + pb * 128 + (w & 127); t.ld = DFF; t.gain = in_of(p, m == 0 ? 1 : 24) + l * DM;
        t.dst = (bf16_t*)(wl + (m == 0 ? LO_W13A : LO_W13B));
    } else if (m == 1 || m == 3) {
        t.colp = in_of(p, m == 1 ? 4 : 27) + (size_t)l * DFF * DM + np; t.ld = DM;
        t.dst = (bf16_t*)(wl + (m == 1 ? LO_W2A : LO_W2B));
    } else if (m == 4) {
        const int sc = winmap(np);
        if (sc >= 0) t.colp = in_of(p, 6) + (size_t)l * DM * DIN + sc;
        t.ld = DIN; t.gain = in_of(p, 5) + l * DM;
        t.dst = (bf16_t*)(wl + LO_WIN);
    } else if (m == 5) {
        t.colp = in_of(p, 23) + (size_t)l * DM * DM + np; t.ld = DM;
        t.dst = (bf16_t*)(wl + LO_WOUT);
    } else {
        t.colp = in_of(p, m == 6 ? 8 : 11) + (size_t)l * 2048 * 256 + np; t.ld = 256;
        t.dst = (bf16_t*)(wl + (m == 6 ? LO_CW1K : LO_CW1V));
    }
}
__device__ __forceinline__ void tr_load(const TrTile& t, int tid, f32x4 (&v)[8], float (&gv)[8]) {
    const int kc = (tid & 7);
#pragma unroll
    for (int e = 0; e < 8; ++e) {
        const int k = t.k0 + 8 * kc + e;
        v[e] = (f32x4){0.f, 0.f, 0.f, 0.f}; gv[e] = 1.0f;
        if (t.colp) { v[e] = __builtin_nontemporal_load((const f32x4*)(t.colp + (size_t)k * t.ld)); if (t.gain) gv[e] = t.gain[k]; }
    }
}
__device__ void prologue(const Params& p, LAS unsigned char* lds, int bid, int G) {
    const int tid = opaque_tid();
    LAS float* tile = (LAS float*)lds;
    {
        constexpr int N_TR = 4 * 1376;
        int it = bid;
        TrTile t; f32x4 v[8]; float gv[8];
        if (it < N_TR) { tr_decode(p, it, tid, t); tr_load(t, tid, v, gv); }
        while (it < N_TR) {
            bf16_t* dst = t.dst + (size_t)(t.n0 + 4 * ((tid >> 3))) * t.K + t.k0 + 8 * ((tid & 7));
            const int K = t.K;
            u32x4 o[4];
#pragma unroll
            for (int q = 0; q < 4; ++q) { o[q].x = cvt_pk_bf16(v[0][q] * gv[0], v[1][q] * gv[1]); o[q].y = cvt_pk_bf16(v[2][q] * gv[2], v[3][q] * gv[3]); o[q].z = cvt_pk_bf16(v[4][q] * gv[4], v[5][q] * gv[5]); o[q].w = cvt_pk_bf16(v[6][q] * gv[6], v[7][q] * gv[7]); }
            const int nx = it + G;
            if (nx < N_TR) { tr_decode(p, nx, tid, t); tr_load(t, tid, v, gv); }
#pragma unroll
            for (int q = 0; q < 4; ++q) *(u32x4*)(dst + (size_t)q * K) = o[q];
            it = nx;
        }
    }
    constexpr int N_BIAS = 256, N_XROW = T_ / 16, N_LW = 32;
    for (int it = bid; it < N_BIAS + N_XROW + N_LW; it += G) {
        if (it >= N_BIAS + N_XROW) {
            const int q = it - N_BIAS - N_XROW, ln = q >> 1, gate = q & 1;
            const float* W = in_of(p, gate ? 17 : 15) + (size_t)ln * 4096;
            bf16_t* WT = (bf16_t*)(ws_of(p) + WS_LRUWT) + (size_t)q * 4096;
            float wv[8];
#pragma unroll
            for (int rr = 0; rr < 8; ++rr) { const int idx = tid + rr * NTHREADS, d = idx >> 6, c = idx & 63; wv[rr] = W[c * 64 + d]; }
#pragma unroll
            for (int rr = 0; rr < 8; ++rr) WT[tid + rr * NTHREADS] = f2bf(wv[rr]);
        } else if (it < N_BIAS) {
            const int lkv = it >> 5, part = it & 31, l = lkv >> 1, kv = lkv & 1;
            const float* pos = in_of(p, kv ? 10 : 7) + (size_t)l * 2048;
            const float* w1 = in_of(p, kv ? 11 : 8) + (size_t)l * 2048 * 256;
            const int j = tid & 255, half = tid >> 8;
            float sacc = 0.f;
            const int kb = part * 64 + half * 32;
            for (int k = kb; k < kb + 32; k += 8) {
                float a[8];
#pragma unroll
                for (int q = 0; q < 8; ++q) a[q] = w1[(size_t)(k + q) * 256 + j];
#pragma unroll
                for (int q = 0; q < 8; ++q) sacc += pos[k + q] * a[q];
            }
            tile[tid] = sacc;
            __syncthreads();
            if (tid < 256) ((float*)(ws_of(p) + WS_CBP))[(size_t)it * 256 + tid] = tile[tid] + tile[tid + 256];
            __syncthreads();
        } else {
            const int row0 = (it - N_BIAS) * 16 + (tid >> 6) * 2, lane = tid & 63;
            f32x4 xv[2][4];
#pragma unroll
            for (int rq = 0; rq < 2; ++rq)
#pragma unroll
                for (int i = 0; i < 4; ++i) xv[rq][i] = *(const f32x4*)(in_of(p, 0) + (size_t)(row0 + rq) * DM + i * 256 + lane * 4);
#pragma unroll
            for (int rq = 0; rq < 2; ++rq) {
                const int row = row0 + rq;
                bf16_t* hb = (bf16_t*)(ws_of(p) + WS_HB) + (size_t)row * DM;
                float ss = 0.f;
#pragma unroll
                for (int i = 0; i < 4; ++i) {
                    const f32x4 v = xv[rq][i];
                    ss += (v[0] * v[0] + v[1] * v[1]) + (v[2] * v[2] + v[3] * v[3]);
                    u32x2 w; w.x = cvt_pk_bf16(v[0], v[1]); w.y = cvt_pk_bf16(v[2], v[3]);
                    *(u32x2*)(hb + i * 256 + lane * 4) = w;
                }
                ss = wave_sum(ss);
                if (lane < 16) ((float*)(ws_of(p) + WS_SSQ))[(size_t)row * 16 + lane] = (lane == 0) ? ss : 0.f;
            }
        }
    }
}

__device__ void lru_x_item(const Params& p, int l, int b, int n, int ck, LAS unsigned char* lds) {
    const int tid = opaque_tid(), lane = tid & 63, w = __builtin_amdgcn_readfirstlane(tid >> 6), fr = lane & 15, fq = lane >> 4;
    LAS float* xs = (LAS float*)lds;
    LAS float* xc = (LAS float*)(lds + 17152);
    LAS bf16_t* xb = (LAS bf16_t*)(lds + 33536);
    LAS bf16_t* wt = (LAS bf16_t*)(lds + 42752);
    LAS float* pre = (LAS float*)(lds + 61184);
    LAS float* segA = (LAS float*)(lds + 93952);
    LAS float* segH = segA + 512;
    const bf16_t* U = (const bf16_t*)(ws_of(p) + WS_U);
    const int t0 = ck * 64, rowbase = b * SEQ;
    {
        u32x4 xv[2];
#pragma unroll
        for (int rr = 0; rr < 2; ++rr) {
            const int idx = tid + rr * NTHREADS, tt = idx >> 3, ch = idx & 7, t = t0 - 3 + tt;
            xv[rr] = (u32x4){0u, 0u, 0u, 0u};
            if (idx < 67 * 8 && t >= 0) xv[rr] = *(const u32x4*)(U + (size_t)(rowbase + t) * UW + 1280 + n * 64 + ch * 8);
        }
#pragma unroll
        for (int rr = 0; rr < 2; ++rr) {
            const int idx = tid + rr * NTHREADS, tt = idx >> 3, ch = idx & 7;
            if (idx < 67 * 8) {
                f32x4 lo, hi;
                lo[0] = __uint_as_float(xv[rr][0] << 16); lo[1] = __uint_as_float(xv[rr][0] & 0xffff0000u); lo[2] = __uint_as_float(xv[rr][1] << 16); lo[3] = __uint_as_float(xv[rr][1] & 0xffff0000u);
                hi[0] = __uint_as_float(xv[rr][2] << 16); hi[1] = __uint_as_float(xv[rr][2] & 0xffff0000u); hi[2] = __uint_as_float(xv[rr][3] << 16); hi[3] = __uint_as_float(xv[rr][3] & 0xffff0000u);
                *(LAS f32x4*)(xs + tt * 64 + ch * 8) = lo; *(LAS f32x4*)(xs + tt * 64 + ch * 8 + 4) = hi;
            }
        }
    }
    {
        const bf16_t* WT = (const bf16_t*)(ws_of(p) + WS_LRUWT) + (size_t)((l * 4 + n) * 2) * 4096;
#pragma unroll
        for (int rr = 0; rr < 2; ++rr) {
            const int idx = tid + rr * NTHREADS, row = idx >> 3, ch = idx & 7;
            *(LAS u32x4*)(wt + row * 72 + ch * 8) = *(const u32x4*)(WT + row * 64 + ch * 8);
        }
    }
    __syncthreads();
    {
        const float* cw = in_of(p, 13) + (size_t)l * 4 * 256 + n * 64; const float* cb = in_of(p, 14) + l * 256 + n * 64;
        const int c = tid & 63;
        const float w0 = cw[c], w1 = cw[256 + c], w2 = cw[512 + c], w3 = cw[768 + c], bc = cb[c];
#pragma unroll
        for (int k = 0; k < 8; ++k) {
            const int t = (tid >> 6) + 8 * k;
            const float v = bc + xs[t * 64 + c] * w0 + xs[(t + 1) * 64 + c] * w1 + xs[(t + 2) * 64 + c] * w2 + xs[(t + 3) * 64 + c] * w3;
            xc[t * 64 + c] = v; xb[t * 72 + c] = f2bf(v);
        }
    }
    __syncthreads();
    {
        const int tt = w & 3, gate = w >> 2;
        bf16x8 xa[2];
#pragma unroll
        for (int ks = 0; ks < 2; ++ks) xa[ks] = *(const LAS bf16x8*)(xb + (16 * tt + fr) * 72 + 32 * ks + 8 * fq);
        const float* bias = in_of(p, gate ? 18 : 16) + (l * 4 + n) * 64;
#pragma unroll
        for (int dt = 0; dt < 4; ++dt) {
            f32x4 acc = (f32x4){0.f, 0.f, 0.f, 0.f};
#pragma unroll
            for (int ks = 0; ks < 2; ++ks) {
                const bf16x8 wb = *(const LAS bf16x8*)(wt + (gate * 64 + 16 * dt + fr) * 72 + 32 * ks + 8 * fq);
                acc = __builtin_amdgcn_mfma_f32_16x16x32_bf16(xa[ks], wb, acc, 0, 0, 0);
            }
            const float bv = bias[16 * dt + fr];
#pragma unroll
            for (int i = 0; i < 4; ++i) pre[(gate * 64 + 16 * tt + 4 * fq + i) * 64 + 16 * dt + fr] = acc[i] + bv;
        }
    }
    __syncthreads();
    const int d = tid & 63, tq = tid >> 6;
    const float lam = in_of(p, 19)[l * 256 + n * 64 + d];
    const float sp = log1pf(expf(-lam));
    float hl[8], cl[8];
    float h = 0.f, ca = 1.f;
#pragma unroll
    for (int i = 0; i < 8; ++i) {
        const float r = __builtin_amdgcn_rcpf(1.0f + __expf(-pre[(tq * 8 + i) * 64 + d])), ii = __builtin_amdgcn_rcpf(1.0f + __expf(-pre[(64 + tq * 8 + i) * 64 + d]));
        const float la = -8.0f * r * sp;
        const float a = __expf(la);
        const float uu = __builtin_amdgcn_sqrtf(fmaxf(1.0f - a * a, 0.f)) * (ii * xc[(tq * 8 + i) * 64 + d]);
        h = a * h + uu; ca *= a; hl[i] = h; cl[i] = ca;
    }
    segA[tq * 64 + d] = ca; segH[tq * 64 + d] = h;
    __syncthreads();
    float cin_h = 0.f, cin_a = 1.f;
    for (int sgi = 0; sgi < tq; ++sgi) { const float sa = segA[sgi * 64 + d]; cin_h = sa * cin_h + segH[sgi * 64 + d]; cin_a *= sa; }
    float* LH = (float*)(ws_of(p) + WS_LRUH); float* LA = (float*)(ws_of(p) + WS_LRUA);
#pragma unroll
    for (int i = 0; i < 8; ++i) {
        const size_t o = (size_t)(rowbase + t0 + tq * 8 + i) * 256 + n * 64 + d;
        LH[o] = hl[i] + cl[i] * cin_h; LA[o] = cl[i] * cin_a;
    }
    __syncthreads();
}

__device__ __forceinline__ float logsigmoidf_(float x) { return fminf(x, 0.f) - log1pf(expf(-fabsf(x))); }

__device__ __forceinline__ int vt_off(int d, int key, int pitch) {
    const int kc = key >> 3;
    return d * pitch + ((((kc ^ (d >> 3)) & 7) | (kc & ~7)) << 3) + (key & 7);
}
__device__ void ml_x_item(const Params& p, int l, int bh, int ck, LAS unsigned char* lds) {
    const int tid = opaque_tid(), lane = tid & 63, w = __builtin_amdgcn_readfirstlane(tid >> 6), fr = lane & 15, fq = lane >> 4;
    const int b = bh >> 2, hh = bh & 3;
    LAS bf16_t* KwT = (LAS bf16_t*)lds;
    LAS bf16_t* VT = (LAS bf16_t*)(lds + 9216);
    LAS float* wks = (LAS float*)(lds + 20736);
    const bf16_t* U = (const bf16_t*)(ws_of(p) + WS_U);
    const float* GT = (const float*)(ws_of(p) + WS_GATES);
    const int rowbase = b * SEQ + ck * 64;
    if (tid < 64) {
        const float ig = GT[(size_t)(rowbase + lane) * 32 + 24 + hh] + in_of(p, 20)[l * 4 + hh];
        const float fp = GT[(size_t)(rowbase + lane) * 32 + 28 + hh] + in_of(p, 21)[l * 4 + hh];
        float a = logsigmoidf_(fp);
#pragma unroll
        for (int o = 1; o < 64; o <<= 1) { const float t = __shfl_up(a, o); if (lane >= o) a += t; }
        const float A = __shfl(a, 63);
        const float wend = A - a + ig;
        const float mu = wave_max(wend);
        wks[lane] = expf(wend - mu);
        if (lane == 0) { ((float*)(ws_of(p) + WS_MLMU))[bh * 32 + ck] = mu; ((float*)(ws_of(p) + WS_MLAT))[bh * 32 + ck] = A; }
    }
    const int srow = tid >> 3, sch = tid & 7;
    const bf16_t* src = U + (size_t)(rowbase + srow) * UW + hh * 64 + sch * 8;
    const u32x4 kk = *(const u32x4*)(src + 2048);
    {
        const u32x4 vv = *(const u32x4*)(src + 2304);
#pragma unroll
        for (int e = 0; e < 4; ++e) {
            VT[vt_off(sch * 8 + 2 * e, srow, 72)] = (bf16_t)(vv[e] & 0xffffu);
            VT[vt_off(sch * 8 + 2 * e + 1, srow, 72)] = (bf16_t)(vv[e] >> 16);
        }
        for (int idx = tid; idx < 16 * 72; idx += NTHREADS) VT[64 * 72 + idx] = (idx < 72) ? (bf16_t)0x3f80 : (bf16_t)0;
    }
    __syncthreads();
    {
        const float wk = wks[srow];
#pragma unroll
        for (int e = 0; e < 4; ++e) {
            KwT[vt_off(sch * 8 + 2 * e, srow, 72)] = f2bf(wk * __uint_as_float(kk[e] << 16));
            KwT[vt_off(sch * 8 + 2 * e + 1, srow, 72)] = f2bf(wk * __uint_as_float(kk[e] & 0xffff0000u));
        }
    }
    __syncthreads();
    {
        const int dt = w & 3, hf = w >> 2;
        bf16x8 ka[2];
#pragma unroll
        for (int ks = 0; ks < 2; ++ks) ka[ks] = *(const LAS bf16x8*)(KwT + vt_off(16 * dt + fr, 32 * ks + 8 * fq, 72));
        float* C = (float*)(ws_of(p) + WS_MLC) + (size_t)(bh * 32 + ck) * 4096;
#pragma unroll
        for (int ee = 0; ee < 2; ++ee) {
            const int et = 2 * hf + ee;
            f32x4 acc = (f32x4){0.f, 0.f, 0.f, 0.f};
#pragma unroll
            for (int ks = 0; ks < 2; ++ks) {
                const bf16x8 vb = *(const LAS bf16x8*)(VT + vt_off(16 * et + fr, 32 * ks + 8 * fq, 72));
                acc = __builtin_amdgcn_mfma_f32_16x16x32_bf16(ka[ks], vb, acc, 0, 0, 0);
            }
#pragma unroll
            for (int i = 0; i < 4; ++i) C[(16 * dt + 4 * fq + i) * 64 + 16 * et + fr] = acc[i];
        }
        if (hf == 0) {
            f32x4 acc = (f32x4){0.f, 0.f, 0.f, 0.f};
#pragma unroll
            for (int ks = 0; ks < 2; ++ks) {
                const bf16x8 vb = *(const LAS bf16x8*)(VT + (64 + fr) * 72 + 32 * ks + 8 * fq);
                acc = __builtin_amdgcn_mfma_f32_16x16x32_bf16(ka[ks], vb, acc, 0, 0, 0);
            }
            if (fr == 0) {
#pragma unroll
                for (int i = 0; i < 4; ++i) ((float*)(ws_of(p) + WS_MLN))[(size_t)(bh * 32 + ck) * 64 + 16 * dt + 4 * fq + i] = acc[i];
            }
        }
    }
    __syncthreads();
}

__device__ void phase_m2(const Params& p, int l, int cls, LAS unsigned char* lds, int bid, int G) {
    const int tid = opaque_tid();
    constexpr int N_KC = 128, N_LC = 4, N_MC = 256, N_MN = 4, TOTAL = N_KC + N_LC + N_MC + N_MN;
    for (int it = bid; it < TOTAL; it += G) {
        if (it < N_KC) {
            if (!(cls & 1)) continue;
            const int kv = it >> 6, r0 = (it & 63) * 32;
            LAS float* hid = (LAS float*)lds;
            LAS float* w2s = hid + 32 * 256;
            const float* part = (const float*)(ws_of(p) + WS_HID) + (size_t)(kv * 2048 + r0) * 256;
            const float* cb = (const float*)(ws_of(p) + WS_CBIAS) + (l * 2 + kv) * 256;
            const float* w2 = in_of(p, kv ? 12 : 9) + (size_t)l * 256 * 64;
            f32x4 pr[4][4];
#pragma unroll
            for (int rr = 0; rr < 4; ++rr) {
                const int idx = tid + rr * NTHREADS, row = idx >> 6, j4 = (idx & 63) * 4;
#pragma unroll
                for (int kp = 0; kp < 4; ++kp) pr[rr][kp] = *(const f32x4*)(part + (size_t)kp * 2 * 2048 * 256 + row * 256 + j4);
            }
#pragma unroll
            for (int rr = 0; rr < 4; ++rr) {
                const int idx = tid + rr * NTHREADS, row = idx >> 6, j4 = (idx & 63) * 4;
                f32x4 hv = *(const f32x4*)(cb + j4);
#pragma unroll
                for (int kp = 0; kp < 4; ++kp) hv = hv + pr[rr][kp];
#pragma unroll
                for (int q = 0; q < 4; ++q) hv[q] = hv[q] * __builtin_amdgcn_rcpf(1.0f + __expf(-hv[q]));
                *(LAS f32x4*)(hid + row * 256 + j4) = hv;
            }
#pragma unroll
            for (int rr = 0; rr < 8; ++rr) { const int idx = tid + rr * NTHREADS; *(LAS f32x4*)(w2s + idx * 4) = *(const f32x4*)(w2 + idx * 4); }
            __syncthreads();
            {
                const int d = tid & 63, rq = tid >> 6;
                float acc[4] = {0.f, 0.f, 0.f, 0.f};
                for (int j = 0; j < 256; j += 4) {
                    float wv[4];
#pragma unroll
                    for (int q = 0; q < 4; ++q) wv[q] = w2s[(j + q) * 64 + d];
#pragma unroll
                    for (int i = 0; i < 4; ++i) {
                        const f32x4 hv = *(const LAS f32x4*)(hid + (rq * 4 + i) * 256 + j);
#pragma unroll
                        for (int q = 0; q < 4; ++q) acc[i] += hv[q] * wv[q];
                    }
                }
                bf16_t* KCo = (bf16_t*)(ws_of(p) + WS_KC);
#pragma unroll
                for (int i = 0; i < 4; ++i) {
                    const int r = r0 + rq * 4 + i;
                    KCo[(size_t)(kv * 2048 + r) * 64 + d] = f2bf(((r & 127) == 127) ? 0.f : acc[i]);
                }
            }
            __syncthreads();
        } else if (it < N_KC + N_LC) {
            if (!(cls & 2)) continue;
            const int idx = (it - N_KC) * NTHREADS + tid;
            const int b = idx >> 8, ch = idx & 255;
            const float* LH = (const float*)(ws_of(p) + WS_LRUH); const float* LA = (const float*)(ws_of(p) + WS_LRUA);
            float* LC = (float*)(ws_of(p) + WS_LRUC);
            float la[32], lh[32];
#pragma unroll
            for (int ck = 0; ck < 32; ++ck) { const size_t o = (size_t)(b * SEQ + ck * 64 + 63) * 256 + ch; la[ck] = LA[o]; lh[ck] = LH[o]; }
            float carry = 0.f;
#pragma unroll
            for (int ck = 0; ck < 32; ++ck) { LC[(b * 32 + ck) * 256 + ch] = carry; carry = la[ck] * carry + lh[ck]; }
        } else {
            if (!(cls & 4)) continue;
            const bool isn = it >= N_KC + N_LC + N_MC;
            const int idx = (it - N_KC - N_LC - (isn ? N_MC : 0)) * NTHREADS + tid;
            const int bh = isn ? (idx >> 6) : (idx >> 12), de = isn ? (idx & 63) : (idx & 4095);
            const int esz = isn ? 64 : 4096;
            float* buf = (float*)(ws_of(p) + (isn ? WS_MLN : WS_MLC)) + (size_t)bh * 32 * esz + de;
            const float* MU = (const float*)(ws_of(p) + WS_MLMU) + bh * 32; const float* AT = (const float*)(ws_of(p) + WS_MLAT) + bh * 32;
            float* MP = (float*)(ws_of(p) + WS_MLMP) + bh * 32;
            float dc[32];
#pragma unroll
            for (int ck = 0; ck < 32; ++ck) dc[ck] = buf[(size_t)ck * esz];
            float C = 0.f, m = 0.f;
#pragma unroll
            for (int ck = 0; ck < 32; ++ck) {
                buf[(size_t)ck * esz] = C;
                if (!isn && de == 0) MP[ck] = m;
                const float at = AT[ck], mu = MU[ck];
                const float mn = fmaxf(at + m, mu);
                C = __expf(at + m - mn) * C + __expf(mu - mn) * dc[ck];
                m = mn;
            }
        }
    }
}

__device__ __forceinline__ float gelu_tanh(float x) { const float u = 0.7978845608028654f * (x + 0.044715f * x * x * x); return 0.5f * x * (1.0f + tanhf(u)); }

__device__ void lru_y_item(const Params& p, int l, int item) {
    const int tid = opaque_tid(), lane = tid & 63;
    const float* LH = (const float*)(ws_of(p) + WS_LRUH); const float* LA = (const float*)(ws_of(p) + WS_LRUA); const float* LC = (const float*)(ws_of(p) + WS_LRUC);
    const bf16_t* U = (const bf16_t*)(ws_of(p) + WS_U);
    const float* hn = in_of(p, 22) + l * 1024;
    bf16_t* HD = (bf16_t*)(ws_of(p) + WS_HEADS);
    const int pair0 = item * 128 + (tid >> 6) * 16;
    float lh[16], la[16], lc[16]; bf16_t gg[16];
    float gn[4];
#pragma unroll
    for (int n = 0; n < 4; ++n) gn[n] = hn[(8 + n) * 64 + lane];
#pragma unroll
    for (int q = 0; q < 16; ++q) {
        const int pair = pair0 + q, row = pair >> 2, n = pair & 3, ch = n * 64 + lane;
        lh[q] = LH[(size_t)row * 256 + ch]; la[q] = LA[(size_t)row * 256 + ch];
        lc[q] = LC[((row >> 11) * 32 + ((row & 2047) >> 6)) * 256 + ch];
        gg[q] = U[(size_t)row * UW + 1536 + ch];
    }
#pragma unroll
    for (int q = 0; q < 16; ++q) {
        const int pair = pair0 + q, row = pair >> 2, n = pair & 3;
        const float h = lh[q] + la[q] * lc[q];
        const float y = h * gelu_tanh(bf2f(gg[q]));
        const float ss = wave_sum(y * y);
        HD[(size_t)row * DM + (8 + n) * 64 + lane] = f2bf(y * rsqrtf(ss * (1.0f / 64.0f) + EPS) * gn[q & 3]);
    }
}

__device__ __forceinline__ int vt_lane(int fr, int fq, int pitch) { return fr * pitch + ((((fq >> 1) ^ (fr >> 3)) & 1) << 3) + ((fq & 1) << 2); }
__device__ __forceinline__ constexpr int vt_cst(int dt, int kc2, int pitch) { return dt * 16 * pitch + ((((kc2 ^ (2 * dt)) & 6) | (kc2 & ~7)) << 3); }
__device__ void ml_y_item(const Params& p, int l, int bh, int ck, LAS unsigned char* lds) {
    const int tid = opaque_tid(), lane = tid & 63, w = __builtin_amdgcn_readfirstlane(tid >> 6), fr = lane & 15, fq = lane >> 4;
    const int b = bh >> 2, hh = bh & 3;
    LAS bf16_t* Ql = (LAS bf16_t*)lds;
    LAS bf16_t* Kl = (LAS bf16_t*)(lds + 9216);
    LAS bf16_t* Vt = (LAS bf16_t*)(lds + 18432);
    LAS bf16_t* Ct = (LAS bf16_t*)(lds + 27648);
    LAS bf16_t* Wl = (LAS bf16_t*)(lds + 39168);
    LAS float* as_ = (LAS float*)(lds + 57600);
    LAS float* bs_ = as_ + 64;
    LAS float* Ms_ = bs_ + 64;
    LAS float* ssl = Ms_ + 64;
    const bf16_t* U = (const bf16_t*)(ws_of(p) + WS_U);
    const float* GT = (const float*)(ws_of(p) + WS_GATES);
    const int rowbase = b * SEQ + ck * 64;
    const float mprev = ((const float*)(ws_of(p) + WS_MLMP))[bh * 32 + ck];
    if (tid < 64) {
        const float ig = GT[(size_t)(rowbase + lane) * 32 + 24 + hh] + in_of(p, 20)[l * 4 + hh];
        const float fp = GT[(size_t)(rowbase + lane) * 32 + 28 + hh] + in_of(p, 21)[l * 4 + hh];
        float a = logsigmoidf_(fp);
#pragma unroll
        for (int o = 1; o < 64; o <<= 1) { const float t = __shfl_up(a, o); if (lane >= o) a += t; }
        const float bb = ig - a;
        float pm = bb;
#pragma unroll
        for (int o = 1; o < 64; o <<= 1) { const float t = __shfl_up(pm, o); if (lane >= o) pm = fmaxf(pm, t); }
        as_[lane] = a; bs_[lane] = bb; Ms_[lane] = fmaxf(mprev, pm);
        Ct[64 * 72 + lane] = f2bf(((const float*)(ws_of(p) + WS_MLN))[(size_t)(bh * 32 + ck) * 64 + lane]);
    }
    {
        const int row = tid >> 3, ch = tid & 7;
        const bf16_t* src = U + (size_t)(rowbase + row) * UW + hh * 64 + ch * 8;
        *(LAS u32x4*)(Ql + row * 72 + ch * 8) = *(const u32x4*)(src + 1792);
        *(LAS u32x4*)(Kl + row * 72 + ch * 8) = *(const u32x4*)(src + 2048);
        const u32x4 vv = *(const u32x4*)(src + 2304);
#pragma unroll
        for (int e = 0; e < 4; ++e) {
            Vt[vt_off(ch * 8 + 2 * e, row, 72)] = (bf16_t)(vv[e] & 0xffffu);
            Vt[vt_off(ch * 8 + 2 * e + 1, row, 72)] = (bf16_t)(vv[e] >> 16);
        }
        const float* C = (const float*)(ws_of(p) + WS_MLC) + (size_t)(bh * 32 + ck) * 4096;
#pragma unroll
        for (int rr = 0; rr < 2; ++rr) {
            const int idx = tid + rr * NTHREADS, d = idx >> 4, e4 = (idx & 15) * 4;
            const f32x4 c = *(const f32x4*)(C + d * 64 + e4);
#pragma unroll
            for (int i = 0; i < 4; ++i) Ct[(e4 + i) * 72 + d] = f2bf(c[i]);
        }
        for (int idx = tid; idx < 15 * 72; idx += NTHREADS) Ct[65 * 72 + idx] = 0;
    }
    __syncthreads();
    const int jt = w & 3, hf = w >> 2;
    bf16_t opre[2][4];
#pragma unroll
    for (int i = 0; i < 4; ++i)
#pragma unroll
        for (int ee = 0; ee < 2; ++ee) opre[ee][i] = U[(size_t)(rowbase + 16 * jt + 4 * fq + i) * UW + 2560 + hh * 64 + 16 * (2 * hf + ee) + fr];
    bf16x8 qa[2];
#pragma unroll
    for (int ks = 0; ks < 2; ++ks) qa[ks] = *(const LAS bf16x8*)(Ql + (16 * jt + fr) * 72 + 32 * ks + 8 * fq);
    f32x4 sacc[4];
#pragma unroll
    for (int st = 0; st < 4; ++st) {
        const bf16x8 k0 = *(const LAS bf16x8*)(Kl + (16 * st + fr) * 72 + 8 * fq), k1 = *(const LAS bf16x8*)(Kl + (16 * st + fr) * 72 + 32 + 8 * fq);
        sacc[st] = __builtin_amdgcn_mfma_f32_16x16x32_bf16(qa[0], k0, (f32x4){0.f, 0.f, 0.f, 0.f}, 0, 0, 0);
        sacc[st] = __builtin_amdgcn_mfma_f32_16x16x32_bf16(qa[1], k1, sacc[st], 0, 0, 0);
    }
    float sw[4], Mj[4];
    LAS bf16_t* Ww = Wl + w * (16 * 72);
#pragma unroll
    for (int i = 0; i < 4; ++i) {
        const int j = 16 * jt + 4 * fq + i;
        Mj[i] = Ms_[j];
        float acc = 0.f;
#pragma unroll
        for (int st = 0; st < 4; ++st) {
            const int sidx = 16 * st + fr;
            const float wv = (sidx <= j) ? __expf(bs_[sidx] - Mj[i]) * sacc[st][i] : 0.f;
            acc += wv;
            Ww[(4 * fq + i) * 72 + sidx] = f2bf(wv);
        }
        acc += __shfl_xor(acc, 1); acc += __shfl_xor(acc, 2); acc += __shfl_xor(acc, 4); acc += __shfl_xor(acc, 8);
        sw[i] = acc;
    }
    asm volatile("s_waitcnt lgkmcnt(0)" ::: "memory");
    bf16x8 wa[2];
#pragma unroll
    for (int ks = 0; ks < 2; ++ks) wa[ks] = *(const LAS bf16x8*)(Ww + fr * 72 + 32 * ks + 8 * fq);
    f32x4 acc1[2], acc2[2], accn;
#pragma unroll
    for (int ee = 0; ee < 2; ++ee) {
        const int et = 2 * hf + ee;
        acc1[ee] = (f32x4){0.f, 0.f, 0.f, 0.f}; acc2[ee] = (f32x4){0.f, 0.f, 0.f, 0.f};
#pragma unroll
        for (int ks = 0; ks < 2; ++ks) {
            const bf16x8 cf = *(const LAS bf16x8*)(Ct + (16 * et + fr) * 72 + 32 * ks + 8 * fq);
            const bf16x8 vf = *(const LAS bf16x8*)(Vt + vt_off(16 * et + fr, 32 * ks + 8 * fq, 72));
            acc1[ee] = __builtin_amdgcn_mfma_f32_16x16x32_bf16(qa[ks], cf, acc1[ee], 0, 0, 0);
            acc2[ee] = __builtin_amdgcn_mfma_f32_16x16x32_bf16(wa[ks], vf, acc2[ee], 0, 0, 0);
        }
    }
    accn = (f32x4){0.f, 0.f, 0.f, 0.f};
#pragma unroll
    for (int ks = 0; ks < 2; ++ks) {
        const bf16x8 cf = *(const LAS bf16x8*)(Ct + (64 + fr) * 72 + 32 * ks + 8 * fq);
        accn = __builtin_amdgcn_mfma_f32_16x16x32_bf16(qa[ks], cf, accn, 0, 0, 0);
    }
    float ov[2][4];
#pragma unroll
    for (int i = 0; i < 4; ++i) {
        const int j = 16 * jt + 4 * fq + i;
        const float qn = __shfl(accn[i], lane & 48);
        const float inter = expf(mprev - Mj[i]);
        const float den = inter * qn + sw[i];
        const float lim = expf(-(as_[j] + Mj[i]));
        const float inv = 1.0f / fmaxf(fabsf(den), lim);
        float ssp = 0.f;
#pragma unroll
        for (int ee = 0; ee < 2; ++ee) {
            const int e = 16 * (2 * hf + ee) + fr;
            const float hv = (inter * acc1[ee][i] + acc2[ee][i]) * inv;
            const float o = sigmoidf_(bf2f(opre[ee][i])) * hv;
            ov[ee][i] = o; ssp += o * o;
        }
        ssp += __shfl_xor(ssp, 1); ssp += __shfl_xor(ssp, 2); ssp += __shfl_xor(ssp, 4); ssp += __shfl_xor(ssp, 8);
        if (fr == 0) ssl[w * 16 + 4 * fq + i] = ssp;
    }
    __syncthreads();
    {
        bf16_t* HD = (bf16_t*)(ws_of(p) + WS_HEADS);
        const float* hn = in_of(p, 22) + l * 1024 + (12 + hh) * 64;
#pragma unroll
        for (int i = 0; i < 4; ++i) {
            const int j = 16 * jt + 4 * fq + i;
            const float tot = ssl[jt * 16 + 4 * fq + i] + ssl[(jt + 4) * 16 + 4 * fq + i];
            const float rs = rsqrtf(tot * (1.0f / 64.0f) + EPS);
#pragma unroll
            for (int ee = 0; ee < 2; ++ee) {
                const int e = 16 * (2 * hf + ee) + fr;
                HD[(size_t)(rowbase + j) * DM + (12 + hh) * 64 + e] = f2bf(ov[ee][i] * rs * hn[e]);
            }
        }
    }
    __syncthreads();
}

__device__ __forceinline__ bf16x8 pack8(const f32x4 lo, const f32x4 hi) {
    u32x4 r; r.x = cvt_pk_bf16(lo[0], lo[1]); r.y = cvt_pk_bf16(lo[2], lo[3]); r.z = cvt_pk_bf16(hi[0], hi[1]); r.w = cvt_pk_bf16(hi[2], hi[3]);
    return __builtin_bit_cast(bf16x8, r);
}
__device__ __forceinline__ bf16x8 join8(const u32x2 lo, const u32x2 hi) { u32x4 r; r.x = lo.x; r.y = lo.y; r.z = hi.x; r.w = hi.y; return __builtin_bit_cast(bf16x8, r); }
__device__ void nsa_item(const Params& p, int l, int b, int g, int qb, LAS unsigned char* lds, int mode = 0) {
    int tid = opaque_tid(), w = __builtin_amdgcn_readfirstlane(tid >> 6), lane = tid & 63, fr = lane & 15, fq = lane >> 4;
    LAS bf16_t* Kc = (LAS bf16_t*)lds;
    LAS bf16_t* Vc = (LAS bf16_t*)(lds + 18432);
    LAS bf16_t* Pl = (LAS bf16_t*)(lds + 36864);
    LAS float* impl = (LAS float*)(lds + 106496);
    LAS unsigned* selm = (LAS unsigned*)(lds + 114688);
    LAS int* steps = (LAS int*)(lds + 114944);
    const bf16_t* U = (const bf16_t*)(ws_of(p) + WS_U);
    const int bg = b * 2 + g, rowbase = b * SEQ;
    const int head = 4 * g + (w >> 1);
    const float sl2 = exp2f(-(float)(head + 1)) * 1.4426950408889634f;
    const int tw0 = qb * 64 + (w & 1) * 32;
    bf16x8 qf[2][2];
#pragma unroll
    for (int mt = 0; mt < 2; ++mt)
#pragma unroll
        for (int ks = 0; ks < 2; ++ks)
            qf[mt][ks] = *(const bf16x8*)(U + (size_t)(rowbase + tw0 + mt * 16 + fr) * UW + head * 64 + ks * 32 + fq * 8);
    const float* GT = (const float*)(ws_of(p) + WS_GATES);
    float gpre[2][3];
#pragma unroll
    for (int mt = 0; mt < 2; ++mt)
#pragma unroll
        for (int q = 0; q < 3; ++q) gpre[mt][q] = GT[(size_t)(rowbase + tw0 + mt * 16 + fr) * 32 + head * 3 + q];
    f32x4 y[2][4];
    {
        LAS float* impM = (LAS float*)Pl;
        LAS float* impT = impM + 4 * 64 * 33;
        const bf16_t* KC = (const bf16_t*)(ws_of(p) + WS_KC) + (size_t)bg * 128 * 64;
        const bf16_t* VC = KC + (size_t)2048 * 64;
        u32x4 kvr[2], vvr[2];
#pragma unroll
        for (int rr = 0; rr < 2; ++rr) { const int idx = tid + rr * NTHREADS; kvr[rr] = *(const u32x4*)(KC + idx * 8); vvr[rr] = *(const u32x4*)(VC + idx * 8); }
#pragma unroll
        for (int rr = 0; rr < 2; ++rr) {
            const int idx = tid + rr * NTHREADS, key = idx >> 3, ch = idx & 7;
            const u32x4 kv = kvr[rr];
            const u32x4 vv = vvr[rr];
            *(LAS u32x4*)(Kc + key * 72 + ch * 8) = kv;
#pragma unroll
            for (int e = 0; e < 4; ++e) {
                Vc[vt_off(ch * 8 + 2 * e, key, 136)] = (bf16_t)(vv[e] & 0xffffu);
                Vc[vt_off(ch * 8 + 2 * e + 1, key, 136)] = (bf16_t)(vv[e] >> 16);
            }
        }
        __syncthreads();
        const int vl136 = vt_lane(fr, fq, 136);
#pragma unroll
        for (int mt = 0; mt < 2; ++mt) {
            const int t = tw0 + mt * 16 + fr;
            f32x4 s[8];
#pragma unroll
            for (int nt = 0; nt < 8; ++nt) {
                const bf16x8 k0 = *(const LAS bf16x8*)(Kc + (16 * nt + fr) * 72 + fq * 8), k1 = *(const LAS bf16x8*)(Kc + (16 * nt + fr) * 72 + 32 + fq * 8);
                s[nt] = __builtin_amdgcn_mfma_f32_16x16x32_bf16(k0, qf[mt][0], (f32x4){0.f, 0.f, 0.f, 0.f}, 0, 0, 0);
                s[nt] = __builtin_amdgcn_mfma_f32_16x16x32_bf16(k1, qf[mt][1], s[nt], 0, 0, 0);
            }
            float mx = NEGF;
#pragma unroll
            for (int nt = 0; nt < 8; ++nt)
#pragma unroll
                for (int i = 0; i < 4; ++i) {
                    const int n = 16 * nt + 4 * fq + i, cend = 16 * n + 31;
                    const bool valid = (t >= cend) && (n < 127);
                    const float sv = valid ? fmaf(sl2, (float)cend, s[nt][i]) : NEGF;
                    s[nt][i] = sv; mx = fmaxf(mx, sv);
                }
            mx = fq_max(mx);
            const float ms = (mx < -1e29f) ? 0.f : mx;
            float sum = 0.f;
#pragma unroll
            for (int nt = 0; nt < 8; ++nt)
#pragma unroll
                for (int i = 0; i < 4; ++i) { const float pv = __builtin_amdgcn_exp2f(s[nt][i] - ms); s[nt][i] = pv; sum += pv; }
            sum = fq_sum(sum);
            const float inv = sum > 0.f ? 1.0f / sum : 0.f;
            {
                LAS float* mrow_ = impM + ((w >> 1) * 64 + (w & 1) * 32 + mt * 16 + fr) * 33 + fq;
                LAS float* trow_ = impT + ((w >> 1) * 64 + (w & 1) * 32 + mt * 16 + fr) * 33 + fq + 1;
#pragma unroll
                for (int nt = 0; nt < 8; ++nt) {
                    s[nt] = s[nt] * inv;
                    mrow_[4 * nt] = (s[nt][0] + s[nt][1]) + (s[nt][2] + s[nt][3]);
                    trow_[4 * nt] = s[nt][3];
                }
            }
            f32x4 oc[4];
#pragma unroll
            for (int dt = 0; dt < 4; ++dt) oc[dt] = (f32x4){0.f, 0.f, 0.f, 0.f};
#pragma unroll
            for (int ks2 = 0; ks2 < 4; ++ks2) {
                const bf16x8 pb = pack8(s[2 * ks2], s[2 * ks2 + 1]);
#pragma unroll
                for (int dt = 0; dt < 4; ++dt) {
                    const u32x2 lo = *(const LAS u32x2*)(Vc + vl136 + vt_cst(dt, 4 * ks2, 136));
                    const u32x2 hi = *(const LAS u32x2*)(Vc + vl136 + vt_cst(dt, 4 * ks2 + 2, 136));
                    oc[dt] = __builtin_amdgcn_mfma_f32_16x16x32_bf16(join8(lo, hi), pb, oc[dt], 0, 0, 0);
                }
            }
            const float g0 = sigmoidf_(gpre[mt][0]);
#pragma unroll
            for (int dt = 0; dt < 4; ++dt) y[mt][dt] = oc[dt] * g0;
        }
        if (tid < 256) impT[tid * 33] = 0.f;
        __syncthreads();
#pragma unroll 1
        for (int rr = 0; rr < 4; ++rr) {
            const int idx = tid + rr * NTHREADS, tau = idx >> 5, j = idx & 31;
            float mine = 0.f;
#pragma unroll
            for (int hh = 0; hh < 4; ++hh) mine += impM[(hh * 64 + tau) * 33 + j] + impT[(hh * 64 + tau) * 33 + j];
            bool sel;
            if (qb < 16) sel = (j <= qb);
            else {
                const bool forced = (j == 0) || (j == qb) || (j == qb - 1);
                const bool cand = (j >= 1) && (j <= qb - 2);
                int rank = 0;
#pragma unroll
                for (int jp = 1; jp < 30; ++jp) {
                    const float o = __shfl(mine, (lane & 32) + jp);
                    rank += (jp <= qb - 2 && (o > mine || (o == mine && jp < j))) ? 1 : 0;
                }
                sel = forced || (cand && rank < 13);
            }
            const unsigned long long bal = __ballot(sel);
            if ((lane & 31) == 0) selm[tau] = (lane < 32) ? (unsigned)bal : (unsigned)(bal >> 32);
        }
        __syncthreads();
        if (tid < 64) {
            unsigned m = selm[tid], uni = m, all = m;
#pragma unroll
            for (int o = 32; o >= 1; o >>= 1) { uni |= __shfl_xor(uni, o); all &= __shfl_xor(all, o); }
            uni &= (qb >= 31) ? 0xffffffffu : ((2u << qb) - 1u);
            const int nsel = __popc(uni);
            const int kb = tid;
            if (kb <= qb && ((uni >> kb) & 1u)) {
                const int pos = nsel - 1 - __popc(uni & ((1u << kb) - 1u));
                steps[1 + pos] = ((((all >> kb) & 1u) && kb < qb) ? 4096 : 0) | (1 << 8) | kb;
            }
            const int kb0 = (qb - 8 < 0) ? 0 : qb - 8;
            if (kb >= kb0 && kb <= qb) steps[1 + nsel + (qb - kb)] = ((kb > qb - 8 && kb < qb) ? 4096 : 0) | (2 << 8) | kb;
            if (tid == 0) steps[0] = nsel + (qb - kb0 + 1);
        }
        __syncthreads();
    }
    if (mode == 1) { asm volatile("" :: "v"(y[0][0][0]), "v"(y[1][3][3])); __syncthreads(); return; }
    tid = opaque_tid(); w = __builtin_amdgcn_readfirstlane(tid >> 6); lane = tid & 63; fr = lane & 15; fq = lane >> 4;
    unsigned smask[2];
#pragma unroll
    for (int mt = 0; mt < 2; ++mt) smask[mt] = selm[(w & 1) * 32 + mt * 16 + fr];
    const int nsteps = __builtin_amdgcn_readfirstlane(steps[0]);
    const int mystep = steps[1 + (lane < 48 ? lane : 47)];
#define NSA_ST(k) __builtin_amdgcn_readlane(mystep, (k))
    float mrow[2], lrow[2];
    f32x4 oacc[2][4];
#pragma unroll
    for (int mt = 0; mt < 2; ++mt) {
        mrow[mt] = NEGF; lrow[mt] = 0.f;
#pragma unroll
        for (int dt = 0; dt < 4; ++dt) oacc[mt][dt] = (f32x4){0.f, 0.f, 0.f, 0.f};
    }
    const int skey = tid >> 3, sch = tid & 7;
    const int vl72 = vt_lane(fr, fq, 72);
    const int vsw = vt_off(sch * 8, skey, 72);
    bf16x8 kx[4], qx;
    {
        const float sh = bf2f(f2bf(sl2)), slo = sl2 - sh;
        u32x4 t = (u32x4){0u, 0u, 0u, 0u};
        if (fq == 0) t.x = cvt_pk_bf16(sh, slo);
        qx = __builtin_bit_cast(bf16x8, t);
#pragma unroll
        for (int nt = 0; nt < 4; ++nt) {
            u32x4 k = (u32x4){0u, 0u, 0u, 0u};
            const float r = (float)(16 * nt + fr);
            if (fq == 0) k.x = cvt_pk_bf16(r, r);
            kx[nt] = __builtin_bit_cast(bf16x8, k);
        }
    }
    const bf16_t* Ubase = U + (size_t)(rowbase + skey) * UW + g * 64 + sch * 8;
#define NSA_SRC(st_) (Ubase + (size_t)((st_) & 255) * 64 * UW + ((((st_) >> 8) & 15) == 1 ? 768 : 1024))
#define NSA_STAGE(buf_, kr_, vr_) do { \
        *(LAS u32x4*)(Kc + (buf_) * (64 * 72) + skey * 72 + sch * 8) = kr_; \
        LAS bf16_t* _vn = Vc + (buf_) * (64 * 72) + vsw; \
        _Pragma("unroll") for (int e = 0; e < 4; ++e) { _vn[(2 * e) * 72] = (bf16_t)(vr_[e] & 0xffffu); _vn[(2 * e + 1) * 72] = (bf16_t)(vr_[e] >> 16); } } while (0)
    u32x4 kregA, vregA;
    {
        const bf16_t* src = NSA_SRC(NSA_ST(0));
        kregA = *(const u32x4*)src; vregA = *(const u32x4*)(src + 128);
        NSA_STAGE(0, kregA, vregA);
    }
    if (nsteps > 1) { const bf16_t* src = NSA_SRC(NSA_ST(1)); kregA = *(const u32x4*)src; vregA = *(const u32x4*)(src + 128); }
    __syncthreads();
    int curkind = 1;
#define NSA_STEP(si, kX, vX) do { \
        const int st = NSA_ST(si), kind = (st >> 8) & 15, kb = st & 255; \
        const bool nomask = (st & 4096) != 0; \
        LAS bf16_t* Kl = Kc + ((si) & 1) * (64 * 72); \
        LAS bf16_t* Vt = Vc + ((si) & 1) * (64 * 72); \
        if (kind != curkind) { \
            _Pragma("unroll") for (int mt = 0; mt < 2; ++mt) { \
                float lt = lrow[mt]; \
                lt = fq_sum(lt); \
                const float sc = sigmoidf_(gpre[mt][1]) / lt; \
                _Pragma("unroll") for (int dt = 0; dt < 4; ++dt) { y[mt][dt] += oacc[mt][dt] * sc; oacc[mt][dt] = (f32x4){0.f, 0.f, 0.f, 0.f}; } \
                mrow[mt] = NEGF; lrow[mt] = 0.f; \
            } \
            curkind = kind; \
        } \
        const float Bs = sl2 * (float)(kb * 64); \
        int kbi = kb * 64 + 4 * fq; \
        asm volatile("" : "+v"(kbi)); \
        f32x4 s[2][4]; \
        _Pragma("unroll") for (int nt = 0; nt < 4; ++nt) { \
            const bf16x8 k0 = *(const LAS bf16x8*)(Kl + (16 * nt + fr) * 72 + fq * 8), k1 = *(const LAS bf16x8*)(Kl + (16 * nt + fr) * 72 + 32 + fq * 8); \
            _Pragma("unroll") for (int mt = 0; mt < 2; ++mt) { \
                s[mt][nt] = __builtin_amdgcn_mfma_f32_16x16x32_bf16(k0, qf[mt][0], (f32x4){0.f, 0.f, 0.f, 0.f}, 0, 0, 0); \
                s[mt][nt] = __builtin_amdgcn_mfma_f32_16x16x32_bf16(k1, qf[mt][1], s[mt][nt], 0, 0, 0); \
                s[mt][nt] = __builtin_amdgcn_mfma_f32_16x16x32_bf16(kx[nt], qx, s[mt][nt], 0, 0, 0); \
            } \
        } \
        bf16x8 pb[2][2]; \
        _Pragma("unroll") for (int mt = 0; mt < 2; ++mt) { \
            float mx = NEGF; \
            if (nomask) { \
                _Pragma("unroll") for (int nt = 0; nt < 4; ++nt) \
                    _Pragma("unroll") for (int i = 0; i < 4; ++i) mx = fmaxf(mx, s[mt][nt][i]); \
            } else { \
                const int t = tw0 + mt * 16 + fr; \
                const bool rowok = (kind == 1) ? (((smask[mt] >> kb) & 1u) != 0u) : true; \
                _Pragma("unroll") for (int nt = 0; nt < 4; ++nt) \
                    _Pragma("unroll") for (int i = 0; i < 4; ++i) { \
                        const int dist = t - (kbi + 16 * nt + i); \
                        const bool valid = rowok && dist >= 0 && (kind == 1 || dist < 512); \
                        const float sv = valid ? s[mt][nt][i] : NEGF; \
                        s[mt][nt][i] = sv; mx = fmaxf(mx, sv); \
                    } \
            } \
            mx = fq_max(mx) + Bs; \
            const bool grow = __builtin_amdgcn_ballot_w64(mx > mrow[mt] + 8.0f) != 0ull;     \
            if (grow) { \
                const float mn_ = fmaxf(mrow[mt], mx); \
                const float alpha = __builtin_amdgcn_exp2f(mrow[mt] - mn_); \
                mrow[mt] = mn_; lrow[mt] *= alpha; \
                _Pragma("unroll") for (int dt = 0; dt < 4; ++dt) oacc[mt][dt] = oacc[mt][dt] * alpha; \
            } \
            const float mn = mrow[mt]; \
            const float ms = ((mn < -1e29f) ? 0.f : mn) - Bs; \
            float ls = 0.f; \
            _Pragma("unroll") for (int nt = 0; nt < 4; ++nt) \
                _Pragma("unroll") for (int i = 0; i < 4; ++i) { const float pv = __builtin_amdgcn_exp2f(s[mt][nt][i] - ms); s[mt][nt][i] = pv; ls += pv; } \
            lrow[mt] += ls; \
            pb[mt][0] = pack8(s[mt][0], s[mt][1]); pb[mt][1] = pack8(s[mt][2], s[mt][3]); \
        } \
        _Pragma("unroll") for (int ks2 = 0; ks2 < 2; ++ks2) \
            _Pragma("unroll") for (int dt = 0; dt < 4; ++dt) { \
                const u32x2 lo = *(const LAS u32x2*)(Vt + vl72 + vt_cst(dt, 4 * ks2, 72)); \
                const u32x2 hi = *(const LAS u32x2*)(Vt + vl72 + vt_cst(dt, 4 * ks2 + 2, 72)); \
                const bf16x8 va = join8(lo, hi); \
                _Pragma("unroll") for (int mt = 0; mt < 2; ++mt) oacc[mt][dt] = __builtin_amdgcn_mfma_f32_16x16x32_bf16(va, pb[mt][ks2], oacc[mt][dt], 0, 0, 0); \
            } \
        if ((si) + 1 < nsteps) NSA_STAGE(((si) + 1) & 1, kX, vX); \
        if ((si) + 2 < nsteps) { const bf16_t* src = NSA_SRC(NSA_ST((si) + 2)); kX = *(const u32x4*)src; vX = *(const u32x4*)(src + 128); } \
        __syncthreads(); \
    } while (0)
    for (int si = 0; si < nsteps; ++si) {
        NSA_STEP(si, kregA, vregA);
    }
#undef NSA_STEP
#undef NSA_ST
#undef NSA_STAGE
#undef NSA_SRC
    tid = opaque_tid(); lane = tid & 63; fr = lane & 15; fq = lane >> 4;
    {
        const float* hn = in_of(p, 22) + l * 1024 + head * 64;
        bf16_t* HD = (bf16_t*)(ws_of(p) + WS_HEADS);
        f32x4 gnv[4];
#pragma unroll
        for (int dt = 0; dt < 4; ++dt) gnv[dt] = *(const f32x4*)(hn + 16 * dt + 4 * fq);
#pragma unroll
        for (int mt = 0; mt < 2; ++mt) {
            const int t = tw0 + mt * 16 + fr;
            float lt = lrow[mt];
            lt = fq_sum(lt);
            const float sc = sigmoidf_(gpre[mt][2]) / lt;
            float ss = 0.f;
            f32x4 yy[4];
#pragma unroll
            for (int dt = 0; dt < 4; ++dt) { yy[dt] = y[mt][dt] + oacc[mt][dt] * sc; ss += (yy[dt][0] * yy[dt][0] + yy[dt][1] * yy[dt][1]) + (yy[dt][2] * yy[dt][2] + yy[dt][3] * yy[dt][3]); }
            ss = fq_sum(ss);
            const float rs = rsqrtf(ss * (1.0f / 64.0f) + EPS);
#pragma unroll
            for (int dt = 0; dt < 4; ++dt) {
                const f32x4 gn = gnv[dt];
                const f32x4 o = yy[dt] * rs * gn;
                u32x2 pk; pk.x = cvt_pk_bf16(o[0], o[1]); pk.y = cvt_pk_bf16(o[2], o[3]);
                *(u32x2*)(HD + (size_t)(rowbase + t) * DM + head * 64 + 16 * dt + 4 * fq) = pk;
            }
        }
    }
    __syncthreads();
}

#define XB_TMO      128
#define XB_XCNT(j)  (256  + 64 * (j))
#define XB_XSUB(j)  (1280 + 64 * (j))
#define XB_XGEN(j)  (2304 + 64 * (j))
#define XB_TOP      3328
#define XB_TOPGEN   3392
#define XCD_BAR_WORDS 3456
#define XB_SPIN_CAP (1u << 22)
__device__ __forceinline__ unsigned xb_ld(unsigned* p)              { return __hip_atomic_load(p, __ATOMIC_RELAXED, __HIP_MEMORY_SCOPE_AGENT); }
__device__ __forceinline__ unsigned xb_add(unsigned* p, unsigned v) { return __hip_atomic_fetch_add(p, v, __ATOMIC_RELAXED, __HIP_MEMORY_SCOPE_AGENT); }
__device__ __forceinline__ unsigned xb_xcc_id() { return (unsigned)__builtin_amdgcn_s_getreg((3 << 11) | 20) & 0xFu; }
#define XB_SPIN(cond, bar) do { unsigned _sp = 0; while (cond) { __builtin_amdgcn_s_sleep(1); \
    if ((++_sp & 255u) == 0u) { if (xb_ld(&(bar)[XB_TMO])) break; if (_sp > XB_SPIN_CAP) { atomicAdd(&(bar)[XB_TMO], 1u); break; } } } } while (0)
struct XcdBarrier { unsigned* bar; unsigned x; volatile LAS unsigned* st; };
__device__ __forceinline__ XcdBarrier xcd_barrier_post(unsigned* bar, volatile LAS unsigned* st) {
    XcdBarrier b; b.bar = bar; b.x = xb_xcc_id(); b.st = st;
    if (threadIdx.x == 0) (void)xb_add(&bar[XB_XCNT(b.x)], 1u);
    return b;
}
__device__ __forceinline__ void xcd_barrier_complete(unsigned* bar, unsigned x, unsigned& nloc, unsigned& nx) {
    const unsigned G = gridDim.x * gridDim.y * gridDim.z;
    unsigned sum, cnt, mine, sp = 0u;
    for (;;) {
        sum = 0u; cnt = 0u; mine = 0u;
#pragma unroll
        for (unsigned j = 0; j < 16; ++j) { const unsigned c = xb_ld(&bar[XB_XCNT(j)]); sum += c; cnt += (c > 0u) ? 1u : 0u; mine = (j == x) ? c : mine; }
        if (sum == G) break;
        __builtin_amdgcn_s_sleep(1);
        if ((++sp & 255u) == 0u) { if (xb_ld(&bar[XB_TMO])) break; if (sp > XB_SPIN_CAP) { atomicAdd(&bar[XB_TMO], 1u); break; } }
    }
    nloc = mine > 0u ? mine : 1u; nx = cnt > 0u ? cnt : 1u;
}
__device__ __forceinline__ void xcd_barrier(const XcdBarrier& b) {
    asm volatile("s_waitcnt vmcnt(0)" ::: "memory");
    __syncthreads();
    if (threadIdx.x == 0) {
        unsigned* bar = b.bar;
        __builtin_amdgcn_s_waitcnt(0);
        unsigned nloc = b.st[0], nx = b.st[1];
        if (nloc == 0u) { xcd_barrier_complete(bar, b.x, nloc, nx); b.st[0] = nloc; b.st[1] = nx; }
        const unsigned old = xb_add(&bar[XB_XSUB(b.x)], 1u);
        const unsigned gen = old / nloc;
        if (old + 1u == (gen + 1u) * nloc) {
            __builtin_amdgcn_fence(__ATOMIC_RELEASE, "agent");
            asm volatile("s_waitcnt vmcnt(0)" ::: "memory");
            const unsigned og = xb_add(&bar[XB_TOP], 1u);
            const unsigned tg = og / nx;
            if (og + 1u == (tg + 1u) * nx) xb_add(&bar[XB_TOPGEN], 1u);
            else XB_SPIN(xb_ld(&bar[XB_TOPGEN]) == tg, bar);
            __builtin_amdgcn_fence(__ATOMIC_ACQUIRE, "agent");
            xb_add(&bar[XB_XGEN(b.x)], 1u);
            asm volatile("s_waitcnt vmcnt(0)" ::: "memory");
        } else {
            XB_SPIN(xb_ld(&bar[XB_XGEN(b.x)]) == gen, bar);
            __builtin_amdgcn_fence(__ATOMIC_ACQUIRE, "agent");
            asm volatile("s_waitcnt vmcnt(0)" ::: "memory");
        }
    }
    __syncthreads();
}

__global__ void __launch_bounds__(NTHREADS) hymba_fwd(Params p) {
    extern __shared__ __attribute__((aligned(16))) unsigned char lds_raw[];
    LAS unsigned char* lds = (LAS unsigned char*)lds_raw;
    cg::grid_group grid = cg::this_grid();
    volatile LAS unsigned* xbw = (volatile LAS unsigned*)(lds + LDS_BYTES - 16);
    if (threadIdx.x < 4) xbw[threadIdx.x] = 0u;
    __syncthreads();
    XcdBarrier xbar = xcd_barrier_post((unsigned*)(ws_of(p) + WS_BAR), xbw);
    if (p.ph_hi - p.ph_lo > 1) grid.sync();
    for (int ph = p.ph_lo; ph < p.ph_hi; ++ph) {
        int G = gridDim.x, bid = blockIdx.x;
        asm volatile("" : "+s"(G), "+s"(bid));
        const int tpx = opaque_tid();
        if (ph == 0) {
            if (PHEN(0)) prologue(p, lds, bid, G);
            if (REP_SUB == 100) { __syncthreads(); prologue(p, lds, bid, G); }
        } else if (ph == 37) { if (PHEN(10)) {
            const float* ssq = (const float*)(ws_of(p) + WS_SSQ) + (size_t)(12 & 1) * T_ * 16;
            float* outp = out_of(p);
            const f32x4 gn = *(const f32x4*)(in_of(p, 28) + (tpx & 255) * 4);
            for (int it = bid; it < T_ / 8; it += G) {
                f32x4 v[4], pa[4][4];
#pragma unroll
                for (int q = 0; q < 4; ++q) {
                    const int row = it * 8 + q * 2 + (tpx >> 8);
                    v[q] = *(const f32x4*)(outp + (size_t)row * DM + (tpx & 255) * 4);
#pragma unroll
                    for (int k = 0; k < 4; ++k) pa[q][k] = *(const f32x4*)(ssq + (size_t)row * 16 + 4 * k);
                }
#pragma unroll
                for (int q = 0; q < 4; ++q) {
                    const int row = it * 8 + q * 2 + (tpx >> 8);
                    const float sm = (((pa[q][0][0] + pa[q][0][1]) + (pa[q][0][2] + pa[q][0][3])) + ((pa[q][1][0] + pa[q][1][1]) + (pa[q][1][2] + pa[q][1][3]))) + (((pa[q][2][0] + pa[q][2][1]) + (pa[q][2][2] + pa[q][2][3])) + ((pa[q][3][0] + pa[q][3][1]) + (pa[q][3][2] + pa[q][3][3])));
                    const float r = rsqrtf(sm * (1.0f / DM) + EPS);
                    *(f32x4*)(outp + (size_t)row * DM + (tpx & 255) * 4) = v[q] * r * gn;
                }
            } }
        } else {
            const int l = (ph - 1) / 9, sub = (ph - 1) % 9;
            unsigned char* wl = ws_of(p) + WS_W + (size_t)l * LAYER_W;
            float* ssq = (float*)(ws_of(p) + WS_SSQ);
            bf16_t* HB = (bf16_t*)(ws_of(p) + WS_HB);
            bf16_t* UB = (bf16_t*)(ws_of(p) + WS_U);
            if (PHEN(1) && (sub == 0 || sub == 7)) {
                const bool second = sub == 7;
                pg8::Gemm g{HB, (const bf16_t*)(wl + (second ? LO_W13B : LO_W13A)), T_, NUP, DM, DM, DM};
                pg8::StaticOrder S; S.init(T_, NUP, G, bid);
                EpiSwiGLU E{UB, ssq + (size_t)((3 * l + (second ? 2 : 0)) & 1) * T_ * 16};
                pg8::gemm_phase(lds, g, S, E);
                if (REP_SUB == 0) { __syncthreads(); pg8::gemm_phase(lds, g, S, E); }
            } else if (PHEN(2) && (sub == 1 || sub == 8 || sub == 6)) {
                const bool wout = sub == 6, second = sub == 8;
                pg8::Gemm g;
                if (wout) g = pg8::Gemm{(const bf16_t*)(ws_of(p) + WS_HEADS), (const bf16_t*)(wl + LO_WOUT), T_, DM, DM, DM, DM};
                else g = pg8::Gemm{UB, (const bf16_t*)(wl + (second ? LO_W2B : LO_W2A)), T_, DM, DFF, DFF, DFF};
                pg8::StaticOrder S; S.init(T_, DM, G, bid);
                const float* resid = (l == 0 && sub == 1) ? in_of(p, 0) : out_of(p);
                const int nxt = 3 * l + (sub == 1 ? 1 : (sub == 6 ? 2 : 3));
                EpiResid E{resid, out_of(p), HB, ssq + (size_t)(nxt & 1) * T_ * 16, wout ? 1.0f : 0.5f};
                pg8::gemm_phase(lds, g, S, E);
                if (REP_SUB == 1) { __syncthreads(); EpiResid E2{out_of(p), out_of(p), HB, ssq + (size_t)(nxt & 1) * T_ * 16, 0.0f}; pg8::gemm_phase(lds, g, S, E2); }
            } else if (PHEN(3) && sub == 2) {
                if (bid < 2 && tpx < 256) {
                    const float* cbp = (const float*)(ws_of(p) + WS_CBP) + (size_t)((l * 2 + bid) * 32) * 256 + tpx;
                    float sb = 0.f;
#pragma unroll
                    for (int q = 0; q < 32; ++q) sb += cbp[q * 256];
                    ((float*)(ws_of(p) + WS_CBIAS))[(l * 2 + bid) * 256 + tpx] = sb;
                }
                pg8::Gemm g{HB, (const bf16_t*)(wl + LO_WIN), T_, NINP, DM, DM, DM};
                pg8::StaticOrder S; S.init(T_, NINP, G, bid);
                EpiWin E{UB, (bf16_t*)(ws_of(p) + WS_KCMP), (bf16_t*)(ws_of(p) + WS_VCMP), (float*)(ws_of(p) + WS_GATES), ssq + (size_t)((3 * l + 1) & 1) * T_ * 16};
                pg8::gemm_phase(lds, g, S, E);
                if (REP_SUB == 2) { __syncthreads(); pg8::gemm_phase(lds, g, S, E); }
            } else if (sub == 3) {
                const int ngemm = 64;
                for (int rep = 0; rep < (REP_SUB == 3 ? 2 : 1); ++rep) {
                const int cls = rep == 0 ? 7 : REP_CLASS;
                if (rep) __syncthreads();
                if (G > ngemm) {
                    if (bid < ngemm) { if (PHEN(4) && (cls & 1)) {
                        const int kp = bid >> 4, kv = (bid >> 3) & 1;
                        pg8::Gemm g{(const bf16_t*)(ws_of(p) + (kv ? WS_VCMP : WS_KCMP)) + kp * 512, (const bf16_t*)(wl + (kv ? LO_CW1V : LO_CW1K)) + kp * 512, 2048, 256, 512, 1024, 2048};
                        pg8::SingleUnit S{bid & 7};
                        EpiCmp E{(float*)(ws_of(p) + WS_HID) + (size_t)(kp * 2 + kv) * 2048 * 256};
                        pg8::gemm_phase(lds, g, S, E); }
                    }
                    if (PHEN(5)) {
                        const bool gb = bid < ngemm;
                        const int i0 = gb ? 1728 + bid : bid - ngemm, i1 = gb ? 2048 : 1728, st = gb ? ngemm : G - ngemm;
                        for (int it = i0; it < i1; it += st) {
                            if (it < 1024) { if (cls & 2) lru_x_item(p, l, it >> 7, (it >> 5) & 3, it & 31, lds); }
                            else if (cls & 4) ml_x_item(p, l, (it - 1024) >> 5, it & 31, lds);
                        }
                    }
                }
                }
            } else if (PHEN(6) && sub == 4) {
                phase_m2(p, l, 7, lds, bid, G);
                if (REP_SUB == 4) { __syncthreads(); phase_m2(p, l, REP_CLASS, lds, bid, G); }
            } else if (sub == 5) {
                for (int rep = 0; rep < (REP_SUB == 5 ? 2 : 1); ++rep) {
                const int cls = rep == 0 ? 7 : REP_CLASS;
                if (rep) __syncthreads();
                for (int it = bid; it < 512 + 1024 + 512; it += G) {
                    if (it < 512) { if (PHEN(7) && (cls & 1)) {
                        const int qb = it < 256 ? 31 - (it >> 4) : ((it - 256) >> 4), bg = it & 15;
                        nsa_item(p, l, bg >> 1, bg & 1, qb, lds, (rep == 1 && REP_CLASS == 9) ? 1 : 0); }
                    } else if (it < 1536) {
                        if (PHEN(8) && (cls & 2)) ml_y_item(p, l, (it - 512) >> 5, (it - 512) & 31, lds);
                    } else {
                        if (PHEN(9) && (cls & 4)) lru_y_item(p, l, it - 1536);
                    }
                }
                }
            }
        }
        if (ph + 1 < p.ph_hi) {
            xcd_barrier(xbar);
            if (REP_SUB == 200) xcd_barrier(xbar);
        }
    }
}

extern "C" void kernel_launch(void* const* d_in, const int* in_sizes, int n_in, void* d_out, int out_size, void* d_ws, size_t ws_size, hipStream_t stream) {
    static int grid = 0;
    if (grid == 0) {
        if (n_in != 29 || out_size != T_ * DM || ws_size < WS_END) { fprintf(stderr, "kernel_launch: unexpected shapes (n_in %d out %d ws %zu need %zu)\n", n_in, out_size, ws_size, (size_t)WS_END); grid = -1; return; }
        int dev = 0, cus = 0, per_cu = 0;
        hipGetDevice(&dev);
        hipDeviceGetAttribute(&cus, hipDeviceAttributeMultiprocessorCount, dev);
        hipFuncSetAttribute((const void*)hymba_fwd, hipFuncAttributeMaxDynamicSharedMemorySize, LDS_BYTES);
        hipOccupancyMaxActiveBlocksPerMultiprocessor(&per_cu, (const void*)hymba_fwd, NTHREADS, LDS_BYTES);
        if (per_cu < 1) { fprintf(stderr, "kernel_launch: occupancy query says %d blocks per CU\n", per_cu); per_cu = 1; }
        (void)hipGetLastError();
        grid = cus;
    }
    if (grid < 0) return;
    Params p{};
    for (int i = 0; i < 29; ++i) p.in[i] = (const float*)d_in[i];
    p.out = (float*)d_out; p.ws = (unsigned char*)d_ws;
#if ONE_LAUNCH
    (void)hipMemsetAsync((unsigned char*)d_ws + WS_BAR, 0, 16384, stream);
    p.ph_lo = 0; p.ph_hi = 38;
    void* args[] = {&p};
    hipError_t e = hipLaunchCooperativeKernel((const void*)hymba_fwd, dim3(grid), dim3(NTHREADS), args, LDS_BYTES, stream);
    if (e != hipSuccess) fprintf(stderr, "cooperative launch failed: %s (grid %d)\n", hipGetErrorString(e), grid);
#else
    for (int ph = 0; ph < 38; ++ph) {
        p.ph_lo = ph; p.ph_hi = ph + 1;
        hipLaunchKernelGGL(hymba_fwd, dim3(grid), dim3(NTHREADS), LDS_BYTES, stream, p);
    }
#endif
}
```

```cpp
#include <hip/hip_runtime.h>
#include <hip/hip_cooperative_groups.h>
#include <cstdio>
namespace cg = cooperative_groups;

#define LAS __attribute__((address_space(3)))
typedef unsigned short bf16_t;
typedef short bf16x8 __attribute__((ext_vector_type(8)));
typedef float f32x4 __attribute__((ext_vector_type(4)));
typedef float f32x2 __attribute__((ext_vector_type(2)));
typedef unsigned u32x4 __attribute__((ext_vector_type(4)));
typedef unsigned u32x2 __attribute__((ext_vector_type(2)));

#ifndef ONE_LAUNCH
#define ONE_LAUNCH 1
#endif
#ifndef PHMASK
#define PHMASK 0xFFFF
#endif
#define PHEN(k) ((PHMASK >> (k)) & 1)
#ifndef REP_SUB
#define REP_SUB -1
#endif
#ifndef REP_CLASS
#define REP_CLASS 7
#endif

constexpr int T_ = 16384, SEQ = 2048, DM = 1024, DFF = 2816, NUP = 5632, NINP = 3072, UW = 2816, DIN = 2848;
constexpr float EPS = 1e-6f;
constexpr float NEGF = -1e30f;
constexpr int NTHREADS = 512;
constexpr int LDS_BYTES = 147456;

constexpr size_t SZ_W13T = (size_t)NUP * DM * 2, SZ_W2T = (size_t)DM * DFF * 2, SZ_WINT = (size_t)NINP * DM * 2, SZ_WOUTT = (size_t)DM * DM * 2, SZ_CW1T = (size_t)256 * 2048 * 2;
constexpr size_t LO_W13A = 0, LO_W2A = LO_W13A + SZ_W13T, LO_W13B = LO_W2A + SZ_W2T, LO_W2B = LO_W13B + SZ_W13T, LO_WIN = LO_W2B + SZ_W2T, LO_WOUT = LO_WIN + SZ_WINT,
                 LO_CW1K = LO_WOUT + SZ_WOUTT, LO_CW1V = LO_CW1K + SZ_CW1T, LAYER_W = LO_CW1V + SZ_CW1T;
constexpr size_t WS_W = 0;
constexpr size_t WS_HB = WS_W + 4 * LAYER_W;
constexpr size_t WS_U = WS_HB + (size_t)T_ * DM * 2;
constexpr size_t WS_HEADS = WS_U + (size_t)T_ * UW * 2;
constexpr size_t SZ_CMPIN = (size_t)16 * 2048 * 64 * 2 + 4096;
constexpr size_t WS_KCMP = WS_HEADS + (size_t)T_ * DM * 2;
constexpr size_t WS_VCMP = WS_KCMP + SZ_CMPIN;
constexpr size_t WS_HID = WS_VCMP + SZ_CMPIN;
constexpr size_t WS_KC = WS_HID + (size_t)4 * 2 * 2048 * 256 * 4;
constexpr size_t WS_GATES = WS_KC + (size_t)2 * 2048 * 64 * 2;
constexpr size_t WS_SSQ = WS_GATES + (size_t)T_ * 32 * 4;
constexpr size_t WS_CBIAS = WS_SSQ + (size_t)2 * T_ * 16 * 4;
constexpr size_t WS_LRUH = WS_CBIAS + 8192;
constexpr size_t WS_LRUA = WS_LRUH + (size_t)T_ * 256 * 4;
constexpr size_t WS_LRUC = WS_LRUA + (size_t)T_ * 256 * 4;
constexpr size_t WS_MLC = WS_LRUC + (size_t)8 * 32 * 256 * 4;
constexpr size_t WS_MLN = WS_MLC + (size_t)1024 * 4096 * 4;
constexpr size_t WS_MLMU = WS_MLN + (size_t)1024 * 64 * 4;
constexpr size_t WS_MLAT = WS_MLMU + 4096;
constexpr size_t WS_MLMP = WS_MLAT + 4096;
constexpr size_t WS_CBP = WS_MLMP + 4096;
constexpr size_t WS_LRUWT = WS_CBP + 262144;
constexpr size_t WS_BAR = WS_LRUWT + 262144;
constexpr size_t WS_END = WS_BAR + 16384;
static_assert(WS_END <= 425365632ull, "workspace too large");
static_assert(LAYER_W % 256 == 0 && WS_HB % 256 == 0 && WS_U % 256 == 0 && WS_KCMP % 256 == 0 && WS_VCMP % 256 == 0 && WS_HID % 256 == 0, "align");

struct Params {
    const float* in[29];
    float* out;
    unsigned char* ws;
    int ph_lo, ph_hi;
};
static_assert(sizeof(Params) == 256, "Params has padding");
#define GAS __attribute__((address_space(1)))
__device__ __forceinline__ unsigned char* ws_of(const Params& p) { unsigned long long w = (unsigned long long)p.ws; asm volatile("" : "+s"(w)); return (unsigned char*)(GAS unsigned char*)w; }
__device__ __forceinline__ float* out_of(const Params& p) { unsigned long long w = (unsigned long long)p.out; asm volatile("" : "+s"(w)); return (float*)(GAS float*)w; }
__device__ __forceinline__ const float* in_of(const Params& p, int i) { unsigned long long w = (unsigned long long)p.in[i]; asm volatile("" : "+s"(w)); return (const float*)(GAS const float*)w; }
__device__ __forceinline__ unsigned cvt_pk_bf16(float lo, float hi) { unsigned r; asm volatile("v_cvt_pk_bf16_f32 %0, %1, %2" : "=v"(r) : "v"(lo), "v"(hi)); return r; }
__device__ __forceinline__ bf16_t f2bf(float f) { return (bf16_t)(cvt_pk_bf16(f, 0.f) & 0xffffu); }
__device__ __forceinline__ float bf2f(bf16_t b) { return __uint_as_float(((unsigned)b) << 16); }
__device__ __forceinline__ float sigmoidf_(float x) { return 1.0f / (1.0f + __expf(-x)); }
__device__ __forceinline__ int opaque_tid() { int x = threadIdx.x; asm volatile("" : "+v"(x)); return x; }
__device__ __forceinline__ float row_rstd(const float* part, int row) {
    const f32x4 a = *(const f32x4*)(part + (size_t)row * 16), b = *(const f32x4*)(part + (size_t)row * 16 + 4), c = *(const f32x4*)(part + (size_t)row * 16 + 8), d = *(const f32x4*)(part + (size_t)row * 16 + 12);
    const float s = (((a[0] + a[1]) + (a[2] + a[3])) + ((b[0] + b[1]) + (b[2] + b[3]))) + (((c[0] + c[1]) + (c[2] + c[3])) + ((d[0] + d[1]) + (d[2] + d[3])));
    return rsqrtf(s * (1.0f / DM) + EPS);
}
__device__ __forceinline__ float fq_max(float x) {
    auto a = __builtin_amdgcn_permlane16_swap(__float_as_uint(x), __float_as_uint(x), false, false);
    const float m = fmaxf(__uint_as_float(a[0]), __uint_as_float(a[1]));
    auto b = __builtin_amdgcn_permlane32_swap(__float_as_uint(m), __float_as_uint(m), false, false);
    return fmaxf(__uint_as_float(b[0]), __uint_as_float(b[1]));
}
__device__ __forceinline__ float fq_sum(float x) {
    auto a = __builtin_amdgcn_permlane16_swap(__float_as_uint(x), __float_as_uint(x), false, false);
    const float m = __uint_as_float(a[0]) + __uint_as_float(a[1]);
    auto b = __builtin_amdgcn_permlane32_swap(__float_as_uint(m), __float_as_uint(m), false, false);
    return __uint_as_float(b[0]) + __uint_as_float(b[1]);
}
__device__ __forceinline__ float wave_sum(float v) {
#pragma unroll
    for (int o = 32; o >= 1; o >>= 1) v += __shfl_xor(v, o);
    return v;
}
__device__ __forceinline__ float wave_max(float v) {
#pragma unroll
    for (int o = 32; o >= 1; o >>= 1) v = fmaxf(v, __shfl_xor(v, o));
    return v;
}

namespace pg8 {
constexpr int BM = 256, BK = 64, HALF = 128, HTB = HALF * BK * 2, STAGE_BYTES = 8 * HTB, NXCD = 8, WGM = 8;
__device__ __forceinline__ int lds_byte(int r, int c) { const int st = (r >> 4) * 2 + (c >> 5), rr = r & 15, cc = c & 31, ob = rr * 64 + cc * 2; return st * 1024 + (ob ^ (((ob >> 9) & 1) << 5)); }
__device__ __forceinline__ void stage_rc(int b, int& R, int& C) { const int st = b / 1024, sb = b % 1024, swz = sb ^ (((sb >> 9) & 1) << 5); R = (st >> 1) * 16 + swz / 64; C = (st & 1) * 32 + (swz % 64) / 2; }

struct Unit { int pm, pn; };
struct Gemm { const bf16_t* A; const bf16_t* Bt; int M, N, K, lda, ldb; };

struct StaticOrder {
    int nM, nN, nwg, G, c;
    __device__ void init(int M, int N, int G_, int c_) { nM = M / BM; nN = N / BM; nwg = nM * nN; G = G_; c = c_; }
    __device__ bool next(int i, Unit& u) const {
        const long L = (long)i * G + c; if (L >= nwg) return false;
        int wgid = (int)L; { const int q = nwg / NXCD, r = nwg % NXCD, xcd = wgid % NXCD, off = wgid / NXCD; wgid = (xcd < r ? xcd * (q + 1) : r * (q + 1) + (xcd - r) * q) + off; }
        const int nig = WGM * nN, gid = wgid / nig, fm = gid * WGM, gsz = (nM - fm) < WGM ? (nM - fm) : WGM;
        u.pm = fm + ((wgid % nig) % gsz); u.pn = (wgid % nig) / gsz; return true;
    }
};
struct SingleUnit {
    int pm;
    __device__ bool next(int i, Unit& u) const { if (i != 0 || pm < 0) return false; u.pm = pm; u.pn = 0; return true; }
};

template <class Epi, class Sched>
__device__ __forceinline__ void gemm_phase(LAS unsigned char* lds, const Gemm g, const Sched& S, const Epi& E) {
    const int tid = opaque_tid(), wid = __builtin_amdgcn_readfirstlane(tid >> 6), lane = tid & 63, wr = wid >> 2, wc = wid & 3, fr = lane & 15, fq = lane >> 4;
    const int K = g.K, nt = K / BK;
    unsigned voffA[2], voffB[2];
#pragma unroll
    for (int i = 0; i < 2; ++i) { int R, C; stage_rc(tid * 16 + i * 8192, R, C);
        voffA[i] = (unsigned)(R * g.lda + C) * 2u; voffB[i] = (unsigned)(R * g.ldb + C) * 2u; }
    const size_t kstep = (size_t)(BK * 2);
    const size_t hstepA = (size_t)HALF * g.lda * 2, hstepB = (size_t)HALF * g.ldb * 2;
    const size_t tstepA = 2 * hstepA, tstepB = 2 * hstepB;
    const unsigned ldsw = (unsigned)wid * 1024u;
    const int aoff = lds_byte(wr * 64 + fr, fq * 8), boff = lds_byte(wc * 32 + fr, fq * 8);
#define PG8_SA(b, h) (((b) * 2 + (h)) * HTB)
#define PG8_SB(b, h) ((4 + (b) * 2 + (h)) * HTB)
#define PG8_STAGE(bufoff, gbase, voff) do { _Pragma("unroll") for (int _i = 0; _i < 2; ++_i) \
        __builtin_amdgcn_global_load_lds((const unsigned*)((const char*)(gbase) + (voff)[_i]), (LAS unsigned*)(lds + (bufoff) + ldsw + _i * 8192), 16, 0, 0); } while (0)
#define PG8_LDA(dst, b, h) do { _Pragma("unroll") for (int m = 0; m < 4; ++m) _Pragma("unroll") for (int k = 0; k < 2; ++k) dst[m][k] = *(const LAS bf16x8*)(lds + PG8_SA(b, h) + aoff + m * 2048 + k * 1024); } while (0)
#define PG8_LDB(dst, b, h) do { _Pragma("unroll") for (int n = 0; n < 2; ++n) _Pragma("unroll") for (int k = 0; k < 2; ++k) dst[n][k] = *(const LAS bf16x8*)(lds + PG8_SB(b, h) + boff + n * 2048 + k * 1024); } while (0)
#define PG8_MMA(ai, bj, At, Bt) do { __builtin_amdgcn_s_setprio(1); _Pragma("unroll") for (int m = 0; m < 4; ++m) _Pragma("unroll") for (int n = 0; n < 2; ++n) _Pragma("unroll") for (int k = 0; k < 2; ++k) \
        acc[ai][bj][m][n] = __builtin_amdgcn_mfma_f32_16x16x32_bf16(Bt[n][k], At[m][k], acc[ai][bj][m][n], 0, 0, 0); __builtin_amdgcn_s_setprio(0); } while (0)
#define PG8_WAIT_V(n) asm volatile("s_waitcnt vmcnt(" #n ")" ::: "memory")
#define PG8_WAIT_L(n) asm volatile("s_waitcnt lgkmcnt(" #n ")" ::: "memory")
#define PG8_BAR __builtin_amdgcn_s_barrier()
#define PG8_SCHED __builtin_amdgcn_sched_barrier(0)
    Unit cur, nxt; int ui = 0;
    if (!S.next(0, cur)) return;
    f32x4 acc[2][2][4][2];
#pragma unroll
    for (int a = 0; a < 2; ++a)
#pragma unroll
        for (int b = 0; b < 2; ++b)
#pragma unroll
            for (int m = 0; m < 4; ++m)
#pragma unroll
                for (int n = 0; n < 2; ++n) acc[a][b][m][n] = (f32x4){0.f, 0.f, 0.f, 0.f};
    bf16x8 At[4][2], B0[2][2], B1[2][2];
    const char* cA = (const char*)g.A + (size_t)cur.pm * tstepA; const char* cB = (const char*)g.Bt + (size_t)cur.pn * tstepB;
    PG8_STAGE(PG8_SB(0, 0), cB, voffB); PG8_STAGE(PG8_SA(0, 0), cA, voffA); PG8_STAGE(PG8_SB(0, 1), cB + hstepB, voffB); PG8_STAGE(PG8_SA(0, 1), cA + hstepA, voffA);
    if (wr == 1) PG8_BAR;
    PG8_WAIT_V(4); PG8_BAR;
    PG8_STAGE(PG8_SB(1, 0), cB + kstep, voffB); PG8_STAGE(PG8_SA(1, 0), cA + kstep, voffA); PG8_STAGE(PG8_SB(1, 1), cB + hstepB + kstep, voffB);
    PG8_WAIT_V(6); PG8_BAR;
    for (;;) {
        const bool has_next = S.next(ui + 1, nxt);
        const char* nA = has_next ? (const char*)g.A + (size_t)nxt.pm * tstepA : cA; const char* nB = has_next ? (const char*)g.Bt + (size_t)nxt.pn * tstepB : cB;
        for (int t = 0; t < nt; t += 2) {
            const bool last = (t == nt - 2);
            const char* a1 = cA + (size_t)(t + 1) * kstep;
            const char* a2 = last ? nA : cA + (size_t)(t + 2) * kstep; const char* b2 = last ? nB : cB + (size_t)(t + 2) * kstep;
            const char* a3 = a2 + kstep; const char* b3 = b2 + kstep;
            PG8_LDB(B0, 0, 0); PG8_SCHED; PG8_LDA(At, 0, 0); PG8_STAGE(PG8_SA(1, 1), a1 + hstepA, voffA);
            PG8_WAIT_L(8); PG8_BAR; PG8_WAIT_L(0); PG8_MMA(0, 0, At, B0); PG8_BAR; PG8_SCHED;
            PG8_LDB(B1, 0, 1); PG8_STAGE(PG8_SB(0, 0), b2, voffB);
            PG8_BAR; PG8_WAIT_L(0); PG8_MMA(0, 1, At, B1); PG8_BAR;
            PG8_LDA(At, 0, 1); PG8_STAGE(PG8_SA(0, 0), a2, voffA);
            PG8_BAR; PG8_WAIT_L(0); PG8_MMA(1, 0, At, B0); PG8_BAR; PG8_SCHED;
            PG8_STAGE(PG8_SB(0, 1), b2 + hstepB, voffB);
            PG8_WAIT_V(6); PG8_BAR; PG8_MMA(1, 1, At, B1); PG8_BAR;
            PG8_LDB(B0, 1, 0); PG8_SCHED; PG8_LDA(At, 1, 0); PG8_STAGE(PG8_SA(0, 1), a2 + hstepA, voffA);
            PG8_WAIT_L(8); PG8_BAR; PG8_WAIT_L(0); PG8_MMA(0, 0, At, B0); PG8_BAR; PG8_SCHED;
            PG8_LDB(B1, 1, 1); PG8_STAGE(PG8_SB(1, 0), b3, voffB);
            PG8_BAR; PG8_WAIT_L(0); PG8_MMA(0, 1, At, B1); PG8_BAR;
            PG8_LDA(At, 1, 1); PG8_STAGE(PG8_SA(1, 0), a3, voffA);
            PG8_BAR; PG8_WAIT_L(0); PG8_MMA(1, 0, At, B0); PG8_BAR; PG8_SCHED;
            PG8_STAGE(PG8_SB(1, 1), b3 + hstepB, voffB);
            PG8_WAIT_V(6); PG8_BAR; PG8_MMA(1, 1, At, B1); PG8_BAR;
        }
        E(acc, cur, wr, wc, fr, fq);
        if (!has_next) break;
#pragma unroll
        for (int a = 0; a < 2; ++a)
#pragma unroll
            for (int b = 0; b < 2; ++b)
#pragma unroll
                for (int m = 0; m < 4; ++m)
#pragma unroll
                    for (int n = 0; n < 2; ++n) acc[a][b][m][n] = (f32x4){0.f, 0.f, 0.f, 0.f};
        cur = nxt; cA = nA; cB = nB; ++ui;
    }
    PG8_WAIT_V(0);
    if (wr == 0) PG8_BAR;
    PG8_BAR;
#undef PG8_SA
#undef PG8_SB
#undef PG8_STAGE
#undef PG8_LDA
#undef PG8_LDB
#undef PG8_MMA
#undef PG8_WAIT_V
#undef PG8_WAIT_L
#undef PG8_BAR
#undef PG8_SCHED
}
}

typedef __attribute__((address_space(1))) float gf32;
typedef __attribute__((address_space(1))) const float gcf32;
typedef __attribute__((address_space(1))) bf16_t gbf16;
typedef __attribute__((address_space(1))) f32x4 gf32x4;
typedef __attribute__((address_space(1))) const f32x4 gcf32x4;
typedef __attribute__((address_space(1))) u32x2 gu32x2;
__device__ __forceinline__ void rows_rstd(const float* ssq, int row0, int fq, float (&r8)[2][4]) {
    f32x4 pv[2][4];
#pragma unroll
    for (int ai = 0; ai < 2; ++ai)
#pragma unroll
        for (int m = 0; m < 4; ++m) pv[ai][m] = *(gcf32x4*)(ssq + (size_t)(row0 + ai * 128 + m * 16) * 16 + 4 * fq);
#pragma unroll
    for (int ai = 0; ai < 2; ++ai)
#pragma unroll
        for (int m = 0; m < 4; ++m) {
            float sm = (pv[ai][m][0] + pv[ai][m][1]) + (pv[ai][m][2] + pv[ai][m][3]);
            sm = fq_sum(sm);
            r8[ai][m] = rsqrtf(sm * (1.0f / DM) + EPS);
        }
}
struct EpiSwiGLU {
    bf16_t* act; const float* ssq;
    __device__ __forceinline__ void operator()(const f32x4 (&acc)[2][2][4][2], const pg8::Unit& u, int wr, int wc, int fr, int fq) const {
        const int row0 = u.pm * 256 + wr * 64 + fr, col0 = u.pn * 128 + wc * 32 + 8 * fq;
        float r8[2][4];
        rows_rstd(ssq, row0, fq, r8);
#pragma unroll
        for (int ai = 0; ai < 2; ++ai)
#pragma unroll
            for (int m = 0; m < 4; ++m) {
                const int row = row0 + ai * 128 + m * 16;
                const float r = r8[ai][m];
                float o[8];
#pragma unroll
                for (int n = 0; n < 2; ++n) {
                    const f32x4 a1 = acc[ai][0][m][n] * r, a3 = acc[ai][1][m][n] * r;
#pragma unroll
                    for (int j = 0; j < 4; ++j) o[4 * n + j] = a1[j] * __builtin_amdgcn_rcpf(1.0f + __expf(-a1[j])) * a3[j];
                }
                u32x4 w; w.x = cvt_pk_bf16(o[0], o[1]); w.y = cvt_pk_bf16(o[2], o[3]); w.z = cvt_pk_bf16(o[4], o[5]); w.w = cvt_pk_bf16(o[6], o[7]);
                *(GAS u32x4*)(act + (size_t)row * DFF + col0) = w;
            }
    }
};
struct EpiResid {
    const float* resid; float* out; bf16_t* hb; float* ssq_next; float scale;
    __device__ __forceinline__ void load2(f32x4 (&rs)[2][2][2], int row0, int col0, int ai, int mp) const {
#pragma unroll
        for (int mm = 0; mm < 2; ++mm)
#pragma unroll
            for (int bj = 0; bj < 2; ++bj)
#pragma unroll
                for (int n = 0; n < 2; ++n)
                    rs[mm][bj][n] = *(gcf32x4*)(resid + (size_t)(row0 + ai * 128 + (2 * mp + mm) * 16) * DM + col0 + bj * 128 + n * 4);
    }
    __device__ __forceinline__ void operator()(const f32x4 (&acc)[2][2][4][2], const pg8::Unit& u, int wr, int wc, int fr, int fq) const {
        const int row0 = u.pm * 256 + wr * 64 + fr, col0 = u.pn * 256 + wc * 32 + 8 * fq;
        f32x4 rsA[2][2][2], rsB[2][2][2];
        load2(rsA, row0, col0, 0, 0);
#pragma unroll
        for (int bt = 0; bt < 4; ++bt) {
            const int ai = bt >> 1, mp = bt & 1;
            if (bt < 3) { if (bt & 1) load2(rsA, row0, col0, (bt + 1) >> 1, (bt + 1) & 1); else load2(rsB, row0, col0, (bt + 1) >> 1, (bt + 1) & 1); }
#pragma unroll
            for (int mm = 0; mm < 2; ++mm) {
                const int m = 2 * mp + mm, row = row0 + ai * 128 + m * 16;
                const size_t off = (size_t)row * DM + col0;
                float ss = 0.f;
#pragma unroll
                for (int bj = 0; bj < 2; ++bj) {
                    const f32x4 r0 = (bt & 1) ? rsB[mm][bj][0] : rsA[mm][bj][0], r1 = (bt & 1) ? rsB[mm][bj][1] : rsA[mm][bj][1];
                    const f32x4 v0 = r0 + acc[ai][bj][m][0] * scale, v1 = r1 + acc[ai][bj][m][1] * scale;
                    *(gf32x4*)(out + off + bj * 128) = v0;
                    *(gf32x4*)(out + off + bj * 128 + 4) = v1;
                    u32x4 w; w.x = cvt_pk_bf16(v0[0], v0[1]); w.y = cvt_pk_bf16(v0[2], v0[3]); w.z = cvt_pk_bf16(v1[0], v1[1]); w.w = cvt_pk_bf16(v1[2], v1[3]);
                    *(GAS u32x4*)(hb + off + bj * 128) = w;
                    ss += ((v0[0] * v0[0] + v0[1] * v0[1]) + (v0[2] * v0[2] + v0[3] * v0[3])) + ((v1[0] * v1[0] + v1[1] * v1[1]) + (v1[2] * v1[2] + v1[3] * v1[3]));
                }
                ss = fq_sum(ss);
                if (fq == 0) *(gf32*)(ssq_next + (size_t)row * 16 + u.pn * 4 + wc) = ss;
            }
            asm volatile("" ::: "memory");
        }
    }
};
struct EpiWin {
    bf16_t* U; bf16_t* kcmp; bf16_t* vcmp; float* gates; const float* ssq;
    __device__ __forceinline__ void operator()(const f32x4 (&acc)[2][2][4][2], const pg8::Unit& u, int wr, int wc, int fr, int fq) const {
        const int row0 = u.pm * 256 + wr * 64 + fr;
        float r8[2][4];
        rows_rstd(ssq, row0, fq, r8);
#pragma unroll
        for (int bj = 0; bj < 2; ++bj) {
            const int c0 = u.pn * 256 + bj * 128 + wc * 32;
            if (c0 >= 2848) continue;
            const float sc = (c0 < 512) ? 0.125f * 1.4426950408889634f : ((c0 >= 2048 && c0 < 2304) ? 0.125f : 1.0f);
            const int cl = 8 * fq;
#pragma unroll
            for (int ai = 0; ai < 2; ++ai)
#pragma unroll
                for (int m = 0; m < 4; ++m) {
                    const int row = row0 + ai * 128 + m * 16;
                    const float r = r8[ai][m] * sc;
                    const f32x4 v0 = acc[ai][bj][m][0] * r, v1 = acc[ai][bj][m][1] * r;
                    if (c0 == 2816) { *(gf32x4*)(gates + (size_t)row * 32 + cl) = v0; *(gf32x4*)(gates + (size_t)row * 32 + cl + 4) = v1; }
                    else {
                        u32x4 w; w.x = cvt_pk_bf16(v0[0], v0[1]); w.y = cvt_pk_bf16(v0[2], v0[3]); w.z = cvt_pk_bf16(v1[0], v1[1]); w.w = cvt_pk_bf16(v1[2], v1[3]);
                        if (c0 >= 512 && c0 < 768) {
                            const int cc = c0 - 512 + cl;
                            const int gg = (cc >> 6) & 1, d = cc & 63;
                            bf16_t* dst = (cc < 128 ? kcmp : vcmp) + ((size_t)(((row >> 11) * 2 + gg) * 2048 + (row & 2047))) * 64 + d;
                            *(GAS u32x4*)dst = w;
                        } else {
                            *(GAS u32x4*)(U + (size_t)row * UW + c0 + cl) = w;
                        }
                    }
                }
        }
    }
};
struct EpiCmp {
    float* part;
    __device__ __forceinline__ void operator()(const f32x4 (&acc)[2][2][4][2], const pg8::Unit& u, int wr, int wc, int fr, int fq) const {
        const int row0 = u.pm * 256 + wr * 64 + fr, col0 = wc * 32 + 8 * fq;
#pragma unroll
        for (int ai = 0; ai < 2; ++ai)
#pragma unroll
            for (int m = 0; m < 4; ++m) {
                const int row = row0 + ai * 128 + m * 16;
#pragma unroll
                for (int bj = 0; bj < 2; ++bj)
#pragma unroll
                    for (int n = 0; n < 2; ++n) *(gf32x4*)(part + (size_t)row * 256 + col0 + bj * 128 + n * 4) = acc[ai][bj][m][n];
            }
    }
};

__device__ __forceinline__ int winmap(int n) {
    if (n < 1280) return n;
    if (n < 2560) return n + 24;
    if (n < 2816) return n + 32;
    if (n < 2840) return 1280 + (n - 2816);
    if (n < 2844) return 2584 + (n - 2840);
    if (n < 2848) return 2588 + (n - 2844);
    return -1;
}
struct TrTile { const float* colp; const float* gain; bf16_t* dst; int ld, K, k0, n0; };
__device__ __forceinline__ void tr_decode(const Params& p, int idx, int tid, TrTile& t) {
    constexpr int TPL = 1376;
    const int l = idx / TPL; int r = idx % TPL;
    int m, ntile, ktile, K;
    if (r < 352) { m = 0; ntile = r % 22; ktile = r / 22; K = DM; }
    else if (r < 528) { r -= 352; m = 1; ntile = r % 4; ktile = r / 4; K = DFF; }
    else if (r < 880) { r -= 528; m = 2; ntile = r % 22; ktile = r / 22; K = DM; }
    else if (r < 1056) { r -= 880; m = 3; ntile = r % 4; ktile = r / 4; K = DFF; }
    else if (r < 1248) { r -= 1056; m = 4; ntile = r % 12; ktile = r / 12; K = DM; }
    else if (r < 1312) { r -= 1248; m = 5; ntile = r % 4; ktile = r / 4; K = DM; }
    else if (r < 1344) { r -= 1312; m = 6; ntile = 0; ktile = r; K = 2048; }
    else { r -= 1344; m = 7; ntile = 0; ktile = r; K = 2048; }
    t.K = K; t.k0 = ktile * 64; t.n0 = ntile * 256; t.colp = nullptr; t.gain = nullptr; t.ld = 0;
    const int npp = t.n0 + 4 * ((tid >> 3));
    const int np = (npp & ~31) + 8 * ((npp & 15) >> 2) + 4 * ((npp >> 4) & 1);
    unsigned char* wl = ws_of(p) + WS_W + (size_t)l * LAYER_W;
    if (m == 0 || m == 2) {
        const int pb = np >> 8, w = np & 255;
        const float* src = (w < 128) ? in_of(p, m == 0 ? 2 : 25) : in_of(p, m == 0 ? 3 : 26);
        t.colp = src + (size_t)l * DM * DFF + pb * 128 + (w & 127); t.ld = DFF; t.gain = in_of(p, m == 0 ? 1 : 24) + l * DM;
        t.dst = (bf16_t*)(wl + (m == 0 ? LO_W13A : LO_W13B));
    } else if (m == 1 || m == 3) {
        t.colp = in_of(p, m == 1 ? 4 : 27) + (size_t)l * DFF * DM + np; t.ld = DM;
        t.dst = (bf16_t*)(wl + (m == 1 ? LO_W2A : LO_W2B));
    } else if (m == 4) {
        const int sc = winmap(np);
        if (sc >= 0) t.colp = in_of(p, 6) + (size_t)l * DM * DIN + sc;
        t.ld = DIN; t.gain = in_of(p, 5) + l * DM;
        t.dst = (bf16_t*)(wl + LO_WIN);
    } else if (m == 5) {
        t.colp = in_of(p, 23) + (size_t)l * DM * DM + np; t.ld = DM;
        t.dst = (bf16_t*)(wl + LO_WOUT);
    } else {
        t.colp = in_of(p, m == 6 ? 8 : 11) + (size_t)l * 2048 * 256 + np; t.ld = 256;
        t.dst = (bf16_t*)(wl + (m == 6 ? LO_CW1K : LO_CW1V));
    }
}
__device__ __forceinline__ void tr_load(const TrTile& t, int tid, f32x4 (&v)[8], float (&gv)[8]) {
    const int kc = (tid & 7);
#pragma unroll
    for (int e = 0; e < 8; ++e) {
        const int k = t.k0 + 8 * kc + e;
        v[e] = (f32x4){0.f, 0.f, 0.f, 0.f}; gv[e] = 1.0f;
        if (t.colp) { v[e] = __builtin_nontemporal_load((const f32x4*)(t.colp + (size_t)k * t.ld)); if (t.gain) gv[e] = t.gain[k]; }
    }
}
__device__ void prologue(const Params& p, LAS unsigned char* lds, int bid, int G) {
    const int tid = opaque_tid();
    LAS float* tile = (LAS float*)lds;
    {
        constexpr int N_TR = 4 * 1376;
        int it = bid;
        TrTile t; f32x4 v[8]; float gv[8];
        if (it < N_TR) { tr_decode(p, it, tid, t); tr_load(t, tid, v, gv); }
        while (it < N_TR) {
            bf16_t* dst = t.dst + (size_t)(t.n0 + 4 * ((tid >> 3))) * t.K + t.k0 + 8 * ((tid & 7));
            const int K = t.K;
            u32x4 o[4];
#pragma unroll
            for (int q = 0; q < 4; ++q) { o[q].x = cvt_pk_bf16(v[0][q] * gv[0], v[1][q] * gv[1]); o[q].y = cvt_pk_bf16(v[2][q] * gv[2], v[3][q] * gv[3]); o[q].z = cvt_pk_bf16(v[4][q] * gv[4], v[5][q] * gv[5]); o[q].w = cvt_pk_bf16(v[6][q] * gv[6], v[7][q] * gv[7]); }
            const int nx = it + G;
            if (nx < N_TR) { tr_decode(p, nx, tid, t); tr_load(t, tid, v, gv); }
#pragma unroll
            for (int q = 0; q < 4; ++q) *(u32x4*)(dst + (size_t)q * K) = o[q];
            it = nx;
        }
    }
    constexpr int N_BIAS = 256, N_XROW = T_ / 16, N_LW = 32;
    for (int it = bid; it < N_BIAS + N_XROW + N_LW; it += G) {
        if (it >= N_BIAS + N_XROW) {
            const int q = it - N_BIAS - N_XROW, ln = q >> 1, gate = q & 1;
            const float* W = in_of(p, gate ? 17 : 15) + (size_t)ln * 4096;
            bf16_t* WT = (bf16_t*)(ws_of(p) + WS_LRUWT) + (size_t)q * 4096;
            float wv[8];
#pragma unroll
            for (int rr = 0; rr < 8; ++rr) { const int idx = tid + rr * NTHREADS, d = idx >> 6, c = idx & 63; wv[rr] = W[c * 64 + d]; }
#pragma unroll
            for (int rr = 0; rr < 8; ++rr) WT[tid + rr * NTHREADS] = f2bf(wv[rr]);
        } else if (it < N_BIAS) {
            const int lkv = it >> 5, part = it & 31, l = lkv >> 1, kv = lkv & 1;
            const float* pos = in_of(p, kv ? 10 : 7) + (size_t)l * 2048;
            const float* w1 = in_of(p, kv ? 11 : 8) + (size_t)l * 2048 * 256;
            const int j = tid & 255, half = tid >> 8;
            float sacc = 0.f;
            const int kb = part * 64 + half * 32;
            for (int k = kb; k < kb + 32; k += 8) {
                float a[8];
#pragma unroll
                for (int q = 0; q < 8; ++q) a[q] = w1[(size_t)(k + q) * 256 + j];
#pragma unroll
                for (int q = 0; q < 8; ++q) sacc += pos[k + q] * a[q];
            }
            tile[tid] = sacc;
            __syncthreads();
            if (tid < 256) ((float*)(ws_of(p) + WS_CBP))[(size_t)it * 256 + tid] = tile[tid] + tile[tid + 256];
            __syncthreads();
        } else {
            const int row0 = (it - N_BIAS) * 16 + (tid >> 6) * 2, lane = tid & 63;
            f32x4 xv[2][4];
#pragma unroll
            for (int rq = 0; rq < 2; ++rq)
#pragma unroll
                for (int i = 0; i < 4; ++i) xv[rq][i] = *(const f32x4*)(in_of(p, 0) + (size_t)(row0 + rq) * DM + i * 256 + lane * 4);
#pragma unroll
            for (int rq = 0; rq < 2; ++rq) {
                const int row = row0 + rq;
                bf16_t* hb = (bf16_t*)(ws_of(p) + WS_HB) + (size_t)row * DM;
                float ss = 0.f;
#pragma unroll
                for (int i = 0; i < 4; ++i) {
                    const f32x4 v = xv[rq][i];
                    ss += (v[0] * v[0] + v[1] * v[1]) + (v[2] * v[2] + v[3] * v[3]);
                    u32x2 w; w.x = cvt_pk_bf16(v[0], v[1]); w.y = cvt_pk_bf16(v[2], v[3]);
                    *(u32x2*)(hb + i * 256 + lane * 4) = w;
                }
                ss = wave_sum(ss);
                if (lane < 16) ((float*)(ws_of(p) + WS_SSQ))[(size_t)row * 16 + lane] = (lane == 0) ? ss : 0.f;
            }
        }
    }
}

__device__ void lru_x_item(const Params& p, int l, int b, int n, int ck, LAS unsigned char* lds) {
    const int tid = opaque_tid(), lane = tid & 63, w = __builtin_amdgcn_readfirstlane(tid >> 6), fr = lane & 15, fq = lane >> 4;
    LAS float* xs = (LAS float*)lds;
    LAS float* xc = (LAS float*)(lds + 17152);
    LAS bf16_t* xb = (LAS bf16_t*)(lds + 33536);
    LAS bf16_t* wt = (LAS bf16_t*)(lds + 42752);
    LAS float* pre = (LAS float*)(lds + 61184);
    LAS float* segA = (LAS float*)(lds + 93952);
    LAS float* segH = segA + 512;
    const bf16_t* U = (const bf16_t*)(ws_of(p) + WS_U);
    const int t0 = ck * 64, rowbase = b * SEQ;
    {
        u32x4 xv[2];
#pragma unroll
        for (int rr = 0; rr < 2; ++rr) {
            const int idx = tid + rr * NTHREADS, tt = idx >> 3, ch = idx & 7, t = t0 - 3 + tt;
            xv[rr] = (u32x4){0u, 0u, 0u, 0u};
            if (idx < 67 * 8 && t >= 0) xv[rr] = *(const u32x4*)(U + (size_t)(rowbase + t) * UW + 1280 + n * 64 + ch * 8);
        }
#pragma unroll
        for (int rr = 0; rr < 2; ++rr) {
            const int idx = tid + rr * NTHREADS, tt = idx >> 3, ch = idx & 7;
            if (idx < 67 * 8) {
                f32x4 lo, hi;
                lo[0] = __uint_as_float(xv[rr][0] << 16); lo[1] = __uint_as_float(xv[rr][0] & 0xffff0000u); lo[2] = __uint_as_float(xv[rr][1] << 16); lo[3] = __uint_as_float(xv[rr][1] & 0xffff0000u);
                hi[0] = __uint_as_float(xv[rr][2] << 16); hi[1] = __uint_as_float(xv[rr][2] & 0xffff0000u); hi[2] = __uint_as_float(xv[rr][3] << 16); hi[3] = __uint_as_float(xv[rr][3] & 0xffff0000u);
                *(LAS f32x4*)(xs + tt * 64 + ch * 8) = lo; *(LAS f32x4*)(xs + tt * 64 + ch * 8 + 4) = hi;
            }
        }
    }
    {
        const bf16_t* WT = (const bf16_t*)(ws_of(p) + WS_LRUWT) + (size_t)((l * 4 + n) * 2) * 4096;
#pragma unroll
        for (int rr = 0; rr < 2; ++rr) {
            const int idx = tid + rr * NTHREADS, row = idx >> 3, ch = idx & 7;
            *(LAS u32x4*)(wt + row * 72 + ch * 8) = *(const u32x4*)(WT + row * 64 + ch * 8);
        }
    }
    __syncthreads();
    {
        const float* cw = in_of(p, 13) + (size_t)l * 4 * 256 + n * 64; const float* cb = in_of(p, 14) + l * 256 + n * 64;
        const int c = tid & 63;
        const float w0 = cw[c], w1 = cw[256 + c], w2 = cw[512 + c], w3 = cw[768 + c], bc = cb[c];
#pragma unroll
        for (int k = 0; k < 8; ++k) {
            const int t = (tid >> 6) + 8 * k;
            const float v = bc + xs[t * 64 + c] * w0 + xs[(t + 1) * 64 + c] * w1 + xs[(t + 2) * 64 + c] * w2 + xs[(t + 3) * 64 + c] * w3;
            xc[t * 64 + c] = v; xb[t * 72 + c] = f2bf(v);
        }
    }
    __syncthreads();
    {
        const int tt = w & 3, gate = w >> 2;
        bf16x8 xa[2];
#pragma unroll
        for (int ks = 0; ks < 2; ++ks) xa[ks] = *(const LAS bf16x8*)(xb + (16 * tt + fr) * 72 + 32 * ks + 8 * fq);
        const float* bias = in_of(p, gate ? 18 : 16) + (l * 4 + n) * 64;
#pragma unroll
        for (int dt = 0; dt < 4; ++dt) {
            f32x4 acc = (f32x4){0.f, 0.f, 0.f, 0.f};
#pragma unroll
            for (int ks = 0; ks < 2; ++ks) {
                const bf16x8 wb = *(const LAS bf16x8*)(wt + (gate * 64 + 16 * dt + fr) * 72 + 32 * ks + 8 * fq);
                acc = __builtin_amdgcn_mfma_f32_16x16x32_bf16(xa[ks], wb, acc, 0, 0, 0);
            }
            const float bv = bias[16 * dt + fr];
#pragma unroll
            for (int i = 0; i < 4; ++i) pre[(gate * 64 + 16 * tt + 4 * fq + i) * 64 + 16 * dt + fr] = acc[i] + bv;
        }
    }
    __syncthreads();
    const int d = tid & 63, tq = tid >> 6;
    const float lam = in_of(p, 19)[l * 256 + n * 64 + d];
    const float sp = log1pf(expf(-lam));
    float hl[8], cl[8];
    float h = 0.f, ca = 1.f;
#pragma unroll
    for (int i = 0; i < 8; ++i) {
        const float r = __builtin_amdgcn_rcpf(1.0f + __expf(-pre[(tq * 8 + i) * 64 + d])), ii = __builtin_amdgcn_rcpf(1.0f + __expf(-pre[(64 + tq * 8 + i) * 64 + d]));
        const float la = -8.0f * r * sp;
        const float a = __expf(la);
        const float uu = __builtin_amdgcn_sqrtf(fmaxf(1.0f - a * a, 0.f)) * (ii * xc[(tq * 8 + i) * 64 + d]);
        h = a * h + uu; ca *= a; hl[i] = h; cl[i] = ca;
    }
    segA[tq * 64 + d] = ca; segH[tq * 64 + d] = h;
    __syncthreads();
    float cin_h = 0.f, cin_a = 1.f;
    for (int sgi = 0; sgi < tq; ++sgi) { const float sa = segA[sgi * 64 + d]; cin_h = sa * cin_h + segH[sgi * 64 + d]; cin_a *= sa; }
    float* LH = (float*)(ws_of(p) + WS_LRUH); float* LA = (float*)(ws_of(p) + WS_LRUA);
#pragma unroll
    for (int i = 0; i < 8; ++i) {
        const size_t o = (size_t)(rowbase + t0 + tq * 8 + i) * 256 + n * 64 + d;
        LH[o] = hl[i] + cl[i] * cin_h; LA[o] = cl[i] * cin_a;
    }
    __syncthreads();
}

__device__ __forceinline__ float logsigmoidf_(float x) { return fminf(x, 0.f) - log1pf(expf(-fabsf(x))); }

__device__ __forceinline__ int vt_off(int d, int key, int pitch) {
    const int kc = key >> 3;
    return d * pitch + ((((kc ^ (d >> 3)) & 7) | (kc & ~7)) << 3) + (key & 7);
}
__device__ void ml_x_item(const Params& p, int l, int bh, int ck, LAS unsigned char* lds) {
    const int tid = opaque_tid(), lane = tid & 63, w = __builtin_amdgcn_readfirstlane(tid >> 6), fr = lane & 15, fq = lane >> 4;
    const int b = bh >> 2, hh = bh & 3;
    LAS bf16_t* KwT = (LAS bf16_t*)lds;
    LAS bf16_t* VT = (LAS bf16_t*)(lds + 9216);
    LAS float* wks = (LAS float*)(lds + 20736);
    const bf16_t* U = (const bf16_t*)(ws_of(p) + WS_U);
    const float* GT = (const float*)(ws_of(p) + WS_GATES);
    const int rowbase = b * SEQ + ck * 64;
    if (tid < 64) {
        const float ig = GT[(size_t)(rowbase + lane) * 32 + 24 + hh] + in_of(p, 20)[l * 4 + hh];
        const float fp = GT[(size_t)(rowbase + lane) * 32 + 28 + hh] + in_of(p, 21)[l * 4 + hh];
        float a = logsigmoidf_(fp);
#pragma unroll
        for (int o = 1; o < 64; o <<= 1) { const float t = __shfl_up(a, o); if (lane >= o) a += t; }
        const float A = __shfl(a, 63);
        const float wend = A - a + ig;
        const float mu = wave_max(wend);
        wks[lane] = expf(wend - mu);
        if (lane == 0) { ((float*)(ws_of(p) + WS_MLMU))[bh * 32 + ck] = mu; ((float*)(ws_of(p) + WS_MLAT))[bh * 32 + ck] = A; }
    }
    const int srow = tid >> 3, sch = tid & 7;
    const bf16_t* src = U + (size_t)(rowbase + srow) * UW + hh * 64 + sch * 8;
    const u32x4 kk = *(const u32x4*)(src + 2048);
    {
        const u32x4 vv = *(const u32x4*)(src + 2304);
#pragma unroll
        for (int e = 0; e < 4; ++e) {
            VT[vt_off(sch * 8 + 2 * e, srow, 72)] = (bf16_t)(vv[e] & 0xffffu);
            VT[vt_off(sch * 8 + 2 * e + 1, srow, 72)] = (bf16_t)(vv[e] >> 16);
        }
        for (int idx = tid; idx < 16 * 72; idx += NTHREADS) VT[64 * 72 + idx] = (idx < 72) ? (bf16_t)0x3f80 : (bf16_t)0;
    }
    __syncthreads();
    {
        const float wk = wks[srow];
#pragma unroll
        for (int e = 0; e < 4; ++e) {
            KwT[vt_off(sch * 8 + 2 * e, srow, 72)] = f2bf(wk * __uint_as_float(kk[e] << 16));
            KwT[vt_off(sch * 8 + 2 * e + 1, srow, 72)] = f2bf(wk * __uint_as_float(kk[e] & 0xffff0000u));
        }
    }
    __syncthreads();
    {
        const int dt = w & 3, hf = w >> 2;
        bf16x8 ka[2];
#pragma unroll
        for (int ks = 0; ks < 2; ++ks) ka[ks] = *(const LAS bf16x8*)(KwT + vt_off(16 * dt + fr, 32 * ks + 8 * fq, 72));
        float* C = (float*)(ws_of(p) + WS_MLC) + (size_t)(bh * 32 + ck) * 4096;
#pragma unroll
        for (int ee = 0; ee < 2; ++ee) {
            const int et = 2 * hf + ee;
            f32x4 acc = (f32x4){0.f, 0.f, 0.f, 0.f};
#pragma unroll
            for (int ks = 0; ks < 2; ++ks) {
                const bf16x8 vb = *(const LAS bf16x8*)(VT + vt_off(16 * et + fr, 32 * ks + 8 * fq, 72));
                acc = __builtin_amdgcn_mfma_f32_16x16x32_bf16(ka[ks], vb, acc, 0, 0, 0);
            }
#pragma unroll
            for (int i = 0; i < 4; ++i) C[(16 * dt + 4 * fq + i) * 64 + 16 * et + fr] = acc[i];
        }
        if (hf == 0) {
            f32x4 acc = (f32x4){0.f, 0.f, 0.f, 0.f};
#pragma unroll
            for (int ks = 0; ks < 2; ++ks) {
                const bf16x8 vb = *(const LAS bf16x8*)(VT + (64 + fr) * 72 + 32 * ks + 8 * fq);
                acc = __builtin_amdgcn_mfma_f32_16x16x32_bf16(ka[ks], vb, acc, 0, 0, 0);
            }
            if (fr == 0) {
#pragma unroll
                for (int i = 0; i < 4; ++i) ((float*)(ws_of(p) + WS_MLN))[(size_t)(bh * 32 + ck) * 64 + 16 * dt + 4 * fq + i] = acc[i];
            }
        }
    }
    __syncthreads();
}

__device__ void phase_m2(const Params& p, int l, int cls, LAS unsigned char* lds, int bid, int G) {
    const int tid = opaque_tid();
    constexpr int N_KC = 128, N_LC = 4, N_MC = 256, N_MN = 4, TOTAL = N_KC + N_LC + N_MC + N_MN;
    for (int it = bid; it < TOTAL; it += G) {
        if (it < N_KC) {
            if (!(cls & 1)) continue;
            const int kv = it >> 6, r0 = (it & 63) * 32;
            LAS float* hid = (LAS float*)lds;
            LAS float* w2s = hid + 32 * 256;
            const float* part = (const float*)(ws_of(p) + WS_HID) + (size_t)(kv * 2048 + r0) * 256;
            const float* cb = (const float*)(ws_of(p) + WS_CBIAS) + (l * 2 + kv) * 256;
            const float* w2 = in_of(p, kv ? 12 : 9) + (size_t)l * 256 * 64;
            f32x4 pr[4][4];
#pragma unroll
            for (int rr = 0; rr < 4; ++rr) {
                const int idx = tid + rr * NTHREADS, row = idx >> 6, j4 = (idx & 63) * 4;
#pragma unroll
                for (int kp = 0; kp < 4; ++kp) pr[rr][kp] = *(const f32x4*)(part + (size_t)kp * 2 * 2048 * 256 + row * 256 + j4);
            }
#pragma unroll
            for (int rr = 0; rr < 4; ++rr) {
                const int idx = tid + rr * NTHREADS, row = idx >> 6, j4 = (idx & 63) * 4;
                f32x4 hv = *(const f32x4*)(cb + j4);
#pragma unroll
                for (int kp = 0; kp < 4; ++kp) hv = hv + pr[rr][kp];
#pragma unroll
                for (int q = 0; q < 4; ++q) hv[q] = hv[q] * __builtin_amdgcn_rcpf(1.0f + __expf(-hv[q]));
                *(LAS f32x4*)(hid + row * 256 + j4) = hv;
            }
#pragma unroll
            for (int rr = 0; rr < 8; ++rr) { const int idx = tid + rr * NTHREADS; *(LAS f32x4*)(w2s + idx * 4) = *(const f32x4*)(w2 + idx * 4); }
            __syncthreads();
            {
                const int d = tid & 63, rq = tid >> 6;
                float acc[4] = {0.f, 0.f, 0.f, 0.f};
                for (int j = 0; j < 256; j += 4) {
                    float wv[4];
#pragma unroll
                    for (int q = 0; q < 4; ++q) wv[q] = w2s[(j + q) * 64 + d];
#pragma unroll
                    for (int i = 0; i < 4; ++i) {
                        const f32x4 hv = *(const LAS f32x4*)(hid + (rq * 4 + i) * 256 + j);
#pragma unroll
                        for (int q = 0; q < 4; ++q) acc[i] += hv[q] * wv[q];
                    }
                }
                bf16_t* KCo = (bf16_t*)(ws_of(p) + WS_KC);
#pragma unroll
                for (int i = 0; i < 4; ++i) {
                    const int r = r0 + rq * 4 + i;
                    KCo[(size_t)(kv * 2048 + r) * 64 + d] = f2bf(((r & 127) == 127) ? 0.f : acc[i]);
                }
            }
            __syncthreads();
        } else if (it < N_KC + N_LC) {
            if (!(cls & 2)) continue;
            const int idx = (it - N_KC) * NTHREADS + tid;
            const int b = idx >> 8, ch = idx & 255;
            const float* LH = (const float*)(ws_of(p) + WS_LRUH); const float* LA = (const float*)(ws_of(p) + WS_LRUA);
            float* LC = (float*)(ws_of(p) + WS_LRUC);
            float la[32], lh[32];
#pragma unroll
            for (int ck = 0; ck < 32; ++ck) { const size_t o = (size_t)(b * SEQ + ck * 64 + 63) * 256 + ch; la[ck] = LA[o]; lh[ck] = LH[o]; }
            float carry = 0.f;
#pragma unroll
            for (int ck = 0; ck < 32; ++ck) { LC[(b * 32 + ck) * 256 + ch] = carry; carry = la[ck] * carry + lh[ck]; }
        } else {
            if (!(cls & 4)) continue;
            const bool isn = it >= N_KC + N_LC + N_MC;
            const int idx = (it - N_KC - N_LC - (isn ? N_MC : 0)) * NTHREADS + tid;
            const int bh = isn ? (idx >> 6) : (idx >> 12), de = isn ? (idx & 63) : (idx & 4095);
            const int esz = isn ? 64 : 4096;
            float* buf = (float*)(ws_of(p) + (isn ? WS_MLN : WS_MLC)) + (size_t)bh * 32 * esz + de;
            const float* MU = (const float*)(ws_of(p) + WS_MLMU) + bh * 32; const float* AT = (const float*)(ws_of(p) + WS_MLAT) + bh * 32;
            float* MP = (float*)(ws_of(p) + WS_MLMP) + bh * 32;
            float dc[32];
#pragma unroll
            for (int ck = 0; ck < 32; ++ck) dc[ck] = buf[(size_t)ck * esz];
            float C = 0.f, m = 0.f;
#pragma unroll
            for (int ck = 0; ck < 32; ++ck) {
                buf[(size_t)ck * esz] = C;
                if (!isn && de == 0) MP[ck] = m;
                const float at = AT[ck], mu = MU[ck];
                const float mn = fmaxf(at + m, mu);
                C = __expf(at + m - mn) * C + __expf(mu - mn) * dc[ck];
                m = mn;
            }
        }
    }
}

__device__ __forceinline__ float gelu_tanh(float x) { const float u = 0.7978845608028654f * (x + 0.044715f * x * x * x); return x * __builtin_amdgcn_rcpf(1.0f + __expf(-2.0f * u)); }

__device__ void lru_y_item(const Params& p, int l, int item) {
    const int tid = opaque_tid(), lane = tid & 63;
    const float* LH = (const float*)(ws_of(p) + WS_LRUH); const float* LA = (const float*)(ws_of(p) + WS_LRUA); const float* LC = (const float*)(ws_of(p) + WS_LRUC);
    const bf16_t* U = (const bf16_t*)(ws_of(p) + WS_U);
    const float* hn = in_of(p, 22) + l * 1024;
    bf16_t* HD = (bf16_t*)(ws_of(p) + WS_HEADS);
    const int pair0 = item * 128 + (tid >> 6) * 16;
    float lh[16], la[16], lc[16]; bf16_t gg[16];
    float gn[4];
#pragma unroll
    for (int n = 0; n < 4; ++n) gn[n] = hn[(8 + n) * 64 + lane];
#pragma unroll
    for (int q = 0; q < 16; ++q) {
        const int pair = pair0 + q, row = pair >> 2, n = pair & 3, ch = n * 64 + lane;
        lh[q] = LH[(size_t)row * 256 + ch]; la[q] = LA[(size_t)row * 256 + ch];
        lc[q] = LC[((row >> 11) * 32 + ((row & 2047) >> 6)) * 256 + ch];
        gg[q] = U[(size_t)row * UW + 1536 + ch];
    }
#pragma unroll
    for (int q = 0; q < 16; ++q) {
        const int pair = pair0 + q, row = pair >> 2, n = pair & 3;
        const float h = lh[q] + la[q] * lc[q];
        const float y = h * gelu_tanh(bf2f(gg[q]));
        const float ss = wave_sum(y * y);
        HD[(size_t)row * DM + (8 + n) * 64 + lane] = f2bf(y * rsqrtf(ss * (1.0f / 64.0f) + EPS) * gn[q & 3]);
    }
}

__device__ __forceinline__ int vt_lane(int fr, int fq, int pitch) { return fr * pitch + ((((fq >> 1) ^ (fr >> 3)) & 1) << 3) + ((fq & 1) << 2); }
__device__ __forceinline__ constexpr int vt_cst(int dt, int kc2, int pitch) { return dt * 16 * pitch + ((((kc2 ^ (2 * dt)) & 6) | (kc2 & ~7)) << 3); }
__device__ void ml_y_item(const Params& p, int l, int bh, int ck, LAS unsigned char* lds) {
    const int tid = opaque_tid(), lane = tid & 63, w = __builtin_amdgcn_readfirstlane(tid >> 6), fr = lane & 15, fq = lane >> 4;
    const int b = bh >> 2, hh = bh & 3;
    LAS bf16_t* Ql = (LAS bf16_t*)lds;
    LAS bf16_t* Kl = (LAS bf16_t*)(lds + 9216);
    LAS bf16_t* Vt = (LAS bf16_t*)(lds + 18432);
    LAS bf16_t* Ct = (LAS bf16_t*)(lds + 27648);
    LAS bf16_t* Wl = (LAS bf16_t*)(lds + 39168);
    LAS float* as_ = (LAS float*)(lds + 57600);
    LAS float* bs_ = as_ + 64;
    LAS float* Ms_ = bs_ + 64;
    LAS float* ssl = Ms_ + 64;
    const bf16_t* U = (const bf16_t*)(ws_of(p) + WS_U);
    const float* GT = (const float*)(ws_of(p) + WS_GATES);
    const int rowbase = b * SEQ + ck * 64;
    const float mprev = ((const float*)(ws_of(p) + WS_MLMP))[bh * 32 + ck];
    if (tid < 64) {
        const float ig = GT[(size_t)(rowbase + lane) * 32 + 24 + hh] + in_of(p, 20)[l * 4 + hh];
        const float fp = GT[(size_t)(rowbase + lane) * 32 + 28 + hh] + in_of(p, 21)[l * 4 + hh];
        float a = logsigmoidf_(fp);
#pragma unroll
        for (int o = 1; o < 64; o <<= 1) { const float t = __shfl_up(a, o); if (lane >= o) a += t; }
        const float bb = ig - a;
        float pm = bb;
#pragma unroll
        for (int o = 1; o < 64; o <<= 1) { const float t = __shfl_up(pm, o); if (lane >= o) pm = fmaxf(pm, t); }
        as_[lane] = a; bs_[lane] = bb; Ms_[lane] = fmaxf(mprev, pm);
        Ct[64 * 72 + lane] = f2bf(((const float*)(ws_of(p) + WS_MLN))[(size_t)(bh * 32 + ck) * 64 + lane]);
    }
    {
        const int row = tid >> 3, ch = tid & 7;
        const bf16_t* src = U + (size_t)(rowbase + row) * UW + hh * 64 + ch * 8;
        *(LAS u32x4*)(Ql + row * 72 + ch * 8) = *(const u32x4*)(src + 1792);
        *(LAS u32x4*)(Kl + row * 72 + ch * 8) = *(const u32x4*)(src + 2048);
        const u32x4 vv = *(const u32x4*)(src + 2304);
#pragma unroll
        for (int e = 0; e < 4; ++e) {
            Vt[vt_off(ch * 8 + 2 * e, row, 72)] = (bf16_t)(vv[e] & 0xffffu);
            Vt[vt_off(ch * 8 + 2 * e + 1, row, 72)] = (bf16_t)(vv[e] >> 16);
        }
        const float* C = (const float*)(ws_of(p) + WS_MLC) + (size_t)(bh * 32 + ck) * 4096;
#pragma unroll
        for (int rr = 0; rr < 2; ++rr) {
            const int idx = tid + rr * NTHREADS, d = idx >> 4, e4 = (idx & 15) * 4;
            const f32x4 c = *(const f32x4*)(C + d * 64 + e4);
#pragma unroll
            for (int i = 0; i < 4; ++i) Ct[(e4 + i) * 72 + d] = f2bf(c[i]);
        }
        for (int idx = tid; idx < 15 * 72; idx += NTHREADS) Ct[65 * 72 + idx] = 0;
    }
    __syncthreads();
    const int jt = w & 3, hf = w >> 2;
    bf16_t opre[2][4];
#pragma unroll
    for (int i = 0; i < 4; ++i)
#pragma unroll
        for (int ee = 0; ee < 2; ++ee) opre[ee][i] = U[(size_t)(rowbase + 16 * jt + 4 * fq + i) * UW + 2560 + hh * 64 + 16 * (2 * hf + ee) + fr];
    bf16x8 qa[2];
#pragma unroll
    for (int ks = 0; ks < 2; ++ks) qa[ks] = *(const LAS bf16x8*)(Ql + (16 * jt + fr) * 72 + 32 * ks + 8 * fq);
    f32x4 sacc[4];
#pragma unroll
    for (int st = 0; st < 4; ++st) {
        const bf16x8 k0 = *(const LAS bf16x8*)(Kl + (16 * st + fr) * 72 + 8 * fq), k1 = *(const LAS bf16x8*)(Kl + (16 * st + fr) * 72 + 32 + 8 * fq);
        sacc[st] = __builtin_amdgcn_mfma_f32_16x16x32_bf16(qa[0], k0, (f32x4){0.f, 0.f, 0.f, 0.f}, 0, 0, 0);
        sacc[st] = __builtin_amdgcn_mfma_f32_16x16x32_bf16(qa[1], k1, sacc[st], 0, 0, 0);
    }
    float sw[4], Mj[4];
    LAS bf16_t* Ww = Wl + w * (16 * 72);
#pragma unroll
    for (int i = 0; i < 4; ++i) {
        const int j = 16 * jt + 4 * fq + i;
        Mj[i] = Ms_[j];
        float acc = 0.f;
#pragma unroll
        for (int st = 0; st < 4; ++st) {
            const int sidx = 16 * st + fr;
            const float wv = (sidx <= j) ? __expf(bs_[sidx] - Mj[i]) * sacc[st][i] : 0.f;
            acc += wv;
            Ww[(4 * fq + i) * 72 + sidx] = f2bf(wv);
        }
        acc += __shfl_xor(acc, 1); acc += __shfl_xor(acc, 2); acc += __shfl_xor(acc, 4); acc += __shfl_xor(acc, 8);
        sw[i] = acc;
    }
    asm volatile("s_waitcnt lgkmcnt(0)" ::: "memory");
    bf16x8 wa[2];
#pragma unroll
    for (int ks = 0; ks < 2; ++ks) wa[ks] = *(const LAS bf16x8*)(Ww + fr * 72 + 32 * ks + 8 * fq);
    f32x4 acc1[2], acc2[2], accn;
#pragma unroll
    for (int ee = 0; ee < 2; ++ee) {
        const int et = 2 * hf + ee;
        acc1[ee] = (f32x4){0.f, 0.f, 0.f, 0.f}; acc2[ee] = (f32x4){0.f, 0.f, 0.f, 0.f};
#pragma unroll
        for (int ks = 0; ks < 2; ++ks) {
            const bf16x8 cf = *(const LAS bf16x8*)(Ct + (16 * et + fr) * 72 + 32 * ks + 8 * fq);
            const bf16x8 vf = *(const LAS bf16x8*)(Vt + vt_off(16 * et + fr, 32 * ks + 8 * fq, 72));
            acc1[ee] = __builtin_amdgcn_mfma_f32_16x16x32_bf16(qa[ks], cf, acc1[ee], 0, 0, 0);
            acc2[ee] = __builtin_amdgcn_mfma_f32_16x16x32_bf16(wa[ks], vf, acc2[ee], 0, 0, 0);
        }
    }
    accn = (f32x4){0.f, 0.f, 0.f, 0.f};
#pragma unroll
    for (int ks = 0; ks < 2; ++ks) {
        const bf16x8 cf = *(const LAS bf16x8*)(Ct + (64 + fr) * 72 + 32 * ks + 8 * fq);
        accn = __builtin_amdgcn_mfma_f32_16x16x32_bf16(qa[ks], cf, accn, 0, 0, 0);
    }
    float ov[2][4];
#pragma unroll
    for (int i = 0; i < 4; ++i) {
        const int j = 16 * jt + 4 * fq + i;
        const float qn = __shfl(accn[i], lane & 48);
        const float inter = __expf(mprev - Mj[i]);
        const float den = inter * qn + sw[i];
        const float lim = __expf(-(as_[j] + Mj[i]));
        const float inv = 1.0f / fmaxf(fabsf(den), lim);
        float ssp = 0.f;
#pragma unroll
        for (int ee = 0; ee < 2; ++ee) {
            const int e = 16 * (2 * hf + ee) + fr;
            const float hv = (inter * acc1[ee][i] + acc2[ee][i]) * inv;
            const float o = sigmoidf_(bf2f(opre[ee][i])) * hv;
            ov[ee][i] = o; ssp += o * o;
        }
        ssp += __shfl_xor(ssp, 1); ssp += __shfl_xor(ssp, 2); ssp += __shfl_xor(ssp, 4); ssp += __shfl_xor(ssp, 8);
        if (fr == 0) ssl[w * 16 + 4 * fq + i] = ssp;
    }
    __syncthreads();
    {
        bf16_t* HD = (bf16_t*)(ws_of(p) + WS_HEADS);
        const float* hn = in_of(p, 22) + l * 1024 + (12 + hh) * 64;
#pragma unroll
        for (int i = 0; i < 4; ++i) {
            const int j = 16 * jt + 4 * fq + i;
            const float tot = ssl[jt * 16 + 4 * fq + i] + ssl[(jt + 4) * 16 + 4 * fq + i];
            const float rs = rsqrtf(tot * (1.0f / 64.0f) + EPS);
#pragma unroll
            for (int ee = 0; ee < 2; ++ee) {
                const int e = 16 * (2 * hf + ee) + fr;
                HD[(size_t)(rowbase + j) * DM + (12 + hh) * 64 + e] = f2bf(ov[ee][i] * rs * hn[e]);
            }
        }
    }
    __syncthreads();
}

__device__ __forceinline__ bf16x8 pack8(const f32x4 lo, const f32x4 hi) {
    u32x4 r; r.x = cvt_pk_bf16(lo[0], lo[1]); r.y = cvt_pk_bf16(lo[2], lo[3]); r.z = cvt_pk_bf16(hi[0], hi[1]); r.w = cvt_pk_bf16(hi[2], hi[3]);
    return __builtin_bit_cast(bf16x8, r);
}
__device__ __forceinline__ bf16x8 join8(const u32x2 lo, const u32x2 hi) { u32x4 r; r.x = lo.x; r.y = lo.y; r.z = hi.x; r.w = hi.y; return __builtin_bit_cast(bf16x8, r); }
__device__ void nsa_item(const Params& p, int l, int b, int g, int qb, LAS unsigned char* lds, int mode = 0) {
    int tid = opaque_tid(), w = __builtin_amdgcn_readfirstlane(tid >> 6), lane = tid & 63, fr = lane & 15, fq = lane >> 4;
    LAS bf16_t* Kc = (LAS bf16_t*)lds;
    LAS bf16_t* Vc = (LAS bf16_t*)(lds + 18432);
    LAS bf16_t* Pl = (LAS bf16_t*)(lds + 36864);
    LAS float* impl = (LAS float*)(lds + 106496);
    LAS unsigned* selm = (LAS unsigned*)(lds + 114688);
    LAS int* steps = (LAS int*)(lds + 114944);
    const bf16_t* U = (const bf16_t*)(ws_of(p) + WS_U);
    const int bg = b * 2 + g, rowbase = b * SEQ;
    const int head = 4 * g + (w >> 1);
    const float sl2 = exp2f(-(float)(head + 1)) * 1.4426950408889634f;
    const int tw0 = qb * 64 + (w & 1) * 32;
    bf16x8 qf[2][2];
#pragma unroll
    for (int mt = 0; mt < 2; ++mt)
#pragma unroll
        for (int ks = 0; ks < 2; ++ks)
            qf[mt][ks] = *(const bf16x8*)(U + (size_t)(rowbase + tw0 + mt * 16 + fr) * UW + head * 64 + ks * 32 + fq * 8);
    const float* GT = (const float*)(ws_of(p) + WS_GATES);
    float gpre[2][3];
#pragma unroll
    for (int mt = 0; mt < 2; ++mt)
#pragma unroll
        for (int q = 0; q < 3; ++q) gpre[mt][q] = GT[(size_t)(rowbase + tw0 + mt * 16 + fr) * 32 + head * 3 + q];
    f32x4 y[2][4];
    {
        LAS float* impM = (LAS float*)Pl;
        LAS float* impT = impM + 4 * 64 * 33;
        const bf16_t* KC = (const bf16_t*)(ws_of(p) + WS_KC) + (size_t)bg * 128 * 64;
        const bf16_t* VC = KC + (size_t)2048 * 64;
        u32x4 kvr[2], vvr[2];
#pragma unroll
        for (int rr = 0; rr < 2; ++rr) { const int idx = tid + rr * NTHREADS; kvr[rr] = *(const u32x4*)(KC + idx * 8); vvr[rr] = *(const u32x4*)(VC + idx * 8); }
#pragma unroll
        for (int rr = 0; rr < 2; ++rr) {
            const int idx = tid + rr * NTHREADS, key = idx >> 3, ch = idx & 7;
            const u32x4 kv = kvr[rr];
            const u32x4 vv = vvr[rr];
            *(LAS u32x4*)(Kc + key * 72 + ch * 8) = kv;
#pragma unroll
            for (int e = 0; e < 4; ++e) {
                Vc[vt_off(ch * 8 + 2 * e, key, 136)] = (bf16_t)(vv[e] & 0xffffu);
                Vc[vt_off(ch * 8 + 2 * e + 1, key, 136)] = (bf16_t)(vv[e] >> 16);
            }
        }
        __syncthreads();
        const int vl136 = vt_lane(fr, fq, 136);
#pragma unroll
        for (int mt = 0; mt < 2; ++mt) {
            const int t = tw0 + mt * 16 + fr;
            f32x4 s[8];
#pragma unroll
            for (int nt = 0; nt < 8; ++nt) {
                const bf16x8 k0 = *(const LAS bf16x8*)(Kc + (16 * nt + fr) * 72 + fq * 8), k1 = *(const LAS bf16x8*)(Kc + (16 * nt + fr) * 72 + 32 + fq * 8);
                s[nt] = __builtin_amdgcn_mfma_f32_16x16x32_bf16(k0, qf[mt][0], (f32x4){0.f, 0.f, 0.f, 0.f}, 0, 0, 0);
                s[nt] = __builtin_amdgcn_mfma_f32_16x16x32_bf16(k1, qf[mt][1], s[nt], 0, 0, 0);
            }
            float mx = NEGF;
#pragma unroll
            for (int nt = 0; nt < 8; ++nt)
#pragma unroll
                for (int i = 0; i < 4; ++i) {
                    const int n = 16 * nt + 4 * fq + i, cend = 16 * n + 31;
                    const bool valid = (t >= cend) && (n < 127);
                    const float sv = valid ? fmaf(sl2, (float)cend, s[nt][i]) : NEGF;
                    s[nt][i] = sv; mx = fmaxf(mx, sv);
                }
            mx = fq_max(mx);
            const float ms = (mx < -1e29f) ? 0.f : mx;
            float sum = 0.f;
#pragma unroll
            for (int nt = 0; nt < 8; ++nt)
#pragma unroll
                for (int i = 0; i < 4; ++i) { const float pv = __builtin_amdgcn_exp2f(s[nt][i] - ms); s[nt][i] = pv; sum += pv; }
            sum = fq_sum(sum);
            const float inv = sum > 0.f ? 1.0f / sum : 0.f;
            {
                LAS float* mrow_ = impM + ((w >> 1) * 64 + (w & 1) * 32 + mt * 16 + fr) * 33 + fq;
                LAS float* trow_ = impT + ((w >> 1) * 64 + (w & 1) * 32 + mt * 16 + fr) * 33 + fq + 1;
#pragma unroll
                for (int nt = 0; nt < 8; ++nt) {
                    s[nt] = s[nt] * inv;
                    mrow_[4 * nt] = (s[nt][0] + s[nt][1]) + (s[nt][2] + s[nt][3]);
                    trow_[4 * nt] = s[nt][3];
                }
            }
            f32x4 oc[4];
#pragma unroll
            for (int dt = 0; dt < 4; ++dt) oc[dt] = (f32x4){0.f, 0.f, 0.f, 0.f};
#pragma unroll
            for (int ks2 = 0; ks2 < 4; ++ks2) {
                const bf16x8 pb = pack8(s[2 * ks2], s[2 * ks2 + 1]);
#pragma unroll
                for (int dt = 0; dt < 4; ++dt) {
                    const u32x2 lo = *(const LAS u32x2*)(Vc + vl136 + vt_cst(dt, 4 * ks2, 136));
                    const u32x2 hi = *(const LAS u32x2*)(Vc + vl136 + vt_cst(dt, 4 * ks2 + 2, 136));
                    oc[dt] = __builtin_amdgcn_mfma_f32_16x16x32_bf16(join8(lo, hi), pb, oc[dt], 0, 0, 0);
                }
            }
            const float g0 = sigmoidf_(gpre[mt][0]);
#pragma unroll
            for (int dt = 0; dt < 4; ++dt) y[mt][dt] = oc[dt] * g0;
        }
        if (tid < 256) impT[tid * 33] = 0.f;
        __syncthreads();
#pragma unroll 1
        for (int rr = 0; rr < 4; ++rr) {
            const int idx = tid + rr * NTHREADS, tau = idx >> 5, j = idx & 31;
            float mine = 0.f;
#pragma unroll
            for (int hh = 0; hh < 4; ++hh) mine += impM[(hh * 64 + tau) * 33 + j] + impT[(hh * 64 + tau) * 33 + j];
            bool sel;
            if (qb < 16) sel = (j <= qb);
            else {
                const bool forced = (j == 0) || (j == qb) || (j == qb - 1);
                const bool cand = (j >= 1) && (j <= qb - 2);
                int rank = 0;
#pragma unroll
                for (int jp = 1; jp < 30; ++jp) {
                    const float o = __shfl(mine, (lane & 32) + jp);
                    rank += (jp <= qb - 2 && (o > mine || (o == mine && jp < j))) ? 1 : 0;
                }
                sel = forced || (cand && rank < 13);
            }
            const unsigned long long bal = __ballot(sel);
            if ((lane & 31) == 0) selm[tau] = (lane < 32) ? (unsigned)bal : (unsigned)(bal >> 32);
        }
        __syncthreads();
        if (tid < 64) {
            unsigned m = selm[tid], uni = m, all = m;
#pragma unroll
            for (int o = 32; o >= 1; o >>= 1) { uni |= __shfl_xor(uni, o); all &= __shfl_xor(all, o); }
            uni &= (qb >= 31) ? 0xffffffffu : ((2u << qb) - 1u);
            const int nsel = __popc(uni);
            const int kb = tid;
            if (kb <= qb && ((uni >> kb) & 1u)) {
                const int pos = nsel - 1 - __popc(uni & ((1u << kb) - 1u));
                steps[1 + pos] = ((((all >> kb) & 1u) && kb < qb) ? 4096 : 0) | (1 << 8) | kb;
            }
            const int kb0 = (qb - 8 < 0) ? 0 : qb - 8;
            if (kb >= kb0 && kb <= qb) steps[1 + nsel + (qb - kb)] = ((kb > qb - 8 && kb < qb) ? 4096 : 0) | (2 << 8) | kb;
            if (tid == 0) steps[0] = nsel + (qb - kb0 + 1);
        }
        __syncthreads();
    }
    if (mode == 1) { asm volatile("" :: "v"(y[0][0][0]), "v"(y[1][3][3])); __syncthreads(); return; }
    tid = opaque_tid(); w = __builtin_amdgcn_readfirstlane(tid >> 6); lane = tid & 63; fr = lane & 15; fq = lane >> 4;
    unsigned smask[2];
#pragma unroll
    for (int mt = 0; mt < 2; ++mt) smask[mt] = selm[(w & 1) * 32 + mt * 16 + fr];
    const int nsteps = __builtin_amdgcn_readfirstlane(steps[0]);
    const int mystep = steps[1 + (lane < 48 ? lane : 47)];
#define NSA_ST(k) __builtin_amdgcn_readlane(mystep, (k))
    float mrow[2], lrow[2];
    f32x4 oacc[2][4];
#pragma unroll
    for (int mt = 0; mt < 2; ++mt) {
        mrow[mt] = NEGF; lrow[mt] = 0.f;
#pragma unroll
        for (int dt = 0; dt < 4; ++dt) oacc[mt][dt] = (f32x4){0.f, 0.f, 0.f, 0.f};
    }
    const int skey = tid >> 3, sch = tid & 7;
    const int vl72 = vt_lane(fr, fq, 72);
    const int vsw = vt_off(sch * 8, skey, 72);
    bf16x8 kx[4], qx;
    {
        const float sh = bf2f(f2bf(sl2)), slo = sl2 - sh;
        u32x4 t = (u32x4){0u, 0u, 0u, 0u};
        if (fq == 0) t.x = cvt_pk_bf16(sh, slo);
        qx = __builtin_bit_cast(bf16x8, t);
#pragma unroll
        for (int nt = 0; nt < 4; ++nt) {
            u32x4 k = (u32x4){0u, 0u, 0u, 0u};
            const float r = (float)(16 * nt + fr);
            if (fq == 0) k.x = cvt_pk_bf16(r, r);
            kx[nt] = __builtin_bit_cast(bf16x8, k);
        }
    }
    const bf16_t* Ubase = U + (size_t)(rowbase + skey) * UW + g * 64 + sch * 8;
#define NSA_SRC(st_) (Ubase + (size_t)((st_) & 255) * 64 * UW + ((((st_) >> 8) & 15) == 1 ? 768 : 1024))
#define NSA_STAGE(buf_, kr_, vr_) do { \
        *(LAS u32x4*)(Kc + (buf_) * (64 * 72) + skey * 72 + sch * 8) = kr_; \
        LAS bf16_t* _vn = Vc + (buf_) * (64 * 72) + vsw; \
        _Pragma("unroll") for (int e = 0; e < 4; ++e) { _vn[(2 * e) * 72] = (bf16_t)(vr_[e] & 0xffffu); _vn[(2 * e + 1) * 72] = (bf16_t)(vr_[e] >> 16); } } while (0)
    u32x4 kregA, vregA;
    {
        const bf16_t* src = NSA_SRC(NSA_ST(0));
        kregA = *(const u32x4*)src; vregA = *(const u32x4*)(src + 128);
        NSA_STAGE(0, kregA, vregA);
    }
    if (nsteps > 1) { const bf16_t* src = NSA_SRC(NSA_ST(1)); kregA = *(const u32x4*)src; vregA = *(const u32x4*)(src + 128); }
    __syncthreads();
    int curkind = 1;
#define NSA_STEP(si, kX, vX) do { \
        const int st = NSA_ST(si), kind = (st >> 8) & 15, kb = st & 255; \
        const bool nomask = (st & 4096) != 0; \
        LAS bf16_t* Kl = Kc + ((si) & 1) * (64 * 72); \
        LAS bf16_t* Vt = Vc + ((si) & 1) * (64 * 72); \
        if (kind != curkind) { \
            _Pragma("unroll") for (int mt = 0; mt < 2; ++mt) { \
                float lt = lrow[mt]; \
                lt = fq_sum(lt); \
                const float sc = sigmoidf_(gpre[mt][1]) / lt; \
                _Pragma("unroll") for (int dt = 0; dt < 4; ++dt) { y[mt][dt] += oacc[mt][dt] * sc; oacc[mt][dt] = (f32x4){0.f, 0.f, 0.f, 0.f}; } \
                mrow[mt] = NEGF; lrow[mt] = 0.f; \
            } \
            curkind = kind; \
        } \
        const float Bs = sl2 * (float)(kb * 64); \
        int kbi = kb * 64 + 4 * fq; \
        asm volatile("" : "+v"(kbi)); \
        f32x4 s[2][4]; \
        _Pragma("unroll") for (int nt = 0; nt < 4; ++nt) { \
            const bf16x8 k0 = *(const LAS bf16x8*)(Kl + (16 * nt + fr) * 72 + fq * 8), k1 = *(const LAS bf16x8*)(Kl + (16 * nt + fr) * 72 + 32 + fq * 8); \
            _Pragma("unroll") for (int mt = 0; mt < 2; ++mt) { \
                s[mt][nt] = __builtin_amdgcn_mfma_f32_16x16x32_bf16(k0, qf[mt][0], (f32x4){0.f, 0.f, 0.f, 0.f}, 0, 0, 0); \
                s[mt][nt] = __builtin_amdgcn_mfma_f32_16x16x32_bf16(k1, qf[mt][1], s[mt][nt], 0, 0, 0); \
                s[mt][nt] = __builtin_amdgcn_mfma_f32_16x16x32_bf16(kx[nt], qx, s[mt][nt], 0, 0, 0); \
            } \
        } \
        bf16x8 pb[2][2]; \
        _Pragma("unroll") for (int mt = 0; mt < 2; ++mt) { \
            float mx = NEGF; \
            if (nomask) { \
                _Pragma("unroll") for (int nt = 0; nt < 4; ++nt) \
                    _Pragma("unroll") for (int i = 0; i < 4; ++i) mx = fmaxf(mx, s[mt][nt][i]); \
            } else { \
                const int t = tw0 + mt * 16 + fr; \
                const bool rowok = (kind == 1) ? (((smask[mt] >> kb) & 1u) != 0u) : true; \
                _Pragma("unroll") for (int nt = 0; nt < 4; ++nt) \
                    _Pragma("unroll") for (int i = 0; i < 4; ++i) { \
                        const int dist = t - (kbi + 16 * nt + i); \
                        const bool valid = rowok && dist >= 0 && (kind == 1 || dist < 512); \
                        const float sv = valid ? s[mt][nt][i] : NEGF; \
                        s[mt][nt][i] = sv; mx = fmaxf(mx, sv); \
                    } \
            } \
            mx = fq_max(mx) + Bs; \
            const bool grow = __builtin_amdgcn_ballot_w64(mx > mrow[mt] + 8.0f) != 0ull;     \
            if (grow) { \
                const float mn_ = fmaxf(mrow[mt], mx); \
                const float alpha = __builtin_amdgcn_exp2f(mrow[mt] - mn_); \
                mrow[mt] = mn_; lrow[mt] *= alpha; \
                _Pragma("unroll") for (int dt = 0; dt < 4; ++dt) oacc[mt][dt] = oacc[mt][dt] * alpha; \
            } \
            const float mn = mrow[mt]; \
            const float ms = ((mn < -1e29f) ? 0.f : mn) - Bs; \
            float ls = 0.f; \
            _Pragma("unroll") for (int nt = 0; nt < 4; ++nt) \
                _Pragma("unroll") for (int i = 0; i < 4; ++i) { const float pv = __builtin_amdgcn_exp2f(s[mt][nt][i] - ms); s[mt][nt][i] = pv; ls += pv; } \
            lrow[mt] += ls; \
            pb[mt][0] = pack8(s[mt][0], s[mt][1]); pb[mt][1] = pack8(s[mt][2], s[mt][3]); \
        } \
        _Pragma("unroll") for (int ks2 = 0; ks2 < 2; ++ks2) \
            _Pragma("unroll") for (int dt = 0; dt < 4; ++dt) { \
                const u32x2 lo = *(const LAS u32x2*)(Vt + vl72 + vt_cst(dt, 4 * ks2, 72)); \
                const u32x2 hi = *(const LAS u32x2*)(Vt + vl72 + vt_cst(dt, 4 * ks2 + 2, 72)); \
                const bf16x8 va = join8(lo, hi); \
                _Pragma("unroll") for (int mt = 0; mt < 2; ++mt) oacc[mt][dt] = __builtin_amdgcn_mfma_f32_16x16x32_bf16(va, pb[mt][ks2], oacc[mt][dt], 0, 0, 0); \
            } \
        if ((si) + 1 < nsteps) NSA_STAGE(((si) + 1) & 1, kX, vX); \
        if ((si) + 2 < nsteps) { const bf16_t* src = NSA_SRC(NSA_ST((si) + 2)); kX = *(const u32x4*)src; vX = *(const u32x4*)(src + 128); } \
        __syncthreads(); \
    } while (0)
    for (int si = 0; si < nsteps; ++si) {
        NSA_STEP(si, kregA, vregA);
    }
#undef NSA_STEP
#undef NSA_ST
#undef NSA_STAGE
#undef NSA_SRC
    tid = opaque_tid(); lane = tid & 63; fr = lane & 15; fq = lane >> 4;
    {
        const float* hn = in_of(p, 22) + l * 1024 + head * 64;
        bf16_t* HD = (bf16_t*)(ws_of(p) + WS_HEADS);
        f32x4 gnv[4];
#pragma unroll
        for (int dt = 0; dt < 4; ++dt) gnv[dt] = *(const f32x4*)(hn + 16 * dt + 4 * fq);
#pragma unroll
        for (int mt = 0; mt < 2; ++mt) {
            const int t = tw0 + mt * 16 + fr;
            float lt = lrow[mt];
            lt = fq_sum(lt);
            const float sc = sigmoidf_(gpre[mt][2]) / lt;
            float ss = 0.f;
            f32x4 yy[4];
#pragma unroll
            for (int dt = 0; dt < 4; ++dt) { yy[dt] = y[mt][dt] + oacc[mt][dt] * sc; ss += (yy[dt][0] * yy[dt][0] + yy[dt][1] * yy[dt][1]) + (yy[dt][2] * yy[dt][2] + yy[dt][3] * yy[dt][3]); }
            ss = fq_sum(ss);
            const float rs = rsqrtf(ss * (1.0f / 64.0f) + EPS);
#pragma unroll
            for (int dt = 0; dt < 4; ++dt) {
                const f32x4 gn = gnv[dt];
                const f32x4 o = yy[dt] * rs * gn;
                u32x2 pk; pk.x = cvt_pk_bf16(o[0], o[1]); pk.y = cvt_pk_bf16(o[2], o[3]);
                *(u32x2*)(HD + (size_t)(rowbase + t) * DM + head * 64 + 16 * dt + 4 * fq) = pk;
            }
        }
    }
    __syncthreads();
}

#define XB_TMO      128
#define XB_XCNT(j)  (256  + 64 * (j))
#define XB_XSUB(j)  (1280 + 64 * (j))
#define XB_XGEN(j)  (2304 + 64 * (j))
#define XB_TOP      3328
#define XB_TOPGEN   3392
#define XCD_BAR_WORDS 3456
#define XB_SPIN_CAP (1u << 22)
__device__ __forceinline__ unsigned xb_ld(unsigned* p)              { return __hip_atomic_load(p, __ATOMIC_RELAXED, __HIP_MEMORY_SCOPE_AGENT); }
__device__ __forceinline__ unsigned xb_add(unsigned* p, unsigned v) { return __hip_atomic_fetch_add(p, v, __ATOMIC_RELAXED, __HIP_MEMORY_SCOPE_AGENT); }
__device__ __forceinline__ unsigned xb_xcc_id() { return (unsigned)__builtin_amdgcn_s_getreg((3 << 11) | 20) & 0xFu; }
#define XB_SPIN(cond, bar) do { unsigned _sp = 0; while (cond) { __builtin_amdgcn_s_sleep(1); \
    if ((++_sp & 255u) == 0u) { if (xb_ld(&(bar)[XB_TMO])) break; if (_sp > XB_SPIN_CAP) { atomicAdd(&(bar)[XB_TMO], 1u); break; } } } } while (0)
struct XcdBarrier { unsigned* bar; unsigned x; volatile LAS unsigned* st; };
__device__ __forceinline__ XcdBarrier xcd_barrier_post(unsigned* bar, volatile LAS unsigned* st) {
    XcdBarrier b; b.bar = bar; b.x = xb_xcc_id(); b.st = st;
    if (threadIdx.x == 0) (void)xb_add(&bar[XB_XCNT(b.x)], 1u);
    return b;
}
__device__ __forceinline__ void xcd_barrier_complete(unsigned* bar, unsigned x, unsigned& nloc, unsigned& nx) {
    const unsigned G = gridDim.x * gridDim.y * gridDim.z;
    unsigned sum, cnt, mine, sp = 0u;
    for (;;) {
        sum = 0u; cnt = 0u; mine = 0u;
#pragma unroll
        for (unsigned j = 0; j < 16; ++j) { const unsigned c = xb_ld(&bar[XB_XCNT(j)]); sum += c; cnt += (c > 0u) ? 1u : 0u; mine = (j == x) ? c : mine; }
        if (sum == G) break;
        __builtin_amdgcn_s_sleep(1);
        if ((++sp & 255u) == 0u) { if (xb_ld(&bar[XB_TMO])) break; if (sp > XB_SPIN_CAP) { atomicAdd(&bar[XB_TMO], 1u); break; } }
    }
    nloc = mine > 0u ? mine : 1u; nx = cnt > 0u ? cnt : 1u;
}
__device__ __forceinline__ void xcd_barrier(const XcdBarrier& b) {
    asm volatile("s_waitcnt vmcnt(0)" ::: "memory");
    __syncthreads();
    if (threadIdx.x == 0) {
        unsigned* bar = b.bar;
        __builtin_amdgcn_s_waitcnt(0);
        unsigned nloc = b.st[0], nx = b.st[1];
        if (nloc == 0u) { xcd_barrier_complete(bar, b.x, nloc, nx); b.st[0] = nloc; b.st[1] = nx; }
        const unsigned old = xb_add(&bar[XB_XSUB(b.x)], 1u);
        const unsigned gen = old / nloc;
        if (old + 1u == (gen + 1u) * nloc) {
            __builtin_amdgcn_fence(__ATOMIC_RELEASE, "agent");
            asm volatile("s_waitcnt vmcnt(0)" ::: "memory");
            const unsigned og = xb_add(&bar[XB_TOP], 1u);
            const unsigned tg = og / nx;
            if (og + 1u == (tg + 1u) * nx) xb_add(&bar[XB_TOPGEN], 1u);
            else XB_SPIN(xb_ld(&bar[XB_TOPGEN]) == tg, bar);
            __builtin_amdgcn_fence(__ATOMIC_ACQUIRE, "agent");
            xb_add(&bar[XB_XGEN(b.x)], 1u);
            asm volatile("s_waitcnt vmcnt(0)" ::: "memory");
        } else {
            XB_SPIN(xb_ld(&bar[XB_XGEN(b.x)]) == gen, bar);
            __builtin_amdgcn_fence(__ATOMIC_ACQUIRE, "agent");
            asm volatile("s_waitcnt vmcnt(0)" ::: "memory");
        }
    }
    __syncthreads();
}

__global__ void __launch_bounds__(NTHREADS) hymba_fwd(Params p) {
    extern __shared__ __attribute__((aligned(16))) unsigned char lds_raw[];
    LAS unsigned char* lds = (LAS unsigned char*)lds_raw;
    cg::grid_group grid = cg::this_grid();
    volatile LAS unsigned* xbw = (volatile LAS unsigned*)(lds + LDS_BYTES - 16);
    if (threadIdx.x < 4) xbw[threadIdx.x] = 0u;
    __syncthreads();
    XcdBarrier xbar = xcd_barrier_post((unsigned*)(ws_of(p) + WS_BAR), xbw);
    if (p.ph_hi - p.ph_lo > 1) grid.sync();
    for (int ph = p.ph_lo; ph < p.ph_hi; ++ph) {
        int G = gridDim.x, bid = blockIdx.x;
        asm volatile("" : "+s"(G), "+s"(bid));
        const int tpx = opaque_tid();
        if (ph == 0) {
            if (PHEN(0)) prologue(p, lds, bid, G);
            if (REP_SUB == 100) { __syncthreads(); prologue(p, lds, bid, G); }
        } else if (ph == 37) { if (PHEN(10)) {
            const float* ssq = (const float*)(ws_of(p) + WS_SSQ) + (size_t)(12 & 1) * T_ * 16;
            float* outp = out_of(p);
            const f32x4 gn = *(const f32x4*)(in_of(p, 28) + (tpx & 255) * 4);
            for (int it = bid; it < T_ / 8; it += G) {
                f32x4 v[4], pa[4][4];
#pragma unroll
                for (int q = 0; q < 4; ++q) {
                    const int row = it * 8 + q * 2 + (tpx >> 8);
                    v[q] = *(const f32x4*)(outp + (size_t)row * DM + (tpx & 255) * 4);
#pragma unroll
                    for (int k = 0; k < 4; ++k) pa[q][k] = *(const f32x4*)(ssq + (size_t)row * 16 + 4 * k);
                }
#pragma unroll
                for (int q = 0; q < 4; ++q) {
                    const int row = it * 8 + q * 2 + (tpx >> 8);
                    const float sm = (((pa[q][0][0] + pa[q][0][1]) + (pa[q][0][2] + pa[q][0][3])) + ((pa[q][1][0] + pa[q][1][1]) + (pa[q][1][2] + pa[q][1][3]))) + (((pa[q][2][0] + pa[q][2][1]) + (pa[q][2][2] + pa[q][2][3])) + ((pa[q][3][0] + pa[q][3][1]) + (pa[q][3][2] + pa[q][3][3])));
                    const float r = rsqrtf(sm * (1.0f / DM) + EPS);
                    *(f32x4*)(outp + (size_t)row * DM + (tpx & 255) * 4) = v[q] * r * gn;
                }
            } }
        } else {
            const int l = (ph - 1) / 9, sub = (ph - 1) % 9;
            unsigned char* wl = ws_of(p) + WS_W + (size_t)l * LAYER_W;
            float* ssq = (float*)(ws_of(p) + WS_SSQ);
            bf16_t* HB = (bf16_t*)(ws_of(p) + WS_HB);
            bf16_t* UB = (bf16_t*)(ws_of(p) + WS_U);
            if (PHEN(1) && (sub == 0 || sub == 7)) {
                const bool second = sub == 7;
                pg8::Gemm g{HB, (const bf16_t*)(wl + (second ? LO_W13B : LO_W13A)), T_, NUP, DM, DM, DM};
                pg8::StaticOrder S; S.init(T_, NUP, G, bid);
                EpiSwiGLU E{UB, ssq + (size_t)((3 * l + (second ? 2 : 0)) & 1) * T_ * 16};
                pg8::gemm_phase(lds, g, S, E);
                if (REP_SUB == 0) { __syncthreads(); pg8::gemm_phase(lds, g, S, E); }
            } else if (PHEN(2) && (sub == 1 || sub == 8 || sub == 6)) {
                const bool wout = sub == 6, second = sub == 8;
                pg8::Gemm g;
                if (wout) g = pg8::Gemm{(const bf16_t*)(ws_of(p) + WS_HEADS), (const bf16_t*)(wl + LO_WOUT), T_, DM, DM, DM, DM};
                else g = pg8::Gemm{UB, (const bf16_t*)(wl + (second ? LO_W2B : LO_W2A)), T_, DM, DFF, DFF, DFF};
                pg8::StaticOrder S; S.init(T_, DM, G, bid);
                const float* resid = (l == 0 && sub == 1) ? in_of(p, 0) : out_of(p);
                const int nxt = 3 * l + (sub == 1 ? 1 : (sub == 6 ? 2 : 3));
                EpiResid E{resid, out_of(p), HB, ssq + (size_t)(nxt & 1) * T_ * 16, wout ? 1.0f : 0.5f};
                pg8::gemm_phase(lds, g, S, E);
                if (REP_SUB == 1) { __syncthreads(); EpiResid E2{out_of(p), out_of(p), HB, ssq + (size_t)(nxt & 1) * T_ * 16, 0.0f}; pg8::gemm_phase(lds, g, S, E2); }
            } else if (PHEN(3) && sub == 2) {
                if (bid < 2 && tpx < 256) {
                    const float* cbp = (const float*)(ws_of(p) + WS_CBP) + (size_t)((l * 2 + bid) * 32) * 256 + tpx;
                    float sb = 0.f;
#pragma unroll
                    for (int q = 0; q < 32; ++q) sb += cbp[q * 256];
                    ((float*)(ws_of(p) + WS_CBIAS))[(l * 2 + bid) * 256 + tpx] = sb;
                }
                pg8::Gemm g{HB, (const bf16_t*)(wl + LO_WIN), T_, NINP, DM, DM, DM};
                pg8::StaticOrder S; S.init(T_, NINP, G, bid);
                EpiWin E{UB, (bf16_t*)(ws_of(p) + WS_KCMP), (bf16_t*)(ws_of(p) + WS_VCMP), (float*)(ws_of(p) + WS_GATES), ssq + (size_t)((3 * l + 1) & 1) * T_ * 16};
                pg8::gemm_phase(lds, g, S, E);
                if (REP_SUB == 2) { __syncthreads(); pg8::gemm_phase(lds, g, S, E); }
            } else if (sub == 3) {
                const int ngemm = 64;
                for (int rep = 0; rep < (REP_SUB == 3 ? 2 : 1); ++rep) {
                const int cls = rep == 0 ? 7 : REP_CLASS;
                if (rep) __syncthreads();
                if (G > ngemm) {
                    if (bid < ngemm) { if (PHEN(4) && (cls & 1)) {
                        const int kp = bid >> 4, kv = (bid >> 3) & 1;
                        pg8::Gemm g{(const bf16_t*)(ws_of(p) + (kv ? WS_VCMP : WS_KCMP)) + kp * 512, (const bf16_t*)(wl + (kv ? LO_CW1V : LO_CW1K)) + kp * 512, 2048, 256, 512, 1024, 2048};
                        pg8::SingleUnit S{bid & 7};
                        EpiCmp E{(float*)(ws_of(p) + WS_HID) + (size_t)(kp * 2 + kv) * 2048 * 256};
                        pg8::gemm_phase(lds, g, S, E); }
                    }
                    if (PHEN(5)) {
                        const bool gb = bid < ngemm;
                        const int i0 = gb ? 1728 + bid : bid - ngemm, i1 = gb ? 2048 : 1728, st = gb ? ngemm : G - ngemm;
                        for (int it = i0; it < i1; it += st) {
                            if (it < 1024) { if (cls & 2) lru_x_item(p, l, it >> 7, (it >> 5) & 3, it & 31, lds); }
                            else if (cls & 4) ml_x_item(p, l, (it - 1024) >> 5, it & 31, lds);
                        }
                    }
                }
                }
            } else if (PHEN(6) && sub == 4) {
                phase_m2(p, l, 7, lds, bid, G);
                if (REP_SUB == 4) { __syncthreads(); phase_m2(p, l, REP_CLASS, lds, bid, G); }
            } else if (sub == 5) {
                for (int rep = 0; rep < (REP_SUB == 5 ? 2 : 1); ++rep) {
                const int cls = rep == 0 ? 7 : REP_CLASS;
                if (rep) __syncthreads();
                for (int it = bid; it < 512 + 1024 + 512; it += G) {
                    if (it < 512) { if (PHEN(7) && (cls & 1)) {
                        const int qb = it < 256 ? 31 - (it >> 4) : ((it - 256) >> 4), bg = it & 15;
                        nsa_item(p, l, bg >> 1, bg & 1, qb, lds, (rep == 1 && REP_CLASS == 9) ? 1 : 0); }
                    } else if (it < 1536) {
                        if (PHEN(8) && (cls & 2)) ml_y_item(p, l, (it - 512) >> 5, (it - 512) & 31, lds);
                    } else {
                        if (PHEN(9) && (cls & 4)) lru_y_item(p, l, it - 1536);
                    }
                }
                }
            }
        }
        if (ph + 1 < p.ph_hi) {
            xcd_barrier(xbar);
            if (REP_SUB == 200) xcd_barrier(xbar);
        }
    }
}

extern "C" void kernel_launch(void* const* d_in, const int* in_sizes, int n_in, void* d_out, int out_size, void* d_ws, size_t ws_size, hipStream_t stream) {
    static int grid = 0;
    if (grid == 0) {
        if (n_in != 29 || out_size != T_ * DM || ws_size < WS_END) { fprintf(stderr, "kernel_launch: unexpected shapes (n_in %d out %d ws %zu need %zu)\n", n_in, out_size, ws_size, (size_t)WS_END); grid = -1; return; }
        int dev = 0, cus = 0, per_cu = 0;
        hipGetDevice(&dev);
        hipDeviceGetAttribute(&cus, hipDeviceAttributeMultiprocessorCount, dev);
        hipFuncSetAttribute((const void*)hymba_fwd, hipFuncAttributeMaxDynamicSharedMemorySize, LDS_BYTES);
        hipOccupancyMaxActiveBlocksPerMultiprocessor(&per_cu, (const void*)hymba_fwd, NTHREADS, LDS_BYTES);
        if (per_cu < 1) { fprintf(stderr, "kernel_launch: occupancy query says %d blocks per CU\n", per_cu); per_cu = 1; }
        (void)hipGetLastError();
        grid = cus;
    }
    if (grid < 0) return;
    Params p{};
    for (int i = 0; i < 29; ++i) p.in[i] = (const float*)d_in[i];
    p.out = (float*)d_out; p.ws = (unsigned char*)d_ws;
#if ONE_LAUNCH
    (void)hipMemsetAsync((unsigned char*)d_ws + WS_BAR, 0, 16384, stream);
    p.ph_lo = 0; p.ph_hi = 38;
    void* args[] = {&p};
    hipError_t e = hipLaunchCooperativeKernel((const void*)hymba_fwd, dim3(grid), dim3(NTHREADS), args, LDS_BYTES, stream);
    if (e != hipSuccess) fprintf(stderr, "cooperative launch failed: %s (grid %d)\n", hipGetErrorString(e), grid);
#else
    for (int ph = 0; ph < 38; ++ph) {
        p.ph_lo = ph; p.ph_hi = ph + 1;
        hipLaunchKernelGGL(hymba_fwd, dim3(grid), dim3(NTHREADS), LDS_BYTES, stream, p);
    }
#endif
}
```

```cpp
#include <hip/hip_runtime.h>
#include <hip/hip_cooperative_groups.h>
#include <cstdio>
namespace cg = cooperative_groups;

#define LAS __attribute__((address_space(3)))
typedef unsigned short bf16_t;
typedef short bf16x8 __attribute__((ext_vector_type(8)));
typedef float f32x4 __attribute__((ext_vector_type(4)));
typedef float f32x2 __attribute__((ext_vector_type(2)));
typedef unsigned u32x4 __attribute__((ext_vector_type(4)));
typedef unsigned u32x2 __attribute__((ext_vector_type(2)));

#ifndef ONE_LAUNCH
#define ONE_LAUNCH 1
#endif
#ifndef PHMASK
#define PHMASK 0xFFFF
#endif
#define PHEN(k) ((PHMASK >> (k)) & 1)
#ifndef REP_SUB
#define REP_SUB -1
#endif
#ifndef REP_CLASS
#define REP_CLASS 7
#endif

constexpr int T_ = 16384, SEQ = 2048, DM = 1024, DFF = 2816, NUP = 5632, NINP = 3072, UW = 2816, DIN = 2848;
constexpr float EPS = 1e-6f;
constexpr float NEGF = -1e30f;
constexpr int NTHREADS = 512;
constexpr int LDS_BYTES = 147456;

constexpr size_t SZ_W13T = (size_t)NUP * DM * 2, SZ_W2T = (size_t)DM * DFF * 2, SZ_WINT = (size_t)NINP * DM * 2, SZ_WOUTT = (size_t)DM * DM * 2, SZ_CW1T = (size_t)256 * 2048 * 2;
constexpr size_t LO_W13A = 0, LO_W2A = LO_W13A + SZ_W13T, LO_W13B = LO_W2A + SZ_W2T, LO_W2B = LO_W13B + SZ_W13T, LO_WIN = LO_W2B + SZ_W2T, LO_WOUT = LO_WIN + SZ_WINT,
                 LO_CW1K = LO_WOUT + SZ_WOUTT, LO_CW1V = LO_CW1K + SZ_CW1T, LAYER_W = LO_CW1V + SZ_CW1T;
constexpr size_t WS_W = 0;
constexpr size_t WS_HB = WS_W + 4 * LAYER_W;
constexpr size_t WS_U = WS_HB + (size_t)T_ * DM * 2;
constexpr size_t WS_HEADS = WS_U + (size_t)T_ * UW * 2;
constexpr size_t SZ_CMPIN = (size_t)16 * 2048 * 64 * 2 + 4096;
constexpr size_t WS_KCMP = WS_HEADS + (size_t)T_ * DM * 2;
constexpr size_t WS_VCMP = WS_KCMP + SZ_CMPIN;
constexpr size_t WS_HID = WS_VCMP + SZ_CMPIN;
constexpr size_t WS_KC = WS_HID + (size_t)4 * 2 * 2048 * 256 * 4;
constexpr size_t WS_GATES = WS_KC + (size_t)2 * 2048 * 64 * 2;
constexpr size_t WS_SSQ = WS_GATES + (size_t)T_ * 32 * 4;
constexpr size_t WS_CBIAS = WS_SSQ + (size_t)2 * T_ * 16 * 4;
constexpr size_t WS_LRUH = WS_CBIAS + 8192;
constexpr size_t WS_LRUA = WS_LRUH + (size_t)T_ * 256 * 4;
constexpr size_t WS_LRUC = WS_LRUA + (size_t)T_ * 256 * 4;
constexpr size_t WS_MLC = WS_LRUC + (size_t)8 * 32 * 256 * 4;
constexpr size_t WS_MLN = WS_MLC + (size_t)1024 * 4096 * 4;
constexpr size_t WS_MLMU = WS_MLN + (size_t)1024 * 64 * 4;
constexpr size_t WS_MLAT = WS_MLMU + 4096;
constexpr size_t WS_MLMP = WS_MLAT + 4096;
constexpr size_t WS_CBP = WS_MLMP + 4096;
constexpr size_t WS_LRUWT = WS_CBP + 262144;
constexpr size_t WS_BAR = WS_LRUWT + 262144;
constexpr size_t WS_END = WS_BAR + 16384;
static_assert(WS_END <= 425365632ull, "workspace too large");
static_assert(LAYER_W % 256 == 0 && WS_HB % 256 == 0 && WS_U % 256 == 0 && WS_KCMP % 256 == 0 && WS_VCMP % 256 == 0 && WS_HID % 256 == 0, "align");

struct Params {
    const float* in[29];
    float* out;
    unsigned char* ws;
    int ph_lo, ph_hi;
};
static_assert(sizeof(Params) == 256, "Params has padding");
#define GAS __attribute__((address_space(1)))
__device__ __forceinline__ unsigned char* ws_of(const Params& p) { unsigned long long w = (unsigned long long)p.ws; asm volatile("" : "+s"(w)); return (unsigned char*)(GAS unsigned char*)w; }
__device__ __forceinline__ float* out_of(const Params& p) { unsigned long long w = (unsigned long long)p.out; asm volatile("" : "+s"(w)); return (float*)(GAS float*)w; }
__device__ __forceinline__ const float* in_of(const Params& p, int i) { unsigned long long w = (unsigned long long)p.in[i]; asm volatile("" : "+s"(w)); return (const float*)(GAS const float*)w; }
__device__ __forceinline__ unsigned cvt_pk_bf16(float lo, float hi) { unsigned r; asm volatile("v_cvt_pk_bf16_f32 %0, %1, %2" : "=v"(r) : "v"(lo), "v"(hi)); return r; }
__device__ __forceinline__ bf16_t f2bf(float f) { return (bf16_t)(cvt_pk_bf16(f, 0.f) & 0xffffu); }
__device__ __forceinline__ float bf2f(bf16_t b) { return __uint_as_float(((unsigned)b) << 16); }
__device__ __forceinline__ float sigmoidf_(float x) { return 1.0f / (1.0f + __expf(-x)); }
__device__ __forceinline__ int opaque_tid() { int x = threadIdx.x; asm volatile("" : "+v"(x)); return x; }
__device__ __forceinline__ float row_rstd(const float* part, int row) {
    const f32x4 a = *(const f32x4*)(part + (size_t)row * 16), b = *(const f32x4*)(part + (size_t)row * 16 + 4), c = *(const f32x4*)(part + (size_t)row * 16 + 8), d = *(const f32x4*)(part + (size_t)row * 16 + 12);
    const float s = (((a[0] + a[1]) + (a[2] + a[3])) + ((b[0] + b[1]) + (b[2] + b[3]))) + (((c[0] + c[1]) + (c[2] + c[3])) + ((d[0] + d[1]) + (d[2] + d[3])));
    return rsqrtf(s * (1.0f / DM) + EPS);
}
__device__ __forceinline__ float fq_max(float x) {
    auto a = __builtin_amdgcn_permlane16_swap(__float_as_uint(x), __float_as_uint(x), false, false);
    const float m = fmaxf(__uint_as_float(a[0]), __uint_as_float(a[1]));
    auto b = __builtin_amdgcn_permlane32_swap(__float_as_uint(m), __float_as_uint(m), false, false);
    return fmaxf(__uint_as_float(b[0]), __uint_as_float(b[1]));
}
__device__ __forceinline__ float fq_sum(float x) {
    auto a = __builtin_amdgcn_permlane16_swap(__float_as_uint(x), __float_as_uint(x), false, false);
    const float m = __uint_as_float(a[0]) + __uint_as_float(a[1]);
    auto b = __builtin_amdgcn_permlane32_swap(__float_as_uint(m), __float_as_uint(m), false, false);
    return __uint_as_float(b[0]) + __uint_as_float(b[1]);
}
__device__ __forceinline__ float wave_sum(float v) {
#pragma unroll
    for (int o = 32; o >= 1; o >>= 1) v += __shfl_xor(v, o);
    return v;
}
__device__ __forceinline__ float wave_max(float v) {
#pragma unroll
    for (int o = 32; o >= 1; o >>= 1) v = fmaxf(v, __shfl_xor(v, o));
    return v;
}

namespace pg8 {
constexpr int BM = 256, BK = 64, HALF = 128, HTB = HALF * BK * 2, STAGE_BYTES = 8 * HTB, NXCD = 8, WGM = 8;
__device__ __forceinline__ int lds_byte(int r, int c) { const int st = (r >> 4) * 2 + (c >> 5), rr = r & 15, cc = c & 31, ob = rr * 64 + cc * 2; return st * 1024 + (ob ^ (((ob >> 9) & 1) << 5)); }
__device__ __forceinline__ void stage_rc(int b, int& R, int& C) { const int st = b / 1024, sb = b % 1024, swz = sb ^ (((sb >> 9) & 1) << 5); R = (st >> 1) * 16 + swz / 64; C = (st & 1) * 32 + (swz % 64) / 2; }

struct Unit { int pm, pn; };
struct Gemm { const bf16_t* A; const bf16_t* Bt; int M, N, K, lda, ldb; };

struct StaticOrder {
    int nM, nN, nwg, G, c;
    __device__ void init(int M, int N, int G_, int c_) { nM = M / BM; nN = N / BM; nwg = nM * nN; G = G_; c = c_; }
    __device__ bool next(int i, Unit& u) const {
        const long L = (long)i * G + c; if (L >= nwg) return false;
        int wgid = (int)L; { const int q = nwg / NXCD, r = nwg % NXCD, xcd = wgid % NXCD, off = wgid / NXCD; wgid = (xcd < r ? xcd * (q + 1) : r * (q + 1) + (xcd - r) * q) + off; }
        const int nig = WGM * nN, gid = wgid / nig, fm = gid * WGM, gsz = (nM - fm) < WGM ? (nM - fm) : WGM;
        u.pm = fm + ((wgid % nig) % gsz); u.pn = (wgid % nig) / gsz; return true;
    }
};
struct SingleUnit {
    int pm;
    __device__ bool next(int i, Unit& u) const { if (i != 0 || pm < 0) return false; u.pm = pm; u.pn = 0; return true; }
};

template <class Epi, class Sched>
__device__ __forceinline__ void gemm_phase(LAS unsigned char* lds, const Gemm g, const Sched& S, const Epi& E) {
    const int tid = opaque_tid(), wid = __builtin_amdgcn_readfirstlane(tid >> 6), lane = tid & 63, wr = wid >> 2, wc = wid & 3, fr = lane & 15, fq = lane >> 4;
    const int K = g.K, nt = K / BK;
    unsigned voffA[2], voffB[2];
#pragma unroll
    for (int i = 0; i < 2; ++i) { int R, C; stage_rc(tid * 16 + i * 8192, R, C);
        voffA[i] = (unsigned)(R * g.lda + C) * 2u; voffB[i] = (unsigned)(R * g.ldb + C) * 2u; }
    const size_t kstep = (size_t)(BK * 2);
    const size_t hstepA = (size_t)HALF * g.lda * 2, hstepB = (size_t)HALF * g.ldb * 2;
    const size_t tstepA = 2 * hstepA, tstepB = 2 * hstepB;
    const unsigned ldsw = (unsigned)wid * 1024u;
    const int aoff = lds_byte(wr * 64 + fr, fq * 8), boff = lds_byte(wc * 32 + fr, fq * 8);
#define PG8_SA(b, h) (((b) * 2 + (h)) * HTB)
#define PG8_SB(b, h) ((4 + (b) * 2 + (h)) * HTB)
#define PG8_STAGE(bufoff, gbase, voff) do { _Pragma("unroll") for (int _i = 0; _i < 2; ++_i) \
        __builtin_amdgcn_global_load_lds((const unsigned*)((const char*)(gbase) + (voff)[_i]), (LAS unsigned*)(lds + (bufoff) + ldsw + _i * 8192), 16, 0, 0); } while (0)
#define PG8_LDA(dst, b, h) do { _Pragma("unroll") for (int m = 0; m < 4; ++m) _Pragma("unroll") for (int k = 0; k < 2; ++k) dst[m][k] = *(const LAS bf16x8*)(lds + PG8_SA(b, h) + aoff + m * 2048 + k * 1024); } while (0)
#define PG8_LDB(dst, b, h) do { _Pragma("unroll") for (int n = 0; n < 2; ++n) _Pragma("unroll") for (int k = 0; k < 2; ++k) dst[n][k] = *(const LAS bf16x8*)(lds + PG8_SB(b, h) + boff + n * 2048 + k * 1024); } while (0)
#define PG8_MMA(ai, bj, At, Bt) do { __builtin_amdgcn_s_setprio(1); _Pragma("unroll") for (int m = 0; m < 4; ++m) _Pragma("unroll") for (int n = 0; n < 2; ++n) _Pragma("unroll") for (int k = 0; k < 2; ++k) \
        acc[ai][bj][m][n] = __builtin_amdgcn_mfma_f32_16x16x32_bf16(Bt[n][k], At[m][k], acc[ai][bj][m][n], 0, 0, 0); __builtin_amdgcn_s_setprio(0); } while (0)
#define PG8_WAIT_V(n) asm volatile("s_waitcnt vmcnt(" #n ")" ::: "memory")
#define PG8_WAIT_L(n) asm volatile("s_waitcnt lgkmcnt(" #n ")" ::: "memory")
#define PG8_BAR __builtin_amdgcn_s_barrier()
#define PG8_SCHED __builtin_amdgcn_sched_barrier(0)
    Unit cur, nxt; int ui = 0;
    if (!S.next(0, cur)) return;
    f32x4 acc[2][2][4][2];
#pragma unroll
    for (int a = 0; a < 2; ++a)
#pragma unroll
        for (int b = 0; b < 2; ++b)
#pragma unroll
            for (int m = 0; m < 4; ++m)
#pragma unroll
                for (int n = 0; n < 2; ++n) acc[a][b][m][n] = (f32x4){0.f, 0.f, 0.f, 0.f};
    bf16x8 At[4][2], B0[2][2], B1[2][2];
    const char* cA = (const char*)g.A + (size_t)cur.pm * tstepA; const char* cB = (const char*)g.Bt + (size_t)cur.pn * tstepB;
    PG8_STAGE(PG8_SB(0, 0), cB, voffB); PG8_STAGE(PG8_SA(0, 0), cA, voffA); PG8_STAGE(PG8_SB(0, 1), cB + hstepB, voffB); PG8_STAGE(PG8_SA(0, 1), cA + hstepA, voffA);
    if (wr == 1) PG8_BAR;
    PG8_WAIT_V(4); PG8_BAR;
    PG8_STAGE(PG8_SB(1, 0), cB + kstep, voffB); PG8_STAGE(PG8_SA(1, 0), cA + kstep, voffA); PG8_STAGE(PG8_SB(1, 1), cB + hstepB + kstep, voffB);
    PG8_WAIT_V(6); PG8_BAR;
    for (;;) {
        const bool has_next = S.next(ui + 1, nxt);
        const char* nA = has_next ? (const char*)g.A + (size_t)nxt.pm * tstepA : cA; const char* nB = has_next ? (const char*)g.Bt + (size_t)nxt.pn * tstepB : cB;
        for (int t = 0; t < nt; t += 2) {
            const bool last = (t == nt - 2);
            const char* a1 = cA + (size_t)(t + 1) * kstep;
            const char* a2 = last ? nA : cA + (size_t)(t + 2) * kstep; const char* b2 = last ? nB : cB + (size_t)(t + 2) * kstep;
            const char* a3 = a2 + kstep; const char* b3 = b2 + kstep;
            PG8_LDB(B0, 0, 0); PG8_SCHED; PG8_LDA(At, 0, 0); PG8_STAGE(PG8_SA(1, 1), a1 + hstepA, voffA);
            PG8_WAIT_L(8); PG8_BAR; PG8_WAIT_L(0); PG8_MMA(0, 0, At, B0); PG8_BAR; PG8_SCHED;
            PG8_LDB(B1, 0, 1); PG8_STAGE(PG8_SB(0, 0), b2, voffB);
            PG8_BAR; PG8_WAIT_L(0); PG8_MMA(0, 1, At, B1); PG8_BAR;
            PG8_LDA(At, 0, 1); PG8_STAGE(PG8_SA(0, 0), a2, voffA);
            PG8_BAR; PG8_WAIT_L(0); PG8_MMA(1, 0, At, B0); PG8_BAR; PG8_SCHED;
            PG8_STAGE(PG8_SB(0, 1), b2 + hstepB, voffB);
            PG8_WAIT_V(6); PG8_BAR; PG8_MMA(1, 1, At, B1); PG8_BAR;
            PG8_LDB(B0, 1, 0); PG8_SCHED; PG8_LDA(At, 1, 0); PG8_STAGE(PG8_SA(0, 1), a2 + hstepA, voffA);
            PG8_WAIT_L(8); PG8_BAR; PG8_WAIT_L(0); PG8_MMA(0, 0, At, B0); PG8_BAR; PG8_SCHED;
            PG8_LDB(B1, 1, 1); PG8_STAGE(PG8_SB(1, 0), b3, voffB);
            PG8_BAR; PG8_WAIT_L(0); PG8_MMA(0, 1, At, B1); PG8_BAR;
            PG8_LDA(At, 1, 1); PG8_STAGE(PG8_SA(1, 0), a3, voffA);
            PG8_BAR; PG8_WAIT_L(0); PG8_MMA(1, 0, At, B0); PG8_BAR; PG8_SCHED;
            PG8_STAGE(PG8_SB(1, 1), b3 + hstepB, voffB);
            PG8_WAIT_V(6); PG8_BAR; PG8_MMA(1, 1, At, B1); PG8_BAR;
        }
        E(acc, cur, wr, wc, fr, fq);
        if (!has_next) break;
#pragma unroll
        for (int a = 0; a < 2; ++a)
#pragma unroll
            for (int b = 0; b < 2; ++b)
#pragma unroll
                for (int m = 0; m < 4; ++m)
#pragma unroll
                    for (int n = 0; n < 2; ++n) acc[a][b][m][n] = (f32x4){0.f, 0.f, 0.f, 0.f};
        cur = nxt; cA = nA; cB = nB; ++ui;
    }
    PG8_WAIT_V(0);
    if (wr == 0) PG8_BAR;
    PG8_BAR;
#undef PG8_SA
#undef PG8_SB
#undef PG8_STAGE
#undef PG8_LDA
#undef PG8_LDB
#undef PG8_MMA
#undef PG8_WAIT_V
#undef PG8_WAIT_L
#undef PG8_BAR
#undef PG8_SCHED
}
}

typedef __attribute__((address_space(1))) float gf32;
typedef __attribute__((address_space(1))) const float gcf32;
typedef __attribute__((address_space(1))) bf16_t gbf16;
typedef __attribute__((address_space(1))) f32x4 gf32x4;
typedef __attribute__((address_space(1))) const f32x4 gcf32x4;
typedef __attribute__((address_space(1))) u32x2 gu32x2;
__device__ __forceinline__ void rows_rstd(const float* ssq, int row0, int fq, float (&r8)[2][4]) {
    f32x4 pv[2][4];
#pragma unroll
    for (int ai = 0; ai < 2; ++ai)
#pragma unroll
        for (int m = 0; m < 4; ++m) pv[ai][m] = *(gcf32x4*)(ssq + (size_t)(row0 + ai * 128 + m * 16) * 16 + 4 * fq);
#pragma unroll
    for (int ai = 0; ai < 2; ++ai)
#pragma unroll
        for (int m = 0; m < 4; ++m) {
            float sm = (pv[ai][m][0] + pv[ai][m][1]) + (pv[ai][m][2] + pv[ai][m][3]);
            sm = fq_sum(sm);
            r8[ai][m] = rsqrtf(sm * (1.0f / DM) + EPS);
        }
}
struct EpiSwiGLU {
    bf16_t* act; const float* ssq;
    __device__ __forceinline__ void operator()(const f32x4 (&acc)[2][2][4][2], const pg8::Unit& u, int wr, int wc, int fr, int fq) const {
        const int row0 = u.pm * 256 + wr * 64 + fr, col0 = u.pn * 128 + wc * 32 + 8 * fq;
        float r8[2][4];
        rows_rstd(ssq, row0, fq, r8);
#pragma unroll
        for (int ai = 0; ai < 2; ++ai)
#pragma unroll
            for (int m = 0; m < 4; ++m) {
                const int row = row0 + ai * 128 + m * 16;
                const float r = r8[ai][m];
                float o[8];
#pragma unroll
                for (int n = 0; n < 2; ++n) {
                    const f32x4 a1 = acc[ai][0][m][n] * r, a3 = acc[ai][1][m][n] * r;
#pragma unroll
                    for (int j = 0; j < 4; ++j) o[4 * n + j] = a1[j] * __builtin_amdgcn_rcpf(1.0f + __expf(-a1[j])) * a3[j];
                }
                u32x4 w; w.x = cvt_pk_bf16(o[0], o[1]); w.y = cvt_pk_bf16(o[2], o[3]); w.z = cvt_pk_bf16(o[4], o[5]); w.w = cvt_pk_bf16(o[6], o[7]);
                *(GAS u32x4*)(act + (size_t)row * DFF + col0) = w;
            }
    }
};
struct EpiResid {
    const float* resid; float* out; bf16_t* hb; float* ssq_next; float scale;
    __device__ __forceinline__ void load2(f32x4 (&rs)[2][2][2], int row0, int col0, int ai, int mp) const {
#pragma unroll
        for (int mm = 0; mm < 2; ++mm)
#pragma unroll
            for (int bj = 0; bj < 2; ++bj)
#pragma unroll
                for (int n = 0; n < 2; ++n)
                    rs[mm][bj][n] = *(gcf32x4*)(resid + (size_t)(row0 + ai * 128 + (2 * mp + mm) * 16) * DM + col0 + bj * 128 + n * 4);
    }
    __device__ __forceinline__ void operator()(const f32x4 (&acc)[2][2][4][2], const pg8::Unit& u, int wr, int wc, int fr, int fq) const {
        const int row0 = u.pm * 256 + wr * 64 + fr, col0 = u.pn * 256 + wc * 32 + 8 * fq;
        f32x4 rsA[2][2][2], rsB[2][2][2];
        load2(rsA, row0, col0, 0, 0);
#pragma unroll
        for (int bt = 0; bt < 4; ++bt) {
            const int ai = bt >> 1, mp = bt & 1;
            if (bt < 3) { if (bt & 1) load2(rsA, row0, col0, (bt + 1) >> 1, (bt + 1) & 1); else load2(rsB, row0, col0, (bt + 1) >> 1, (bt + 1) & 1); }
#pragma unroll
            for (int mm = 0; mm < 2; ++mm) {
                const int m = 2 * mp + mm, row = row0 + ai * 128 + m * 16;
                const size_t off = (size_t)row * DM + col0;
                float ss = 0.f;
#pragma unroll
                for (int bj = 0; bj < 2; ++bj) {
                    const f32x4 r0 = (bt & 1) ? rsB[mm][bj][0] : rsA[mm][bj][0], r1 = (bt & 1) ? rsB[mm][bj][1] : rsA[mm][bj][1];
                    const f32x4 v0 = r0 + acc[ai][bj][m][0] * scale, v1 = r1 + acc[ai][bj][m][1] * scale;
                    *(gf32x4*)(out + off + bj * 128) = v0;
                    *(gf32x4*)(out + off + bj * 128 + 4) = v1;
                    u32x4 w; w.x = cvt_pk_bf16(v0[0], v0[1]); w.y = cvt_pk_bf16(v0[2], v0[3]); w.z = cvt_pk_bf16(v1[0], v1[1]); w.w = cvt_pk_bf16(v1[2], v1[3]);
                    *(GAS u32x4*)(hb + off + bj * 128) = w;
                    ss += ((v0[0] * v0[0] + v0[1] * v0[1]) + (v0[2] * v0[2] + v0[3] * v0[3])) + ((v1[0] * v1[0] + v1[1] * v1[1]) + (v1[2] * v1[2] + v1[3] * v1[3]));
                }
                ss = fq_sum(ss);
                if (fq == 0) *(gf32*)(ssq_next + (size_t)row * 16 + u.pn * 4 + wc) = ss;
            }
            asm volatile("" ::: "memory");
        }
    }
};
struct EpiWin {
    bf16_t* U; bf16_t* kcmp; bf16_t* vcmp; float* gates; const float* ssq;
    __device__ __forceinline__ void operator()(const f32x4 (&acc)[2][2][4][2], const pg8::Unit& u, int wr, int wc, int fr, int fq) const {
        const int row0 = u.pm * 256 + wr * 64 + fr;
        float r8[2][4];
        rows_rstd(ssq, row0, fq, r8);
#pragma unroll
        for (int bj = 0; bj < 2; ++bj) {
            const int c0 = u.pn * 256 + bj * 128 + wc * 32;
            if (c0 >= 2848) continue;
            const float sc = (c0 < 512) ? 0.125f * 1.4426950408889634f : ((c0 >= 2048 && c0 < 2304) ? 0.125f : 1.0f);
            const int cl = 8 * fq;
#pragma unroll
            for (int ai = 0; ai < 2; ++ai)
#pragma unroll
                for (int m = 0; m < 4; ++m) {
                    const int row = row0 + ai * 128 + m * 16;
                    const float r = r8[ai][m] * sc;
                    const f32x4 v0 = acc[ai][bj][m][0] * r, v1 = acc[ai][bj][m][1] * r;
                    if (c0 == 2816) { *(gf32x4*)(gates + (size_t)row * 32 + cl) = v0; *(gf32x4*)(gates + (size_t)row * 32 + cl + 4) = v1; }
                    else {
                        u32x4 w; w.x = cvt_pk_bf16(v0[0], v0[1]); w.y = cvt_pk_bf16(v0[2], v0[3]); w.z = cvt_pk_bf16(v1[0], v1[1]); w.w = cvt_pk_bf16(v1[2], v1[3]);
                        if (c0 >= 512 && c0 < 768) {
                            const int cc = c0 - 512 + cl;
                            const int gg = (cc >> 6) & 1, d = cc & 63;
                            bf16_t* dst = (cc < 128 ? kcmp : vcmp) + ((size_t)(((row >> 11) * 2 + gg) * 2048 + (row & 2047))) * 64 + d;
                            *(GAS u32x4*)dst = w;
                        } else {
                            *(GAS u32x4*)(U + (size_t)row * UW + c0 + cl) = w;
                        }
                    }
                }
        }
    }
};
struct EpiCmp {
    float* part;
    __device__ __forceinline__ void operator()(const f32x4 (&acc)[2][2][4][2], const pg8::Unit& u, int wr, int wc, int fr, int fq) const {
        const int row0 = u.pm * 256 + wr * 64 + fr, col0 = wc * 32 + 8 * fq;
#pragma unroll
        for (int ai = 0; ai < 2; ++ai)
#pragma unroll
            for (int m = 0; m < 4; ++m) {
                const int row = row0 + ai * 128 + m * 16;
#pragma unroll
                for (int bj = 0; bj < 2; ++bj)
#pragma unroll
                    for (int n = 0; n < 2; ++n) *(gf32x4*)(part + (size_t)row * 256 + col0 + bj * 128 + n * 4) = acc[ai][bj][m][n];
            }
    }
};

__device__ __forceinline__ int winmap(int n) {
    if (n < 1280) return n;
    if (n < 2560) return n + 24;
    if (n < 2816) return n + 32;
    if (n < 2840) return 1280 + (n - 2816);
    if (n < 2844) return 2584 + (n - 2840);
    if (n < 2848) return 2588 + (n - 2844);
    return -1;
}
struct TrTile { const float* colp; const float* gain; bf16_t* dst; int ld, K, k0, n0; };
__device__ __forceinline__ void tr_decode(const Params& p, int idx, int tid, TrTile& t) {
    constexpr int TPL = 1376;
    const int l = idx / TPL; int r = idx % TPL;
    int m, ntile, ktile, K;
    if (r < 352) { m = 0; ntile = r % 22; ktile = r / 22; K = DM; }
    else if (r < 528) { r -= 352; m = 1; ntile = r % 4; ktile = r / 4; K = DFF; }
    else if (r < 880) { r -= 528; m = 2; ntile = r % 22; ktile = r / 22; K = DM; }
    else if (r < 1056) { r -= 880; m = 3; ntile = r % 4; ktile = r / 4; K = DFF; }
    else if (r < 1248) { r -= 1056; m = 4; ntile = r % 12; ktile = r / 12; K = DM; }
    else if (r < 1312) { r -= 1248; m = 5; ntile = r % 4; ktile = r / 4; K = DM; }
    else if (r < 1344) { r -= 1312; m = 6; ntile = 0; ktile = r; K = 2048; }
    else { r -= 1344; m = 7; ntile = 0; ktile = r; K = 2048; }
    t.K = K; t.k0 = ktile * 64; t.n0 = ntile * 256; t.colp = nullptr; t.gain = nullptr; t.ld = 0;
    const int npp = t.n0 + 4 * ((tid >> 3));
    const int np = (npp & ~31) + 8 * ((npp & 15) >> 2) + 4 * ((npp >> 4) & 1);
    unsigned char* wl = ws_of(p) + WS_W + (size_t)l * LAYER_W;
    if (m == 0 || m == 2) {
        const int pb = np >> 8, w = np & 255;
        const float* src = (w < 128) ? in_of(p, m == 0 ? 2 : 25) : in_of(p, m == 0 ? 3 : 26);
        t.colp = src + (size_t)l * DM * DFF + pb * 128 + (w & 127); t.ld = DFF; t.gain = in_of(p, m == 0 ? 1 : 24) + l * DM;
        t.dst = (bf16_t*)(wl + (m == 0 ? LO_W13A : LO_W13B));
    } else if (m == 1 || m == 3) {
        t.colp = in_of(p, m == 1 ? 4 : 27) + (size_t)l * DFF * DM + np; t.ld = DM;
        t.dst = (bf16_t*)(wl + (m == 1 ? LO_W2A : LO_W2B));
    } else if (m == 4) {
        const int sc = winmap(np);
        if (sc >= 0) t.colp = in_of(p, 6) + (size_t)l * DM * DIN + sc;
        t.ld = DIN; t.gain = in_of(p, 5) + l * DM;
        t.dst = (bf16_t*)(wl + LO_WIN);
    } else if (m == 5) {
        t.colp = in_of(p, 23) + (size_t)l * DM * DM + np; t.ld = DM;
        t.dst = (bf16_t*)(wl + LO_WOUT);
    } else {
        t.colp = in_of(p, m == 6 ? 8 : 11) + (size_t)l * 2048 * 256 + np; t.ld = 256;
        t.dst = (bf16_t*)(wl + (m == 6 ? LO_CW1K : LO_CW1V));
    }
}
__device__ __forceinline__ void tr_load(const TrTile& t, int tid, f32x4 (&v)[8], float (&gv)[8]) {
    const int kc = (tid & 7);
#pragma unroll
    for (int e = 0; e < 8; ++e) {
        const int k = t.k0 + 8 * kc + e;
        v[e] = (f32x4){0.f, 0.f, 0.f, 0.f}; gv[e] = 1.0f;
        if (t.colp) { v[e] = __builtin_nontemporal_load((const f32x4*)(t.colp + (size_t)k * t.ld)); if (t.gain) gv[e] = t.gain[k]; }
    }
}
__device__ void prologue(const Params& p, LAS unsigned char* lds, int bid, int G) {
    const int tid = opaque_tid();
    LAS float* tile = (LAS float*)lds;
    {
        constexpr int N_TR = 4 * 1376;
        int it = bid;
        TrTile t; f32x4 v[8]; float gv[8];
        if (it < N_TR) { tr_decode(p, it, tid, t); tr_load(t, tid, v, gv); }
        while (it < N_TR) {
            bf16_t* dst = t.dst + (size_t)(t.n0 + 4 * ((tid >> 3))) * t.K + t.k0 + 8 * ((tid & 7));
            const int K = t.K;
            u32x4 o[4];
#pragma unroll
            for (int q = 0; q < 4; ++q) { o[q].x = cvt_pk_bf16(v[0][q] * gv[0], v[1][q] * gv[1]); o[q].y = cvt_pk_bf16(v[2][q] * gv[2], v[3][q] * gv[3]); o[q].z = cvt_pk_bf16(v[4][q] * gv[4], v[5][q] * gv[5]); o[q].w = cvt_pk_bf16(v[6][q] * gv[6], v[7][q] * gv[7]); }
            const int nx = it + G;
            if (nx < N_TR) { tr_decode(p, nx, tid, t); tr_load(t, tid, v, gv); }
#pragma unroll
            for (int q = 0; q < 4; ++q) *(u32x4*)(dst + (size_t)q * K) = o[q];
            it = nx;
        }
    }
    constexpr int N_BIAS = 256, N_XROW = T_ / 16, N_LW = 32;
    for (int it = bid; it < N_BIAS + N_XROW + N_LW; it += G) {
        if (it >= N_BIAS + N_XROW) {
            const int q = it - N_BIAS - N_XROW, ln = q >> 1, gate = q & 1;
            const float* W = in_of(p, gate ? 17 : 15) + (size_t)ln * 4096;
            bf16_t* WT = (bf16_t*)(ws_of(p) + WS_LRUWT) + (size_t)q * 4096;
            float wv[8];
#pragma unroll
            for (int rr = 0; rr < 8; ++rr) { const int idx = tid + rr * NTHREADS, d = idx >> 6, c = idx & 63; wv[rr] = W[c * 64 + d]; }
#pragma unroll
            for (int rr = 0; rr < 8; ++rr) WT[tid + rr * NTHREADS] = f2bf(wv[rr]);
        } else if (it < N_BIAS) {
            const int lkv = it >> 5, part = it & 31, l = lkv >> 1, kv = lkv & 1;
            const float* pos = in_of(p, kv ? 10 : 7) + (size_t)l * 2048;
            const float* w1 = in_of(p, kv ? 11 : 8) + (size_t)l * 2048 * 256;
            const int j = tid & 255, half = tid >> 8;
            float sacc = 0.f;
            const int kb = part * 64 + half * 32;
            for (int k = kb; k < kb + 32; k += 8) {
                float a[8];
#pragma unroll
                for (int q = 0; q < 8; ++q) a[q] = w1[(size_t)(k + q) * 256 + j];
#pragma unroll
                for (int q = 0; q < 8; ++q) sacc += pos[k + q] * a[q];
            }
            tile[tid] = sacc;
            __syncthreads();
            if (tid < 256) ((float*)(ws_of(p) + WS_CBP))[(size_t)it * 256 + tid] = tile[tid] + tile[tid + 256];
            __syncthreads();
        } else {
            const int row0 = (it - N_BIAS) * 16 + (tid >> 6) * 2, lane = tid & 63;
            f32x4 xv[2][4];
#pragma unroll
            for (int rq = 0; rq < 2; ++rq)
#pragma unroll
                for (int i = 0; i < 4; ++i) xv[rq][i] = *(const f32x4*)(in_of(p, 0) + (size_t)(row0 + rq) * DM + i * 256 + lane * 4);
#pragma unroll
            for (int rq = 0; rq < 2; ++rq) {
                const int row = row0 + rq;
                bf16_t* hb = (bf16_t*)(ws_of(p) + WS_HB) + (size_t)row * DM;
                float ss = 0.f;
#pragma unroll
                for (int i = 0; i < 4; ++i) {
                    const f32x4 v = xv[rq][i];
                    ss += (v[0] * v[0] + v[1] * v[1]) + (v[2] * v[2] + v[3] * v[3]);
                    u32x2 w; w.x = cvt_pk_bf16(v[0], v[1]); w.y = cvt_pk_bf16(v[2], v[3]);
                    *(u32x2*)(hb + i * 256 + lane * 4) = w;
                }
                ss = wave_sum(ss);
                if (lane < 16) ((float*)(ws_of(p) + WS_SSQ))[(size_t)row * 16 + lane] = (lane == 0) ? ss : 0.f;
            }
        }
    }
}

__device__ void lru_x_item(const Params& p, int l, int b, int n, int ck, LAS unsigned char* lds) {
    const int tid = opaque_tid(), lane = tid & 63, w = __builtin_amdgcn_readfirstlane(tid >> 6), fr = lane & 15, fq = lane >> 4;
    LAS float* xs = (LAS float*)lds;
    LAS float* xc = (LAS float*)(lds + 17152);
    LAS bf16_t* xb = (LAS bf16_t*)(lds + 33536);
    LAS bf16_t* wt = (LAS bf16_t*)(lds + 42752);
    LAS float* pre = (LAS float*)(lds + 61184);
    LAS float* segA = (LAS float*)(lds + 93952);
    LAS float* segH = segA + 512;
    const bf16_t* U = (const bf16_t*)(ws_of(p) + WS_U);
    const int t0 = ck * 64, rowbase = b * SEQ;
    {
        u32x4 xv[2];
#pragma unroll
        for (int rr = 0; rr < 2; ++rr) {
            const int idx = tid + rr * NTHREADS, tt = idx >> 3, ch = idx & 7, t = t0 - 3 + tt;
            xv[rr] = (u32x4){0u, 0u, 0u, 0u};
            if (idx < 67 * 8 && t >= 0) xv[rr] = *(const u32x4*)(U + (size_t)(rowbase + t) * UW + 1280 + n * 64 + ch * 8);
        }
#pragma unroll
        for (int rr = 0; rr < 2; ++rr) {
            const int idx = tid + rr * NTHREADS, tt = idx >> 3, ch = idx & 7;
            if (idx < 67 * 8) {
                f32x4 lo, hi;
                lo[0] = __uint_as_float(xv[rr][0] << 16); lo[1] = __uint_as_float(xv[rr][0] & 0xffff0000u); lo[2] = __uint_as_float(xv[rr][1] << 16); lo[3] = __uint_as_float(xv[rr][1] & 0xffff0000u);
                hi[0] = __uint_as_float(xv[rr][2] << 16); hi[1] = __uint_as_float(xv[rr][2] & 0xffff0000u); hi[2] = __uint_as_float(xv[rr][3] << 16); hi[3] = __uint_as_float(xv[rr][3] & 0xffff0000u);
                *(LAS f32x4*)(xs + tt * 64 + ch * 8) = lo; *(LAS f32x4*)(xs + tt * 64 + ch * 8 + 4) = hi;
            }
        }
    }
    {
        const bf16_t* WT = (const bf16_t*)(ws_of(p) + WS_LRUWT) + (size_t)((l * 4 + n) * 2) * 4096;
#pragma unroll
        for (int rr = 0; rr < 2; ++rr) {
            const int idx = tid + rr * NTHREADS, row = idx >> 3, ch = idx & 7;
            *(LAS u32x4*)(wt + row * 72 + ch * 8) = *(const u32x4*)(WT + row * 64 + ch * 8);
        }
    }
    __syncthreads();
    {
        const float* cw = in_of(p, 13) + (size_t)l * 4 * 256 + n * 64; const float* cb = in_of(p, 14) + l * 256 + n * 64;
        const int c = tid & 63;
        const float w0 = cw[c], w1 = cw[256 + c], w2 = cw[512 + c], w3 = cw[768 + c], bc = cb[c];
#pragma unroll
        for (int k = 0; k < 8; ++k) {
            const int t = (tid >> 6) + 8 * k;
            const float v = bc + xs[t * 64 + c] * w0 + xs[(t + 1) * 64 + c] * w1 + xs[(t + 2) * 64 + c] * w2 + xs[(t + 3) * 64 + c] * w3;
            xc[t * 64 + c] = v; xb[t * 72 + c] = f2bf(v);
        }
    }
    __syncthreads();
    {
        const int tt = w & 3, gate = w >> 2;
        bf16x8 xa[2];
#pragma unroll
        for (int ks = 0; ks < 2; ++ks) xa[ks] = *(const LAS bf16x8*)(xb + (16 * tt + fr) * 72 + 32 * ks + 8 * fq);
        const float* bias = in_of(p, gate ? 18 : 16) + (l * 4 + n) * 64;
#pragma unroll
        for (int dt = 0; dt < 4; ++dt) {
            f32x4 acc = (f32x4){0.f, 0.f, 0.f, 0.f};
#pragma unroll
            for (int ks = 0; ks < 2; ++ks) {
                const bf16x8 wb = *(const LAS bf16x8*)(wt + (gate * 64 + 16 * dt + fr) * 72 + 32 * ks + 8 * fq);
                acc = __builtin_amdgcn_mfma_f32_16x16x32_bf16(xa[ks], wb, acc, 0, 0, 0);
            }
            const float bv = bias[16 * dt + fr];
#pragma unroll
            for (int i = 0; i < 4; ++i) pre[(gate * 64 + 16 * tt + 4 * fq + i) * 64 + 16 * dt + fr] = acc[i] + bv;
        }
    }
    __syncthreads();
    const int d = tid & 63, tq = tid >> 6;
    const float lam = in_of(p, 19)[l * 256 + n * 64 + d];
    const float sp = __logf(1.0f + __expf(-lam));
    float hl[8], cl[8];
    float h = 0.f, ca = 1.f;
#pragma unroll
    for (int i = 0; i < 8; ++i) {
        const float r = __builtin_amdgcn_rcpf(1.0f + __expf(-pre[(tq * 8 + i) * 64 + d])), ii = __builtin_amdgcn_rcpf(1.0f + __expf(-pre[(64 + tq * 8 + i) * 64 + d]));
        const float la = -8.0f * r * sp;
        const float a = __expf(la);
        const float uu = __builtin_amdgcn_sqrtf(fmaxf(1.0f - a * a, 0.f)) * (ii * xc[(tq * 8 + i) * 64 + d]);
        h = a * h + uu; ca *= a; hl[i] = h; cl[i] = ca;
    }
    segA[tq * 64 + d] = ca; segH[tq * 64 + d] = h;
    __syncthreads();
    float cin_h = 0.f, cin_a = 1.f;
    for (int sgi = 0; sgi < tq; ++sgi) { const float sa = segA[sgi * 64 + d]; cin_h = sa * cin_h + segH[sgi * 64 + d]; cin_a *= sa; }
    float* LH = (float*)(ws_of(p) + WS_LRUH); float* LA = (float*)(ws_of(p) + WS_LRUA);
#pragma unroll
    for (int i = 0; i < 8; ++i) {
        const size_t o = (size_t)(rowbase + t0 + tq * 8 + i) * 256 + n * 64 + d;
        LH[o] = hl[i] + cl[i] * cin_h; LA[o] = cl[i] * cin_a;
    }
    __syncthreads();
}

__device__ __forceinline__ float logsigmoidf_(float x) { return fminf(x, 0.f) - __logf(1.0f + __expf(-fabsf(x))); }

__device__ __forceinline__ int vt_off(int d, int key, int pitch) {
    const int kc = key >> 3;
    return d * pitch + ((((kc ^ (d >> 3)) & 7) | (kc & ~7)) << 3) + (key & 7);
}
__device__ void ml_x_item(const Params& p, int l, int bh, int ck, LAS unsigned char* lds) {
    const int tid = opaque_tid(), lane = tid & 63, w = __builtin_amdgcn_readfirstlane(tid >> 6), fr = lane & 15, fq = lane >> 4;
    const int b = bh >> 2, hh = bh & 3;
    LAS bf16_t* KwT = (LAS bf16_t*)lds;
    LAS bf16_t* VT = (LAS bf16_t*)(lds + 9216);
    LAS float* wks = (LAS float*)(lds + 20736);
    const bf16_t* U = (const bf16_t*)(ws_of(p) + WS_U);
    const float* GT = (const float*)(ws_of(p) + WS_GATES);
    const int rowbase = b * SEQ + ck * 64;
    if (tid < 64) {
        const float ig = GT[(size_t)(rowbase + lane) * 32 + 24 + hh] + in_of(p, 20)[l * 4 + hh];
        const float fp = GT[(size_t)(rowbase + lane) * 32 + 28 + hh] + in_of(p, 21)[l * 4 + hh];
        float a = logsigmoidf_(fp);
#pragma unroll
        for (int o = 1; o < 64; o <<= 1) { const float t = __shfl_up(a, o); if (lane >= o) a += t; }
        const float A = __shfl(a, 63);
        const float wend = A - a + ig;
        const float mu = wave_max(wend);
        wks[lane] = __expf(wend - mu);
        if (lane == 0) { ((float*)(ws_of(p) + WS_MLMU))[bh * 32 + ck] = mu; ((float*)(ws_of(p) + WS_MLAT))[bh * 32 + ck] = A; }
    }
    const int srow = tid >> 3, sch = tid & 7;
    const bf16_t* src = U + (size_t)(rowbase + srow) * UW + hh * 64 + sch * 8;
    const u32x4 kk = *(const u32x4*)(src + 2048);
    {
        const u32x4 vv = *(const u32x4*)(src + 2304);
#pragma unroll
        for (int e = 0; e < 4; ++e) {
            VT[vt_off(sch * 8 + 2 * e, srow, 72)] = (bf16_t)(vv[e] & 0xffffu);
            VT[vt_off(sch * 8 + 2 * e + 1, srow, 72)] = (bf16_t)(vv[e] >> 16);
        }
        for (int idx = tid; idx < 16 * 72; idx += NTHREADS) VT[64 * 72 + idx] = (idx < 72) ? (bf16_t)0x3f80 : (bf16_t)0;
    }
    __syncthreads();
    {
        const float wk = wks[srow];
#pragma unroll
        for (int e = 0; e < 4; ++e) {
            KwT[vt_off(sch * 8 + 2 * e, srow, 72)] = f2bf(wk * __uint_as_float(kk[e] << 16));
            KwT[vt_off(sch * 8 + 2 * e + 1, srow, 72)] = f2bf(wk * __uint_as_float(kk[e] & 0xffff0000u));
        }
    }
    __syncthreads();
    {
        const int dt = w & 3, hf = w >> 2;
        bf16x8 ka[2];
#pragma unroll
        for (int ks = 0; ks < 2; ++ks) ka[ks] = *(const LAS bf16x8*)(KwT + vt_off(16 * dt + fr, 32 * ks + 8 * fq, 72));
        float* C = (float*)(ws_of(p) + WS_MLC) + (size_t)(bh * 32 + ck) * 4096;
#pragma unroll
        for (int ee = 0; ee < 2; ++ee) {
            const int et = 2 * hf + ee;
            f32x4 acc = (f32x4){0.f, 0.f, 0.f, 0.f};
#pragma unroll
            for (int ks = 0; ks < 2; ++ks) {
                const bf16x8 vb = *(const LAS bf16x8*)(VT + vt_off(16 * et + fr, 32 * ks + 8 * fq, 72));
                acc = __builtin_amdgcn_mfma_f32_16x16x32_bf16(ka[ks], vb, acc, 0, 0, 0);
            }
#pragma unroll
            for (int i = 0; i < 4; ++i) C[(16 * dt + 4 * fq + i) * 64 + 16 * et + fr] = acc[i];
        }
        if (hf == 0) {
            f32x4 acc = (f32x4){0.f, 0.f, 0.f, 0.f};
#pragma unroll
            for (int ks = 0; ks < 2; ++ks) {
                const bf16x8 vb = *(const LAS bf16x8*)(VT + (64 + fr) * 72 + 32 * ks + 8 * fq);
                acc = __builtin_amdgcn_mfma_f32_16x16x32_bf16(ka[ks], vb, acc, 0, 0, 0);
            }
            if (fr == 0) {
#pragma unroll
                for (int i = 0; i < 4; ++i) ((float*)(ws_of(p) + WS_MLN))[(size_t)(bh * 32 + ck) * 64 + 16 * dt + 4 * fq + i] = acc[i];
            }
        }
    }
    __syncthreads();
}

__device__ void phase_m2(const Params& p, int l, int cls, LAS unsigned char* lds, int bid, int G) {
    const int tid = opaque_tid();
    constexpr int N_KC = 128, N_LC = 4, N_MC = 256, N_MN = 4, TOTAL = N_KC + N_LC + N_MC + N_MN;
    for (int it = bid; it < TOTAL; it += G) {
        if (it < N_KC) {
            if (!(cls & 1)) continue;
            const int kv = it >> 6, r0 = (it & 63) * 32;
            LAS float* hid = (LAS float*)lds;
            LAS float* w2s = hid + 32 * 256;
            const float* part = (const float*)(ws_of(p) + WS_HID) + (size_t)(kv * 2048 + r0) * 256;
            const float* cb = (const float*)(ws_of(p) + WS_CBIAS) + (l * 2 + kv) * 256;
            const float* w2 = in_of(p, kv ? 12 : 9) + (size_t)l * 256 * 64;
            f32x4 pr[4][4];
#pragma unroll
            for (int rr = 0; rr < 4; ++rr) {
                const int idx = tid + rr * NTHREADS, row = idx >> 6, j4 = (idx & 63) * 4;
#pragma unroll
                for (int kp = 0; kp < 4; ++kp) pr[rr][kp] = *(const f32x4*)(part + (size_t)kp * 2 * 2048 * 256 + row * 256 + j4);
            }
#pragma unroll
            for (int rr = 0; rr < 4; ++rr) {
                const int idx = tid + rr * NTHREADS, row = idx >> 6, j4 = (idx & 63) * 4;
                f32x4 hv = *(const f32x4*)(cb + j4);
#pragma unroll
                for (int kp = 0; kp < 4; ++kp) hv = hv + pr[rr][kp];
#pragma unroll
                for (int q = 0; q < 4; ++q) hv[q] = hv[q] * __builtin_amdgcn_rcpf(1.0f + __expf(-hv[q]));
                *(LAS f32x4*)(hid + row * 256 + j4) = hv;
            }
#pragma unroll
            for (int rr = 0; rr < 8; ++rr) { const int idx = tid + rr * NTHREADS; *(LAS f32x4*)(w2s + idx * 4) = *(const f32x4*)(w2 + idx * 4); }
            __syncthreads();
            {
                const int d = tid & 63, rq = tid >> 6;
                float acc[4] = {0.f, 0.f, 0.f, 0.f};
                for (int j = 0; j < 256; j += 4) {
                    float wv[4];
#pragma unroll
                    for (int q = 0; q < 4; ++q) wv[q] = w2s[(j + q) * 64 + d];
#pragma unroll
                    for (int i = 0; i < 4; ++i) {
                        const f32x4 hv = *(const LAS f32x4*)(hid + (rq * 4 + i) * 256 + j);
#pragma unroll
                        for (int q = 0; q < 4; ++q) acc[i] += hv[q] * wv[q];
                    }
                }
                bf16_t* KCo = (bf16_t*)(ws_of(p) + WS_KC);
#pragma unroll
                for (int i = 0; i < 4; ++i) {
                    const int r = r0 + rq * 4 + i;
                    KCo[(size_t)(kv * 2048 + r) * 64 + d] = f2bf(((r & 127) == 127) ? 0.f : acc[i]);
                }
            }
            __syncthreads();
        } else if (it < N_KC + N_LC) {
            if (!(cls & 2)) continue;
            const int idx = (it - N_KC) * NTHREADS + tid;
            const int b = idx >> 8, ch = idx & 255;
            const float* LH = (const float*)(ws_of(p) + WS_LRUH); const float* LA = (const float*)(ws_of(p) + WS_LRUA);
            float* LC = (float*)(ws_of(p) + WS_LRUC);
            float la[32], lh[32];
#pragma unroll
            for (int ck = 0; ck < 32; ++ck) { const size_t o = (size_t)(b * SEQ + ck * 64 + 63) * 256 + ch; la[ck] = LA[o]; lh[ck] = LH[o]; }
            float carry = 0.f;
#pragma unroll
            for (int ck = 0; ck < 32; ++ck) { LC[(b * 32 + ck) * 256 + ch] = carry; carry = la[ck] * carry + lh[ck]; }
        } else {
            if (!(cls & 4)) continue;
            const bool isn = it >= N_KC + N_LC + N_MC;
            const int idx = (it - N_KC - N_LC - (isn ? N_MC : 0)) * NTHREADS + tid;
            const int bh = isn ? (idx >> 6) : (idx >> 12), de = isn ? (idx & 63) : (idx & 4095);
            const int esz = isn ? 64 : 4096;
            float* buf = (float*)(ws_of(p) + (isn ? WS_MLN : WS_MLC)) + (size_t)bh * 32 * esz + de;
            const float* MU = (const float*)(ws_of(p) + WS_MLMU) + bh * 32; const float* AT = (const float*)(ws_of(p) + WS_MLAT) + bh * 32;
            float* MP = (float*)(ws_of(p) + WS_MLMP) + bh * 32;
            float dc[32];
#pragma unroll
            for (int ck = 0; ck < 32; ++ck) dc[ck] = buf[(size_t)ck * esz];
            float C = 0.f, m = 0.f;
#pragma unroll
            for (int ck = 0; ck < 32; ++ck) {
                buf[(size_t)ck * esz] = C;
                if (!isn && de == 0) MP[ck] = m;
                const float at = AT[ck], mu = MU[ck];
                const float mn = fmaxf(at + m, mu);
                C = __expf(at + m - mn) * C + __expf(mu - mn) * dc[ck];
                m = mn;
            }
        }
    }
}

__device__ __forceinline__ float gelu_tanh(float x) { const float u = 0.7978845608028654f * (x + 0.044715f * x * x * x); return x * __builtin_amdgcn_rcpf(1.0f + __expf(-2.0f * u)); }

__device__ void lru_y_item(const Params& p, int l, int item) {
    const int tid = opaque_tid(), lane = tid & 63;
    const float* LH = (const float*)(ws_of(p) + WS_LRUH); const float* LA = (const float*)(ws_of(p) + WS_LRUA); const float* LC = (const float*)(ws_of(p) + WS_LRUC);
    const bf16_t* U = (const bf16_t*)(ws_of(p) + WS_U);
    const float* hn = in_of(p, 22) + l * 1024;
    bf16_t* HD = (bf16_t*)(ws_of(p) + WS_HEADS);
    const int pair0 = item * 128 + (tid >> 6) * 16;
    float lh[16], la[16], lc[16]; bf16_t gg[16];
    float gn[4];
#pragma unroll
    for (int n = 0; n < 4; ++n) gn[n] = hn[(8 + n) * 64 + lane];
#pragma unroll
    for (int q = 0; q < 16; ++q) {
        const int pair = pair0 + q, row = pair >> 2, n = pair & 3, ch = n * 64 + lane;
        lh[q] = LH[(size_t)row * 256 + ch]; la[q] = LA[(size_t)row * 256 + ch];
        lc[q] = LC[((row >> 11) * 32 + ((row & 2047) >> 6)) * 256 + ch];
        gg[q] = U[(size_t)row * UW + 1536 + ch];
    }
#pragma unroll
    for (int q = 0; q < 16; ++q) {
        const int pair = pair0 + q, row = pair >> 2, n = pair & 3;
        const float h = lh[q] + la[q] * lc[q];
        const float y = h * gelu_tanh(bf2f(gg[q]));
        const float ss = wave_sum(y * y);
        HD[(size_t)row * DM + (8 + n) * 64 + lane] = f2bf(y * rsqrtf(ss * (1.0f / 64.0f) + EPS) * gn[q & 3]);
    }
}

__device__ __forceinline__ int vt_lane(int fr, int fq, int pitch) { return fr * pitch + ((((fq >> 1) ^ (fr >> 3)) & 1) << 3) + ((fq & 1) << 2); }
__device__ __forceinline__ constexpr int vt_cst(int dt, int kc2, int pitch) { return dt * 16 * pitch + ((((kc2 ^ (2 * dt)) & 6) | (kc2 & ~7)) << 3); }
__device__ void ml_y_item(const Params& p, int l, int bh, int ck, LAS unsigned char* lds) {
    const int tid = opaque_tid(), lane = tid & 63, w = __builtin_amdgcn_readfirstlane(tid >> 6), fr = lane & 15, fq = lane >> 4;
    const int b = bh >> 2, hh = bh & 3;
    LAS bf16_t* Ql = (LAS bf16_t*)lds;
    LAS bf16_t* Kl = (LAS bf16_t*)(lds + 9216);
    LAS bf16_t* Vt = (LAS bf16_t*)(lds + 18432);
    LAS bf16_t* Ct = (LAS bf16_t*)(lds + 27648);
    LAS bf16_t* Wl = (LAS bf16_t*)(lds + 39168);
    LAS float* as_ = (LAS float*)(lds + 57600);
    LAS float* bs_ = as_ + 64;
    LAS float* Ms_ = bs_ + 64;
    LAS float* ssl = Ms_ + 64;
    const bf16_t* U = (const bf16_t*)(ws_of(p) + WS_U);
    const float* GT = (const float*)(ws_of(p) + WS_GATES);
    const int rowbase = b * SEQ + ck * 64;
    const float mprev = ((const float*)(ws_of(p) + WS_MLMP))[bh * 32 + ck];
    if (tid < 64) {
        const float ig = GT[(size_t)(rowbase + lane) * 32 + 24 + hh] + in_of(p, 20)[l * 4 + hh];
        const float fp = GT[(size_t)(rowbase + lane) * 32 + 28 + hh] + in_of(p, 21)[l * 4 + hh];
        float a = logsigmoidf_(fp);
#pragma unroll
        for (int o = 1; o < 64; o <<= 1) { const float t = __shfl_up(a, o); if (lane >= o) a += t; }
        const float bb = ig - a;
        float pm = bb;
#pragma unroll
        for (int o = 1; o < 64; o <<= 1) { const float t = __shfl_up(pm, o); if (lane >= o) pm = fmaxf(pm, t); }
        as_[lane] = a; bs_[lane] = bb; Ms_[lane] = fmaxf(mprev, pm);
        Ct[64 * 72 + lane] = f2bf(((const float*)(ws_of(p) + WS_MLN))[(size_t)(bh * 32 + ck) * 64 + lane]);
    }
    {
        const int row = tid >> 3, ch = tid & 7;
        const bf16_t* src = U + (size_t)(rowbase + row) * UW + hh * 64 + ch * 8;
        *(LAS u32x4*)(Ql + row * 72 + ch * 8) = *(const u32x4*)(src + 1792);
        *(LAS u32x4*)(Kl + row * 72 + ch * 8) = *(const u32x4*)(src + 2048);
        const u32x4 vv = *(const u32x4*)(src + 2304);
#pragma unroll
        for (int e = 0; e < 4; ++e) {
            Vt[vt_off(ch * 8 + 2 * e, row, 72)] = (bf16_t)(vv[e] & 0xffffu);
            Vt[vt_off(ch * 8 + 2 * e + 1, row, 72)] = (bf16_t)(vv[e] >> 16);
        }
        const float* C = (const float*)(ws_of(p) + WS_MLC) + (size_t)(bh * 32 + ck) * 4096;
#pragma unroll
        for (int rr = 0; rr < 2; ++rr) {
            const int idx = tid + rr * NTHREADS, d = idx >> 4, e4 = (idx & 15) * 4;
            const f32x4 c = *(const f32x4*)(C + d * 64 + e4);
#pragma unroll
            for (int i = 0; i < 4; ++i) Ct[(e4 + i) * 72 + d] = f2bf(c[i]);
        }
        for (int idx = tid; idx < 15 * 72; idx += NTHREADS) Ct[65 * 72 + idx] = 0;
    }
    __syncthreads();
    const int jt = w & 3, hf = w >> 2;
    bf16_t opre[2][4];
#pragma unroll
    for (int i = 0; i < 4; ++i)
#pragma unroll
        for (int ee = 0; ee < 2; ++ee) opre[ee][i] = U[(size_t)(rowbase + 16 * jt + 4 * fq + i) * UW + 2560 + hh * 64 + 16 * (2 * hf + ee) + fr];
    bf16x8 qa[2];
#pragma unroll
    for (int ks = 0; ks < 2; ++ks) qa[ks] = *(const LAS bf16x8*)(Ql + (16 * jt + fr) * 72 + 32 * ks + 8 * fq);
    f32x4 sacc[4];
#pragma unroll
    for (int st = 0; st < 4; ++st) {
        const bf16x8 k0 = *(const LAS bf16x8*)(Kl + (16 * st + fr) * 72 + 8 * fq), k1 = *(const LAS bf16x8*)(Kl + (16 * st + fr) * 72 + 32 + 8 * fq);
        sacc[st] = __builtin_amdgcn_mfma_f32_16x16x32_bf16(qa[0], k0, (f32x4){0.f, 0.f, 0.f, 0.f}, 0, 0, 0);
        sacc[st] = __builtin_amdgcn_mfma_f32_16x16x32_bf16(qa[1], k1, sacc[st], 0, 0, 0);
    }
    float sw[4], Mj[4];
    LAS bf16_t* Ww = Wl + w * (16 * 72);
#pragma unroll
    for (int i = 0; i < 4; ++i) {
        const int j = 16 * jt + 4 * fq + i;
        Mj[i] = Ms_[j];
        float acc = 0.f;
#pragma unroll
        for (int st = 0; st < 4; ++st) {
            const int sidx = 16 * st + fr;
            const float wv = (sidx <= j) ? __expf(bs_[sidx] - Mj[i]) * sacc[st][i] : 0.f;
            acc += wv;
            Ww[(4 * fq + i) * 72 + sidx] = f2bf(wv);
        }
        acc += __shfl_xor(acc, 1); acc += __shfl_xor(acc, 2); acc += __shfl_xor(acc, 4); acc += __shfl_xor(acc, 8);
        sw[i] = acc;
    }
    asm volatile("s_waitcnt lgkmcnt(0)" ::: "memory");
    bf16x8 wa[2];
#pragma unroll
    for (int ks = 0; ks < 2; ++ks) wa[ks] = *(const LAS bf16x8*)(Ww + fr * 72 + 32 * ks + 8 * fq);
    f32x4 acc1[2], acc2[2], accn;
#pragma unroll
    for (int ee = 0; ee < 2; ++ee) {
        const int et = 2 * hf + ee;
        acc1[ee] = (f32x4){0.f, 0.f, 0.f, 0.f}; acc2[ee] = (f32x4){0.f, 0.f, 0.f, 0.f};
#pragma unroll
        for (int ks = 0; ks < 2; ++ks) {
            const bf16x8 cf = *(const LAS bf16x8*)(Ct + (16 * et + fr) * 72 + 32 * ks + 8 * fq);
            const bf16x8 vf = *(const LAS bf16x8*)(Vt + vt_off(16 * et + fr, 32 * ks + 8 * fq, 72));
            acc1[ee] = __builtin_amdgcn_mfma_f32_16x16x32_bf16(qa[ks], cf, acc1[ee], 0, 0, 0);
            acc2[ee] = __builtin_amdgcn_mfma_f32_16x16x32_bf16(wa[ks], vf, acc2[ee], 0, 0, 0);
        }
    }
    accn = (f32x4){0.f, 0.f, 0.f, 0.f};
#pragma unroll
    for (int ks = 0; ks < 2; ++ks) {
        const bf16x8 cf = *(const LAS bf16x8*)(Ct + (64 + fr) * 72 + 32 * ks + 8 * fq);
        accn = __builtin_amdgcn_mfma_f32_16x16x32_bf16(qa[ks], cf, accn, 0, 0, 0);
    }
    float ov[2][4];
#pragma unroll
    for (int i = 0; i < 4; ++i) {
        const int j = 16 * jt + 4 * fq + i;
        const float qn = __shfl(accn[i], lane & 48);
        const float inter = __expf(mprev - Mj[i]);
        const float den = inter * qn + sw[i];
        const float lim = __expf(-(as_[j] + Mj[i]));
        const float inv = 1.0f / fmaxf(fabsf(den), lim);
        float ssp = 0.f;
#pragma unroll
        for (int ee = 0; ee < 2; ++ee) {
            const int e = 16 * (2 * hf + ee) + fr;
            const float hv = (inter * acc1[ee][i] + acc2[ee][i]) * inv;
            const float o = sigmoidf_(bf2f(opre[ee][i])) * hv;
            ov[ee][i] = o; ssp += o * o;
        }
        ssp += __shfl_xor(ssp, 1); ssp += __shfl_xor(ssp, 2); ssp += __shfl_xor(ssp, 4); ssp += __shfl_xor(ssp, 8);
        if (fr == 0) ssl[w * 16 + 4 * fq + i] = ssp;
    }
    __syncthreads();
    {
        bf16_t* HD = (bf16_t*)(ws_of(p) + WS_HEADS);
        const float* hn = in_of(p, 22) + l * 1024 + (12 + hh) * 64;
#pragma unroll
        for (int i = 0; i < 4; ++i) {
            const int j = 16 * jt + 4 * fq + i;
            const float tot = ssl[jt * 16 + 4 * fq + i] + ssl[(jt + 4) * 16 + 4 * fq + i];
            const float rs = rsqrtf(tot * (1.0f / 64.0f) + EPS);
#pragma unroll
            for (int ee = 0; ee < 2; ++ee) {
                const int e = 16 * (2 * hf + ee) + fr;
                HD[(size_t)(rowbase + j) * DM + (12 + hh) * 64 + e] = f2bf(ov[ee][i] * rs * hn[e]);
            }
        }
    }
    __syncthreads();
}

__device__ __forceinline__ bf16x8 pack8(const f32x4 lo, const f32x4 hi) {
    u32x4 r; r.x = cvt_pk_bf16(lo[0], lo[1]); r.y = cvt_pk_bf16(lo[2], lo[3]); r.z = cvt_pk_bf16(hi[0], hi[1]); r.w = cvt_pk_bf16(hi[2], hi[3]);
    return __builtin_bit_cast(bf16x8, r);
}
__device__ __forceinline__ bf16x8 join8(const u32x2 lo, const u32x2 hi) { u32x4 r; r.x = lo.x; r.y = lo.y; r.z = hi.x; r.w = hi.y; return __builtin_bit_cast(bf16x8, r); }
__device__ void nsa_item(const Params& p, int l, int b, int g, int qb, LAS unsigned char* lds, int mode = 0) {
    int tid = opaque_tid(), w = __builtin_amdgcn_readfirstlane(tid >> 6), lane = tid & 63, fr = lane & 15, fq = lane >> 4;
    LAS bf16_t* Kc = (LAS bf16_t*)lds;
    LAS bf16_t* Vc = (LAS bf16_t*)(lds + 18432);
    LAS bf16_t* Pl = (LAS bf16_t*)(lds + 36864);
    LAS float* impl = (LAS float*)(lds + 106496);
    LAS unsigned* selm = (LAS unsigned*)(lds + 114688);
    LAS int* steps = (LAS int*)(lds + 114944);
    const bf16_t* U = (const bf16_t*)(ws_of(p) + WS_U);
    const int bg = b * 2 + g, rowbase = b * SEQ;
    const int head = 4 * g + (w >> 1);
    const float sl2 = exp2f(-(float)(head + 1)) * 1.4426950408889634f;
    const int tw0 = qb * 64 + (w & 1) * 32;
    bf16x8 qf[2][2];
#pragma unroll
    for (int mt = 0; mt < 2; ++mt)
#pragma unroll
        for (int ks = 0; ks < 2; ++ks)
            qf[mt][ks] = *(const bf16x8*)(U + (size_t)(rowbase + tw0 + mt * 16 + fr) * UW + head * 64 + ks * 32 + fq * 8);
    const float* GT = (const float*)(ws_of(p) + WS_GATES);
    float gpre[2][3];
#pragma unroll
    for (int mt = 0; mt < 2; ++mt)
#pragma unroll
        for (int q = 0; q < 3; ++q) gpre[mt][q] = GT[(size_t)(rowbase + tw0 + mt * 16 + fr) * 32 + head * 3 + q];
    f32x4 y[2][4];
    {
        LAS float* impM = (LAS float*)Pl;
        LAS float* impT = impM + 4 * 64 * 33;
        const bf16_t* KC = (const bf16_t*)(ws_of(p) + WS_KC) + (size_t)bg * 128 * 64;
        const bf16_t* VC = KC + (size_t)2048 * 64;
        u32x4 kvr[2], vvr[2];
#pragma unroll
        for (int rr = 0; rr < 2; ++rr) { const int idx = tid + rr * NTHREADS; kvr[rr] = *(const u32x4*)(KC + idx * 8); vvr[rr] = *(const u32x4*)(VC + idx * 8); }
#pragma unroll
        for (int rr = 0; rr < 2; ++rr) {
            const int idx = tid + rr * NTHREADS, key = idx >> 3, ch = idx & 7;
            const u32x4 kv = kvr[rr];
            const u32x4 vv = vvr[rr];
            *(LAS u32x4*)(Kc + key * 72 + ch * 8) = kv;
#pragma unroll
            for (int e = 0; e < 4; ++e) {
                Vc[vt_off(ch * 8 + 2 * e, key, 136)] = (bf16_t)(vv[e] & 0xffffu);
                Vc[vt_off(ch * 8 + 2 * e + 1, key, 136)] = (bf16_t)(vv[e] >> 16);
            }
        }
        __syncthreads();
        const int vl136 = vt_lane(fr, fq, 136);
#pragma unroll
        for (int mt = 0; mt < 2; ++mt) {
            const int t = tw0 + mt * 16 + fr;
            f32x4 s[8];
#pragma unroll
            for (int nt = 0; nt < 8; ++nt) {
                const bf16x8 k0 = *(const LAS bf16x8*)(Kc + (16 * nt + fr) * 72 + fq * 8), k1 = *(const LAS bf16x8*)(Kc + (16 * nt + fr) * 72 + 32 + fq * 8);
                s[nt] = __builtin_amdgcn_mfma_f32_16x16x32_bf16(k0, qf[mt][0], (f32x4){0.f, 0.f, 0.f, 0.f}, 0, 0, 0);
                s[nt] = __builtin_amdgcn_mfma_f32_16x16x32_bf16(k1, qf[mt][1], s[nt], 0, 0, 0);
            }
            float mx = NEGF;
#pragma unroll
            for (int nt = 0; nt < 8; ++nt)
#pragma unroll
                for (int i = 0; i < 4; ++i) {
                    const int n = 16 * nt + 4 * fq + i, cend = 16 * n + 31;
                    const bool valid = (t >= cend) && (n < 127);
                    const float sv = valid ? fmaf(sl2, (float)cend, s[nt][i]) : NEGF;
                    s[nt][i] = sv; mx = fmaxf(mx, sv);
                }
            mx = fq_max(mx);
            const float ms = (mx < -1e29f) ? 0.f : mx;
            float sum = 0.f;
#pragma unroll
            for (int nt = 0; nt < 8; ++nt)
#pragma unroll
                for (int i = 0; i < 4; ++i) { const float pv = __builtin_amdgcn_exp2f(s[nt][i] - ms); s[nt][i] = pv; sum += pv; }
            sum = fq_sum(sum);
            const float inv = sum > 0.f ? 1.0f / sum : 0.f;
            {
                LAS float* mrow_ = impM + ((w >> 1) * 64 + (w & 1) * 32 + mt * 16 + fr) * 33 + fq;
                LAS float* trow_ = impT + ((w >> 1) * 64 + (w & 1) * 32 + mt * 16 + fr) * 33 + fq + 1;
#pragma unroll
                for (int nt = 0; nt < 8; ++nt) {
                    s[nt] = s[nt] * inv;
                    mrow_[4 * nt] = (s[nt][0] + s[nt][1]) + (s[nt][2] + s[nt][3]);
                    trow_[4 * nt] = s[nt][3];
                }
            }
            f32x4 oc[4];
#pragma unroll
            for (int dt = 0; dt < 4; ++dt) oc[dt] = (f32x4){0.f, 0.f, 0.f, 0.f};
#pragma unroll
            for (int ks2 = 0; ks2 < 4; ++ks2) {
                const bf16x8 pb = pack8(s[2 * ks2], s[2 * ks2 + 1]);
#pragma unroll
                for (int dt = 0; dt < 4; ++dt) {
                    const u32x2 lo = *(const LAS u32x2*)(Vc + vl136 + vt_cst(dt, 4 * ks2, 136));
                    const u32x2 hi = *(const LAS u32x2*)(Vc + vl136 + vt_cst(dt, 4 * ks2 + 2, 136));
                    oc[dt] = __builtin_amdgcn_mfma_f32_16x16x32_bf16(join8(lo, hi), pb, oc[dt], 0, 0, 0);
                }
            }
            const float g0 = sigmoidf_(gpre[mt][0]);
#pragma unroll
            for (int dt = 0; dt < 4; ++dt) y[mt][dt] = oc[dt] * g0;
        }
        if (tid < 256) impT[tid * 33] = 0.f;
        __syncthreads();
#pragma unroll 1
        for (int rr = 0; rr < 4; ++rr) {
            const int idx = tid + rr * NTHREADS, tau = idx >> 5, j = idx & 31;
            float mine = 0.f;
#pragma unroll
            for (int hh = 0; hh < 4; ++hh) mine += impM[(hh * 64 + tau) * 33 + j] + impT[(hh * 64 + tau) * 33 + j];
            bool sel;
            if (qb < 16) sel = (j <= qb);
            else {
                const bool forced = (j == 0) || (j == qb) || (j == qb - 1);
                const bool cand = (j >= 1) && (j <= qb - 2);
                int rank = 0;
#pragma unroll
                for (int jp = 1; jp < 30; ++jp) {
                    const float o = __shfl(mine, (lane & 32) + jp);
                    rank += (jp <= qb - 2 && (o > mine || (o == mine && jp < j))) ? 1 : 0;
                }
                sel = forced || (cand && rank < 13);
            }
            const unsigned long long bal = __ballot(sel);
            if ((lane & 31) == 0) selm[tau] = (lane < 32) ? (unsigned)bal : (unsigned)(bal >> 32);
        }
        __syncthreads();
        if (tid < 64) {
            unsigned m = selm[tid], uni = m, all = m;
#pragma unroll
            for (int o = 32; o >= 1; o >>= 1) { uni |= __shfl_xor(uni, o); all &= __shfl_xor(all, o); }
            uni &= (qb >= 31) ? 0xffffffffu : ((2u << qb) - 1u);
            const int nsel = __popc(uni);
            const int kb = tid;
            if (kb <= qb && ((uni >> kb) & 1u)) {
                const int pos = nsel - 1 - __popc(uni & ((1u << kb) - 1u));
                steps[1 + pos] = ((((all >> kb) & 1u) && kb < qb) ? 4096 : 0) | (1 << 8) | kb;
            }
            const int kb0 = (qb - 8 < 0) ? 0 : qb - 8;
            if (kb >= kb0 && kb <= qb) steps[1 + nsel + (qb - kb)] = ((kb > qb - 8 && kb < qb) ? 4096 : 0) | (2 << 8) | kb;
            if (tid == 0) steps[0] = nsel + (qb - kb0 + 1);
        }
        __syncthreads();
    }
    if (mode == 1) { asm volatile("" :: "v"(y[0][0][0]), "v"(y[1][3][3])); __syncthreads(); return; }
    tid = opaque_tid(); w = __builtin_amdgcn_readfirstlane(tid >> 6); lane = tid & 63; fr = lane & 15; fq = lane >> 4;
    unsigned smask[2];
#pragma unroll
    for (int mt = 0; mt < 2; ++mt) smask[mt] = selm[(w & 1) * 32 + mt * 16 + fr];
    const int nsteps = __builtin_amdgcn_readfirstlane(steps[0]);
    const int mystep = steps[1 + (lane < 48 ? lane : 47)];
#define NSA_ST(k) __builtin_amdgcn_readlane(mystep, (k))
    float mrow[2], lrow[2];
    f32x4 oacc[2][4];
#pragma unroll
    for (int mt = 0; mt < 2; ++mt) {
        mrow[mt] = NEGF; lrow[mt] = 0.f;
#pragma unroll
        for (int dt = 0; dt < 4; ++dt) oacc[mt][dt] = (f32x4){0.f, 0.f, 0.f, 0.f};
    }
    const int skey = tid >> 3, sch = tid & 7;
    const int vl72 = vt_lane(fr, fq, 72);
    const int vsw = vt_off(sch * 8, skey, 72);
    bf16x8 kx[4], qx;
    {
        const float sh = bf2f(f2bf(sl2)), slo = sl2 - sh;
        u32x4 t = (u32x4){0u, 0u, 0u, 0u};
        if (fq == 0) t.x = cvt_pk_bf16(sh, slo);
        qx = __builtin_bit_cast(bf16x8, t);
#pragma unroll
        for (int nt = 0; nt < 4; ++nt) {
            u32x4 k = (u32x4){0u, 0u, 0u, 0u};
            const float r = (float)(16 * nt + fr);
            if (fq == 0) k.x = cvt_pk_bf16(r, r);
            kx[nt] = __builtin_bit_cast(bf16x8, k);
        }
    }
    const bf16_t* Ubase = U + (size_t)(rowbase + skey) * UW + g * 64 + sch * 8;
#define NSA_SRC(st_) (Ubase + (size_t)((st_) & 255) * 64 * UW + ((((st_) >> 8) & 15) == 1 ? 768 : 1024))
#define NSA_STAGE(buf_, kr_, vr_) do { \
        *(LAS u32x4*)(Kc + (buf_) * (64 * 72) + skey * 72 + sch * 8) = kr_; \
        LAS bf16_t* _vn = Vc + (buf_) * (64 * 72) + vsw; \
        _Pragma("unroll") for (int e = 0; e < 4; ++e) { _vn[(2 * e) * 72] = (bf16_t)(vr_[e] & 0xffffu); _vn[(2 * e + 1) * 72] = (bf16_t)(vr_[e] >> 16); } } while (0)
    u32x4 kregA, vregA;
    {
        const bf16_t* src = NSA_SRC(NSA_ST(0));
        kregA = *(const u32x4*)src; vregA = *(const u32x4*)(src + 128);
        NSA_STAGE(0, kregA, vregA);
    }
    if (nsteps > 1) { const bf16_t* src = NSA_SRC(NSA_ST(1)); kregA = *(const u32x4*)src; vregA = *(const u32x4*)(src + 128); }
    __syncthreads();
    int curkind = 1;
#define NSA_STEP(si, kX, vX) do { \
        const int st = NSA_ST(si), kind = (st >> 8) & 15, kb = st & 255; \
        const bool nomask = (st & 4096) != 0; \
        LAS bf16_t* Kl = Kc + ((si) & 1) * (64 * 72); \
        LAS bf16_t* Vt = Vc + ((si) & 1) * (64 * 72); \
        if (kind != curkind) { \
            _Pragma("unroll") for (int mt = 0; mt < 2; ++mt) { \
                float lt = lrow[mt]; \
                lt = fq_sum(lt); \
                const float sc = sigmoidf_(gpre[mt][1]) / lt; \
                _Pragma("unroll") for (int dt = 0; dt < 4; ++dt) { y[mt][dt] += oacc[mt][dt] * sc; oacc[mt][dt] = (f32x4){0.f, 0.f, 0.f, 0.f}; } \
                mrow[mt] = NEGF; lrow[mt] = 0.f; \
            } \
            curkind = kind; \
        } \
        const float Bs = sl2 * (float)(kb * 64); \
        int kbi = kb * 64 + 4 * fq; \
        asm volatile("" : "+v"(kbi)); \
        f32x4 s[2][4]; \
        _Pragma("unroll") for (int nt = 0; nt < 4; ++nt) { \
            const bf16x8 k0 = *(const LAS bf16x8*)(Kl + (16 * nt + fr) * 72 + fq * 8), k1 = *(const LAS bf16x8*)(Kl + (16 * nt + fr) * 72 + 32 + fq * 8); \
            _Pragma("unroll") for (int mt = 0; mt < 2; ++mt) { \
                s[mt][nt] = __builtin_amdgcn_mfma_f32_16x16x32_bf16(k0, qf[mt][0], (f32x4){0.f, 0.f, 0.f, 0.f}, 0, 0, 0); \
                s[mt][nt] = __builtin_amdgcn_mfma_f32_16x16x32_bf16(k1, qf[mt][1], s[mt][nt], 0, 0, 0); \
                s[mt][nt] = __builtin_amdgcn_mfma_f32_16x16x32_bf16(kx[nt], qx, s[mt][nt], 0, 0, 0); \
            } \
        } \
        bf16x8 pb[2][2]; \
        _Pragma("unroll") for (int mt = 0; mt < 2; ++mt) { \
            float mx = NEGF; \
            if (nomask) { \
                _Pragma("unroll") for (int nt = 0; nt < 4; ++nt) \
                    _Pragma("unroll") for (int i = 0; i < 4; ++i) mx = fmaxf(mx, s[mt][nt][i]); \
            } else { \
                const int t = tw0 + mt * 16 + fr; \
                const bool rowok = (kind == 1) ? (((smask[mt] >> kb) & 1u) != 0u) : true; \
                _Pragma("unroll") for (int nt = 0; nt < 4; ++nt) \
                    _Pragma("unroll") for (int i = 0; i < 4; ++i) { \
                        const int dist = t - (kbi + 16 * nt + i); \
                        const bool valid = rowok && dist >= 0 && (kind == 1 || dist < 512); \
                        const float sv = valid ? s[mt][nt][i] : NEGF; \
                        s[mt][nt][i] = sv; mx = fmaxf(mx, sv); \
                    } \
            } \
            mx = fq_max(mx) + Bs; \
            const bool grow = __builtin_amdgcn_ballot_w64(mx > mrow[mt] + 8.0f) != 0ull;     \
            if (grow) { \
                const float mn_ = fmaxf(mrow[mt], mx); \
                const float alpha = __builtin_amdgcn_exp2f(mrow[mt] - mn_); \
                mrow[mt] = mn_; lrow[mt] *= alpha; \
                _Pragma("unroll") for (int dt = 0; dt < 4; ++dt) oacc[mt][dt] = oacc[mt][dt] * alpha; \
            } \
            const float mn = mrow[mt]; \
            const float ms = ((mn < -1e29f) ? 0.f : mn) - Bs; \
            float ls = 0.f; \
            _Pragma("unroll") for (int nt = 0; nt < 4; ++nt) \
                _Pragma("unroll") for (int i = 0; i < 4; ++i) { const float pv = __builtin_amdgcn_exp2f(s[mt][nt][i] - ms); s[mt][nt][i] = pv; ls += pv; } \
            lrow[mt] += ls; \
            pb[mt][0] = pack8(s[mt][0], s[mt][1]); pb[mt][1] = pack8(s[mt][2], s[mt][3]); \
        } \
        _Pragma("unroll") for (int ks2 = 0; ks2 < 2; ++ks2) \
            _Pragma("unroll") for (int dt = 0; dt < 4; ++dt) { \
                const u32x2 lo = *(const LAS u32x2*)(Vt + vl72 + vt_cst(dt, 4 * ks2, 72)); \
                const u32x2 hi = *(const LAS u32x2*)(Vt + vl72 + vt_cst(dt, 4 * ks2 + 2, 72)); \
                const bf16x8 va = join8(lo, hi); \
                _Pragma("unroll") for (int mt = 0; mt < 2; ++mt) oacc[mt][dt] = __builtin_amdgcn_mfma_f32_16x16x32_bf16(va, pb[mt][ks2], oacc[mt][dt], 0, 0, 0); \
            } \
        if ((si) + 1 < nsteps) NSA_STAGE(((si) + 1) & 1, kX, vX); \
        if ((si) + 2 < nsteps) { const bf16_t* src = NSA_SRC(NSA_ST((si) + 2)); kX = *(const u32x4*)src; vX = *(const u32x4*)(src + 128); } \
        __syncthreads(); \
    } while (0)
    for (int si = 0; si < nsteps; ++si) {
        NSA_STEP(si, kregA, vregA);
    }
#undef NSA_STEP
#undef NSA_ST
#undef NSA_STAGE
#undef NSA_SRC
    tid = opaque_tid(); lane = tid & 63; fr = lane & 15; fq = lane >> 4;
    {
        const float* hn = in_of(p, 22) + l * 1024 + head * 64;
        bf16_t* HD = (bf16_t*)(ws_of(p) + WS_HEADS);
        f32x4 gnv[4];
#pragma unroll
        for (int dt = 0; dt < 4; ++dt) gnv[dt] = *(const f32x4*)(hn + 16 * dt + 4 * fq);
#pragma unroll
        for (int mt = 0; mt < 2; ++mt) {
            const int t = tw0 + mt * 16 + fr;
            float lt = lrow[mt];
            lt = fq_sum(lt);
            const float sc = sigmoidf_(gpre[mt][2]) / lt;
            float ss = 0.f;
            f32x4 yy[4];
#pragma unroll
            for (int dt = 0; dt < 4; ++dt) { yy[dt] = y[mt][dt] + oacc[mt][dt] * sc; ss += (yy[dt][0] * yy[dt][0] + yy[dt][1] * yy[dt][1]) + (yy[dt][2] * yy[dt][2] + yy[dt][3] * yy[dt][3]); }
            ss = fq_sum(ss);
            const float rs = rsqrtf(ss * (1.0f / 64.0f) + EPS);
#pragma unroll
            for (int dt = 0; dt < 4; ++dt) {
                const f32x4 gn = gnv[dt];
                const f32x4 o = yy[dt] * rs * gn;
                u32x2 pk; pk.x = cvt_pk_bf16(o[0], o[1]); pk.y = cvt_pk_bf16(o[2], o[3]);
                *(u32x2*)(HD + (size_t)(rowbase + t) * DM + head * 64 + 16 * dt + 4 * fq) = pk;
            }
        }
    }
    __syncthreads();
}

#define XB_TMO      128
#define XB_XCNT(j)  (256  + 64 * (j))
#define XB_XSUB(j)  (1280 + 64 * (j))
#define XB_XGEN(j)  (2304 + 64 * (j))
#define XB_TOP      3328
#define XB_TOPGEN   3392
#define XCD_BAR_WORDS 3456
#define XB_SPIN_CAP (1u << 22)
__device__ __forceinline__ unsigned xb_ld(unsigned* p)              { return __hip_atomic_load(p, __ATOMIC_RELAXED, __HIP_MEMORY_SCOPE_AGENT); }
__device__ __forceinline__ unsigned xb_add(unsigned* p, unsigned v) { return __hip_atomic_fetch_add(p, v, __ATOMIC_RELAXED, __HIP_MEMORY_SCOPE_AGENT); }
__device__ __forceinline__ unsigned xb_xcc_id() { return (unsigned)__builtin_amdgcn_s_getreg((3 << 11) | 20) & 0xFu; }
#define XB_SPIN(cond, bar) do { unsigned _sp = 0; while (cond) { __builtin_amdgcn_s_sleep(1); \
    if ((++_sp & 255u) == 0u) { if (xb_ld(&(bar)[XB_TMO])) break; if (_sp > XB_SPIN_CAP) { atomicAdd(&(bar)[XB_TMO], 1u); break; } } } } while (0)
struct XcdBarrier { unsigned* bar; unsigned x; volatile LAS unsigned* st; };
__device__ __forceinline__ XcdBarrier xcd_barrier_post(unsigned* bar, volatile LAS unsigned* st) {
    XcdBarrier b; b.bar = bar; b.x = xb_xcc_id(); b.st = st;
    if (threadIdx.x == 0) (void)xb_add(&bar[XB_XCNT(b.x)], 1u);
    return b;
}
__device__ __forceinline__ void xcd_barrier_complete(unsigned* bar, unsigned x, unsigned& nloc, unsigned& nx) {
    const unsigned G = gridDim.x * gridDim.y * gridDim.z;
    unsigned sum, cnt, mine, sp = 0u;
    for (;;) {
        sum = 0u; cnt = 0u; mine = 0u;
#pragma unroll
        for (unsigned j = 0; j < 16; ++j) { const unsigned c = xb_ld(&bar[XB_XCNT(j)]); sum += c; cnt += (c > 0u) ? 1u : 0u; mine = (j == x) ? c : mine; }
        if (sum == G) break;
        __builtin_amdgcn_s_sleep(1);
        if ((++sp & 255u) == 0u) { if (xb_ld(&bar[XB_TMO])) break; if (sp > XB_SPIN_CAP) { atomicAdd(&bar[XB_TMO], 1u); break; } }
    }
    nloc = mine > 0u ? mine : 1u; nx = cnt > 0u ? cnt : 1u;
}
__device__ __forceinline__ void xcd_barrier(const XcdBarrier& b) {
    asm volatile("s_waitcnt vmcnt(0)" ::: "memory");
    __syncthreads();
    if (threadIdx.x == 0) {
        unsigned* bar = b.bar;
        __builtin_amdgcn_s_waitcnt(0);
        unsigned nloc = b.st[0], nx = b.st[1];
        if (nloc == 0u) { xcd_barrier_complete(bar, b.x, nloc, nx); b.st[0] = nloc; b.st[1] = nx; }
        const unsigned old = xb_add(&bar[XB_XSUB(b.x)], 1u);
        const unsigned gen = old / nloc;
        if (old + 1u == (gen + 1u) * nloc) {
            __builtin_amdgcn_fence(__ATOMIC_RELEASE, "agent");
            asm volatile("s_waitcnt vmcnt(0)" ::: "memory");
            const unsigned og = xb_add(&bar[XB_TOP], 1u);
            const unsigned tg = og / nx;
            if (og + 1u == (tg + 1u) * nx) xb_add(&bar[XB_TOPGEN], 1u);
            else XB_SPIN(xb_ld(&bar[XB_TOPGEN]) == tg, bar);
            __builtin_amdgcn_fence(__ATOMIC_ACQUIRE, "agent");
            xb_add(&bar[XB_XGEN(b.x)], 1u);
            asm volatile("s_waitcnt vmcnt(0)" ::: "memory");
        } else {
            XB_SPIN(xb_ld(&bar[XB_XGEN(b.x)]) == gen, bar);
            __builtin_amdgcn_fence(__ATOMIC_ACQUIRE, "agent");
            asm volatile("s_waitcnt vmcnt(0)" ::: "memory");
        }
    }
    __syncthreads();
}

__global__ void __launch_bounds__(NTHREADS) hymba_fwd(Params p) {
    extern __shared__ __attribute__((aligned(16))) unsigned char lds_raw[];
    LAS unsigned char* lds = (LAS unsigned char*)lds_raw;
    cg::grid_group grid = cg::this_grid();
    volatile LAS unsigned* xbw = (volatile LAS unsigned*)(lds + LDS_BYTES - 16);
    if (threadIdx.x < 4) xbw[threadIdx.x] = 0u;
    __syncthreads();
    XcdBarrier xbar = xcd_barrier_post((unsigned*)(ws_of(p) + WS_BAR), xbw);
    if (p.ph_hi - p.ph_lo > 1) grid.sync();
    for (int ph = p.ph_lo; ph < p.ph_hi; ++ph) {
        int G = gridDim.x, bid = blockIdx.x;
        asm volatile("" : "+s"(G), "+s"(bid));
        const int tpx = opaque_tid();
        if (ph == 0) {
            if (PHEN(0)) prologue(p, lds, bid, G);
            if (REP_SUB == 100) { __syncthreads(); prologue(p, lds, bid, G); }
        } else if (ph == 37) { if (PHEN(10)) {
            const float* ssq = (const float*)(ws_of(p) + WS_SSQ) + (size_t)(12 & 1) * T_ * 16;
            float* outp = out_of(p);
            const f32x4 gn = *(const f32x4*)(in_of(p, 28) + (tpx & 255) * 4);
            for (int it = bid; it < T_ / 8; it += G) {
                f32x4 v[4], pa[4][4];
#pragma unroll
                for (int q = 0; q < 4; ++q) {
                    const int row = it * 8 + q * 2 + (tpx >> 8);
                    v[q] = *(const f32x4*)(outp + (size_t)row * DM + (tpx & 255) * 4);
#pragma unroll
                    for (int k = 0; k < 4; ++k) pa[q][k] = *(const f32x4*)(ssq + (size_t)row * 16 + 4 * k);
                }
#pragma unroll
                for (int q = 0; q < 4; ++q) {
                    const int row = it * 8 + q * 2 + (tpx >> 8);
                    const float sm = (((pa[q][0][0] + pa[q][0][1]) + (pa[q][0][2] + pa[q][0][3])) + ((pa[q][1][0] + pa[q][1][1]) + (pa[q][1][2] + pa[q][1][3]))) + (((pa[q][2][0] + pa[q][2][1]) + (pa[q][2][2] + pa[q][2][3])) + ((pa[q][3][0] + pa[q][3][1]) + (pa[q][3][2] + pa[q][3][3])));
                    const float r = rsqrtf(sm * (1.0f / DM) + EPS);
                    *(f32x4*)(outp + (size_t)row * DM + (tpx & 255) * 4) = v[q] * r * gn;
                }
            } }
        } else {
            const int l = (ph - 1) / 9, sub = (ph - 1) % 9;
            unsigned char* wl = ws_of(p) + WS_W + (size_t)l * LAYER_W;
            float* ssq = (float*)(ws_of(p) + WS_SSQ);
            bf16_t* HB = (bf16_t*)(ws_of(p) + WS_HB);
            bf16_t* UB = (bf16_t*)(ws_of(p) + WS_U);
            if (PHEN(1) && (sub == 0 || sub == 7)) {
                const bool second = sub == 7;
                pg8::Gemm g{HB, (const bf16_t*)(wl + (second ? LO_W13B : LO_W13A)), T_, NUP, DM, DM, DM};
                pg8::StaticOrder S; S.init(T_, NUP, G, bid);
                EpiSwiGLU E{UB, ssq + (size_t)((3 * l + (second ? 2 : 0)) & 1) * T_ * 16};
                pg8::gemm_phase(lds, g, S, E);
                if (REP_SUB == 0) { __syncthreads(); pg8::gemm_phase(lds, g, S, E); }
            } else if (PHEN(2) && (sub == 1 || sub == 8 || sub == 6)) {
                const bool wout = sub == 6, second = sub == 8;
                pg8::Gemm g;
                if (wout) g = pg8::Gemm{(const bf16_t*)(ws_of(p) + WS_HEADS), (const bf16_t*)(wl + LO_WOUT), T_, DM, DM, DM, DM};
                else g = pg8::Gemm{UB, (const bf16_t*)(wl + (second ? LO_W2B : LO_W2A)), T_, DM, DFF, DFF, DFF};
                pg8::StaticOrder S; S.init(T_, DM, G, bid);
                const float* resid = (l == 0 && sub == 1) ? in_of(p, 0) : out_of(p);
                const int nxt = 3 * l + (sub == 1 ? 1 : (sub == 6 ? 2 : 3));
                EpiResid E{resid, out_of(p), HB, ssq + (size_t)(nxt & 1) * T_ * 16, wout ? 1.0f : 0.5f};
                pg8::gemm_phase(lds, g, S, E);
                if (REP_SUB == 1) { __syncthreads(); EpiResid E2{out_of(p), out_of(p), HB, ssq + (size_t)(nxt & 1) * T_ * 16, 0.0f}; pg8::gemm_phase(lds, g, S, E2); }
            } else if (PHEN(3) && sub == 2) {
                if (bid < 2 && tpx < 256) {
                    const float* cbp = (const float*)(ws_of(p) + WS_CBP) + (size_t)((l * 2 + bid) * 32) * 256 + tpx;
                    float sb = 0.f;
#pragma unroll
                    for (int q = 0; q < 32; ++q) sb += cbp[q * 256];
                    ((float*)(ws_of(p) + WS_CBIAS))[(l * 2 + bid) * 256 + tpx] = sb;
                }
                pg8::Gemm g{HB, (const bf16_t*)(wl + LO_WIN), T_, NINP, DM, DM, DM};
                pg8::StaticOrder S; S.init(T_, NINP, G, bid);
                EpiWin E{UB, (bf16_t*)(ws_of(p) + WS_KCMP), (bf16_t*)(ws_of(p) + WS_VCMP), (float*)(ws_of(p) + WS_GATES), ssq + (size_t)((3 * l + 1) & 1) * T_ * 16};
                pg8::gemm_phase(lds, g, S, E);
                if (REP_SUB == 2) { __syncthreads(); pg8::gemm_phase(lds, g, S, E); }
            } else if (sub == 3) {
                const int ngemm = 64;
                for (int rep = 0; rep < (REP_SUB == 3 ? 2 : 1); ++rep) {
                const int cls = rep == 0 ? 7 : REP_CLASS;
                if (rep) __syncthreads();
                if (G > ngemm) {
                    if (bid < ngemm) { if (PHEN(4) && (cls & 1)) {
                        const int kp = bid >> 4, kv = (bid >> 3) & 1;
                        pg8::Gemm g{(const bf16_t*)(ws_of(p) + (kv ? WS_VCMP : WS_KCMP)) + kp * 512, (const bf16_t*)(wl + (kv ? LO_CW1V : LO_CW1K)) + kp * 512, 2048, 256, 512, 1024, 2048};
                        pg8::SingleUnit S{bid & 7};
                        EpiCmp E{(float*)(ws_of(p) + WS_HID) + (size_t)(kp * 2 + kv) * 2048 * 256};
                        pg8::gemm_phase(lds, g, S, E); }
                    }
                    if (PHEN(5)) {
                        const bool gb = bid < ngemm;
                        const int i0 = gb ? 1728 + bid : bid - ngemm, i1 = gb ? 2048 : 1728, st = gb ? ngemm : G - ngemm;
                        for (int it = i0; it < i1; it += st) {
                            if (it < 1024) { if (cls & 2) lru_x_item(p, l, it >> 7, (it >> 5) & 3, it & 31, lds); }
                            else if (cls & 4) ml_x_item(p, l, (it - 1024) >> 5, it & 31, lds);
                        }
                    }
                }
                }
            } else if (PHEN(6) && sub == 4) {
                phase_m2(p, l, 7, lds, bid, G);
                if (REP_SUB == 4) { __syncthreads(); phase_m2(p, l, REP_CLASS, lds, bid, G); }
            } else if (sub == 5) {
                for (int rep = 0; rep < (REP_SUB == 5 ? 2 : 1); ++rep) {
                const int cls = rep == 0 ? 7 : REP_CLASS;
                if (rep) __syncthreads();
                for (int it = bid; it < 512 + 1024 + 512; it += G) {
                    if (it < 512) { if (PHEN(7) && (cls & 1)) {
                        const int qb = it < 256 ? 31 - (it >> 4) : ((it - 256) >> 4), bg = it & 15;
                        nsa_item(p, l, bg >> 1, bg & 1, qb, lds, (rep == 1 && REP_CLASS == 9) ? 1 : 0); }
                    } else if (it < 1536) {
                        if (PHEN(8) && (cls & 2)) ml_y_item(p, l, (it - 512) >> 5, (it - 512) & 31, lds);
                    } else {
                        if (PHEN(9) && (cls & 4)) lru_y_item(p, l, it - 1536);
                    }
                }
                }
            }
        }
        if (ph + 1 < p.ph_hi) {
            xcd_barrier(xbar);
            if (REP_SUB == 200) xcd_barrier(xbar);
        }
    }
}

extern "C" void kernel_launch(void* const* d_in, const int* in_sizes, int n_in, void* d_out, int out_size, void* d_ws, size_t ws_size, hipStream_t stream) {
    static int grid = 0;
    if (grid == 0) {
        if (n_in != 29 || out_size != T_ * DM || ws_size < WS_END) { fprintf(stderr, "kernel_launch: unexpected shapes (n_in %d out %d ws %zu need %zu)\n", n_in, out_size, ws_size, (size_t)WS_END); grid = -1; return; }
        int dev = 0, cus = 0, per_cu = 0;
        hipGetDevice(&dev);
        hipDeviceGetAttribute(&cus, hipDeviceAttributeMultiprocessorCount, dev);
        hipFuncSetAttribute((const void*)hymba_fwd, hipFuncAttributeMaxDynamicSharedMemorySize, LDS_BYTES);
        hipOccupancyMaxActiveBlocksPerMultiprocessor(&per_cu, (const void*)hymba_fwd, NTHREADS, LDS_BYTES);
        if (per_cu < 1) { fprintf(stderr, "kernel_launch: occupancy query says %d blocks per CU\n", per_cu); per_cu = 1; }
        (void)hipGetLastError();
        grid = cus;
    }
    if (grid < 0) return;
    Params p{};
    for (int i = 0; i < 29; ++i) p.in[i] = (const float*)d_in[i];
    p.out = (float*)d_out; p.ws = (unsigned char*)d_ws;
#if ONE_LAUNCH
    (void)hipMemsetAsync((unsigned char*)d_ws + WS_BAR, 0, 16384, stream);
    p.ph_lo = 0; p.ph_hi = 38;
    void* args[] = {&p};
    hipError_t e = hipLaunchCooperativeKernel((const void*)hymba_fwd, dim3(grid), dim3(NTHREADS), args, LDS_BYTES, stream);
    if (e != hipSuccess) fprintf(stderr, "cooperative launch failed: %s (grid %d)\n", hipGetErrorString(e), grid);
#else
    for (int ph = 0; ph < 38; ++ph) {
        p.ph_lo = ph; p.ph_hi = ph + 1;
        hipLaunchKernelGGL(hymba_fwd, dim3(grid), dim3(NTHREADS), LDS_BYTES, stream, p);
    }
#endif
}
```

```cpp
#include <hip/hip_runtime.h>
#include <hip/hip_cooperative_groups.h>
#include <cstdio>
namespace cg = cooperative_groups;

#define LAS __attribute__((address_space(3)))
typedef unsigned short bf16_t;
typedef short bf16x8 __attribute__((ext_vector_type(8)));
typedef float f32x4 __attribute__((ext_vector_type(4)));
typedef float f32x2 __attribute__((ext_vector_type(2)));
typedef unsigned u32x4 __attribute__((ext_vector_type(4)));
typedef unsigned u32x2 __attribute__((ext_vector_type(2)));

#ifndef ONE_LAUNCH
#define ONE_LAUNCH 1
#endif
#ifndef PHMASK
#define PHMASK 0xFFFF
#endif
#define PHEN(k) ((PHMASK >> (k)) & 1)
#ifndef REP_SUB
#define REP_SUB -1
#endif
#ifndef REP_CLASS
#define REP_CLASS 7
#endif

constexpr int T_ = 16384, SEQ = 2048, DM = 1024, DFF = 2816, NUP = 5632, NINP = 3072, UW = 2816, DIN = 2848;
constexpr float EPS = 1e-6f;
constexpr float NEGF = -1e30f;
constexpr int NTHREADS = 512;
constexpr int LDS_BYTES = 147456;

constexpr size_t SZ_W13T = (size_t)NUP * DM * 2, SZ_W2T = (size_t)DM * DFF * 2, SZ_WINT = (size_t)NINP * DM * 2, SZ_WOUTT = (size_t)DM * DM * 2, SZ_CW1T = (size_t)256 * 2048 * 2;
constexpr size_t LO_W13A = 0, LO_W2A = LO_W13A + SZ_W13T, LO_W13B = LO_W2A + SZ_W2T, LO_W2B = LO_W13B + SZ_W13T, LO_WIN = LO_W2B + SZ_W2T, LO_WOUT = LO_WIN + SZ_WINT,
                 LO_CW1K = LO_WOUT + SZ_WOUTT, LO_CW1V = LO_CW1K + SZ_CW1T, LAYER_W = LO_CW1V + SZ_CW1T;
constexpr size_t WS_W = 0;
constexpr size_t WS_HB = WS_W + 4 * LAYER_W;
constexpr size_t WS_U = WS_HB + (size_t)T_ * DM * 2;
constexpr size_t WS_HEADS = WS_U + (size_t)T_ * UW * 2;
constexpr size_t SZ_CMPIN = (size_t)16 * 2048 * 64 * 2 + 4096;
constexpr size_t WS_KCMP = WS_HEADS + (size_t)T_ * DM * 2;
constexpr size_t WS_VCMP = WS_KCMP + SZ_CMPIN;
constexpr size_t WS_HID = WS_VCMP + SZ_CMPIN;
constexpr size_t WS_KC = WS_HID + (size_t)4 * 2 * 2048 * 256 * 4;
constexpr size_t WS_GATES = WS_KC + (size_t)2 * 2048 * 64 * 2;
constexpr size_t WS_SSQ = WS_GATES + (size_t)T_ * 32 * 4;
constexpr size_t WS_CBIAS = WS_SSQ + (size_t)2 * T_ * 16 * 4;
constexpr size_t WS_LRUH = WS_CBIAS + 8192;
constexpr size_t WS_LRUA = WS_LRUH + (size_t)T_ * 256 * 4;
constexpr size_t WS_LRUC = WS_LRUA + (size_t)T_ * 256 * 4;
constexpr size_t WS_MLC = WS_LRUC + (size_t)8 * 32 * 256 * 4;
constexpr size_t WS_MLN = WS_MLC + (size_t)1024 * 4096 * 4;
constexpr size_t WS_MLMU = WS_MLN + (size_t)1024 * 64 * 4;
constexpr size_t WS_MLAT = WS_MLMU + 4096;
constexpr size_t WS_MLMP = WS_MLAT + 4096;
constexpr size_t WS_CBP = WS_MLMP + 4096;
constexpr size_t WS_LRUWT = WS_CBP + 262144;
constexpr size_t WS_BAR = WS_LRUWT + 262144;
constexpr size_t WS_END = WS_BAR + 16384;
static_assert(WS_END <= 425365632ull, "workspace too large");
static_assert(LAYER_W % 256 == 0 && WS_HB % 256 == 0 && WS_U % 256 == 0 && WS_KCMP % 256 == 0 && WS_VCMP % 256 == 0 && WS_HID % 256 == 0, "align");

struct Params {
    const float* in[29];
    float* out;
    unsigned char* ws;
    int ph_lo, ph_hi;
};
static_assert(sizeof(Params) == 256, "Params has padding");
#define GAS __attribute__((address_space(1)))
__device__ __forceinline__ unsigned char* ws_of(const Params& p) { unsigned long long w = (unsigned long long)p.ws; asm volatile("" : "+s"(w)); return (unsigned char*)(GAS unsigned char*)w; }
__device__ __forceinline__ float* out_of(const Params& p) { unsigned long long w = (unsigned long long)p.out; asm volatile("" : "+s"(w)); return (float*)(GAS float*)w; }
__device__ __forceinline__ const float* in_of(const Params& p, int i) { unsigned long long w = (unsigned long long)p.in[i]; asm volatile("" : "+s"(w)); return (const float*)(GAS const float*)w; }
__device__ __forceinline__ unsigned cvt_pk_bf16(float lo, float hi) { unsigned r; asm volatile("v_cvt_pk_bf16_f32 %0, %1, %2" : "=v"(r) : "v"(lo), "v"(hi)); return r; }
__device__ __forceinline__ bf16_t f2bf(float f) { return (bf16_t)(cvt_pk_bf16(f, 0.f) & 0xffffu); }
__device__ __forceinline__ float bf2f(bf16_t b) { return __uint_as_float(((unsigned)b) << 16); }
__device__ __forceinline__ float sigmoidf_(float x) { return __builtin_amdgcn_rcpf(1.0f + __expf(-x)); }
__device__ __forceinline__ int opaque_tid() { int x = threadIdx.x; asm volatile("" : "+v"(x)); return x; }
__device__ __forceinline__ float row_rstd(const float* part, int row) {
    const f32x4 a = *(const f32x4*)(part + (size_t)row * 16), b = *(const f32x4*)(part + (size_t)row * 16 + 4), c = *(const f32x4*)(part + (size_t)row * 16 + 8), d = *(const f32x4*)(part + (size_t)row * 16 + 12);
    const float s = (((a[0] + a[1]) + (a[2] + a[3])) + ((b[0] + b[1]) + (b[2] + b[3]))) + (((c[0] + c[1]) + (c[2] + c[3])) + ((d[0] + d[1]) + (d[2] + d[3])));
    return rsqrtf(s * (1.0f / DM) + EPS);
}
__device__ __forceinline__ float fq_max(float x) {
    auto a = __builtin_amdgcn_permlane16_swap(__float_as_uint(x), __float_as_uint(x), false, false);
    const float m = fmaxf(__uint_as_float(a[0]), __uint_as_float(a[1]));
    auto b = __builtin_amdgcn_permlane32_swap(__float_as_uint(m), __float_as_uint(m), false, false);
    return fmaxf(__uint_as_float(b[0]), __uint_as_float(b[1]));
}
__device__ __forceinline__ float fq_sum(float x) {
    auto a = __builtin_amdgcn_permlane16_swap(__float_as_uint(x), __float_as_uint(x), false, false);
    const float m = __uint_as_float(a[0]) + __uint_as_float(a[1]);
    auto b = __builtin_amdgcn_permlane32_swap(__float_as_uint(m), __float_as_uint(m), false, false);
    return __uint_as_float(b[0]) + __uint_as_float(b[1]);
}
__device__ __forceinline__ float wave_sum(float v) {
#pragma unroll
    for (int o = 32; o >= 1; o >>= 1) v += __shfl_xor(v, o);
    return v;
}
__device__ __forceinline__ float wave_max(float v) {
#pragma unroll
    for (int o = 32; o >= 1; o >>= 1) v = fmaxf(v, __shfl_xor(v, o));
    return v;
}

namespace pg8 {
constexpr int BM = 256, BK = 64, HALF = 128, HTB = HALF * BK * 2, STAGE_BYTES = 8 * HTB, NXCD = 8, WGM = 8;
__device__ __forceinline__ int lds_byte(int r, int c) { const int st = (r >> 4) * 2 + (c >> 5), rr = r & 15, cc = c & 31, ob = rr * 64 + cc * 2; return st * 1024 + (ob ^ (((ob >> 9) & 1) << 5)); }
__device__ __forceinline__ void stage_rc(int b, int& R, int& C) { const int st = b / 1024, sb = b % 1024, swz = sb ^ (((sb >> 9) & 1) << 5); R = (st >> 1) * 16 + swz / 64; C = (st & 1) * 32 + (swz % 64) / 2; }

struct Unit { int pm, pn; };
struct Gemm { const bf16_t* A; const bf16_t* Bt; int M, N, K, lda, ldb; };

struct StaticOrder {
    int nM, nN, nwg, G, c;
    __device__ void init(int M, int N, int G_, int c_) { nM = M / BM; nN = N / BM; nwg = nM * nN; G = G_; c = c_; }
    __device__ bool next(int i, Unit& u) const {
        const long L = (long)i * G + c; if (L >= nwg) return false;
        int wgid = (int)L; { const int q = nwg / NXCD, r = nwg % NXCD, xcd = wgid % NXCD, off = wgid / NXCD; wgid = (xcd < r ? xcd * (q + 1) : r * (q + 1) + (xcd - r) * q) + off; }
        const int nig = WGM * nN, gid = wgid / nig, fm = gid * WGM, gsz = (nM - fm) < WGM ? (nM - fm) : WGM;
        u.pm = fm + ((wgid % nig) % gsz); u.pn = (wgid % nig) / gsz; return true;
    }
};
struct SingleUnit {
    int pm;
    __device__ bool next(int i, Unit& u) const { if (i != 0 || pm < 0) return false; u.pm = pm; u.pn = 0; return true; }
};

template <class Epi, class Sched>
__device__ __forceinline__ void gemm_phase(LAS unsigned char* lds, const Gemm g, const Sched& S, const Epi& E) {
    const int tid = opaque_tid(), wid = __builtin_amdgcn_readfirstlane(tid >> 6), lane = tid & 63, wr = wid >> 2, wc = wid & 3, fr = lane & 15, fq = lane >> 4;
    const int K = g.K, nt = K / BK;
    unsigned voffA[2], voffB[2];
#pragma unroll
    for (int i = 0; i < 2; ++i) { int R, C; stage_rc(tid * 16 + i * 8192, R, C);
        voffA[i] = (unsigned)(R * g.lda + C) * 2u; voffB[i] = (unsigned)(R * g.ldb + C) * 2u; }
    const size_t kstep = (size_t)(BK * 2);
    const size_t hstepA = (size_t)HALF * g.lda * 2, hstepB = (size_t)HALF * g.ldb * 2;
    const size_t tstepA = 2 * hstepA, tstepB = 2 * hstepB;
    const unsigned ldsw = (unsigned)wid * 1024u;
    const int aoff = lds_byte(wr * 64 + fr, fq * 8), boff = lds_byte(wc * 32 + fr, fq * 8);
#define PG8_SA(b, h) (((b) * 2 + (h)) * HTB)
#define PG8_SB(b, h) ((4 + (b) * 2 + (h)) * HTB)
#define PG8_STAGE(bufoff, gbase, voff) do { _Pragma("unroll") for (int _i = 0; _i < 2; ++_i) \
        __builtin_amdgcn_global_load_lds((const unsigned*)((const char*)(gbase) + (voff)[_i]), (LAS unsigned*)(lds + (bufoff) + ldsw + _i * 8192), 16, 0, 0); } while (0)
#define PG8_LDA(dst, b, h) do { _Pragma("unroll") for (int m = 0; m < 4; ++m) _Pragma("unroll") for (int k = 0; k < 2; ++k) dst[m][k] = *(const LAS bf16x8*)(lds + PG8_SA(b, h) + aoff + m * 2048 + k * 1024); } while (0)
#define PG8_LDB(dst, b, h) do { _Pragma("unroll") for (int n = 0; n < 2; ++n) _Pragma("unroll") for (int k = 0; k < 2; ++k) dst[n][k] = *(const LAS bf16x8*)(lds + PG8_SB(b, h) + boff + n * 2048 + k * 1024); } while (0)
#define PG8_MMA(ai, bj, At, Bt) do { __builtin_amdgcn_s_setprio(1); _Pragma("unroll") for (int m = 0; m < 4; ++m) _Pragma("unroll") for (int n = 0; n < 2; ++n) _Pragma("unroll") for (int k = 0; k < 2; ++k) \
        acc[ai][bj][m][n] = __builtin_amdgcn_mfma_f32_16x16x32_bf16(Bt[n][k], At[m][k], acc[ai][bj][m][n], 0, 0, 0); __builtin_amdgcn_s_setprio(0); } while (0)
#define PG8_WAIT_V(n) asm volatile("s_waitcnt vmcnt(" #n ")" ::: "memory")
#define PG8_WAIT_L(n) asm volatile("s_waitcnt lgkmcnt(" #n ")" ::: "memory")
#define PG8_BAR __builtin_amdgcn_s_barrier()
#define PG8_SCHED __builtin_amdgcn_sched_barrier(0)
    Unit cur, nxt; int ui = 0;
    if (!S.next(0, cur)) return;
    f32x4 acc[2][2][4][2];
#pragma unroll
    for (int a = 0; a < 2; ++a)
#pragma unroll
        for (int b = 0; b < 2; ++b)
#pragma unroll
            for (int m = 0; m < 4; ++m)
#pragma unroll
                for (int n = 0; n < 2; ++n) acc[a][b][m][n] = (f32x4){0.f, 0.f, 0.f, 0.f};
    bf16x8 At[4][2], B0[2][2], B1[2][2];
    const char* cA = (const char*)g.A + (size_t)cur.pm * tstepA; const char* cB = (const char*)g.Bt + (size_t)cur.pn * tstepB;
    PG8_STAGE(PG8_SB(0, 0), cB, voffB); PG8_STAGE(PG8_SA(0, 0), cA, voffA); PG8_STAGE(PG8_SB(0, 1), cB + hstepB, voffB); PG8_STAGE(PG8_SA(0, 1), cA + hstepA, voffA);
    if (wr == 1) PG8_BAR;
    PG8_WAIT_V(4); PG8_BAR;
    PG8_STAGE(PG8_SB(1, 0), cB + kstep, voffB); PG8_STAGE(PG8_SA(1, 0), cA + kstep, voffA); PG8_STAGE(PG8_SB(1, 1), cB + hstepB + kstep, voffB);
    PG8_WAIT_V(6); PG8_BAR;
    for (;;) {
        const bool has_next = S.next(ui + 1, nxt);
        const char* nA = has_next ? (const char*)g.A + (size_t)nxt.pm * tstepA : cA; const char* nB = has_next ? (const char*)g.Bt + (size_t)nxt.pn * tstepB : cB;
        for (int t = 0; t < nt; t += 2) {
            const bool last = (t == nt - 2);
            const char* a1 = cA + (size_t)(t + 1) * kstep;
            const char* a2 = last ? nA : cA + (size_t)(t + 2) * kstep; const char* b2 = last ? nB : cB + (size_t)(t + 2) * kstep;
            const char* a3 = a2 + kstep; const char* b3 = b2 + kstep;
            PG8_LDB(B0, 0, 0); PG8_SCHED; PG8_LDA(At, 0, 0); PG8_STAGE(PG8_SA(1, 1), a1 + hstepA, voffA);
            PG8_WAIT_L(8); PG8_BAR; PG8_WAIT_L(0); PG8_MMA(0, 0, At, B0); PG8_BAR; PG8_SCHED;
            PG8_LDB(B1, 0, 1); PG8_STAGE(PG8_SB(0, 0), b2, voffB);
            PG8_BAR; PG8_WAIT_L(0); PG8_MMA(0, 1, At, B1); PG8_BAR;
            PG8_LDA(At, 0, 1); PG8_STAGE(PG8_SA(0, 0), a2, voffA);
            PG8_BAR; PG8_WAIT_L(0); PG8_MMA(1, 0, At, B0); PG8_BAR; PG8_SCHED;
            PG8_STAGE(PG8_SB(0, 1), b2 + hstepB, voffB);
            PG8_WAIT_V(6); PG8_BAR; PG8_MMA(1, 1, At, B1); PG8_BAR;
            PG8_LDB(B0, 1, 0); PG8_SCHED; PG8_LDA(At, 1, 0); PG8_STAGE(PG8_SA(0, 1), a2 + hstepA, voffA);
            PG8_WAIT_L(8); PG8_BAR; PG8_WAIT_L(0); PG8_MMA(0, 0, At, B0); PG8_BAR; PG8_SCHED;
            PG8_LDB(B1, 1, 1); PG8_STAGE(PG8_SB(1, 0), b3, voffB);
            PG8_BAR; PG8_WAIT_L(0); PG8_MMA(0, 1, At, B1); PG8_BAR;
            PG8_LDA(At, 1, 1); PG8_STAGE(PG8_SA(1, 0), a3, voffA);
            PG8_BAR; PG8_WAIT_L(0); PG8_MMA(1, 0, At, B0); PG8_BAR; PG8_SCHED;
            PG8_STAGE(PG8_SB(1, 1), b3 + hstepB, voffB);
            PG8_WAIT_V(6); PG8_BAR; PG8_MMA(1, 1, At, B1); PG8_BAR;
        }
        E(acc, cur, wr, wc, fr, fq);
        if (!has_next) break;
#pragma unroll
        for (int a = 0; a < 2; ++a)
#pragma unroll
            for (int b = 0; b < 2; ++b)
#pragma unroll
                for (int m = 0; m < 4; ++m)
#pragma unroll
                    for (int n = 0; n < 2; ++n) acc[a][b][m][n] = (f32x4){0.f, 0.f, 0.f, 0.f};
        cur = nxt; cA = nA; cB = nB; ++ui;
    }
    PG8_WAIT_V(0);
    if (wr == 0) PG8_BAR;
    PG8_BAR;
#undef PG8_SA
#undef PG8_SB
#undef PG8_STAGE
#undef PG8_LDA
#undef PG8_LDB
#undef PG8_MMA
#undef PG8_WAIT_V
#undef PG8_WAIT_L
#undef PG8_BAR
#undef PG8_SCHED
}
}

typedef __attribute__((address_space(1))) float gf32;
typedef __attribute__((address_space(1))) const float gcf32;
typedef __attribute__((address_space(1))) bf16_t gbf16;
typedef __attribute__((address_space(1))) f32x4 gf32x4;
typedef __attribute__((address_space(1))) const f32x4 gcf32x4;
typedef __attribute__((address_space(1))) u32x2 gu32x2;
__device__ __forceinline__ void rows_rstd(const float* ssq, int row0, int fq, float (&r8)[2][4]) {
    f32x4 pv[2][4];
#pragma unroll
    for (int ai = 0; ai < 2; ++ai)
#pragma unroll
        for (int m = 0; m < 4; ++m) pv[ai][m] = *(gcf32x4*)(ssq + (size_t)(row0 + ai * 128 + m * 16) * 16 + 4 * fq);
#pragma unroll
    for (int ai = 0; ai < 2; ++ai)
#pragma unroll
        for (int m = 0; m < 4; ++m) {
            float sm = (pv[ai][m][0] + pv[ai][m][1]) + (pv[ai][m][2] + pv[ai][m][3]);
            sm = fq_sum(sm);
            r8[ai][m] = rsqrtf(sm * (1.0f / DM) + EPS);
        }
}
struct EpiSwiGLU {
    bf16_t* act; const float* ssq;
    __device__ __forceinline__ void operator()(const f32x4 (&acc)[2][2][4][2], const pg8::Unit& u, int wr, int wc, int fr, int fq) const {
        const int row0 = u.pm * 256 + wr * 64 + fr, col0 = u.pn * 128 + wc * 32 + 8 * fq;
        float r8[2][4];
        rows_rstd(ssq, row0, fq, r8);
#pragma unroll
        for (int ai = 0; ai < 2; ++ai)
#pragma unroll
            for (int m = 0; m < 4; ++m) {
                const int row = row0 + ai * 128 + m * 16;
                const float r = r8[ai][m];
                float o[8];
#pragma unroll
                for (int n = 0; n < 2; ++n) {
                    const f32x4 a1 = acc[ai][0][m][n] * r, a3 = acc[ai][1][m][n] * r;
#pragma unroll
                    for (int j = 0; j < 4; ++j) o[4 * n + j] = a1[j] * __builtin_amdgcn_rcpf(1.0f + __expf(-a1[j])) * a3[j];
                }
                u32x4 w; w.x = cvt_pk_bf16(o[0], o[1]); w.y = cvt_pk_bf16(o[2], o[3]); w.z = cvt_pk_bf16(o[4], o[5]); w.w = cvt_pk_bf16(o[6], o[7]);
                *(GAS u32x4*)(act + (size_t)row * DFF + col0) = w;
            }
    }
};
struct EpiResid {
    const float* resid; float* out; bf16_t* hb; float* ssq_next; float scale;
    __device__ __forceinline__ void load2(f32x4 (&rs)[2][2][2], int row0, int col0, int ai, int mp) const {
#pragma unroll
        for (int mm = 0; mm < 2; ++mm)
#pragma unroll
            for (int bj = 0; bj < 2; ++bj)
#pragma unroll
                for (int n = 0; n < 2; ++n)
                    rs[mm][bj][n] = *(gcf32x4*)(resid + (size_t)(row0 + ai * 128 + (2 * mp + mm) * 16) * DM + col0 + bj * 128 + n * 4);
    }
    __device__ __forceinline__ void operator()(const f32x4 (&acc)[2][2][4][2], const pg8::Unit& u, int wr, int wc, int fr, int fq) const {
        const int row0 = u.pm * 256 + wr * 64 + fr, col0 = u.pn * 256 + wc * 32 + 8 * fq;
        f32x4 rsA[2][2][2], rsB[2][2][2];
        load2(rsA, row0, col0, 0, 0);
#pragma unroll
        for (int bt = 0; bt < 4; ++bt) {
            const int ai = bt >> 1, mp = bt & 1;
            if (bt < 3) { if (bt & 1) load2(rsA, row0, col0, (bt + 1) >> 1, (bt + 1) & 1); else load2(rsB, row0, col0, (bt + 1) >> 1, (bt + 1) & 1); }
#pragma unroll
            for (int mm = 0; mm < 2; ++mm) {
                const int m = 2 * mp + mm, row = row0 + ai * 128 + m * 16;
                const size_t off = (size_t)row * DM + col0;
                float ss = 0.f;
#pragma unroll
                for (int bj = 0; bj < 2; ++bj) {
                    const f32x4 r0 = (bt & 1) ? rsB[mm][bj][0] : rsA[mm][bj][0], r1 = (bt & 1) ? rsB[mm][bj][1] : rsA[mm][bj][1];
                    const f32x4 v0 = r0 + acc[ai][bj][m][0] * scale, v1 = r1 + acc[ai][bj][m][1] * scale;
                    *(gf32x4*)(out + off + bj * 128) = v0;
                    *(gf32x4*)(out + off + bj * 128 + 4) = v1;
                    u32x4 w; w.x = cvt_pk_bf16(v0[0], v0[1]); w.y = cvt_pk_bf16(v0[2], v0[3]); w.z = cvt_pk_bf16(v1[0], v1[1]); w.w = cvt_pk_bf16(v1[2], v1[3]);
                    *(GAS u32x4*)(hb + off + bj * 128) = w;
                    ss += ((v0[0] * v0[0] + v0[1] * v0[1]) + (v0[2] * v0[2] + v0[3] * v0[3])) + ((v1[0] * v1[0] + v1[1] * v1[1]) + (v1[2] * v1[2] + v1[3] * v1[3]));
                }
                ss = fq_sum(ss);
                if (fq == 0) *(gf32*)(ssq_next + (size_t)row * 16 + u.pn * 4 + wc) = ss;
            }
            asm volatile("" ::: "memory");
        }
    }
};
struct EpiWin {
    bf16_t* U; bf16_t* kcmp; bf16_t* vcmp; float* gates; const float* ssq;
    __device__ __forceinline__ void operator()(const f32x4 (&acc)[2][2][4][2], const pg8::Unit& u, int wr, int wc, int fr, int fq) const {
        const int row0 = u.pm * 256 + wr * 64 + fr;
        float r8[2][4];
        rows_rstd(ssq, row0, fq, r8);
#pragma unroll
        for (int bj = 0; bj < 2; ++bj) {
            const int c0 = u.pn * 256 + bj * 128 + wc * 32;
            if (c0 >= 2848) continue;
            const float sc = (c0 < 512) ? 0.125f * 1.4426950408889634f : ((c0 >= 2048 && c0 < 2304) ? 0.125f : 1.0f);
            const int cl = 8 * fq;
#pragma unroll
            for (int ai = 0; ai < 2; ++ai)
#pragma unroll
                for (int m = 0; m < 4; ++m) {
                    const int row = row0 + ai * 128 + m * 16;
                    const float r = r8[ai][m] * sc;
                    const f32x4 v0 = acc[ai][bj][m][0] * r, v1 = acc[ai][bj][m][1] * r;
                    if (c0 == 2816) { *(gf32x4*)(gates + (size_t)row * 32 + cl) = v0; *(gf32x4*)(gates + (size_t)row * 32 + cl + 4) = v1; }
                    else {
                        u32x4 w; w.x = cvt_pk_bf16(v0[0], v0[1]); w.y = cvt_pk_bf16(v0[2], v0[3]); w.z = cvt_pk_bf16(v1[0], v1[1]); w.w = cvt_pk_bf16(v1[2], v1[3]);
                        if (c0 >= 512 && c0 < 768) {
                            const int cc = c0 - 512 + cl;
                            const int gg = (cc >> 6) & 1, d = cc & 63;
                            bf16_t* dst = (cc < 128 ? kcmp : vcmp) + ((size_t)(((row >> 11) * 2 + gg) * 2048 + (row & 2047))) * 64 + d;
                            *(GAS u32x4*)dst = w;
                        } else {
                            *(GAS u32x4*)(U + (size_t)row * UW + c0 + cl) = w;
                        }
                    }
                }
        }
    }
};
struct EpiCmp {
    float* part;
    __device__ __forceinline__ void operator()(const f32x4 (&acc)[2][2][4][2], const pg8::Unit& u, int wr, int wc, int fr, int fq) const {
        const int row0 = u.pm * 256 + wr * 64 + fr, col0 = wc * 32 + 8 * fq;
#pragma unroll
        for (int ai = 0; ai < 2; ++ai)
#pragma unroll
            for (int m = 0; m < 4; ++m) {
                const int row = row0 + ai * 128 + m * 16;
#pragma unroll
                for (int bj = 0; bj < 2; ++bj)
#pragma unroll
                    for (int n = 0; n < 2; ++n) *(gf32x4*)(part + (size_t)row * 256 + col0 + bj * 128 + n * 4) = acc[ai][bj][m][n];
            }
    }
};

__device__ __forceinline__ int winmap(int n) {
    if (n < 1280) return n;
    if (n < 2560) return n + 24;
    if (n < 2816) return n + 32;
    if (n < 2840) return 1280 + (n - 2816);
    if (n < 2844) return 2584 + (n - 2840);
    if (n < 2848) return 2588 + (n - 2844);
    return -1;
}
struct TrTile { const float* colp; const float* gain; bf16_t* dst; int ld, K, k0, n0; };
__device__ __forceinline__ void tr_decode(const Params& p, int idx, int tid, TrTile& t) {
    constexpr int TPL = 1376;
    const int l = idx / TPL; int r = idx % TPL;
    int m, ntile, ktile, K;
    if (r < 352) { m = 0; ntile = r % 22; ktile = r / 22; K = DM; }
    else if (r < 528) { r -= 352; m = 1; ntile = r % 4; ktile = r / 4; K = DFF; }
    else if (r < 880) { r -= 528; m = 2; ntile = r % 22; ktile = r / 22; K = DM; }
    else if (r < 1056) { r -= 880; m = 3; ntile = r % 4; ktile = r / 4; K = DFF; }
    else if (r < 1248) { r -= 1056; m = 4; ntile = r % 12; ktile = r / 12; K = DM; }
    else if (r < 1312) { r -= 1248; m = 5; ntile = r % 4; ktile = r / 4; K = DM; }
    else if (r < 1344) { r -= 1312; m = 6; ntile = 0; ktile = r; K = 2048; }
    else { r -= 1344; m = 7; ntile = 0; ktile = r; K = 2048; }
    t.K = K; t.k0 = ktile * 64; t.n0 = ntile * 256; t.colp = nullptr; t.gain = nullptr; t.ld = 0;
    const int npp = t.n0 + 4 * ((tid >> 3));
    const int np = (npp & ~31) + 8 * ((npp & 15) >> 2) + 4 * ((npp >> 4) & 1);
    unsigned char* wl = ws_of(p) + WS_W + (size_t)l * LAYER_W;
    if (m == 0 || m == 2) {
        const int pb = np >> 8, w = np & 255;
        const float* src = (w < 128) ? in_of(p, m == 0 ? 2 : 25) : in_of(p, m == 0 ? 3 : 26);
        t.colp = src + (size_t)l * DM * DFF + pb * 128 + (w & 127); t.ld = DFF; t.gain = in_of(p, m == 0 ? 1 : 24) + l * DM;
        t.dst = (bf16_t*)(wl + (m == 0 ? LO_W13A : LO_W13B));
    } else if (m == 1 || m == 3) {
        t.colp = in_of(p, m == 1 ? 4 : 27) + (size_t)l * DFF * DM + np; t.ld = DM;
        t.dst = (bf16_t*)(wl + (m == 1 ? LO_W2A : LO_W2B));
    } else if (m == 4) {
        const int sc = winmap(np);
        if (sc >= 0) t.colp = in_of(p, 6) + (size_t)l * DM * DIN + sc;
        t.ld = DIN; t.gain = in_of(p, 5) + l * DM;
        t.dst = (bf16_t*)(wl + LO_WIN);
    } else if (m == 5) {
        t.colp = in_of(p, 23) + (size_t)l * DM * DM + np; t.ld = DM;
        t.dst = (bf16_t*)(wl + LO_WOUT);
    } else {
        t.colp = in_of(p, m == 6 ? 8 : 11) + (size_t)l * 2048 * 256 + np; t.ld = 256;
        t.dst = (bf16_t*)(wl + (m == 6 ? LO_CW1K : LO_CW1V));
    }
}
__device__ __forceinline__ void tr_load(const TrTile& t, int tid, f32x4 (&v)[8], float (&gv)[8]) {
    const int kc = (tid & 7);
#pragma unroll
    for (int e = 0; e < 8; ++e) {
        const int k = t.k0 + 8 * kc + e;
        v[e] = (f32x4){0.f, 0.f, 0.f, 0.f}; gv[e] = 1.0f;
        if (t.colp) { v[e] = __builtin_nontemporal_load((const f32x4*)(t.colp + (size_t)k * t.ld)); if (t.gain) gv[e] = t.gain[k]; }
    }
}
__device__ void prologue(const Params& p, LAS unsigned char* lds, int bid, int G) {
    const int tid = opaque_tid();
    LAS float* tile = (LAS float*)lds;
    {
        constexpr int N_TR = 4 * 1376;
        int it = bid;
        TrTile t; f32x4 v[8]; float gv[8];
        if (it < N_TR) { tr_decode(p, it, tid, t); tr_load(t, tid, v, gv); }
        while (it < N_TR) {
            bf16_t* dst = t.dst + (size_t)(t.n0 + 4 * ((tid >> 3))) * t.K + t.k0 + 8 * ((tid & 7));
            const int K = t.K;
            u32x4 o[4];
#pragma unroll
            for (int q = 0; q < 4; ++q) { o[q].x = cvt_pk_bf16(v[0][q] * gv[0], v[1][q] * gv[1]); o[q].y = cvt_pk_bf16(v[2][q] * gv[2], v[3][q] * gv[3]); o[q].z = cvt_pk_bf16(v[4][q] * gv[4], v[5][q] * gv[5]); o[q].w = cvt_pk_bf16(v[6][q] * gv[6], v[7][q] * gv[7]); }
            const int nx = it + G;
            if (nx < N_TR) { tr_decode(p, nx, tid, t); tr_load(t, tid, v, gv); }
#pragma unroll
            for (int q = 0; q < 4; ++q) *(u32x4*)(dst + (size_t)q * K) = o[q];
            it = nx;
        }
    }
    constexpr int N_BIAS = 256, N_XROW = T_ / 16, N_LW = 32;
    for (int it = bid; it < N_BIAS + N_XROW + N_LW; it += G) {
        if (it >= N_BIAS + N_XROW) {
            const int q = it - N_BIAS - N_XROW, ln = q >> 1, gate = q & 1;
            const float* W = in_of(p, gate ? 17 : 15) + (size_t)ln * 4096;
            bf16_t* WT = (bf16_t*)(ws_of(p) + WS_LRUWT) + (size_t)q * 4096;
            float wv[8];
#pragma unroll
            for (int rr = 0; rr < 8; ++rr) { const int idx = tid + rr * NTHREADS, d = idx >> 6, c = idx & 63; wv[rr] = W[c * 64 + d]; }
#pragma unroll
            for (int rr = 0; rr < 8; ++rr) WT[tid + rr * NTHREADS] = f2bf(wv[rr]);
        } else if (it < N_BIAS) {
            const int lkv = it >> 5, part = it & 31, l = lkv >> 1, kv = lkv & 1;
            const float* pos = in_of(p, kv ? 10 : 7) + (size_t)l * 2048;
            const float* w1 = in_of(p, kv ? 11 : 8) + (size_t)l * 2048 * 256;
            const int j = tid & 255, half = tid >> 8;
            float sacc = 0.f;
            const int kb = part * 64 + half * 32;
            for (int k = kb; k < kb + 32; k += 8) {
                float a[8];
#pragma unroll
                for (int q = 0; q < 8; ++q) a[q] = w1[(size_t)(k + q) * 256 + j];
#pragma unroll
                for (int q = 0; q < 8; ++q) sacc += pos[k + q] * a[q];
            }
            tile[tid] = sacc;
            __syncthreads();
            if (tid < 256) ((float*)(ws_of(p) + WS_CBP))[(size_t)it * 256 + tid] = tile[tid] + tile[tid + 256];
            __syncthreads();
        } else {
            const int row0 = (it - N_BIAS) * 16 + (tid >> 6) * 2, lane = tid & 63;
            f32x4 xv[2][4];
#pragma unroll
            for (int rq = 0; rq < 2; ++rq)
#pragma unroll
                for (int i = 0; i < 4; ++i) xv[rq][i] = *(const f32x4*)(in_of(p, 0) + (size_t)(row0 + rq) * DM + i * 256 + lane * 4);
#pragma unroll
            for (int rq = 0; rq < 2; ++rq) {
                const int row = row0 + rq;
                bf16_t* hb = (bf16_t*)(ws_of(p) + WS_HB) + (size_t)row * DM;
                float ss = 0.f;
#pragma unroll
                for (int i = 0; i < 4; ++i) {
                    const f32x4 v = xv[rq][i];
                    ss += (v[0] * v[0] + v[1] * v[1]) + (v[2] * v[2] + v[3] * v[3]);
                    u32x2 w; w.x = cvt_pk_bf16(v[0], v[1]); w.y = cvt_pk_bf16(v[2], v[3]);
                    *(u32x2*)(hb + i * 256 + lane * 4) = w;
                }
                ss = wave_sum(ss);
                if (lane < 16) ((float*)(ws_of(p) + WS_SSQ))[(size_t)row * 16 + lane] = (lane == 0) ? ss : 0.f;
            }
        }
    }
}

__device__ void lru_x_item(const Params& p, int l, int b, int n, int ck, LAS unsigned char* lds) {
    const int tid = opaque_tid(), lane = tid & 63, w = __builtin_amdgcn_readfirstlane(tid >> 6), fr = lane & 15, fq = lane >> 4;
    LAS float* xs = (LAS float*)lds;
    LAS float* xc = (LAS float*)(lds + 17152);
    LAS bf16_t* xb = (LAS bf16_t*)(lds + 33536);
    LAS bf16_t* wt = (LAS bf16_t*)(lds + 42752);
    LAS float* pre = (LAS float*)(lds + 61184);
    LAS float* segA = (LAS float*)(lds + 93952);
    LAS float* segH = segA + 512;
    const bf16_t* U = (const bf16_t*)(ws_of(p) + WS_U);
    const int t0 = ck * 64, rowbase = b * SEQ;
    {
        u32x4 xv[2];
#pragma unroll
        for (int rr = 0; rr < 2; ++rr) {
            const int idx = tid + rr * NTHREADS, tt = idx >> 3, ch = idx & 7, t = t0 - 3 + tt;
            xv[rr] = (u32x4){0u, 0u, 0u, 0u};
            if (idx < 67 * 8 && t >= 0) xv[rr] = *(const u32x4*)(U + (size_t)(rowbase + t) * UW + 1280 + n * 64 + ch * 8);
        }
#pragma unroll
        for (int rr = 0; rr < 2; ++rr) {
            const int idx = tid + rr * NTHREADS, tt = idx >> 3, ch = idx & 7;
            if (idx < 67 * 8) {
                f32x4 lo, hi;
                lo[0] = __uint_as_float(xv[rr][0] << 16); lo[1] = __uint_as_float(xv[rr][0] & 0xffff0000u); lo[2] = __uint_as_float(xv[rr][1] << 16); lo[3] = __uint_as_float(xv[rr][1] & 0xffff0000u);
                hi[0] = __uint_as_float(xv[rr][2] << 16); hi[1] = __uint_as_float(xv[rr][2] & 0xffff0000u); hi[2] = __uint_as_float(xv[rr][3] << 16); hi[3] = __uint_as_float(xv[rr][3] & 0xffff0000u);
                *(LAS f32x4*)(xs + tt * 64 + ch * 8) = lo; *(LAS f32x4*)(xs + tt * 64 + ch * 8 + 4) = hi;
            }
        }
    }
    {
        const bf16_t* WT = (const bf16_t*)(ws_of(p) + WS_LRUWT) + (size_t)((l * 4 + n) * 2) * 4096;
#pragma unroll
        for (int rr = 0; rr < 2; ++rr) {
            const int idx = tid + rr * NTHREADS, row = idx >> 3, ch = idx & 7;
            *(LAS u32x4*)(wt + row * 72 + ch * 8) = *(const u32x4*)(WT + row * 64 + ch * 8);
        }
    }
    __syncthreads();
    {
        const float* cw = in_of(p, 13) + (size_t)l * 4 * 256 + n * 64; const float* cb = in_of(p, 14) + l * 256 + n * 64;
        const int c = tid & 63;
        const float w0 = cw[c], w1 = cw[256 + c], w2 = cw[512 + c], w3 = cw[768 + c], bc = cb[c];
#pragma unroll
        for (int k = 0; k < 8; ++k) {
            const int t = (tid >> 6) + 8 * k;
            const float v = bc + xs[t * 64 + c] * w0 + xs[(t + 1) * 64 + c] * w1 + xs[(t + 2) * 64 + c] * w2 + xs[(t + 3) * 64 + c] * w3;
            xc[t * 64 + c] = v; xb[t * 72 + c] = f2bf(v);
        }
    }
    __syncthreads();
    {
        const int tt = w & 3, gate = w >> 2;
        bf16x8 xa[2];
#pragma unroll
        for (int ks = 0; ks < 2; ++ks) xa[ks] = *(const LAS bf16x8*)(xb + (16 * tt + fr) * 72 + 32 * ks + 8 * fq);
        const float* bias = in_of(p, gate ? 18 : 16) + (l * 4 + n) * 64;
#pragma unroll
        for (int dt = 0; dt < 4; ++dt) {
            f32x4 acc = (f32x4){0.f, 0.f, 0.f, 0.f};
#pragma unroll
            for (int ks = 0; ks < 2; ++ks) {
                const bf16x8 wb = *(const LAS bf16x8*)(wt + (gate * 64 + 16 * dt + fr) * 72 + 32 * ks + 8 * fq);
                acc = __builtin_amdgcn_mfma_f32_16x16x32_bf16(xa[ks], wb, acc, 0, 0, 0);
            }
            const float bv = bias[16 * dt + fr];
#pragma unroll
            for (int i = 0; i < 4; ++i) pre[(gate * 64 + 16 * tt + 4 * fq + i) * 64 + 16 * dt + fr] = acc[i] + bv;
        }
    }
    __syncthreads();
    const int d = tid & 63, tq = tid >> 6;
    const float lam = in_of(p, 19)[l * 256 + n * 64 + d];
    const float sp = __logf(1.0f + __expf(-lam));
    float hl[8], cl[8];
    float h = 0.f, ca = 1.f;
#pragma unroll
    for (int i = 0; i < 8; ++i) {
        const float r = __builtin_amdgcn_rcpf(1.0f + __expf(-pre[(tq * 8 + i) * 64 + d])), ii = __builtin_amdgcn_rcpf(1.0f + __expf(-pre[(64 + tq * 8 + i) * 64 + d]));
        const float la = -8.0f * r * sp;
        const float a = __expf(la);
        const float uu = __builtin_amdgcn_sqrtf(fmaxf(1.0f - a * a, 0.f)) * (ii * xc[(tq * 8 + i) * 64 + d]);
        h = a * h + uu; ca *= a; hl[i] = h; cl[i] = ca;
    }
    segA[tq * 64 + d] = ca; segH[tq * 64 + d] = h;
    __syncthreads();
    float cin_h = 0.f, cin_a = 1.f;
    for (int sgi = 0; sgi < tq; ++sgi) { const float sa = segA[sgi * 64 + d]; cin_h = sa * cin_h + segH[sgi * 64 + d]; cin_a *= sa; }
    float* LH = (float*)(ws_of(p) + WS_LRUH); float* LA = (float*)(ws_of(p) + WS_LRUA);
#pragma unroll
    for (int i = 0; i < 8; ++i) {
        const size_t o = (size_t)(rowbase + t0 + tq * 8 + i) * 256 + n * 64 + d;
        LH[o] = hl[i] + cl[i] * cin_h; LA[o] = cl[i] * cin_a;
    }
    __syncthreads();
}

__device__ __forceinline__ float logsigmoidf_(float x) { return fminf(x, 0.f) - __logf(1.0f + __expf(-fabsf(x))); }

__device__ __forceinline__ int vt_off(int d, int key, int pitch) {
    const int kc = key >> 3;
    return d * pitch + ((((kc ^ (d >> 3)) & 7) | (kc & ~7)) << 3) + (key & 7);
}
__device__ void ml_x_item(const Params& p, int l, int bh, int ck, LAS unsigned char* lds) {
    const int tid = opaque_tid(), lane = tid & 63, w = __builtin_amdgcn_readfirstlane(tid >> 6), fr = lane & 15, fq = lane >> 4;
    const int b = bh >> 2, hh = bh & 3;
    LAS bf16_t* KwT = (LAS bf16_t*)lds;
    LAS bf16_t* VT = (LAS bf16_t*)(lds + 9216);
    LAS float* wks = (LAS float*)(lds + 20736);
    const bf16_t* U = (const bf16_t*)(ws_of(p) + WS_U);
    const float* GT = (const float*)(ws_of(p) + WS_GATES);
    const int rowbase = b * SEQ + ck * 64;
    if (tid < 64) {
        const float ig = GT[(size_t)(rowbase + lane) * 32 + 24 + hh] + in_of(p, 20)[l * 4 + hh];
        const float fp = GT[(size_t)(rowbase + lane) * 32 + 28 + hh] + in_of(p, 21)[l * 4 + hh];
        float a = logsigmoidf_(fp);
#pragma unroll
        for (int o = 1; o < 64; o <<= 1) { const float t = __shfl_up(a, o); if (lane >= o) a += t; }
        const float A = __shfl(a, 63);
        const float wend = A - a + ig;
        const float mu = wave_max(wend);
        wks[lane] = __expf(wend - mu);
        if (lane == 0) { ((float*)(ws_of(p) + WS_MLMU))[bh * 32 + ck] = mu; ((float*)(ws_of(p) + WS_MLAT))[bh * 32 + ck] = A; }
    }
    const int srow = tid >> 3, sch = tid & 7;
    const bf16_t* src = U + (size_t)(rowbase + srow) * UW + hh * 64 + sch * 8;
    const u32x4 kk = *(const u32x4*)(src + 2048);
    {
        const u32x4 vv = *(const u32x4*)(src + 2304);
#pragma unroll
        for (int e = 0; e < 4; ++e) {
            VT[vt_off(sch * 8 + 2 * e, srow, 72)] = (bf16_t)(vv[e] & 0xffffu);
            VT[vt_off(sch * 8 + 2 * e + 1, srow, 72)] = (bf16_t)(vv[e] >> 16);
        }
        for (int idx = tid; idx < 16 * 72; idx += NTHREADS) VT[64 * 72 + idx] = (idx < 72) ? (bf16_t)0x3f80 : (bf16_t)0;
    }
    __syncthreads();
    {
        const float wk = wks[srow];
#pragma unroll
        for (int e = 0; e < 4; ++e) {
            KwT[vt_off(sch * 8 + 2 * e, srow, 72)] = f2bf(wk * __uint_as_float(kk[e] << 16));
            KwT[vt_off(sch * 8 + 2 * e + 1, srow, 72)] = f2bf(wk * __uint_as_float(kk[e] & 0xffff0000u));
        }
    }
    __syncthreads();
    {
        const int dt = w & 3, hf = w >> 2;
        bf16x8 ka[2];
#pragma unroll
        for (int ks = 0; ks < 2; ++ks) ka[ks] = *(const LAS bf16x8*)(KwT + vt_off(16 * dt + fr, 32 * ks + 8 * fq, 72));
        float* C = (float*)(ws_of(p) + WS_MLC) + (size_t)(bh * 32 + ck) * 4096;
#pragma unroll
        for (int ee = 0; ee < 2; ++ee) {
            const int et = 2 * hf + ee;
            f32x4 acc = (f32x4){0.f, 0.f, 0.f, 0.f};
#pragma unroll
            for (int ks = 0; ks < 2; ++ks) {
                const bf16x8 vb = *(const LAS bf16x8*)(VT + vt_off(16 * et + fr, 32 * ks + 8 * fq, 72));
                acc = __builtin_amdgcn_mfma_f32_16x16x32_bf16(ka[ks], vb, acc, 0, 0, 0);
            }
#pragma unroll
            for (int i = 0; i < 4; ++i) C[(16 * dt + 4 * fq + i) * 64 + 16 * et + fr] = acc[i];
        }
        if (hf == 0) {
            f32x4 acc = (f32x4){0.f, 0.f, 0.f, 0.f};
#pragma unroll
            for (int ks = 0; ks < 2; ++ks) {
                const bf16x8 vb = *(const LAS bf16x8*)(VT + (64 + fr) * 72 + 32 * ks + 8 * fq);
                acc = __builtin_amdgcn_mfma_f32_16x16x32_bf16(ka[ks], vb, acc, 0, 0, 0);
            }
            if (fr == 0) {
#pragma unroll
                for (int i = 0; i < 4; ++i) ((float*)(ws_of(p) + WS_MLN))[(size_t)(bh * 32 + ck) * 64 + 16 * dt + 4 * fq + i] = acc[i];
            }
        }
    }
    __syncthreads();
}

__device__ void phase_m2(const Params& p, int l, int cls, LAS unsigned char* lds, int bid, int G) {
    const int tid = opaque_tid();
    constexpr int N_KC = 128, N_LC = 4, N_MC = 256, N_MN = 4, TOTAL = N_KC + N_LC + N_MC + N_MN;
    for (int it = bid; it < TOTAL; it += G) {
        if (it < N_KC) {
            if (!(cls & 1)) continue;
            const int kv = it >> 6, r0 = (it & 63) * 32;
            LAS float* hid = (LAS float*)lds;
            LAS float* w2s = hid + 32 * 256;
            const float* part = (const float*)(ws_of(p) + WS_HID) + (size_t)(kv * 2048 + r0) * 256;
            const float* cb = (const float*)(ws_of(p) + WS_CBIAS) + (l * 2 + kv) * 256;
            const float* w2 = in_of(p, kv ? 12 : 9) + (size_t)l * 256 * 64;
            f32x4 pr[4][4];
#pragma unroll
            for (int rr = 0; rr < 4; ++rr) {
                const int idx = tid + rr * NTHREADS, row = idx >> 6, j4 = (idx & 63) * 4;
#pragma unroll
                for (int kp = 0; kp < 4; ++kp) pr[rr][kp] = *(const f32x4*)(part + (size_t)kp * 2 * 2048 * 256 + row * 256 + j4);
            }
#pragma unroll
            for (int rr = 0; rr < 4; ++rr) {
                const int idx = tid + rr * NTHREADS, row = idx >> 6, j4 = (idx & 63) * 4;
                f32x4 hv = *(const f32x4*)(cb + j4);
#pragma unroll
                for (int kp = 0; kp < 4; ++kp) hv = hv + pr[rr][kp];
#pragma unroll
                for (int q = 0; q < 4; ++q) hv[q] = hv[q] * __builtin_amdgcn_rcpf(1.0f + __expf(-hv[q]));
                *(LAS f32x4*)(hid + row * 256 + j4) = hv;
            }
#pragma unroll
            for (int rr = 0; rr < 8; ++rr) { const int idx = tid + rr * NTHREADS; *(LAS f32x4*)(w2s + idx * 4) = *(const f32x4*)(w2 + idx * 4); }
            __syncthreads();
            {
                const int d = tid & 63, rq = tid >> 6;
                float acc[4] = {0.f, 0.f, 0.f, 0.f};
                for (int j = 0; j < 256; j += 4) {
                    float wv[4];
#pragma unroll
                    for (int q = 0; q < 4; ++q) wv[q] = w2s[(j + q) * 64 + d];
#pragma unroll
                    for (int i = 0; i < 4; ++i) {
                        const f32x4 hv = *(const LAS f32x4*)(hid + (rq * 4 + i) * 256 + j);
#pragma unroll
                        for (int q = 0; q < 4; ++q) acc[i] += hv[q] * wv[q];
                    }
                }
                bf16_t* KCo = (bf16_t*)(ws_of(p) + WS_KC);
#pragma unroll
                for (int i = 0; i < 4; ++i) {
                    const int r = r0 + rq * 4 + i;
                    KCo[(size_t)(kv * 2048 + r) * 64 + d] = f2bf(((r & 127) == 127) ? 0.f : acc[i]);
                }
            }
            __syncthreads();
        } else if (it < N_KC + N_LC) {
            if (!(cls & 2)) continue;
            const int idx = (it - N_KC) * NTHREADS + tid;
            const int b = idx >> 8, ch = idx & 255;
            const float* LH = (const float*)(ws_of(p) + WS_LRUH); const float* LA = (const float*)(ws_of(p) + WS_LRUA);
            float* LC = (float*)(ws_of(p) + WS_LRUC);
            float la[32], lh[32];
#pragma unroll
            for (int ck = 0; ck < 32; ++ck) { const size_t o = (size_t)(b * SEQ + ck * 64 + 63) * 256 + ch; la[ck] = LA[o]; lh[ck] = LH[o]; }
            float carry = 0.f;
#pragma unroll
            for (int ck = 0; ck < 32; ++ck) { LC[(b * 32 + ck) * 256 + ch] = carry; carry = la[ck] * carry + lh[ck]; }
        } else {
            if (!(cls & 4)) continue;
            const bool isn = it >= N_KC + N_LC + N_MC;
            const int idx = (it - N_KC - N_LC - (isn ? N_MC : 0)) * NTHREADS + tid;
            const int bh = isn ? (idx >> 6) : (idx >> 12), de = isn ? (idx & 63) : (idx & 4095);
            const int esz = isn ? 64 : 4096;
            float* buf = (float*)(ws_of(p) + (isn ? WS_MLN : WS_MLC)) + (size_t)bh * 32 * esz + de;
            const float* MU = (const float*)(ws_of(p) + WS_MLMU) + bh * 32; const float* AT = (const float*)(ws_of(p) + WS_MLAT) + bh * 32;
            float* MP = (float*)(ws_of(p) + WS_MLMP) + bh * 32;
            float dc[32];
#pragma unroll
            for (int ck = 0; ck < 32; ++ck) dc[ck] = buf[(size_t)ck * esz];
            float C = 0.f, m = 0.f;
#pragma unroll
            for (int ck = 0; ck < 32; ++ck) {
                buf[(size_t)ck * esz] = C;
                if (!isn && de == 0) MP[ck] = m;
                const float at = AT[ck], mu = MU[ck];
                const float mn = fmaxf(at + m, mu);
                C = __expf(at + m - mn) * C + __expf(mu - mn) * dc[ck];
                m = mn;
            }
        }
    }
}

__device__ __forceinline__ float gelu_tanh(float x) { const float u = 0.7978845608028654f * (x + 0.044715f * x * x * x); return x * __builtin_amdgcn_rcpf(1.0f + __expf(-2.0f * u)); }

__device__ void lru_y_item(const Params& p, int l, int item) {
    const int tid = opaque_tid(), lane = tid & 63;
    const float* LH = (const float*)(ws_of(p) + WS_LRUH); const float* LA = (const float*)(ws_of(p) + WS_LRUA); const float* LC = (const float*)(ws_of(p) + WS_LRUC);
    const bf16_t* U = (const bf16_t*)(ws_of(p) + WS_U);
    const float* hn = in_of(p, 22) + l * 1024;
    bf16_t* HD = (bf16_t*)(ws_of(p) + WS_HEADS);
    const int pair0 = item * 128 + (tid >> 6) * 16;
    float lh[16], la[16], lc[16]; bf16_t gg[16];
    float gn[4];
#pragma unroll
    for (int n = 0; n < 4; ++n) gn[n] = hn[(8 + n) * 64 + lane];
#pragma unroll
    for (int q = 0; q < 16; ++q) {
        const int pair = pair0 + q, row = pair >> 2, n = pair & 3, ch = n * 64 + lane;
        lh[q] = LH[(size_t)row * 256 + ch]; la[q] = LA[(size_t)row * 256 + ch];
        lc[q] = LC[((row >> 11) * 32 + ((row & 2047) >> 6)) * 256 + ch];
        gg[q] = U[(size_t)row * UW + 1536 + ch];
    }
#pragma unroll
    for (int q = 0; q < 16; ++q) {
        const int pair = pair0 + q, row = pair >> 2, n = pair & 3;
        const float h = lh[q] + la[q] * lc[q];
        const float y = h * gelu_tanh(bf2f(gg[q]));
        const float ss = wave_sum(y * y);
        HD[(size_t)row * DM + (8 + n) * 64 + lane] = f2bf(y * rsqrtf(ss * (1.0f / 64.0f) + EPS) * gn[q & 3]);
    }
}

__device__ __forceinline__ int vt_lane(int fr, int fq, int pitch) { return fr * pitch + ((((fq >> 1) ^ (fr >> 3)) & 1) << 3) + ((fq & 1) << 2); }
__device__ __forceinline__ constexpr int vt_cst(int dt, int kc2, int pitch) { return dt * 16 * pitch + ((((kc2 ^ (2 * dt)) & 6) | (kc2 & ~7)) << 3); }
__device__ void ml_y_item(const Params& p, int l, int bh, int ck, LAS unsigned char* lds) {
    const int tid = opaque_tid(), lane = tid & 63, w = __builtin_amdgcn_readfirstlane(tid >> 6), fr = lane & 15, fq = lane >> 4;
    const int b = bh >> 2, hh = bh & 3;
    LAS bf16_t* Ql = (LAS bf16_t*)lds;
    LAS bf16_t* Kl = (LAS bf16_t*)(lds + 9216);
    LAS bf16_t* Vt = (LAS bf16_t*)(lds + 18432);
    LAS bf16_t* Ct = (LAS bf16_t*)(lds + 27648);
    LAS bf16_t* Wl = (LAS bf16_t*)(lds + 39168);
    LAS float* as_ = (LAS float*)(lds + 57600);
    LAS float* bs_ = as_ + 64;
    LAS float* Ms_ = bs_ + 64;
    LAS float* ssl = Ms_ + 64;
    const bf16_t* U = (const bf16_t*)(ws_of(p) + WS_U);
    const float* GT = (const float*)(ws_of(p) + WS_GATES);
    const int rowbase = b * SEQ + ck * 64;
    const float mprev = ((const float*)(ws_of(p) + WS_MLMP))[bh * 32 + ck];
    if (tid < 64) {
        const float ig = GT[(size_t)(rowbase + lane) * 32 + 24 + hh] + in_of(p, 20)[l * 4 + hh];
        const float fp = GT[(size_t)(rowbase + lane) * 32 + 28 + hh] + in_of(p, 21)[l * 4 + hh];
        float a = logsigmoidf_(fp);
#pragma unroll
        for (int o = 1; o < 64; o <<= 1) { const float t = __shfl_up(a, o); if (lane >= o) a += t; }
        const float bb = ig - a;
        float pm = bb;
#pragma unroll
        for (int o = 1; o < 64; o <<= 1) { const float t = __shfl_up(pm, o); if (lane >= o) pm = fmaxf(pm, t); }
        as_[lane] = a; bs_[lane] = bb; Ms_[lane] = fmaxf(mprev, pm);
        Ct[64 * 72 + lane] = f2bf(((const float*)(ws_of(p) + WS_MLN))[(size_t)(bh * 32 + ck) * 64 + lane]);
    }
    {
        const int row = tid >> 3, ch = tid & 7;
        const bf16_t* src = U + (size_t)(rowbase + row) * UW + hh * 64 + ch * 8;
        *(LAS u32x4*)(Ql + row * 72 + ch * 8) = *(const u32x4*)(src + 1792);
        *(LAS u32x4*)(Kl + row * 72 + ch * 8) = *(const u32x4*)(src + 2048);
        const u32x4 vv = *(const u32x4*)(src + 2304);
#pragma unroll
        for (int e = 0; e < 4; ++e) {
            Vt[vt_off(ch * 8 + 2 * e, row, 72)] = (bf16_t)(vv[e] & 0xffffu);
            Vt[vt_off(ch * 8 + 2 * e + 1, row, 72)] = (bf16_t)(vv[e] >> 16);
        }
        const float* C = (const float*)(ws_of(p) + WS_MLC) + (size_t)(bh * 32 + ck) * 4096;
#pragma unroll
        for (int rr = 0; rr < 2; ++rr) {
            const int idx = tid + rr * NTHREADS, d = idx >> 4, e4 = (idx & 15) * 4;
            const f32x4 c = *(const f32x4*)(C + d * 64 + e4);
#pragma unroll
            for (int i = 0; i < 4; ++i) Ct[(e4 + i) * 72 + d] = f2bf(c[i]);
        }
        for (int idx = tid; idx < 15 * 72; idx += NTHREADS) Ct[65 * 72 + idx] = 0;
    }
    __syncthreads();
    const int jt = w & 3, hf = w >> 2;
    bf16_t opre[2][4];
#pragma unroll
    for (int i = 0; i < 4; ++i)
#pragma unroll
        for (int ee = 0; ee < 2; ++ee) opre[ee][i] = U[(size_t)(rowbase + 16 * jt + 4 * fq + i) * UW + 2560 + hh * 64 + 16 * (2 * hf + ee) + fr];
    bf16x8 qa[2];
#pragma unroll
    for (int ks = 0; ks < 2; ++ks) qa[ks] = *(const LAS bf16x8*)(Ql + (16 * jt + fr) * 72 + 32 * ks + 8 * fq);
    f32x4 sacc[4];
#pragma unroll
    for (int st = 0; st < 4; ++st) {
        const bf16x8 k0 = *(const LAS bf16x8*)(Kl + (16 * st + fr) * 72 + 8 * fq), k1 = *(const LAS bf16x8*)(Kl + (16 * st + fr) * 72 + 32 + 8 * fq);
        sacc[st] = __builtin_amdgcn_mfma_f32_16x16x32_bf16(qa[0], k0, (f32x4){0.f, 0.f, 0.f, 0.f}, 0, 0, 0);
        sacc[st] = __builtin_amdgcn_mfma_f32_16x16x32_bf16(qa[1], k1, sacc[st], 0, 0, 0);
    }
    float sw[4], Mj[4];
    LAS bf16_t* Ww = Wl + w * (16 * 72);
#pragma unroll
    for (int i = 0; i < 4; ++i) {
        const int j = 16 * jt + 4 * fq + i;
        Mj[i] = Ms_[j];
        float acc = 0.f;
#pragma unroll
        for (int st = 0; st < 4; ++st) {
            const int sidx = 16 * st + fr;
            const float wv = (sidx <= j) ? __expf(bs_[sidx] - Mj[i]) * sacc[st][i] : 0.f;
            acc += wv;
            Ww[(4 * fq + i) * 72 + sidx] = f2bf(wv);
        }
        acc += __shfl_xor(acc, 1); acc += __shfl_xor(acc, 2); acc += __shfl_xor(acc, 4); acc += __shfl_xor(acc, 8);
        sw[i] = acc;
    }
    asm volatile("s_waitcnt lgkmcnt(0)" ::: "memory");
    bf16x8 wa[2];
#pragma unroll
    for (int ks = 0; ks < 2; ++ks) wa[ks] = *(const LAS bf16x8*)(Ww + fr * 72 + 32 * ks + 8 * fq);
    f32x4 acc1[2], acc2[2], accn;
#pragma unroll
    for (int ee = 0; ee < 2; ++ee) {
        const int et = 2 * hf + ee;
        acc1[ee] = (f32x4){0.f, 0.f, 0.f, 0.f}; acc2[ee] = (f32x4){0.f, 0.f, 0.f, 0.f};
#pragma unroll
        for (int ks = 0; ks < 2; ++ks) {
            const bf16x8 cf = *(const LAS bf16x8*)(Ct + (16 * et + fr) * 72 + 32 * ks + 8 * fq);
            const bf16x8 vf = *(const LAS bf16x8*)(Vt + vt_off(16 * et + fr, 32 * ks + 8 * fq, 72));
            acc1[ee] = __builtin_amdgcn_mfma_f32_16x16x32_bf16(qa[ks], cf, acc1[ee], 0, 0, 0);
            acc2[ee] = __builtin_amdgcn_mfma_f32_16x16x32_bf16(wa[ks], vf, acc2[ee], 0, 0, 0);
        }
    }
    accn = (f32x4){0.f, 0.f, 0.f, 0.f};
#pragma unroll
    for (int ks = 0; ks < 2; ++ks) {
        const bf16x8 cf = *(const LAS bf16x8*)(Ct + (64 + fr) * 72 + 32 * ks + 8 * fq);
        accn = __builtin_amdgcn_mfma_f32_16x16x32_bf16(qa[ks], cf, accn, 0, 0, 0);
    }
    float ov[2][4];
#pragma unroll
    for (int i = 0; i < 4; ++i) {
        const int j = 16 * jt + 4 * fq + i;
        const float qn = __shfl(accn[i], lane & 48);
        const float inter = __expf(mprev - Mj[i]);
        const float den = inter * qn + sw[i];
        const float lim = __expf(-(as_[j] + Mj[i]));
        const float inv = __builtin_amdgcn_rcpf(fmaxf(fabsf(den), lim));
        float ssp = 0.f;
#pragma unroll
        for (int ee = 0; ee < 2; ++ee) {
            const int e = 16 * (2 * hf + ee) + fr;
            const float hv = (inter * acc1[ee][i] + acc2[ee][i]) * inv;
            const float o = sigmoidf_(bf2f(opre[ee][i])) * hv;
            ov[ee][i] = o; ssp += o * o;
        }
        ssp += __shfl_xor(ssp, 1); ssp += __shfl_xor(ssp, 2); ssp += __shfl_xor(ssp, 4); ssp += __shfl_xor(ssp, 8);
        if (fr == 0) ssl[w * 16 + 4 * fq + i] = ssp;
    }
    __syncthreads();
    {
        bf16_t* HD = (bf16_t*)(ws_of(p) + WS_HEADS);
        const float* hn = in_of(p, 22) + l * 1024 + (12 + hh) * 64;
#pragma unroll
        for (int i = 0; i < 4; ++i) {
            const int j = 16 * jt + 4 * fq + i;
            const float tot = ssl[jt * 16 + 4 * fq + i] + ssl[(jt + 4) * 16 + 4 * fq + i];
            const float rs = rsqrtf(tot * (1.0f / 64.0f) + EPS);
#pragma unroll
            for (int ee = 0; ee < 2; ++ee) {
                const int e = 16 * (2 * hf + ee) + fr;
                HD[(size_t)(rowbase + j) * DM + (12 + hh) * 64 + e] = f2bf(ov[ee][i] * rs * hn[e]);
            }
        }
    }
    __syncthreads();
}

__device__ __forceinline__ bf16x8 pack8(const f32x4 lo, const f32x4 hi) {
    u32x4 r; r.x = cvt_pk_bf16(lo[0], lo[1]); r.y = cvt_pk_bf16(lo[2], lo[3]); r.z = cvt_pk_bf16(hi[0], hi[1]); r.w = cvt_pk_bf16(hi[2], hi[3]);
    return __builtin_bit_cast(bf16x8, r);
}
__device__ __forceinline__ bf16x8 join8(const u32x2 lo, const u32x2 hi) { u32x4 r; r.x = lo.x; r.y = lo.y; r.z = hi.x; r.w = hi.y; return __builtin_bit_cast(bf16x8, r); }
__device__ void nsa_item(const Params& p, int l, int b, int g, int qb, LAS unsigned char* lds, int mode = 0) {
    int tid = opaque_tid(), w = __builtin_amdgcn_readfirstlane(tid >> 6), lane = tid & 63, fr = lane & 15, fq = lane >> 4;
    LAS bf16_t* Kc = (LAS bf16_t*)lds;
    LAS bf16_t* Vc = (LAS bf16_t*)(lds + 18432);
    LAS bf16_t* Pl = (LAS bf16_t*)(lds + 36864);
    LAS float* impl = (LAS float*)(lds + 106496);
    LAS unsigned* selm = (LAS unsigned*)(lds + 114688);
    LAS int* steps = (LAS int*)(lds + 114944);
    const bf16_t* U = (const bf16_t*)(ws_of(p) + WS_U);
    const int bg = b * 2 + g, rowbase = b * SEQ;
    const int head = 4 * g + (w >> 1);
    const float sl2 = exp2f(-(float)(head + 1)) * 1.4426950408889634f;
    const int tw0 = qb * 64 + (w & 1) * 32;
    bf16x8 qf[2][2];
#pragma unroll
    for (int mt = 0; mt < 2; ++mt)
#pragma unroll
        for (int ks = 0; ks < 2; ++ks)
            qf[mt][ks] = *(const bf16x8*)(U + (size_t)(rowbase + tw0 + mt * 16 + fr) * UW + head * 64 + ks * 32 + fq * 8);
    const float* GT = (const float*)(ws_of(p) + WS_GATES);
    float gpre[2][3];
#pragma unroll
    for (int mt = 0; mt < 2; ++mt)
#pragma unroll
        for (int q = 0; q < 3; ++q) gpre[mt][q] = GT[(size_t)(rowbase + tw0 + mt * 16 + fr) * 32 + head * 3 + q];
    f32x4 y[2][4];
    {
        LAS float* impM = (LAS float*)Pl;
        LAS float* impT = impM + 4 * 64 * 33;
        const bf16_t* KC = (const bf16_t*)(ws_of(p) + WS_KC) + (size_t)bg * 128 * 64;
        const bf16_t* VC = KC + (size_t)2048 * 64;
        u32x4 kvr[2], vvr[2];
#pragma unroll
        for (int rr = 0; rr < 2; ++rr) { const int idx = tid + rr * NTHREADS; kvr[rr] = *(const u32x4*)(KC + idx * 8); vvr[rr] = *(const u32x4*)(VC + idx * 8); }
#pragma unroll
        for (int rr = 0; rr < 2; ++rr) {
            const int idx = tid + rr * NTHREADS, key = idx >> 3, ch = idx & 7;
            const u32x4 kv = kvr[rr];
            const u32x4 vv = vvr[rr];
            *(LAS u32x4*)(Kc + key * 72 + ch * 8) = kv;
#pragma unroll
            for (int e = 0; e < 4; ++e) {
                Vc[vt_off(ch * 8 + 2 * e, key, 136)] = (bf16_t)(vv[e] & 0xffffu);
                Vc[vt_off(ch * 8 + 2 * e + 1, key, 136)] = (bf16_t)(vv[e] >> 16);
            }
        }
        __syncthreads();
        const int vl136 = vt_lane(fr, fq, 136);
#pragma unroll
        for (int mt = 0; mt < 2; ++mt) {
            const int t = tw0 + mt * 16 + fr;
            f32x4 s[8];
#pragma unroll
            for (int nt = 0; nt < 8; ++nt) {
                const bf16x8 k0 = *(const LAS bf16x8*)(Kc + (16 * nt + fr) * 72 + fq * 8), k1 = *(const LAS bf16x8*)(Kc + (16 * nt + fr) * 72 + 32 + fq * 8);
                s[nt] = __builtin_amdgcn_mfma_f32_16x16x32_bf16(k0, qf[mt][0], (f32x4){0.f, 0.f, 0.f, 0.f}, 0, 0, 0);
                s[nt] = __builtin_amdgcn_mfma_f32_16x16x32_bf16(k1, qf[mt][1], s[nt], 0, 0, 0);
            }
            float mx = NEGF;
#pragma unroll
            for (int nt = 0; nt < 8; ++nt)
#pragma unroll
                for (int i = 0; i < 4; ++i) {
                    const int n = 16 * nt + 4 * fq + i, cend = 16 * n + 31;
                    const bool valid = (t >= cend) && (n < 127);
                    const float sv = valid ? fmaf(sl2, (float)cend, s[nt][i]) : NEGF;
                    s[nt][i] = sv; mx = fmaxf(mx, sv);
                }
            mx = fq_max(mx);
            const float ms = (mx < -1e29f) ? 0.f : mx;
            float sum = 0.f;
#pragma unroll
            for (int nt = 0; nt < 8; ++nt)
#pragma unroll
                for (int i = 0; i < 4; ++i) { const float pv = __builtin_amdgcn_exp2f(s[nt][i] - ms); s[nt][i] = pv; sum += pv; }
            sum = fq_sum(sum);
            const float inv = sum > 0.f ? __builtin_amdgcn_rcpf(sum) : 0.f;
            {
                LAS float* mrow_ = impM + ((w >> 1) * 64 + (w & 1) * 32 + mt * 16 + fr) * 33 + fq;
                LAS float* trow_ = impT + ((w >> 1) * 64 + (w & 1) * 32 + mt * 16 + fr) * 33 + fq + 1;
#pragma unroll
                for (int nt = 0; nt < 8; ++nt) {
                    s[nt] = s[nt] * inv;
                    mrow_[4 * nt] = (s[nt][0] + s[nt][1]) + (s[nt][2] + s[nt][3]);
                    trow_[4 * nt] = s[nt][3];
                }
            }
            f32x4 oc[4];
#pragma unroll
            for (int dt = 0; dt < 4; ++dt) oc[dt] = (f32x4){0.f, 0.f, 0.f, 0.f};
#pragma unroll
            for (int ks2 = 0; ks2 < 4; ++ks2) {
                const bf16x8 pb = pack8(s[2 * ks2], s[2 * ks2 + 1]);
#pragma unroll
                for (int dt = 0; dt < 4; ++dt) {
                    const u32x2 lo = *(const LAS u32x2*)(Vc + vl136 + vt_cst(dt, 4 * ks2, 136));
                    const u32x2 hi = *(const LAS u32x2*)(Vc + vl136 + vt_cst(dt, 4 * ks2 + 2, 136));
                    oc[dt] = __builtin_amdgcn_mfma_f32_16x16x32_bf16(join8(lo, hi), pb, oc[dt], 0, 0, 0);
                }
            }
            const float g0 = sigmoidf_(gpre[mt][0]);
#pragma unroll
            for (int dt = 0; dt < 4; ++dt) y[mt][dt] = oc[dt] * g0;
        }
        if (tid < 256) impT[tid * 33] = 0.f;
        __syncthreads();
#pragma unroll 1
        for (int rr = 0; rr < 4; ++rr) {
            const int idx = tid + rr * NTHREADS, tau = idx >> 5, j = idx & 31;
            float mine = 0.f;
#pragma unroll
            for (int hh = 0; hh < 4; ++hh) mine += impM[(hh * 64 + tau) * 33 + j] + impT[(hh * 64 + tau) * 33 + j];
            bool sel;
            if (qb < 16) sel = (j <= qb);
            else {
                const bool forced = (j == 0) || (j == qb) || (j == qb - 1);
                const bool cand = (j >= 1) && (j <= qb - 2);
                int rank = 0;
#pragma unroll
                for (int jp = 1; jp < 30; ++jp) {
                    const float o = __shfl(mine, (lane & 32) + jp);
                    rank += (jp <= qb - 2 && (o > mine || (o == mine && jp < j))) ? 1 : 0;
                }
                sel = forced || (cand && rank < 13);
            }
            const unsigned long long bal = __ballot(sel);
            if ((lane & 31) == 0) selm[tau] = (lane < 32) ? (unsigned)bal : (unsigned)(bal >> 32);
        }
        __syncthreads();
        if (tid < 64) {
            unsigned m = selm[tid], uni = m, all = m;
#pragma unroll
            for (int o = 32; o >= 1; o >>= 1) { uni |= __shfl_xor(uni, o); all &= __shfl_xor(all, o); }
            uni &= (qb >= 31) ? 0xffffffffu : ((2u << qb) - 1u);
            const int nsel = __popc(uni);
            const int kb = tid;
            if (kb <= qb && ((uni >> kb) & 1u)) {
                const int pos = nsel - 1 - __popc(uni & ((1u << kb) - 1u));
                steps[1 + pos] = ((((all >> kb) & 1u) && kb < qb) ? 4096 : 0) | (1 << 8) | kb;
            }
            const int kb0 = (qb - 8 < 0) ? 0 : qb - 8;
            if (kb >= kb0 && kb <= qb) steps[1 + nsel + (qb - kb)] = ((kb > qb - 8 && kb < qb) ? 4096 : 0) | (2 << 8) | kb;
            if (tid == 0) steps[0] = nsel + (qb - kb0 + 1);
        }
        __syncthreads();
    }
    if (mode == 1) { asm volatile("" :: "v"(y[0][0][0]), "v"(y[1][3][3])); __syncthreads(); return; }
    tid = opaque_tid(); w = __builtin_amdgcn_readfirstlane(tid >> 6); lane = tid & 63; fr = lane & 15; fq = lane >> 4;
    unsigned smask[2];
#pragma unroll
    for (int mt = 0; mt < 2; ++mt) smask[mt] = selm[(w & 1) * 32 + mt * 16 + fr];
    const int nsteps = __builtin_amdgcn_readfirstlane(steps[0]);
    const int mystep = steps[1 + (lane < 48 ? lane : 47)];
#define NSA_ST(k) __builtin_amdgcn_readlane(mystep, (k))
    float mrow[2], lrow[2];
    f32x4 oacc[2][4];
#pragma unroll
    for (int mt = 0; mt < 2; ++mt) {
        mrow[mt] = NEGF; lrow[mt] = 0.f;
#pragma unroll
        for (int dt = 0; dt < 4; ++dt) oacc[mt][dt] = (f32x4){0.f, 0.f, 0.f, 0.f};
    }
    const int skey = tid >> 3, sch = tid & 7;
    const int vl72 = vt_lane(fr, fq, 72);
    const int vsw = vt_off(sch * 8, skey, 72);
    bf16x8 kx[4], qx;
    {
        const float sh = bf2f(f2bf(sl2)), slo = sl2 - sh;
        u32x4 t = (u32x4){0u, 0u, 0u, 0u};
        if (fq == 0) t.x = cvt_pk_bf16(sh, slo);
        qx = __builtin_bit_cast(bf16x8, t);
#pragma unroll
        for (int nt = 0; nt < 4; ++nt) {
            u32x4 k = (u32x4){0u, 0u, 0u, 0u};
            const float r = (float)(16 * nt + fr);
            if (fq == 0) k.x = cvt_pk_bf16(r, r);
            kx[nt] = __builtin_bit_cast(bf16x8, k);
        }
    }
    const bf16_t* Ubase = U + (size_t)(rowbase + skey) * UW + g * 64 + sch * 8;
#define NSA_SRC(st_) (Ubase + (size_t)((st_) & 255) * 64 * UW + ((((st_) >> 8) & 15) == 1 ? 768 : 1024))
#define NSA_STAGE(buf_, kr_, vr_) do { \
        *(LAS u32x4*)(Kc + (buf_) * (64 * 72) + skey * 72 + sch * 8) = kr_; \
        LAS bf16_t* _vn = Vc + (buf_) * (64 * 72) + vsw; \
        _Pragma("unroll") for (int e = 0; e < 4; ++e) { _vn[(2 * e) * 72] = (bf16_t)(vr_[e] & 0xffffu); _vn[(2 * e + 1) * 72] = (bf16_t)(vr_[e] >> 16); } } while (0)
    u32x4 kregA, vregA;
    {
        const bf16_t* src = NSA_SRC(NSA_ST(0));
        kregA = *(const u32x4*)src; vregA = *(const u32x4*)(src + 128);
        NSA_STAGE(0, kregA, vregA);
    }
    if (nsteps > 1) { const bf16_t* src = NSA_SRC(NSA_ST(1)); kregA = *(const u32x4*)src; vregA = *(const u32x4*)(src + 128); }
    __syncthreads();
    int curkind = 1;
#define NSA_STEP(si, kX, vX) do { \
        const int st = NSA_ST(si), kind = (st >> 8) & 15, kb = st & 255; \
        const bool nomask = (st & 4096) != 0; \
        LAS bf16_t* Kl = Kc + ((si) & 1) * (64 * 72); \
        LAS bf16_t* Vt = Vc + ((si) & 1) * (64 * 72); \
        if (kind != curkind) { \
            _Pragma("unroll") for (int mt = 0; mt < 2; ++mt) { \
                float lt = lrow[mt]; \
                lt = fq_sum(lt); \
                const float sc = sigmoidf_(gpre[mt][1]) * __builtin_amdgcn_rcpf(lt); \
                _Pragma("unroll") for (int dt = 0; dt < 4; ++dt) { y[mt][dt] += oacc[mt][dt] * sc; oacc[mt][dt] = (f32x4){0.f, 0.f, 0.f, 0.f}; } \
                mrow[mt] = NEGF; lrow[mt] = 0.f; \
            } \
            curkind = kind; \
        } \
        const float Bs = sl2 * (float)(kb * 64); \
        int kbi = kb * 64 + 4 * fq; \
        asm volatile("" : "+v"(kbi)); \
        f32x4 s[2][4]; \
        _Pragma("unroll") for (int nt = 0; nt < 4; ++nt) { \
            const bf16x8 k0 = *(const LAS bf16x8*)(Kl + (16 * nt + fr) * 72 + fq * 8), k1 = *(const LAS bf16x8*)(Kl + (16 * nt + fr) * 72 + 32 + fq * 8); \
            _Pragma("unroll") for (int mt = 0; mt < 2; ++mt) { \
                s[mt][nt] = __builtin_amdgcn_mfma_f32_16x16x32_bf16(k0, qf[mt][0], (f32x4){0.f, 0.f, 0.f, 0.f}, 0, 0, 0); \
                s[mt][nt] = __builtin_amdgcn_mfma_f32_16x16x32_bf16(k1, qf[mt][1], s[mt][nt], 0, 0, 0); \
                s[mt][nt] = __builtin_amdgcn_mfma_f32_16x16x32_bf16(kx[nt], qx, s[mt][nt], 0, 0, 0); \
            } \
        } \
        bf16x8 pb[2][2]; \
        _Pragma("unroll") for (int mt = 0; mt < 2; ++mt) { \
            float mx = NEGF; \
            if (nomask) { \
                _Pragma("unroll") for (int nt = 0; nt < 4; ++nt) \
                    _Pragma("unroll") for (int i = 0; i < 4; ++i) mx = fmaxf(mx, s[mt][nt][i]); \
            } else { \
                const int t = tw0 + mt * 16 + fr; \
                const bool rowok = (kind == 1) ? (((smask[mt] >> kb) & 1u) != 0u) : true; \
                _Pragma("unroll") for (int nt = 0; nt < 4; ++nt) \
                    _Pragma("unroll") for (int i = 0; i < 4; ++i) { \
                        const int dist = t - (kbi + 16 * nt + i); \
                        const bool valid = rowok && dist >= 0 && (kind == 1 || dist < 512); \
                        const float sv = valid ? s[mt][nt][i] : NEGF; \
                        s[mt][nt][i] = sv; mx = fmaxf(mx, sv); \
                    } \
            } \
            mx = fq_max(mx) + Bs; \
            const bool grow = __builtin_amdgcn_ballot_w64(mx > mrow[mt] + 8.0f) != 0ull;     \
            if (grow) { \
                const float mn_ = fmaxf(mrow[mt], mx); \
                const float alpha = __builtin_amdgcn_exp2f(mrow[mt] - mn_); \
                mrow[mt] = mn_; lrow[mt] *= alpha; \
                _Pragma("unroll") for (int dt = 0; dt < 4; ++dt) oacc[mt][dt] = oacc[mt][dt] * alpha; \
            } \
            const float mn = mrow[mt]; \
            const float ms = ((mn < -1e29f) ? 0.f : mn) - Bs; \
            float ls = 0.f; \
            _Pragma("unroll") for (int nt = 0; nt < 4; ++nt) \
                _Pragma("unroll") for (int i = 0; i < 4; ++i) { const float pv = __builtin_amdgcn_exp2f(s[mt][nt][i] - ms); s[mt][nt][i] = pv; ls += pv; } \
            lrow[mt] += ls; \
            pb[mt][0] = pack8(s[mt][0], s[mt][1]); pb[mt][1] = pack8(s[mt][2], s[mt][3]); \
        } \
        _Pragma("unroll") for (int ks2 = 0; ks2 < 2; ++ks2) \
            _Pragma("unroll") for (int dt = 0; dt < 4; ++dt) { \
                const u32x2 lo = *(const LAS u32x2*)(Vt + vl72 + vt_cst(dt, 4 * ks2, 72)); \
                const u32x2 hi = *(const LAS u32x2*)(Vt + vl72 + vt_cst(dt, 4 * ks2 + 2, 72)); \
                const bf16x8 va = join8(lo, hi); \
                _Pragma("unroll") for (int mt = 0; mt < 2; ++mt) oacc[mt][dt] = __builtin_amdgcn_mfma_f32_16x16x32_bf16(va, pb[mt][ks2], oacc[mt][dt], 0, 0, 0); \
            } \
        if ((si) + 1 < nsteps) NSA_STAGE(((si) + 1) & 1, kX, vX); \
        if ((si) + 2 < nsteps) { const bf16_t* src = NSA_SRC(NSA_ST((si) + 2)); kX = *(const u32x4*)src; vX = *(const u32x4*)(src + 128); } \
        __syncthreads(); \
    } while (0)
    for (int si = 0; si < nsteps; ++si) {
        NSA_STEP(si, kregA, vregA);
    }
#undef NSA_STEP
#undef NSA_ST
#undef NSA_STAGE
#undef NSA_SRC
    tid = opaque_tid(); lane = tid & 63; fr = lane & 15; fq = lane >> 4;
    {
        const float* hn = in_of(p, 22) + l * 1024 + head * 64;
        bf16_t* HD = (bf16_t*)(ws_of(p) + WS_HEADS);
        f32x4 gnv[4];
#pragma unroll
        for (int dt = 0; dt < 4; ++dt) gnv[dt] = *(const f32x4*)(hn + 16 * dt + 4 * fq);
#pragma unroll
        for (int mt = 0; mt < 2; ++mt) {
            const int t = tw0 + mt * 16 + fr;
            float lt = lrow[mt];
            lt = fq_sum(lt);
            const float sc = sigmoidf_(gpre[mt][2]) * __builtin_amdgcn_rcpf(lt);
            float ss = 0.f;
            f32x4 yy[4];
#pragma unroll
            for (int dt = 0; dt < 4; ++dt) { yy[dt] = y[mt][dt] + oacc[mt][dt] * sc; ss += (yy[dt][0] * yy[dt][0] + yy[dt][1] * yy[dt][1]) + (yy[dt][2] * yy[dt][2] + yy[dt][3] * yy[dt][3]); }
            ss = fq_sum(ss);
            const float rs = rsqrtf(ss * (1.0f / 64.0f) + EPS);
#pragma unroll
            for (int dt = 0; dt < 4; ++dt) {
                const f32x4 gn = gnv[dt];
                const f32x4 o = yy[dt] * rs * gn;
                u32x2 pk; pk.x = cvt_pk_bf16(o[0], o[1]); pk.y = cvt_pk_bf16(o[2], o[3]);
                *(u32x2*)(HD + (size_t)(rowbase + t) * DM + head * 64 + 16 * dt + 4 * fq) = pk;
            }
        }
    }
    __syncthreads();
}

#define XB_TMO      128
#define XB_XCNT(j)  (256  + 64 * (j))
#define XB_XSUB(j)  (1280 + 64 * (j))
#define XB_XGEN(j)  (2304 + 64 * (j))
#define XB_TOP      3328
#define XB_TOPGEN   3392
#define XCD_BAR_WORDS 3456
#define XB_SPIN_CAP (1u << 22)
__device__ __forceinline__ unsigned xb_ld(unsigned* p)              { return __hip_atomic_load(p, __ATOMIC_RELAXED, __HIP_MEMORY_SCOPE_AGENT); }
__device__ __forceinline__ unsigned xb_add(unsigned* p, unsigned v) { return __hip_atomic_fetch_add(p, v, __ATOMIC_RELAXED, __HIP_MEMORY_SCOPE_AGENT); }
__device__ __forceinline__ unsigned xb_xcc_id() { return (unsigned)__builtin_amdgcn_s_getreg((3 << 11) | 20) & 0xFu; }
#define XB_SPIN(cond, bar) do { unsigned _sp = 0; while (cond) { __builtin_amdgcn_s_sleep(1); \
    if ((++_sp & 255u) == 0u) { if (xb_ld(&(bar)[XB_TMO])) break; if (_sp > XB_SPIN_CAP) { atomicAdd(&(bar)[XB_TMO], 1u); break; } } } } while (0)
struct XcdBarrier { unsigned* bar; unsigned x; volatile LAS unsigned* st; };
__device__ __forceinline__ XcdBarrier xcd_barrier_post(unsigned* bar, volatile LAS unsigned* st) {
    XcdBarrier b; b.bar = bar; b.x = xb_xcc_id(); b.st = st;
    if (threadIdx.x == 0) (void)xb_add(&bar[XB_XCNT(b.x)], 1u);
    return b;
}
__device__ __forceinline__ void xcd_barrier_complete(unsigned* bar, unsigned x, unsigned& nloc, unsigned& nx) {
    const unsigned G = gridDim.x * gridDim.y * gridDim.z;
    unsigned sum, cnt, mine, sp = 0u;
    for (;;) {
        sum = 0u; cnt = 0u; mine = 0u;
#pragma unroll
        for (unsigned j = 0; j < 16; ++j) { const unsigned c = xb_ld(&bar[XB_XCNT(j)]); sum += c; cnt += (c > 0u) ? 1u : 0u; mine = (j == x) ? c : mine; }
        if (sum == G) break;
        __builtin_amdgcn_s_sleep(1);
        if ((++sp & 255u) == 0u) { if (xb_ld(&bar[XB_TMO])) break; if (sp > XB_SPIN_CAP) { atomicAdd(&bar[XB_TMO], 1u); break; } }
    }
    nloc = mine > 0u ? mine : 1u; nx = cnt > 0u ? cnt : 1u;
}
__device__ __forceinline__ void xcd_barrier(const XcdBarrier& b) {
    asm volatile("s_waitcnt vmcnt(0)" ::: "memory");
    __syncthreads();
    if (threadIdx.x == 0) {
        unsigned* bar = b.bar;
        __builtin_amdgcn_s_waitcnt(0);
        unsigned nloc = b.st[0], nx = b.st[1];
        if (nloc == 0u) { xcd_barrier_complete(bar, b.x, nloc, nx); b.st[0] = nloc; b.st[1] = nx; }
        const unsigned old = xb_add(&bar[XB_XSUB(b.x)], 1u);
        const unsigned gen = old / nloc;
        if (old + 1u == (gen + 1u) * nloc) {
            __builtin_amdgcn_fence(__ATOMIC_RELEASE, "agent");
            asm volatile("s_waitcnt vmcnt(0)" ::: "memory");
            const unsigned og = xb_add(&bar[XB_TOP], 1u);
            const unsigned tg = og / nx;
            if (og + 1u == (tg + 1u) * nx) xb_add(&bar[XB_TOPGEN], 1u);
            else XB_SPIN(xb_ld(&bar[XB_TOPGEN]) == tg, bar);
            __builtin_amdgcn_fence(__ATOMIC_ACQUIRE, "agent");
            xb_add(&bar[XB_XGEN(b.x)], 1u);
            asm volatile("s_waitcnt vmcnt(0)" ::: "memory");
        } else {
            XB_SPIN(xb_ld(&bar[XB_XGEN(b.x)]) == gen, bar);
            __builtin_amdgcn_fence(__ATOMIC_ACQUIRE, "agent");
            asm volatile("s_waitcnt vmcnt(0)" ::: "memory");
        }
    }
    __syncthreads();
}

__global__ void __launch_bounds__(NTHREADS) hymba_fwd(Params p) {
    extern __shared__ __attribute__((aligned(16))) unsigned char lds_raw[];
    LAS unsigned char* lds = (LAS unsigned char*)lds_raw;
    cg::grid_group grid = cg::this_grid();
    volatile LAS unsigned* xbw = (volatile LAS unsigned*)(lds + LDS_BYTES - 16);
    if (threadIdx.x < 4) xbw[threadIdx.x] = 0u;
    __syncthreads();
    XcdBarrier xbar = xcd_barrier_post((unsigned*)(ws_of(p) + WS_BAR), xbw);
    if (p.ph_hi - p.ph_lo > 1) grid.sync();
    for (int ph = p.ph_lo; ph < p.ph_hi; ++ph) {
        int G = gridDim.x, bid = blockIdx.x;
        asm volatile("" : "+s"(G), "+s"(bid));
        const int tpx = opaque_tid();
        if (ph == 0) {
            if (PHEN(0)) prologue(p, lds, bid, G);
            if (REP_SUB == 100) { __syncthreads(); prologue(p, lds, bid, G); }
        } else if (ph == 37) { if (PHEN(10)) {
            const float* ssq = (const float*)(ws_of(p) + WS_SSQ) + (size_t)(12 & 1) * T_ * 16;
            float* outp = out_of(p);
            const f32x4 gn = *(const f32x4*)(in_of(p, 28) + (tpx & 255) * 4);
            for (int it = bid; it < T_ / 8; it += G) {
                f32x4 v[4], pa[4][4];
#pragma unroll
                for (int q = 0; q < 4; ++q) {
                    const int row = it * 8 + q * 2 + (tpx >> 8);
                    v[q] = *(const f32x4*)(outp + (size_t)row * DM + (tpx & 255) * 4);
#pragma unroll
                    for (int k = 0; k < 4; ++k) pa[q][k] = *(const f32x4*)(ssq + (size_t)row * 16 + 4 * k);
                }
#pragma unroll
                for (int q = 0; q < 4; ++q) {
                    const int row = it * 8 + q * 2 + (tpx >> 8);
                    const float sm = (((pa[q][0][0] + pa[q][0][1]) + (pa[q][0][2] + pa[q][0][3])) + ((pa[q][1][0] + pa[q][1][1]) + (pa[q][1][2] + pa[q][1][3]))) + (((pa[q][2][0] + pa[q][2][1]) + (pa[q][2][2] + pa[q][2][3])) + ((pa[q][3][0] + pa[q][3][1]) + (pa[q][3][2] + pa[q][3][3])));
                    const float r = rsqrtf(sm * (1.0f / DM) + EPS);
                    *(f32x4*)(outp + (size_t)row * DM + (tpx & 255) * 4) = v[q] * r * gn;
                }
            } }
        } else {
            const int l = (ph - 1) / 9, sub = (ph - 1) % 9;
            unsigned char* wl = ws_of(p) + WS_W + (size_t)l * LAYER_W;
            float* ssq = (float*)(ws_of(p) + WS_SSQ);
            bf16_t* HB = (bf16_t*)(ws_of(p) + WS_HB);
            bf16_t* UB = (bf16_t*)(ws_of(p) + WS_U);
            if (PHEN(1) && (sub == 0 || sub == 7)) {
                const bool second = sub == 7;
                pg8::Gemm g{HB, (const bf16_t*)(wl + (second ? LO_W13B : LO_W13A)), T_, NUP, DM, DM, DM};
                pg8::StaticOrder S; S.init(T_, NUP, G, bid);
                EpiSwiGLU E{UB, ssq + (size_t)((3 * l + (second ? 2 : 0)) & 1) * T_ * 16};
                pg8::gemm_phase(lds, g, S, E);
                if (REP_SUB == 0) { __syncthreads(); pg8::gemm_phase(lds, g, S, E); }
            } else if (PHEN(2) && (sub == 1 || sub == 8 || sub == 6)) {
                const bool wout = sub == 6, second = sub == 8;
                pg8::Gemm g;
                if (wout) g = pg8::Gemm{(const bf16_t*)(ws_of(p) + WS_HEADS), (const bf16_t*)(wl + LO_WOUT), T_, DM, DM, DM, DM};
                else g = pg8::Gemm{UB, (const bf16_t*)(wl + (second ? LO_W2B : LO_W2A)), T_, DM, DFF, DFF, DFF};
                pg8::StaticOrder S; S.init(T_, DM, G, bid);
                const float* resid = (l == 0 && sub == 1) ? in_of(p, 0) : out_of(p);
                const int nxt = 3 * l + (sub == 1 ? 1 : (sub == 6 ? 2 : 3));
                EpiResid E{resid, out_of(p), HB, ssq + (size_t)(nxt & 1) * T_ * 16, wout ? 1.0f : 0.5f};
                pg8::gemm_phase(lds, g, S, E);
                if (REP_SUB == 1) { __syncthreads(); EpiResid E2{out_of(p), out_of(p), HB, ssq + (size_t)(nxt & 1) * T_ * 16, 0.0f}; pg8::gemm_phase(lds, g, S, E2); }
            } else if (PHEN(3) && sub == 2) {
                if (bid < 2 && tpx < 256) {
                    const float* cbp = (const float*)(ws_of(p) + WS_CBP) + (size_t)((l * 2 + bid) * 32) * 256 + tpx;
                    float sb = 0.f;
#pragma unroll
                    for (int q = 0; q < 32; ++q) sb += cbp[q * 256];
                    ((float*)(ws_of(p) + WS_CBIAS))[(l * 2 + bid) * 256 + tpx] = sb;
                }
                pg8::Gemm g{HB, (const bf16_t*)(wl + LO_WIN), T_, NINP, DM, DM, DM};
                pg8::StaticOrder S; S.init(T_, NINP, G, bid);
                EpiWin E{UB, (bf16_t*)(ws_of(p) + WS_KCMP), (bf16_t*)(ws_of(p) + WS_VCMP), (float*)(ws_of(p) + WS_GATES), ssq + (size_t)((3 * l + 1) & 1) * T_ * 16};
                pg8::gemm_phase(lds, g, S, E);
                if (REP_SUB == 2) { __syncthreads(); pg8::gemm_phase(lds, g, S, E); }
            } else if (sub == 3) {
                const int ngemm = 64;
                for (int rep = 0; rep < (REP_SUB == 3 ? 2 : 1); ++rep) {
                const int cls = rep == 0 ? 7 : REP_CLASS;
                if (rep) __syncthreads();
                if (G > ngemm) {
                    if (bid < ngemm) { if (PHEN(4) && (cls & 1)) {
                        const int kp = bid >> 4, kv = (bid >> 3) & 1;
                        pg8::Gemm g{(const bf16_t*)(ws_of(p) + (kv ? WS_VCMP : WS_KCMP)) + kp * 512, (const bf16_t*)(wl + (kv ? LO_CW1V : LO_CW1K)) + kp * 512, 2048, 256, 512, 1024, 2048};
                        pg8::SingleUnit S{bid & 7};
                        EpiCmp E{(float*)(ws_of(p) + WS_HID) + (size_t)(kp * 2 + kv) * 2048 * 256};
                        pg8::gemm_phase(lds, g, S, E); }
                    }
                    if (PHEN(5)) {
                        const bool gb = bid < ngemm;
                        const int i0 = gb ? 1728 + bid : bid - ngemm, i1 = gb ? 2048 : 1728, st = gb ? ngemm : G - ngemm;
                        for (int it = i0; it < i1; it += st) {
                            if (it < 1024) { if (cls & 2) lru_x_item(p, l, it >> 7, (it >> 5) & 3, it & 31, lds); }
                            else if (cls & 4) ml_x_item(p, l, (it - 1024) >> 5, it & 31, lds);
                        }
                    }
                }
                }
            } else if (PHEN(6) && sub == 4) {
                phase_m2(p, l, 7, lds, bid, G);
                if (REP_SUB == 4) { __syncthreads(); phase_m2(p, l, REP_CLASS, lds, bid, G); }
            } else if (sub == 5) {
                for (int rep = 0; rep < (REP_SUB == 5 ? 2 : 1); ++rep) {
                const int cls = rep == 0 ? 7 : REP_CLASS;
                if (rep) __syncthreads();
                for (int it = bid; it < 512 + 1024 + 512; it += G) {
                    if (it < 512) { if (PHEN(7) && (cls & 1)) {
                        const int qb = it < 256 ? 31 - (it >> 4) : ((it - 256) >> 4), bg = it & 15;
                        nsa_item(p, l, bg >> 1, bg & 1, qb, lds, (rep == 1 && REP_CLASS == 9) ? 1 : 0); }
                    } else if (it < 1536) {
                        if (PHEN(8) && (cls & 2)) ml_y_item(p, l, (it - 512) >> 5, (it - 512) & 31, lds);
                    } else {
                        if (PHEN(9) && (cls & 4)) lru_y_item(p, l, it - 1536);
                    }
                }
                }
            }
        }
        if (ph + 1 < p.ph_hi) {
            xcd_barrier(xbar);
            if (REP_SUB == 200) xcd_barrier(xbar);
        }
    }
}

extern "C" void kernel_launch(void* const* d_in, const int* in_sizes, int n_in, void* d_out, int out_size, void* d_ws, size_t ws_size, hipStream_t stream) {
    static int grid = 0;
    if (grid == 0) {
        if (n_in != 29 || out_size != T_ * DM || ws_size < WS_END) { fprintf(stderr, "kernel_launch: unexpected shapes (n_in %d out %d ws %zu need %zu)\n", n_in, out_size, ws_size, (size_t)WS_END); grid = -1; return; }
        int dev = 0, cus = 0, per_cu = 0;
        hipGetDevice(&dev);
        hipDeviceGetAttribute(&cus, hipDeviceAttributeMultiprocessorCount, dev);
        hipFuncSetAttribute((const void*)hymba_fwd, hipFuncAttributeMaxDynamicSharedMemorySize, LDS_BYTES);
        hipOccupancyMaxActiveBlocksPerMultiprocessor(&per_cu, (const void*)hymba_fwd, NTHREADS, LDS_BYTES);
        if (per_cu < 1) { fprintf(stderr, "kernel_launch: occupancy query says %d blocks per CU\n", per_cu); per_cu = 1; }
        (void)hipGetLastError();
        grid = cus;
    }
    if (grid < 0) return;
    Params p{};
    for (int i = 0; i < 29; ++i) p.in[i] = (const float*)d_in[i];
    p.out = (float*)d_out; p.ws = (unsigned char*)d_ws;
#if ONE_LAUNCH
    (void)hipMemsetAsync((unsigned char*)d_ws + WS_BAR, 0, 16384, stream);
    p.ph_lo = 0; p.ph_hi = 38;
    void* args[] = {&p};
    hipError_t e = hipLaunchCooperativeKernel((const void*)hymba_fwd, dim3(grid), dim3(NTHREADS), args, LDS_BYTES, stream);
    if (e != hipSuccess) fprintf(stderr, "cooperative launch failed: %s (grid %d)\n", hipGetErrorString(e), grid);
#else
    for (int ph = 0; ph < 38; ++ph) {
        p.ph_lo = ph; p.ph_hi = ph + 1;
        hipLaunchKernelGGL(hymba_fwd, dim3(grid), dim3(NTHREADS), LDS_BYTES, stream, p);
    }
#endif
}
```
